# Optimizing an MI355X kernel written in HIP

```python
import jax, jax.numpy as jnp
from jax import lax
import numpy as np

D_MODEL = 1024
BATCH = 16
SEQ = 256
DEPTH = 2
DEC_BATCH = 4
DEC_SEQ = 1024
PAST_LEN = 512

GRID_W = 64
N_BRANCH = 4
BR_W = D_MODEL // 4
CHUNK = 128
A_GROUPS = 4
A_GD = BR_W // A_GROUPS
RW_HD = 64
RW_HEADS = BR_W // RW_HD
DECAY_RANK = 64
ICL_RANK = 64
ATT_HD = 64
ATT_HEADS = BR_W // ATT_HD
ATT_KV_HEADS = 2
ATT_GROUP = ATT_HEADS // ATT_KV_HEADS
WINDOW = 128
ROPE_BASE = 10000.0
POOL_SIZES = (2, 4, 8, 16)
POOL_GD = BR_W // len(POOL_SIZES)
NORM_EPS = 1e-6
GN_EPS = 64e-5
NEG_INF = -1e30
IN_SIZES = (BR_W, BR_W, BR_W, BR_W, BR_W, DECAY_RANK, ICL_RANK, ATT_HEADS * ATT_HD, ATT_KV_HEADS * ATT_HD, ATT_KV_HEADS * ATT_HD, BR_W, N_BRANCH * BR_W, N_BRANCH * D_MODEL)
IN_W = sum(IN_SIZES)

kernel_name = 'hybrid_flow_gated_branches_step'


def rmsnorm(x, g):
    xf = x.astype(jnp.float32)
    y = xf * lax.rsqrt(jnp.mean(xf * xf, axis=-1, keepdims=True) + NORM_EPS)
    return (y * g.astype(jnp.float32)).astype(x.dtype)


def split_in(p):
    cuts = [int(i) for i in np.cumsum(IN_SIZES)[:-1]]
    return jnp.split(p, cuts, axis=-1)


def chunk_mix(u, v, w_s, b_s):
    B, L, _ = u.shape
    nc = L // CHUNK
    vc = v.reshape(B, nc, CHUNK, A_GROUPS, A_GD)
    sv = jnp.einsum('gij,bcjgd->bcigd', w_s, vc) + b_s.T[None, None, :, :, None]
    return u * sv.reshape(B, L, BR_W)


def wkv_scan(s0, r, w, k, v, kk, a, reverse):
    xs = tuple(t.transpose(1, 0, 2, 3) for t in (r, w, k, v, kk, a))

    def step(S, inp):
        r_t, w_t, k_t, v_t, kk_t, a_t = inp
        sa = jnp.einsum('bhvk,bhk->bhv', S, kk_t)
        S = S * w_t[:, :, None, :] - sa[..., None] * (kk_t * a_t)[:, :, None, :] + v_t[..., None] * k_t[:, :, None, :]
        return S, jnp.einsum('bhvk,bhk->bhv', S, r_t)

    s_fin, o = lax.scan(step, s0.astype(jnp.float32), xs, reverse=reverse)
    return s_fin, o.transpose(1, 0, 2, 3)


def rwkv7_mix(r, k, v, wd, ad, s_init, lp):
    B, L, _ = r.shape
    heads = lambda t: t.astype(jnp.float32).reshape(B, L, RW_HEADS, RW_HD)
    r_h, k_h, v_h = heads(r), heads(k), heads(v)
    kk = heads(k * lp['rw_k_k'])
    kk = kk * lax.rsqrt(jnp.sum(kk * kk, axis=-1, keepdims=True) + 1e-12)
    k_a = lp['rw_k_a'].astype(jnp.float32).reshape(RW_HEADS, RW_HD)
    r_k = lp['rw_r_k'].astype(jnp.float32)
    wd_t = jnp.tanh(wd.astype(jnp.float32))
    adf = ad.astype(jnp.float32)
    o_sum = jnp.zeros_like(v_h)
    bonus = jnp.zeros_like(v_h)
    finals = []
    for d, rev in ((0, False), (1, True)):
        w_log = -jax.nn.softplus(-(lp['rw_w0'][d] + wd_t @ lp['rw_w_up'][d])) - 0.5
        decay = heads(jnp.exp(-jnp.exp(w_log)))
        a = heads(jax.nn.sigmoid(lp['rw_a0'][d] + adf @ lp['rw_a_up'][d]))
        k_d = k_h * (1.0 + (a - 1.0) * k_a)
        s_fin, o = wkv_scan(s_init[:, d], r_h, decay, k_d, v_h, kk, a, rev)
        o_sum = o_sum + o
        bonus = bonus + jnp.sum(r_h * k_d * r_k, axis=-1, keepdims=True) * v_h
        finals.append(s_fin)
    mu = jnp.mean(o_sum, axis=-1, keepdims=True)
    var = jnp.mean(jnp.square(o_sum - mu), axis=-1, keepdims=True)
    on = ((o_sum - mu) * lax.rsqrt(var + GN_EPS)).reshape(B, L, BR_W)
    y = on * lp['rw_ln_g'].astype(jnp.float32) + lp['rw_ln_b'].astype(jnp.float32) + bonus.reshape(B, L, BR_W)
    return y.astype(r.dtype), jnp.stack(finals, axis=1)


def sink_probs(s, sink):
    sk = sink.astype(jnp.float32).reshape(ATT_KV_HEADS, ATT_GROUP, 1)
    m = jnp.maximum(jnp.max(s, axis=-1), sk)
    p = jnp.exp(s - m[..., None])
    den = jnp.sum(p, axis=-1) + jnp.exp(sk - m)
    return p / den[..., None]


def rope_1d(x, pos):
    d = x.shape[-1]
    inv = ROPE_BASE ** (-jnp.arange(0, d, 2, dtype=jnp.float32) / d)
    ang = pos[:, None] * inv[None, :]
    cos, sin = jnp.cos(ang)[None, :, None, :], jnp.sin(ang)[None, :, None, :]
    x1, x2 = x[..., : d // 2], x[..., d // 2:]
    return jnp.concatenate([x1 * cos - x2 * sin, x2 * cos + x1 * sin], axis=-1)


def axial_rope(x):
    L = x.shape[1]
    rows = L // GRID_W
    row = jnp.repeat(jnp.arange(rows, dtype=jnp.float32), GRID_W)
    col = jnp.tile(jnp.arange(GRID_W, dtype=jnp.float32), rows)
    xf = x.astype(jnp.float32)
    half = x.shape[-1] // 2
    return jnp.concatenate([rope_1d(xf[..., :half], row), rope_1d(xf[..., half:], col)], axis=-1)


def ctx_attention(q, k, v, sink):
    B, L, _ = q.shape
    nb = L // CHUNK
    scale = ATT_HD ** -0.5
    qb = q.astype(jnp.float32).reshape(B, nb, CHUNK, ATT_KV_HEADS, ATT_GROUP, ATT_HD).transpose(1, 0, 2, 3, 4, 5)
    kf = k.astype(jnp.float32).reshape(B, L, ATT_KV_HEADS, ATT_HD)
    vf = v.astype(jnp.float32).reshape(B, L, ATT_KV_HEADS, ATT_HD)

    def blk(qi):
        s = jnp.einsum('bqhgd,bkhd->bhgqk', qi, kf) * scale
        return jnp.einsum('bhgqk,bkhd->bqhgd', sink_probs(s, sink), vf)

    o = lax.map(blk, qb)
    return o.transpose(1, 0, 2, 3, 4, 5).reshape(B, L, ATT_HEADS * ATT_HD).astype(q.dtype)


def latent_attention(q, k, v, ck, cv, sink):
    B, L, _ = q.shape
    nb = L // CHUNK
    scale = ATT_HD ** -0.5
    qh = axial_rope(q.reshape(B, L, ATT_HEADS, ATT_HD)).reshape(B, nb, CHUNK, ATT_KV_HEADS, ATT_GROUP, ATT_HD)
    kh = axial_rope(k.reshape(B, L, ATT_KV_HEADS, ATT_HD))
    vh = v.astype(jnp.float32).reshape(B, L, ATT_KV_HEADS, ATT_HD)

    def bands(t):
        tp = jnp.pad(t, ((0, 0), (CHUNK, CHUNK), (0, 0), (0, 0))).reshape(B, nb + 2, CHUNK, ATT_KV_HEADS, ATT_HD)
        return jnp.concatenate([tp[:, :-2], tp[:, 1:-1], tp[:, 2:]], axis=2)

    kb, vb = bands(kh), bands(vh)
    blk = jnp.arange(nb)[:, None] * CHUNK
    qpos = blk + jnp.arange(CHUNK)[None, :]
    kpos = blk - CHUNK + jnp.arange(3 * CHUNK)[None, :]
    valid = (jnp.abs(qpos[:, :, None] - kpos[:, None, :]) <= WINDOW) & (kpos[:, None, :] >= 0) & (kpos[:, None, :] < L)
    ckf, cvf = ck.astype(jnp.float32), cv.astype(jnp.float32)
    s_loc = jnp.einsum('bnqhgd,bnkhd->bnhgqk', qh, kb) * scale
    s_loc = jnp.where(valid[None, :, None, None], s_loc, NEG_INF)
    s_ctx = jnp.einsum('bnqhgd,bkhd->bnhgqk', qh, ckf) * scale
    p = sink_probs(jnp.concatenate([s_loc, s_ctx], axis=-1), sink)
    nl = 3 * CHUNK
    o = jnp.einsum('bnhgqk,bnkhd->bnqhgd', p[..., :nl], vb) + jnp.einsum('bnhgqk,bkhd->bnqhgd', p[..., nl:], cvf)
    return o.reshape(B, L, ATT_HEADS * ATT_HD).astype(q.dtype)


def pool_mix(p, pool_w, pool_scale):
    B, L, _ = p.shape
    pg = p.astype(jnp.float32).reshape(B, L, len(POOL_SIZES), POOL_GD)
    t = jnp.arange(L)
    outs = []
    for g, w in enumerate(POOL_SIZES):
        xg = pg[:, :, g]
        cs = jnp.concatenate([jnp.zeros((B, 1, POOL_GD), jnp.float32), jnp.cumsum(xg, axis=1)], axis=1)
        lo = jnp.clip(t - w // 2, 0, L)
        hi = jnp.clip(t - w // 2 + w, 0, L)
        mean = (cs[:, hi] - cs[:, lo]) / (hi - lo).astype(jnp.float32)[None, :, None]
        outs.append(mean - xg)
    d = jnp.stack(outs, axis=2)
    y = jnp.einsum('blgc,gcd->blgd', d, pool_w.astype(jnp.float32)).reshape(B, L, BR_W) * pool_scale.astype(jnp.float32)
    return y.astype(p.dtype)


def trunk_layer(x, cond, lp, ctx=None):
    B, L, _ = x.shape
    mod = jax.nn.silu(cond) @ lp['w_mod'] + lp['b_mod']
    shift, scale, gate = jnp.split(mod[:, None, :], 3, axis=-1)
    h = rmsnorm(x, lp['g_norm']) * (1 + scale) + shift
    (a_u, a_v, b_r, b_k, b_v, b_wd, b_ad, c_q, c_k, c_v, d_p, z, mg) = split_in(h @ lp['w_in'])
    y_a = chunk_mix(a_u, a_v, lp['w_s'], lp['b_s'])
    if ctx is None:
        s0 = jnp.zeros((B, 2, RW_HEADS, RW_HD, RW_HD), jnp.float32)
        y_c = ctx_attention(c_q, c_k, c_v, lp['att_sink'])
    else:
        ck, cv, s0 = ctx
        y_c = latent_attention(c_q, c_k, c_v, ck, cv, lp['att_sink'])
    y_b, s_fin = rwkv7_mix(b_r, b_k, b_v, b_wd, b_ad, s0, lp)
    y_d = pool_mix(d_p, lp['pool_w'], lp['pool_scale'])
    ys = jnp.stack([y_a, y_b, y_c, y_d], axis=2) * jax.nn.silu(z).reshape(B, L, N_BRANCH, BR_W)
    up = jnp.einsum('blnc,ncd->blnd', ys, lp['w_up'])
    merged = jnp.sum(jax.nn.sigmoid(mg.reshape(B, L, N_BRANCH, D_MODEL)) * up, axis=2)
    x = x + gate * (merged @ lp['w_o'])
    ctx_k = c_k.reshape(B, L, ATT_KV_HEADS, ATT_HD)
    ctx_v = c_v.reshape(B, L, ATT_KV_HEADS, ATT_HD)
    return x, ctx_k, ctx_v, s_fin.astype(x.dtype)


def setup_inputs(seed: int = 0) -> dict:
    key = jax.random.key(seed)
    ks = jax.random.split(key, 32)

    def nrm(k, shape, scale):
        return scale * jax.random.normal(k, shape, jnp.float32)

    D = D_MODEL
    NL = DEPTH
    return {
        'x_prompt': nrm(ks[0], (BATCH, SEQ, D), 1.0),
        'x_sample': nrm(ks[1], (DEC_BATCH, DEC_SEQ, D), 1.0),
        'cache_k': nrm(ks[2], (DEC_BATCH, NL, PAST_LEN, ATT_KV_HEADS, ATT_HD), 1.0),
        'cache_v': nrm(ks[3], (DEC_BATCH, NL, PAST_LEN, ATT_KV_HEADS, ATT_HD), 1.0),
        'state_rwkv': nrm(ks[4], (DEC_BATCH, NL, 2, RW_HEADS, RW_HD, RW_HD), 0.3),
        'c': nrm(ks[5], (DEC_BATCH, D), 1.0),
        'c_ctx': nrm(ks[6], (D,), 1.0),
        'w_mod': nrm(ks[7], (NL, D, 3 * D), 0.5 * D ** -0.5),
        'b_mod': nrm(ks[8], (NL, 3 * D), 0.01),
        'g_norm': 1.0 + nrm(ks[9], (NL, D), 0.05),
        'w_in': nrm(ks[10], (NL, D, IN_W), D ** -0.5),
        'w_s': nrm(ks[11], (NL, A_GROUPS, CHUNK, CHUNK), 0.5 * CHUNK ** -0.5),
        'b_s': 1.0 + nrm(ks[12], (NL, A_GROUPS, CHUNK), 0.02),
        'rw_w0': nrm(ks[13], (NL, 2, BR_W), 1.0),
        'rw_w_up': nrm(ks[14], (NL, 2, DECAY_RANK, BR_W), 0.5 * DECAY_RANK ** -0.5),
        'rw_a0': nrm(ks[15], (NL, 2, BR_W), 0.5),
        'rw_a_up': nrm(ks[16], (NL, 2, ICL_RANK, BR_W), 0.5 * ICL_RANK ** -0.5),
        'rw_k_k': 0.85 + nrm(ks[17], (NL, BR_W), 0.05),
        'rw_k_a': 1.0 + nrm(ks[18], (NL, BR_W), 0.05),
        'rw_r_k': nrm(ks[19], (NL, RW_HEADS, RW_HD), 0.1),
        'rw_ln_g': 1.0 + nrm(ks[20], (NL, BR_W), 0.05),
        'rw_ln_b': nrm(ks[21], (NL, BR_W), 0.01),
        'att_sink': nrm(ks[22], (NL, ATT_HEADS), 0.5),
        'pool_w': nrm(ks[23], (NL, len(POOL_SIZES), POOL_GD, POOL_GD), POOL_GD ** -0.5),
        'pool_scale': 1.0 + nrm(ks[24], (NL, BR_W), 0.05),
        'w_up': nrm(ks[25], (NL, N_BRANCH, BR_W, D), BR_W ** -0.5),
        'w_o': nrm(ks[26], (NL, D, D), D ** -0.5),
        'g_final': 1.0 + nrm(ks[27], (D,), 0.05),
    }


def reference(x_prompt, x_sample, cache_k, cache_v, state_rwkv, c, c_ctx, w_mod, b_mod, g_norm, w_in, w_s, b_s, rw_w0, rw_w_up, rw_a0, rw_a_up, rw_k_k, rw_k_a, rw_r_k, rw_ln_g, rw_ln_b, att_sink, pool_w, pool_scale, w_up, w_o, g_final):
    xp, xs = x_prompt, x_sample
    cond_ctx = jnp.broadcast_to(c_ctx[None, :], (xp.shape[0], D_MODEL))
    ks, vs, ss = [], [], []
    for l in range(DEPTH):
        lp = {
            'w_mod': w_mod[l], 'b_mod': b_mod[l], 'g_norm': g_norm[l], 'w_in': w_in[l],
            'w_s': w_s[l], 'b_s': b_s[l],
            'rw_w0': rw_w0[l], 'rw_w_up': rw_w_up[l], 'rw_a0': rw_a0[l], 'rw_a_up': rw_a_up[l],
            'rw_k_k': rw_k_k[l], 'rw_k_a': rw_k_a[l], 'rw_r_k': rw_r_k[l], 'rw_ln_g': rw_ln_g[l], 'rw_ln_b': rw_ln_b[l],
            'att_sink': att_sink[l], 'pool_w': pool_w[l], 'pool_scale': pool_scale[l],
            'w_up': w_up[l], 'w_o': w_o[l],
        }
        xp, k_l, v_l, s_l = trunk_layer(xp, cond_ctx, lp)
        ks.append(k_l)
        vs.append(v_l)
        ss.append(s_l)
        xs, _, _, _ = trunk_layer(xs, c, lp, (cache_k[:, l], cache_v[:, l], state_rwkv[:, l]))
    y_prompt = rmsnorm(xp, g_final)
    y_sample = rmsnorm(xs, g_final)
    new_k = jnp.stack(ks, axis=1)
    new_v = jnp.stack(vs, axis=1)
    new_state = jnp.stack(ss, axis=1)
    return (y_prompt, y_sample, new_k, new_v, new_state)
```

```cpp
#include <hip/hip_runtime.h>
#include <hip/hip_cooperative_groups.h>
#include <cstdio>
namespace cg = cooperative_groups;

typedef unsigned short bf16_t;
typedef short bf16x8 __attribute__((ext_vector_type(8)));
typedef short bf16x4 __attribute__((ext_vector_type(4)));
typedef float f32x4 __attribute__((ext_vector_type(4)));
typedef float f32x2 __attribute__((ext_vector_type(2)));
typedef unsigned u32x4 __attribute__((ext_vector_type(4)));
typedef unsigned u32x2 __attribute__((ext_vector_type(2)));

constexpr int NT = 8192, NTP = 4096, DM = 1024, INW = 7296, NA_COLS = 3200, PW = 2176;
constexpr int NTHREADS = 512;
constexpr int C_AU = 0, C_AV = 256, C_BR = 512, C_BK = 768, C_BV = 1024, C_WD = 1280, C_AD = 1344, C_CQ = 1408, C_CK = 1664, C_CV = 1792, C_DP = 1920;
constexpr size_t O_YP = 0, O_YS = 4194304, O_NK = 8388608, O_NV = 9437184, O_NS = 10485760;
constexpr size_t WS_WTIN = 0;
constexpr size_t WS_WTUP = WS_WTIN + (size_t)2 * INW * DM * 2;
constexpr size_t WS_WTO  = WS_WTUP + (size_t)2 * 4 * 1024 * 256 * 2;
constexpr size_t WS_MOD  = WS_WTO + (size_t)2 * 1024 * 1024 * 2;
constexpr size_t WS_ROPE = WS_MOD + (size_t)2 * 5 * 3072 * 4;
constexpr size_t WS_CTR  = WS_ROPE + 64 * 16 * 8;
constexpr size_t WS_H    = WS_CTR + 256;
constexpr size_t WS_P    = WS_H + (size_t)NT * DM * 2;
constexpr size_t WS_Z    = WS_P + (size_t)NT * PW * 4;
constexpr size_t WS_RECS = WS_Z + (size_t)NT * DM * 2;
constexpr size_t WS_RECD = WS_RECS + (size_t)NT * 4 * 192 * 4;
constexpr size_t WS_O    = WS_RECD + (size_t)2 * NT * 4 * 192 * 4;
constexpr size_t WS_BC   = WS_O + (size_t)2 * NT * 256 * 4;
constexpr size_t WS_YS   = WS_BC + (size_t)NT * 4 * 4;
constexpr size_t WS_END  = WS_YS + (size_t)NT * DM * 2;
constexpr size_t WS_MERGED = WS_P;
constexpr size_t RECD_STRIDE = (size_t)NT * 4 * 192;

constexpr int LDS_BYTES = 110592;

struct Params {
    const float* in[28];
    float* out;
    unsigned char* ws;
};

__device__ __forceinline__ int TID() { int t = threadIdx.x; asm volatile("" : "+v"(t)); return t; }
__device__ __forceinline__ unsigned cvt_pk_bf16(float lo, float hi) { unsigned r; asm volatile("v_cvt_pk_bf16_f32 %0, %1, %2" : "=v"(r) : "v"(lo), "v"(hi)); return r; }
__device__ __forceinline__ bf16_t f2bf(float f) { return (bf16_t)(cvt_pk_bf16(f, 0.f) & 0xffffu); }
__device__ __forceinline__ float bf2f(bf16_t b) { return __uint_as_float(((unsigned)b) << 16); }
__device__ __forceinline__ float wave_sum(float v) {
#pragma unroll
    for (int o = 32; o >= 1; o >>= 1) v += __shfl_xor(v, o);
    return v;
}
__device__ __forceinline__ float sigmoidf_(float x) { return 1.0f / (1.0f + __expf(-x)); }
__device__ __forceinline__ float siluf_(float x) { return x / (1.0f + __expf(-x)); }
template <int CTRL> __device__ __forceinline__ float dpp_f(float x) { return __int_as_float(__builtin_amdgcn_update_dpp(0, __float_as_int(x), CTRL, 0xF, 0xF, false)); }
__device__ __forceinline__ float row16_sum(float x) {
    x += dpp_f<0x128>(x); x += dpp_f<0x124>(x); x += dpp_f<0x122>(x); x += dpp_f<0x121>(x); return x;
}
__device__ __forceinline__ void seq_of(int tok, int& seqbase, int& L, int& pos) {
    if (tok < NTP) { seqbase = tok & ~255; L = 256; pos = tok & 255; }
    else { int t2 = tok - NTP; seqbase = NTP + (t2 & ~1023); L = 1024; pos = t2 & 1023; }
}
__device__ __forceinline__ int modrow_of(int tok) { return tok < NTP ? 0 : 1 + ((tok - NTP) >> 10); }

__device__ void conv_tile(const float* __restrict__ src, int N, bf16_t* __restrict__ dst, int K, int kt, int nt, float* tile) {
    const int tid = TID();
    { const int r = tid >> 4, c4 = (tid & 15) * 4;
#pragma unroll
      for (int i = 0; i < 2; ++i) { const int k = r + 32 * i; const f32x4 v = *(const f32x4*)(src + (size_t)(kt * 64 + k) * N + nt * 64 + c4);
          tile[k * 65 + c4 + 0] = v[0]; tile[k * 65 + c4 + 1] = v[1]; tile[k * 65 + c4 + 2] = v[2]; tile[k * 65 + c4 + 3] = v[3]; } }
    __syncthreads();
    { const int n = tid >> 3, kc = (tid & 7) * 8; u32x4 w;
      w[0] = cvt_pk_bf16(tile[(kc + 0) * 65 + n], tile[(kc + 1) * 65 + n]); w[1] = cvt_pk_bf16(tile[(kc + 2) * 65 + n], tile[(kc + 3) * 65 + n]);
      w[2] = cvt_pk_bf16(tile[(kc + 4) * 65 + n], tile[(kc + 5) * 65 + n]); w[3] = cvt_pk_bf16(tile[(kc + 6) * 65 + n], tile[(kc + 7) * 65 + n]);
      *(u32x4*)(dst + (size_t)(nt * 64 + n) * K + kt * 64 + kc) = w; }
    __syncthreads();
}

__device__ void mod_item(const Params& p, int l, int cc, float* lds) {
    const int tid = TID();
    float* sc = lds;
    float* red = lds + 5120;
    for (int i = tid; i < 5120; i += NTHREADS) { const int r = i >> 10, k = i & 1023; const float v = (r == 0) ? p.in[6][k] : p.in[5][(r - 1) * 1024 + k]; sc[i] = siluf_(v); }
    __syncthreads();
    const int kg = tid >> 5, c = tid & 31, col = cc * 32 + c;
    float a[5] = {0.f, 0.f, 0.f, 0.f, 0.f};
    const float* w = p.in[7] + (size_t)l * 1024 * 3072 + col;
    for (int k = kg * 64; k < kg * 64 + 64; ++k) { const float wv = w[(size_t)k * 3072];
#pragma unroll
        for (int r = 0; r < 5; ++r) a[r] += sc[r * 1024 + k] * wv; }
#pragma unroll
    for (int r = 0; r < 5; ++r) red[(kg * 5 + r) * 32 + c] = a[r];
    __syncthreads();
    if (tid < 160) { const int r = tid >> 5, c2 = tid & 31; float s = p.in[8][l * 3072 + cc * 32 + c2];
        for (int g = 0; g < 16; ++g) s += red[(g * 5 + r) * 32 + c2];
        ((float*)(p.ws + WS_MOD))[(l * 5 + r) * 3072 + cc * 32 + c2] = s; }
    __syncthreads();
}

__device__ void phase0(const Params& p, unsigned char* lds) {
    const int NCONV_IN = 2 * 16 * 114, NCONV_UP = 8 * 64, NCONV_O = 2 * 256, NMOD = 192;
    const int total = NCONV_IN + NCONV_UP + NCONV_O + NMOD + 1;
    for (int it = blockIdx.x; it < total; it += gridDim.x) {
        int i = it;
        if (i < NCONV_IN) { const int l = i / 1824, r = i % 1824, nt = r / 16, kt = r % 16;
            conv_tile(p.in[10] + (size_t)l * 1024 * INW, INW, (bf16_t*)(p.ws + WS_WTIN) + (size_t)l * INW * 1024, 1024, kt, nt, (float*)lds); continue; }
        i -= NCONV_IN;
        if (i < NCONV_UP) { const int mtx = i / 64, r = i % 64, nt = r / 4, kt = r % 4;
            conv_tile(p.in[25] + (size_t)mtx * 256 * 1024, 1024, (bf16_t*)(p.ws + WS_WTUP) + (size_t)mtx * 1024 * 256, 256, kt, nt, (float*)lds); continue; }
        i -= NCONV_UP;
        if (i < NCONV_O) { const int l = i / 256, r = i % 256, nt = r / 16, kt = r % 16;
            conv_tile(p.in[26] + (size_t)l * 1024 * 1024, 1024, (bf16_t*)(p.ws + WS_WTO) + (size_t)l * 1024 * 1024, 1024, kt, nt, (float*)lds); continue; }
        i -= NCONV_O;
        if (i < NMOD) { mod_item(p, i / 96, i % 96, (float*)lds); continue; }
        for (int e = TID(); e < 1024; e += NTHREADS) { const int pos = e >> 4, f = e & 15;
            const float inv = exp2f(-(float)f * (13.287712379549449f / 16.0f)); const float ang = (float)pos * inv;
            float sn, cs; sn = sinf(ang); cs = cosf(ang);
            ((f32x2*)(p.ws + WS_ROPE))[e] = (f32x2){cs, sn}; }
        if (TID() < 64) ((unsigned*)(p.ws + WS_CTR))[TID()] = 0u;
    }
}

__device__ __forceinline__ const float* xrow_ptr(const Params& p, int l, int row) {
    if (l == 0) return row < NTP ? p.in[0] + (size_t)row * DM : p.in[1] + (size_t)(row - NTP) * DM;
    return p.out + (size_t)row * DM;
}
__device__ void phaseA0(const Params& p, int l) {
    const int lane = TID() & 63, gw = blockIdx.x * 8 + (TID() >> 6), W = gridDim.x * 8;
    const float* g = p.in[9] + l * DM;
    bf16_t* H = (bf16_t*)(p.ws + WS_H);
    for (int row = gw; row < NT; row += W) {
        const float* x = xrow_ptr(p, l, row);
        f32x4 v[4]; float ss = 0.f;
#pragma unroll
        for (int i = 0; i < 4; ++i) { v[i] = *(const f32x4*)(x + i * 256 + lane * 4); ss += v[i][0] * v[i][0] + v[i][1] * v[i][1] + v[i][2] * v[i][2] + v[i][3] * v[i][3]; }
        ss = wave_sum(ss);
        const float rs = rsqrtf(ss * (1.0f / 1024.0f) + 1e-6f);
        const float* mod = (const float*)(p.ws + WS_MOD) + (size_t)(l * 5 + modrow_of(row)) * 3072;
#pragma unroll
        for (int i = 0; i < 4; ++i) { const int c = i * 256 + lane * 4;
            const f32x4 gg = *(const f32x4*)(g + c), sh = *(const f32x4*)(mod + c), scl = *(const f32x4*)(mod + 1024 + c);
            f32x4 h = v[i] * rs * gg * (1.0f + scl) + sh;
            u32x2 w; w[0] = cvt_pk_bf16(h[0], h[1]); w[1] = cvt_pk_bf16(h[2], h[3]);
            *(u32x2*)(H + (size_t)row * DM + c) = w; }
    }
}

template <int MT>
__device__ __forceinline__ void gemm_acc(const bf16_t* __restrict__ A, int lda, const bf16_t* __restrict__ B, int ldb, int K, f32x4 (&acc)[MT][4], unsigned char* lds) {
    constexpr int BM = MT * 64, LDT = 72, A_BYTES = BM * LDT * 2, B_BYTES = 128 * LDT * 2, BUF = A_BYTES + B_BYTES;
    const int tid = TID(), lane = tid & 63, wid = tid >> 6, wr = wid >> 1, wc = wid & 1, fr = lane & 15, fq = lane >> 4;
    u32x4 ra[MT], rb[2];
    const int srow = tid >> 3, skc = tid & 7;
    const bf16_t* Ag = A + (size_t)srow * lda + skc * 8;
    const bf16_t* Bg = B + (size_t)srow * ldb + skc * 8;
    const int soff = (srow * LDT + skc * 8) * 2;
    const int nt = K >> 6;
    __syncthreads();
#pragma unroll
    for (int i = 0; i < MT; ++i) ra[i] = *(const u32x4*)(Ag + (size_t)i * 64 * lda);
#pragma unroll
    for (int i = 0; i < 2; ++i) rb[i] = *(const u32x4*)(Bg + (size_t)i * 64 * ldb);
#pragma unroll
    for (int i = 0; i < MT; ++i) *(u32x4*)(lds + soff + i * 64 * LDT * 2) = ra[i];
#pragma unroll
    for (int i = 0; i < 2; ++i) *(u32x4*)(lds + A_BYTES + soff + i * 64 * LDT * 2) = rb[i];
    __syncthreads();
    const int aoff = ((wr * MT * 16 + fr) * LDT + fq * 8) * 2, boff = A_BYTES + ((wc * 64 + fr) * LDT + fq * 8) * 2;
    for (int t = 0; t < nt; ++t) {
        if (t + 1 < nt) {
#pragma unroll
            for (int i = 0; i < MT; ++i) ra[i] = *(const u32x4*)(Ag + (size_t)i * 64 * lda + (t + 1) * 64);
#pragma unroll
            for (int i = 0; i < 2; ++i) rb[i] = *(const u32x4*)(Bg + (size_t)i * 64 * ldb + (t + 1) * 64);
        }
        const unsigned char* base = lds + (t & 1) * BUF;
#pragma unroll
        for (int kk = 0; kk < 2; ++kk) {
            bf16x8 af[MT], bfr[4];
#pragma unroll
            for (int m = 0; m < MT; ++m) af[m] = *(const bf16x8*)(base + aoff + m * 16 * LDT * 2 + kk * 64);
#pragma unroll
            for (int n = 0; n < 4; ++n) bfr[n] = *(const bf16x8*)(base + boff + n * 16 * LDT * 2 + kk * 64);
#pragma unroll
            for (int m = 0; m < MT; ++m)
#pragma unroll
                for (int n = 0; n < 4; ++n) acc[m][n] = __builtin_amdgcn_mfma_f32_16x16x32_bf16(bfr[n], af[m], acc[m][n], 0, 0, 0);
        }
        if (t + 1 < nt) {
            unsigned char* nb = lds + ((t + 1) & 1) * BUF;
#pragma unroll
            for (int i = 0; i < MT; ++i) *(u32x4*)(nb + soff + i * 64 * LDT * 2) = ra[i];
#pragma unroll
            for (int i = 0; i < 2; ++i) *(u32x4*)(nb + A_BYTES + soff + i * 64 * LDT * 2) = rb[i];
        }
        __syncthreads();
    }
}
template <int MT> __device__ __forceinline__ void zero_acc(f32x4 (&acc)[MT][4]) {
#pragma unroll
    for (int m = 0; m < MT; ++m)
#pragma unroll
        for (int n = 0; n < 4; ++n) acc[m][n] = (f32x4){0.f, 0.f, 0.f, 0.f};
}

__device__ void phaseA(const Params& p, int l, unsigned char* lds) {
    const int tid = TID(), lane = tid & 63, wid = tid >> 6, wr = wid >> 1, wc = wid & 1, fr = lane & 15, fq = lane >> 4;
    const bf16_t* H = (const bf16_t*)(p.ws + WS_H);
    const bf16_t* Wt = (const bf16_t*)(p.ws + WS_WTIN) + (size_t)l * INW * 1024;
    float* P = (float*)(p.ws + WS_P);
    bf16_t* Z = (bf16_t*)(p.ws + WS_Z);
    const int NU = 32 * 25;
    for (int u = blockIdx.x; u < NU; u += gridDim.x) {
        const int pn = u / 32, pm = u % 32;
        f32x4 acc[4][4]; zero_acc<4>(acc);
        gemm_acc<4>(H + (size_t)pm * 256 * 1024, 1024, Wt + (size_t)pn * 128 * 1024, 1024, 1024, acc, lds);
        const int cbase = pn * 128 + wc * 64;
#pragma unroll
        for (int m = 0; m < 4; ++m) {
            const int row = pm * 256 + wr * 64 + m * 16 + fr;
#pragma unroll
            for (int n = 0; n < 4; ++n) {
                const int col = cbase + n * 16 + fq * 4;
                const f32x4 v = acc[m][n];
                if (cbase < PW) {
                    *(f32x4*)(P + (size_t)row * PW + col) = v;
                    if (cbase >= C_CK && cbase < C_DP && row < NTP) {
                        const int b = row >> 8, s = row & 255;
                        const size_t o = (cbase < C_CV ? O_NK : O_NV) + ((size_t)((b * 2 + l) * 256 + s)) * 128 + (col - (cbase < C_CV ? C_CK : C_CV));
                        *(f32x4*)(p.out + o) = v;
                    }
                } else {
                    u32x2 w; w[0] = cvt_pk_bf16(siluf_(v[0]), siluf_(v[1])); w[1] = cvt_pk_bf16(siluf_(v[2]), siluf_(v[3]));
                    *(u32x2*)(Z + (size_t)row * DM + (col - PW)) = w;
                }
            }
        }
    }
}

__device__ void phaseB0(const Params& p, int l, unsigned char* ldsb) {
    const int tid = TID(), lane = tid & 63, half = tid >> 8, c = tid & 255, h = c >> 6, j6 = c & 63;
    float* wdt = (float*)ldsb;
    float* adv = wdt + 1024;
    const float* P = (const float*)(p.ws + WS_P);
    float* recS = (float*)(p.ws + WS_RECS);
    float* recD = (float*)(p.ws + WS_RECD);
    float* BC = (float*)(p.ws + WS_BC);
    const float* w_up = p.in[14] + (size_t)l * 2 * 64 * 256;
    const float* a_up = p.in[16] + (size_t)l * 2 * 64 * 256;
    const float kkc = p.in[17][l * 256 + c], kac = p.in[18][l * 256 + c], rkc = p.in[19][l * 256 + c];
    float w0c[2], a0c[2];
    w0c[0] = p.in[13][(l * 2 + 0) * 256 + c]; w0c[1] = p.in[13][(l * 2 + 1) * 256 + c];
    a0c[0] = p.in[15][(l * 2 + 0) * 256 + c]; a0c[1] = p.in[15][(l * 2 + 1) * 256 + c];
    for (int it = blockIdx.x; it < NT / 16; it += gridDim.x) {
        const int tb = it * 16;
        __syncthreads();
#pragma unroll
        for (int i = 0; i < 4; ++i) { const int idx = tid + i * 512, tk = idx >> 7, j = idx & 127; const float v = P[(size_t)(tb + tk) * PW + C_WD + j];
            if (j < 64) wdt[tk * 64 + j] = tanhf(v); else adv[tk * 64 + j - 64] = v; }
        __syncthreads();
        float aw[2][8], aa[2][8];
#pragma unroll
        for (int i = 0; i < 8; ++i) { aw[0][i] = 0.f; aw[1][i] = 0.f; aa[0][i] = 0.f; aa[1][i] = 0.f; }
        for (int j = 0; j < 64; j += 4) {
            float wu[2][4], au[2][4];
#pragma unroll
            for (int jj = 0; jj < 4; ++jj) { wu[0][jj] = w_up[(size_t)(0 * 64 + j + jj) * 256 + c]; wu[1][jj] = w_up[(size_t)(1 * 64 + j + jj) * 256 + c];
                au[0][jj] = a_up[(size_t)(0 * 64 + j + jj) * 256 + c]; au[1][jj] = a_up[(size_t)(1 * 64 + j + jj) * 256 + c]; }
#pragma unroll
            for (int i = 0; i < 8; ++i) { const f32x4 wv = *(const f32x4*)(wdt + (half * 8 + i) * 64 + j), av = *(const f32x4*)(adv + (half * 8 + i) * 64 + j);
#pragma unroll
                for (int jj = 0; jj < 4; ++jj) { aw[0][i] += wv[jj] * wu[0][jj]; aw[1][i] += wv[jj] * wu[1][jj]; aa[0][i] += av[jj] * au[0][jj]; aa[1][i] += av[jj] * au[1][jj]; } }
        }
#pragma unroll
        for (int i = 0; i < 8; ++i) {
            const int tok = tb + half * 8 + i; int seqbase, L, pos; seq_of(tok, seqbase, L, pos);
            const float* pr = P + (size_t)tok * PW;
            const float r = pr[C_BR + c], k = pr[C_BK + c], v = pr[C_BV + c];
            const float kkr = k * kkc; const float ss = wave_sum(kkr * kkr); const float kk = kkr * rsqrtf(ss + 1e-12f);
            const size_t ridx = ((size_t)seqbase * 4 + (size_t)h * L + pos) * 192 + j6;
            recS[ridx] = r; recS[ridx + 64] = kk; recS[ridx + 128] = v;
            float bsum = 0.f;
#pragma unroll
            for (int d = 0; d < 2; ++d) {
                const float wl = w0c[d] + aw[d][i];
                const float nx = -wl; const float sp = fmaxf(nx, 0.f) + log1pf(expf(-fabsf(nx)));
                const float wlog = -sp - 0.5f; const float dec = expf(-expf(wlog));
                const float a = 1.0f / (1.0f + expf(-(a0c[d] + aa[d][i])));
                const float kd = k * (1.0f + (a - 1.0f) * kac);
                float* rd = recD + (size_t)d * RECD_STRIDE + ridx;
                rd[0] = dec; rd[64] = kk * a; rd[128] = kd;
                bsum += r * kd * rkc;
            }
            bsum = wave_sum(bsum);
            if (lane == 0) BC[tok * 4 + h] = bsum;
        }
    }
}

__device__ void scan_item(const Params& p, int l, int item, float* wl  ) {
    const int lane = TID() & 63, rl = lane >> 4, kl = lane & 15;
    int b, h, dir, rg, L, seqbase; bool sample;
    if (item < 512) { sample = true; rg = item & 15; const int q = item >> 4; dir = q & 1; h = (q >> 1) & 3; b = q >> 3; L = 1024; seqbase = NTP + b * 1024; }
    else { sample = false; const int idx = item - 512; rg = idx & 15; const int q = idx >> 4; dir = q & 1; h = (q >> 1) & 3; b = q >> 3; L = 256; seqbase = b * 256; }
    const int row = rg * 4 + rl;
    f32x4 S;
    const size_t sidx = ((size_t)(((b * 2 + l) * 2 + dir) * 4 + h)) * 4096 + row * 64 + kl * 4;
    if (sample) S = *(const f32x4*)(p.in[4] + sidx); else S = (f32x4){0.f, 0.f, 0.f, 0.f};
    const float* gS = (const float*)(p.ws + WS_RECS) + ((size_t)seqbase * 4 + (size_t)h * L) * 192;
    const float* gD = (const float*)(p.ws + WS_RECD) + (size_t)dir * RECD_STRIDE + ((size_t)seqbase * 4 + (size_t)h * L) * 192;
    float* O = (float*)(p.ws + WS_O) + (size_t)dir * NT * 256 + (size_t)seqbase * 256 + h * 64 + row;
    const int nch = L >> 2;
    f32x4 rA[6], rB[6];
    auto gl = [&](f32x4 (&r)[6], int c) {
        const int pos0 = dir ? (L - 4 * (c + 1)) : 4 * c;
        const float* s = gS + (size_t)pos0 * 192 + lane * 4; const float* d = gD + (size_t)pos0 * 192 + lane * 4;
#pragma unroll
        for (int i = 0; i < 3; ++i) { r[i] = *(const f32x4*)(s + i * 256); r[3 + i] = *(const f32x4*)(d + i * 256); }
    };
    auto st = [&](const f32x4 (&r)[6], float* buf) {
#pragma unroll
        for (int i = 0; i < 3; ++i) { *(f32x4*)(buf + i * 256 + lane * 4) = r[i]; *(f32x4*)(buf + 768 + i * 256 + lane * 4) = r[3 + i]; }
    };
    auto compute = [&](const float* buf, int c) {
        __builtin_amdgcn_wave_barrier();
#pragma unroll
        for (int s = 0; s < 4; ++s) {
            const int tc = dir ? 3 - s : s;
            const int pos = dir ? (L - 1 - (4 * c + s)) : (4 * c + s);
            const float* bs = buf + tc * 192; const float* bd = buf + 768 + tc * 192;
            const f32x4 r4 = *(const f32x4*)(bs + kl * 4), kk4 = *(const f32x4*)(bs + 64 + kl * 4);
            const float vv = bs[128 + row];
            const f32x4 w4 = *(const f32x4*)(bd + kl * 4), ka4 = *(const f32x4*)(bd + 64 + kl * 4), kd4 = *(const f32x4*)(bd + 128 + kl * 4);
            float sa = (S[0] * kk4[0] + S[1] * kk4[1]) + (S[2] * kk4[2] + S[3] * kk4[3]);
            sa = row16_sum(sa);
            S = S * w4 - sa * ka4 + vv * kd4;
            float o = (S[0] * r4[0] + S[1] * r4[1]) + (S[2] * r4[2] + S[3] * r4[3]);
            o = row16_sum(o);
            if (kl == 0) O[(size_t)pos * 256] = o;
        }
        __builtin_amdgcn_wave_barrier();
    };
    gl(rA, 0); gl(rB, 1);
    for (int c = 0; c < nch; c += 2) {
        st(rA, wl); if (c + 2 < nch) gl(rA, c + 2); compute(wl, c);
        st(rB, wl + 1536); if (c + 3 < nch) gl(rB, c + 3); compute(wl + 1536, c + 1);
    }
    if (!sample) *(f32x4*)(p.out + O_NS + sidx) = S;
}

__device__ __forceinline__ void stage_qk(const float* __restrict__ src, int stride, bf16_t* dst, bool rope, int pos0, float scale, const f32x2* __restrict__ rt) {
    const int tid = TID();
#pragma unroll
    for (int i = 0; i < 2; ++i) {
        const int task = tid + i * 512, row = task >> 3, half = (task >> 2) & 1, quad = task & 3;
        const float* s = src + (size_t)row * stride + half * 32 + quad * 4;
        f32x4 x1 = *(const f32x4*)s, x2 = *(const f32x4*)(s + 16);
        if (rope) { const int pos = pos0 + row; const int pi = half ? (pos & 63) : (pos >> 6);
#pragma unroll
            for (int j = 0; j < 4; ++j) { const f32x2 cs = rt[pi * 16 + quad * 4 + j]; const float a = x1[j], b = x2[j]; x1[j] = a * cs[0] - b * cs[1]; x2[j] = b * cs[0] + a * cs[1]; } }
        x1 *= scale; x2 *= scale;
        u32x2 w1, w2; w1[0] = cvt_pk_bf16(x1[0], x1[1]); w1[1] = cvt_pk_bf16(x1[2], x1[3]); w2[0] = cvt_pk_bf16(x2[0], x2[1]); w2[1] = cvt_pk_bf16(x2[2], x2[3]);
        *(u32x2*)(dst + row * 72 + half * 32 + quad * 4) = w1; *(u32x2*)(dst + row * 72 + half * 32 + 16 + quad * 4) = w2;
    }
}
__device__ __forceinline__ void stage_vt(const float* __restrict__ src, int stride, bf16_t* vt) {
    const int tid = TID();
#pragma unroll
    for (int i = 0; i < 4; ++i) { const int task = tid + i * 512, key = task >> 4, dq = task & 15;
        const f32x4 v = *(const f32x4*)(src + (size_t)key * stride + dq * 4);
#pragma unroll
        for (int j = 0; j < 4; ++j) vt[(dq * 4 + j) * 136 + key] = f2bf(v[j]); }
}
__device__ void attn_item(const Params& p, int l, int ai, unsigned char* lds) {
    const int tid = TID(), lane = tid & 63, wid = tid >> 6, fr = lane & 15, fq = lane >> 4;
    bf16_t* Qs = (bf16_t*)lds; bf16_t* Ks = Qs + 128 * 72; bf16_t* Vt = Ks + 128 * 72;
    const float* P = (const float*)(p.ws + WS_P);
    const bf16_t* Z = (const bf16_t*)(p.ws + WS_Z);
    bf16_t* YS = (bf16_t*)(p.ws + WS_YS);
    const f32x2* rt = (const f32x2*)(p.ws + WS_ROPE);
    bool sample; int b, head, qt, seqbase;
    if (ai < 128) { sample = true; b = ai >> 5; head = (ai >> 3) & 3; qt = ai & 7; seqbase = NTP + b * 1024; }
    else { const int j = ai - 128; sample = false; b = j >> 3; head = (j >> 1) & 3; qt = j & 1; seqbase = b * 256; }
    const int kh = head >> 1, qbase = seqbase + qt * 128;
    __syncthreads();
    stage_qk(P + (size_t)qbase * PW + C_CQ + head * 64, PW, Qs, sample, qt * 128, 0.125f, rt);
    __syncthreads();
    bf16x8 qf[2];
    qf[0] = *(const bf16x8*)(Qs + (wid * 16 + fr) * 72 + fq * 8); qf[1] = *(const bf16x8*)(Qs + (wid * 16 + fr) * 72 + 32 + fq * 8);
    float m = p.in[22][l * 4 + head], lsum = 1.0f;
    f32x4 oacc[4];
#pragma unroll
    for (int i = 0; i < 4; ++i) oacc[i] = (f32x4){0.f, 0.f, 0.f, 0.f};
    const int nkb = sample ? 7 : 2;
    const int qpos = qt * 128 + wid * 16 + fr;
    for (int kb = 0; kb < nkb; ++kb) {
        const float* ksrc; const float* vsrc; int stride; bool rope = false, mask = false; int kpos0 = 0;
        if (!sample) { ksrc = P + (size_t)(seqbase + kb * 128) * PW + C_CK + kh * 64; vsrc = ksrc + (C_CV - C_CK); stride = PW; }
        else if (kb < 3) { const int nbk = qt - 1 + kb; if (nbk < 0 || nbk >= 8) continue; kpos0 = nbk * 128;
            ksrc = P + (size_t)(seqbase + kpos0) * PW + C_CK + kh * 64; vsrc = ksrc + (C_CV - C_CK); stride = PW; rope = true; mask = (kb != 1); }
        else { const size_t o = ((size_t)((b * 2 + l) * 512 + (kb - 3) * 128) * 2 + kh) * 64; ksrc = p.in[2] + o; vsrc = p.in[3] + o; stride = 128; }
        __syncthreads();
        stage_qk(ksrc, stride, Ks, rope, kpos0, 1.0f, rt);
        stage_vt(vsrc, stride, Vt);
        __syncthreads();
#pragma unroll
        for (int sb = 0; sb < 4; ++sb) {
            f32x4 s0 = (f32x4){0.f, 0.f, 0.f, 0.f}, s1 = s0;
#pragma unroll
            for (int dh = 0; dh < 2; ++dh) {
                const bf16x8 k0 = *(const bf16x8*)(Ks + (sb * 32 + fr) * 72 + dh * 32 + fq * 8), k1 = *(const bf16x8*)(Ks + (sb * 32 + 16 + fr) * 72 + dh * 32 + fq * 8);
                s0 = __builtin_amdgcn_mfma_f32_16x16x32_bf16(k0, qf[dh], s0, 0, 0, 0);
                s1 = __builtin_amdgcn_mfma_f32_16x16x32_bf16(k1, qf[dh], s1, 0, 0, 0);
            }
            if (mask) {
#pragma unroll
                for (int j = 0; j < 4; ++j) { const int k0p = kpos0 + sb * 32 + fq * 4 + j, k1p = k0p + 16; int d0 = qpos - k0p, d1 = qpos - k1p; d0 = d0 < 0 ? -d0 : d0; d1 = d1 < 0 ? -d1 : d1;
                    if (d0 > 128) s0[j] = -1e30f; if (d1 > 128) s1[j] = -1e30f; }
            }
            float mx = fmaxf(fmaxf(fmaxf(s0[0], s0[1]), fmaxf(s0[2], s0[3])), fmaxf(fmaxf(s1[0], s1[1]), fmaxf(s1[2], s1[3])));
            mx = fmaxf(mx, __shfl_xor(mx, 16)); mx = fmaxf(mx, __shfl_xor(mx, 32));
            const float mn = fmaxf(m, mx), alpha = __expf(m - mn);
            float rs = 0.f;
#pragma unroll
            for (int j = 0; j < 4; ++j) { s0[j] = __expf(s0[j] - mn); s1[j] = __expf(s1[j] - mn); rs += s0[j] + s1[j]; }
            rs += __shfl_xor(rs, 16); rs += __shfl_xor(rs, 32);
            lsum = lsum * alpha + rs; m = mn;
            u32x4 pw; pw[0] = cvt_pk_bf16(s0[0], s0[1]); pw[1] = cvt_pk_bf16(s0[2], s0[3]); pw[2] = cvt_pk_bf16(s1[0], s1[1]); pw[3] = cvt_pk_bf16(s1[2], s1[3]);
            bf16x8 pf; __builtin_memcpy(&pf, &pw, 16);
#pragma unroll
            for (int dt = 0; dt < 4; ++dt) {
                const bf16_t* vp = Vt + (dt * 16 + fr) * 136 + sb * 32 + fq * 4;
                u32x4 vw; const u32x2 va = *(const u32x2*)vp, vb = *(const u32x2*)(vp + 16); vw[0] = va[0]; vw[1] = va[1]; vw[2] = vb[0]; vw[3] = vb[1];
                bf16x8 vf; __builtin_memcpy(&vf, &vw, 16);
                oacc[dt] = oacc[dt] * alpha;
                oacc[dt] = __builtin_amdgcn_mfma_f32_16x16x32_bf16(vf, pf, oacc[dt], 0, 0, 0);
            }
        }
    }
    const float inv = 1.0f / lsum;
    const size_t t = (size_t)(qbase + wid * 16 + fr);
#pragma unroll
    for (int dt = 0; dt < 4; ++dt) {
        const int col = 512 + head * 64 + dt * 16 + fq * 4;
        const bf16x4 z = *(const bf16x4*)(Z + t * DM + col);
        u32x2 w; w[0] = cvt_pk_bf16(oacc[dt][0] * inv * bf2f((bf16_t)z[0]), oacc[dt][1] * inv * bf2f((bf16_t)z[1]));
        w[1] = cvt_pk_bf16(oacc[dt][2] * inv * bf2f((bf16_t)z[2]), oacc[dt][3] * inv * bf2f((bf16_t)z[3]));
        *(u32x2*)(YS + t * DM + col) = w;
    }
}

__device__ void chunk_item(const Params& p, int l, int ci, unsigned char* ldsb) {
    const int tid = TID(), d = tid & 63, ig = tid >> 6;
    const int chunk = ci >> 2, g = ci & 3, base = chunk * 128;
    float* ws = (float*)ldsb;
    float* vt = ws + 128 * 128;
    const float* P = (const float*)(p.ws + WS_P);
    const bf16_t* Z = (const bf16_t*)(p.ws + WS_Z);
    bf16_t* YS = (bf16_t*)(p.ws + WS_YS);
    const float* wsrc = p.in[11] + (size_t)(l * 4 + g) * 128 * 128;
    __syncthreads();
#pragma unroll
    for (int i = 0; i < 8; ++i) { const int idx = tid + i * 512; *(f32x4*)(ws + idx * 4) = *(const f32x4*)(wsrc + idx * 4); }
#pragma unroll
    for (int i = 0; i < 4; ++i) { const int idx = tid + i * 512, j = idx >> 4, d4 = (idx & 15) * 4; *(f32x4*)(vt + j * 64 + d4) = *(const f32x4*)(P + (size_t)(base + j) * PW + C_AV + g * 64 + d4); }
    __syncthreads();
    float acc[16];
#pragma unroll
    for (int ii = 0; ii < 16; ++ii) acc[ii] = 0.f;
    for (int j = 0; j < 128; j += 4) {
        const float v0 = vt[(j + 0) * 64 + d], v1 = vt[(j + 1) * 64 + d], v2 = vt[(j + 2) * 64 + d], v3 = vt[(j + 3) * 64 + d];
#pragma unroll
        for (int ii = 0; ii < 16; ++ii) { const f32x4 w4 = *(const f32x4*)(ws + (ig * 16 + ii) * 128 + j); acc[ii] += (w4[0] * v0 + w4[1] * v1) + (w4[2] * v2 + w4[3] * v3); }
    }
    const float* bs = p.in[12] + (l * 4 + g) * 128;
#pragma unroll
    for (int ii = 0; ii < 16; ++ii) { const int i = ig * 16 + ii; const size_t t = base + i;
        const float u = P[t * PW + C_AU + g * 64 + d];
        const float y = u * (acc[ii] + bs[i]);
        YS[t * DM + g * 64 + d] = f2bf(y * bf2f(Z[t * DM + g * 64 + d])); }
}

__device__ void pool_item(const Params& p, int l, int pi, unsigned char* ldsb) {
    const int tid = TID(), half = tid >> 8, ch = tid & 255, g = ch >> 6;
    const int tb = pi * 32; int seqbase, L, pos0; seq_of(tb, seqbase, L, pos0);
    float* pt = (float*)ldsb;
    float* dl = pt + 48 * 256;
    const float* P = (const float*)(p.ws + WS_P);
    const bf16_t* Z = (const bf16_t*)(p.ws + WS_Z);
    bf16_t* YS = (bf16_t*)(p.ws + WS_YS);
    __syncthreads();
#pragma unroll
    for (int i = 0; i < 6; ++i) { const int idx = tid + i * 512, rr = idx >> 6, c4 = (idx & 63) * 4; const int pos = pos0 - 8 + rr;
        f32x4 v = (f32x4){0.f, 0.f, 0.f, 0.f};
        if (pos >= 0 && pos < L) v = *(const f32x4*)(P + (size_t)(seqbase + pos) * PW + C_DP + c4);
        *(f32x4*)(pt + rr * 256 + c4) = v; }
    __syncthreads();
    const int w = 2 << g;
    for (int i = 0; i < 16; ++i) { const int tk = half * 16 + i, pos = pos0 + tk;
        int lo = pos - (w >> 1), hi = lo + w; lo = lo < 0 ? 0 : lo; hi = hi > L ? L : hi;
        float s = 0.f;
        for (int q = lo; q < hi; ++q) s += pt[(q - pos0 + 8) * 256 + ch];
        dl[tk * 256 + ch] = s / (float)(hi - lo) - pt[(tk + 8) * 256 + ch]; }
    __syncthreads();
    float acc[16];
#pragma unroll
    for (int i = 0; i < 16; ++i) acc[i] = 0.f;
    const float* pw = p.in[23] + (size_t)(l * 4 + g) * 64 * 64 + (ch & 63);
    for (int c = 0; c < 64; c += 4) {
        const float w0 = pw[(c + 0) * 64], w1 = pw[(c + 1) * 64], w2 = pw[(c + 2) * 64], w3 = pw[(c + 3) * 64];
#pragma unroll
        for (int i = 0; i < 16; ++i) { const f32x4 dv = *(const f32x4*)(dl + (half * 16 + i) * 256 + g * 64 + c); acc[i] += (dv[0] * w0 + dv[1] * w1) + (dv[2] * w2 + dv[3] * w3); }
    }
    const float sc = p.in[24][l * 256 + ch];
#pragma unroll
    for (int i = 0; i < 16; ++i) { const size_t t = tb + half * 16 + i;
        YS[t * DM + 768 + ch] = f2bf(acc[i] * sc * bf2f(Z[t * DM + 768 + ch])); }
}

__device__ void phaseB1(const Params& p, int l, unsigned char* lds) {
    const int tid = TID(), wid = tid >> 6;
    float* wl = (float*)lds + wid * 3072;
    if (wid < 2) { for (int it = blockIdx.x * 2 + wid; it < 512; it += gridDim.x * 2) scan_item(p, l, it, wl); }
    else if (wid != 4 && wid != 5) { const int pw = (wid < 4) ? wid - 2 : wid - 4;
        for (int it = blockIdx.x * 4 + pw; it < 2048; it += gridDim.x * 4) scan_item(p, l, 512 + it, wl); }
    __syncthreads();
    __shared__ int s_item;
    unsigned* ctr = (unsigned*)(p.ws + WS_CTR) + l;
    for (;;) {
        if (tid == 0) s_item = (int)atomicAdd(ctr, 1u);
        __syncthreads();
        const int item = s_item;
        __syncthreads();
        if (item >= 768) break;
        if (item < 256) attn_item(p, l, item, lds);
        else if (item < 512) chunk_item(p, l, item - 256, lds);
        else pool_item(p, l, item - 512, lds);
    }
}

__device__ void phaseB2(const Params& p, int l) {
    const int lane = TID() & 63, gw = blockIdx.x * 8 + (TID() >> 6), W = gridDim.x * 8;
    const float* O = (const float*)(p.ws + WS_O);
    const float* P = (const float*)(p.ws + WS_P);
    const float* BC = (const float*)(p.ws + WS_BC);
    const bf16_t* Z = (const bf16_t*)(p.ws + WS_Z);
    bf16_t* YS = (bf16_t*)(p.ws + WS_YS);
    for (int it = gw; it < NT * 4; it += W) {
        const int tok = it >> 2, h = it & 3, c = h * 64 + lane;
        const float o = O[(size_t)tok * 256 + c] + O[(size_t)NT * 256 + (size_t)tok * 256 + c];
        const float mu = wave_sum(o) * (1.0f / 64.0f);
        const float dlt = o - mu;
        const float var = wave_sum(dlt * dlt) * (1.0f / 64.0f);
        const float on = dlt * rsqrtf(var + 64e-5f);
        const float y = on * p.in[20][l * 256 + c] + p.in[21][l * 256 + c] + BC[tok * 4 + h] * P[(size_t)tok * PW + C_BV + c];
        YS[(size_t)tok * DM + 256 + c] = f2bf(y * bf2f(Z[(size_t)tok * DM + 256 + c]));
    }
}

__device__ void phaseC(const Params& p, int l, unsigned char* lds) {
    const int tid = TID(), lane = tid & 63, wid = tid >> 6, wr = wid >> 1, wc = wid & 1, fr = lane & 15, fq = lane >> 4;
    const bf16_t* H = (const bf16_t*)(p.ws + WS_H);
    const bf16_t* YS = (const bf16_t*)(p.ws + WS_YS);
    const bf16_t* Wt = (const bf16_t*)(p.ws + WS_WTIN) + (size_t)l * INW * 1024 + (size_t)NA_COLS * 1024;
    const bf16_t* Wu = (const bf16_t*)(p.ws + WS_WTUP) + (size_t)l * 4 * 1024 * 256;
    bf16_t* MG = (bf16_t*)(p.ws + WS_MERGED);
    const int NU = 64 * 8;
    for (int u = blockIdx.x; u < NU; u += gridDim.x) {
        const int pn = u / 64, pm = u % 64;
        f32x4 mg[2][4]; zero_acc<2>(mg);
#pragma unroll 1
        for (int n = 0; n < 4; ++n) {
            f32x4 a1[2][4]; zero_acc<2>(a1);
            gemm_acc<2>(H + (size_t)pm * 128 * 1024, 1024, Wt + (size_t)(n * 1024 + pn * 128) * 1024, 1024, 1024, a1, lds);
#pragma unroll
            for (int m = 0; m < 2; ++m)
#pragma unroll
                for (int q = 0; q < 4; ++q)
#pragma unroll
                    for (int j = 0; j < 4; ++j) a1[m][q][j] = sigmoidf_(a1[m][q][j]);
            f32x4 a2[2][4]; zero_acc<2>(a2);
            gemm_acc<2>(YS + (size_t)pm * 128 * 1024 + n * 256, 1024, Wu + (size_t)(n * 1024 + pn * 128) * 256, 256, 256, a2, lds);
#pragma unroll
            for (int m = 0; m < 2; ++m)
#pragma unroll
                for (int q = 0; q < 4; ++q) mg[m][q] += a1[m][q] * a2[m][q];
        }
#pragma unroll
        for (int m = 0; m < 2; ++m) { const size_t row = (size_t)pm * 128 + wr * 32 + m * 16 + fr;
#pragma unroll
            for (int q = 0; q < 4; ++q) { const int col = pn * 128 + wc * 64 + q * 16 + fq * 4;
                u32x2 w; w[0] = cvt_pk_bf16(mg[m][q][0], mg[m][q][1]); w[1] = cvt_pk_bf16(mg[m][q][2], mg[m][q][3]);
                *(u32x2*)(MG + row * DM + col) = w; } }
    }
}

__device__ void phaseD(const Params& p, int l, unsigned char* lds) {
    const int tid = TID(), lane = tid & 63, wid = tid >> 6, wr = wid >> 1, wc = wid & 1, fr = lane & 15, fq = lane >> 4;
    const bf16_t* MG = (const bf16_t*)(p.ws + WS_MERGED);
    const bf16_t* Wo = (const bf16_t*)(p.ws + WS_WTO) + (size_t)l * 1024 * 1024;
    const int NU = 64 * 8;
    for (int u = blockIdx.x; u < NU; u += gridDim.x) {
        const int pn = u / 64, pm = u % 64;
        f32x4 acc[2][4]; zero_acc<2>(acc);
        gemm_acc<2>(MG + (size_t)pm * 128 * 1024, 1024, Wo + (size_t)pn * 128 * 1024, 1024, 1024, acc, lds);
#pragma unroll
        for (int m = 0; m < 2; ++m) { const int row = pm * 128 + wr * 32 + m * 16 + fr;
            const float* xr = xrow_ptr(p, l, row);
            const float* gate = (const float*)(p.ws + WS_MOD) + (size_t)(l * 5 + modrow_of(row)) * 3072 + 2048;
#pragma unroll
            for (int q = 0; q < 4; ++q) { const int col = pn * 128 + wc * 64 + q * 16 + fq * 4;
                const f32x4 xo = *(const f32x4*)(xr + col), gt = *(const f32x4*)(gate + col);
                *(f32x4*)(p.out + (size_t)row * DM + col) = xo + gt * acc[m][q]; } }
    }
}

__device__ void phaseF(const Params& p) {
    const int lane = TID() & 63, gw = blockIdx.x * 8 + (TID() >> 6), W = gridDim.x * 8;
    const float* g = p.in[27];
    for (int row = gw; row < NT; row += W) {
        float* x = p.out + (size_t)row * DM;
        f32x4 v[4]; float ss = 0.f;
#pragma unroll
        for (int i = 0; i < 4; ++i) { v[i] = *(const f32x4*)(x + i * 256 + lane * 4); ss += v[i][0] * v[i][0] + v[i][1] * v[i][1] + v[i][2] * v[i][2] + v[i][3] * v[i][3]; }
        ss = wave_sum(ss);
        const float rs = rsqrtf(ss * (1.0f / 1024.0f) + 1e-6f);
#pragma unroll
        for (int i = 0; i < 4; ++i) { const int c = i * 256 + lane * 4; *(f32x4*)(x + c) = v[i] * rs * *(const f32x4*)(g + c); }
    }
}

__global__ void __launch_bounds__(NTHREADS) fwd_megakernel(Params p) {
    extern __shared__ __attribute__((aligned(16))) unsigned char lds[];
    cg::grid_group grid = cg::this_grid();
    phase0(p, lds);
    grid.sync();
#pragma unroll 1
    for (int l = 0; l < 2; ++l) {
        phaseA0(p, l);
        grid.sync();
        phaseA(p, l, lds);
        grid.sync();
        phaseB0(p, l, lds);
        grid.sync();
        phaseB1(p, l, lds);
        grid.sync();
        phaseB2(p, l);
        grid.sync();
        phaseC(p, l, lds);
        grid.sync();
        phaseD(p, l, lds);
        grid.sync();
    }
    phaseF(p);
}

extern "C" void kernel_launch(void* const* d_in, const int* in_sizes, int n_in, void* d_out, int out_size, void* d_ws, size_t ws_size, hipStream_t stream) {
    static int grid_blocks = 0;
    if (!grid_blocks) {
        int dev = 0, cus = 0, per_cu = 0;
        hipGetDevice(&dev);
        hipDeviceGetAttribute(&cus, hipDeviceAttributeMultiprocessorCount, dev);
        hipFuncSetAttribute((const void*)fwd_megakernel, hipFuncAttributeMaxDynamicSharedMemorySize, LDS_BYTES);
        hipOccupancyMaxActiveBlocksPerMultiprocessor(&per_cu, (const void*)fwd_megakernel, NTHREADS, LDS_BYTES);
        if (per_cu < 1) { fprintf(stderr, "occupancy query returned %d\n", per_cu); per_cu = 1; }
        if (per_cu > 1) per_cu = 1;
        grid_blocks = cus * per_cu;
        if (ws_size < WS_END) fprintf(stderr, "workspace too small: %zu < %zu\n", ws_size, (size_t)WS_END);
    }
    Params p{};
    for (int i = 0; i < 28; ++i) p.in[i] = (const float*)d_in[i];
    p.out = (float*)d_out; p.ws = (unsigned char*)d_ws;
    void* args[] = {&p};
    hipError_t e = hipLaunchCooperativeKernel((const void*)fwd_megakernel, dim3(grid_blocks), dim3(NTHREADS), args, LDS_BYTES, stream);
    if (e != hipSuccess) fprintf(stderr, "cooperative launch failed: %s (grid %d)\n", hipGetErrorString(e), grid_blocks);
}
```

```cpp
#include <hip/hip_runtime.h>
#include <hip/hip_cooperative_groups.h>
#include <cstdio>
namespace cg = cooperative_groups;

typedef unsigned short bf16_t;
typedef short bf16x8 __attribute__((ext_vector_type(8)));
typedef short bf16x4 __attribute__((ext_vector_type(4)));
typedef float f32x4 __attribute__((ext_vector_type(4)));
typedef float f32x2 __attribute__((ext_vector_type(2)));
typedef unsigned u32x4 __attribute__((ext_vector_type(4)));
typedef unsigned u32x2 __attribute__((ext_vector_type(2)));

constexpr int NT = 8192, NTP = 4096, DM = 1024, INW = 7296, NA_COLS = 3200, PW = 2176;
constexpr int NTHREADS = 512;
constexpr int C_AU = 0, C_AV = 256, C_BR = 512, C_BK = 768, C_BV = 1024, C_WD = 1280, C_AD = 1344, C_CQ = 1408, C_CK = 1664, C_CV = 1792, C_DP = 1920;
constexpr size_t O_YP = 0, O_YS = 4194304, O_NK = 8388608, O_NV = 9437184, O_NS = 10485760;
constexpr size_t WS_WTIN = 0;
constexpr size_t WS_WTUP = WS_WTIN + (size_t)2 * INW * DM * 2;
constexpr size_t WS_WTO  = WS_WTUP + (size_t)2 * 4 * 1024 * 256 * 2;
constexpr size_t WS_MOD  = WS_WTO + (size_t)2 * 1024 * 1024 * 2;
constexpr size_t WS_ROPE = WS_MOD + (size_t)2 * 5 * 3072 * 4;
constexpr size_t WS_CTR  = WS_ROPE + 64 * 16 * 8;
constexpr size_t WS_BAR  = WS_CTR + 256;
constexpr size_t WS_H    = WS_BAR + 3456 * 4;
constexpr size_t WS_P    = WS_H + (size_t)NT * DM * 2;
constexpr size_t WS_Z    = WS_P + (size_t)NT * PW * 4;
constexpr size_t WS_RECS = WS_Z + (size_t)NT * DM * 2;
constexpr size_t WS_RECD = WS_RECS + (size_t)NT * 4 * 192 * 4;
constexpr size_t WS_O    = WS_RECD + (size_t)2 * NT * 4 * 192 * 4;
constexpr size_t WS_BC   = WS_O + (size_t)2 * NT * 256 * 4;
constexpr size_t WS_YS   = WS_BC + (size_t)NT * 4 * 4;
constexpr size_t WS_END  = WS_YS + (size_t)NT * DM * 2;
constexpr size_t WS_MERGED = WS_P;
constexpr size_t RECD_STRIDE = (size_t)NT * 4 * 192;

constexpr int LDS_MAIN = 110592;
constexpr int LDS_BYTES = LDS_MAIN + 16;
#ifndef DUP
#define DUP 0
#endif

struct Params {
    const float* in[28];
    float* out;
    unsigned char* ws;
};

__device__ __forceinline__ int TID() { int t = threadIdx.x; asm volatile("" : "+v"(t)); return t; }
__device__ __forceinline__ unsigned cvt_pk_bf16(float lo, float hi) { unsigned r; asm volatile("v_cvt_pk_bf16_f32 %0, %1, %2" : "=v"(r) : "v"(lo), "v"(hi)); return r; }
__device__ __forceinline__ bf16_t f2bf(float f) { return (bf16_t)(cvt_pk_bf16(f, 0.f) & 0xffffu); }
__device__ __forceinline__ float bf2f(bf16_t b) { return __uint_as_float(((unsigned)b) << 16); }
__device__ __forceinline__ float wave_sum(float v) {
#pragma unroll
    for (int o = 32; o >= 1; o >>= 1) v += __shfl_xor(v, o);
    return v;
}
__device__ __forceinline__ float sigmoidf_(float x) { return 1.0f / (1.0f + __expf(-x)); }
__device__ __forceinline__ float siluf_(float x) { return x / (1.0f + __expf(-x)); }
template <int CTRL> __device__ __forceinline__ float dpp_f(float x) { return __int_as_float(__builtin_amdgcn_update_dpp(0, __float_as_int(x), CTRL, 0xF, 0xF, false)); }
__device__ __forceinline__ float row16_sum(float x) {
    x += dpp_f<0x128>(x); x += dpp_f<0x124>(x); x += dpp_f<0x122>(x); x += dpp_f<0x121>(x); return x;
}
__device__ __forceinline__ void seq_of(int tok, int& seqbase, int& L, int& pos) {
    if (tok < NTP) { seqbase = tok & ~255; L = 256; pos = tok & 255; }
    else { int t2 = tok - NTP; seqbase = NTP + (t2 & ~1023); L = 1024; pos = t2 & 1023; }
}
__device__ __forceinline__ int modrow_of(int tok) { return tok < NTP ? 0 : 1 + ((tok - NTP) >> 10); }


#define XB_TMO      128
#define XB_XCNT(j)  (256  + 64 * (j))
#define XB_XSUB(j)  (1280 + 64 * (j))
#define XB_XGEN(j)  (2304 + 64 * (j))
#define XB_TOP      3328
#define XB_TOPGEN   3392
#define XCD_BAR_WORDS 3456
#define XB_SPIN_CAP (1u << 18)
#define LAS __attribute__((address_space(3)))
__device__ __forceinline__ unsigned xb_ld(unsigned* p)              { return __hip_atomic_load(p, __ATOMIC_RELAXED, __HIP_MEMORY_SCOPE_AGENT); }
__device__ __forceinline__ unsigned xb_add(unsigned* p, unsigned v) { return __hip_atomic_fetch_add(p, v, __ATOMIC_RELAXED, __HIP_MEMORY_SCOPE_AGENT); }
__device__ __forceinline__ unsigned xb_xcc_id() { return (unsigned)__builtin_amdgcn_s_getreg((3 << 11) | 20) & 0xFu; }
#define XB_SPIN(cond, bar) do { unsigned _sp = 0; while (cond) { __builtin_amdgcn_s_sleep(1); \
    if ((++_sp & 255u) == 0u) { if (xb_ld(&(bar)[XB_TMO])) break; if (_sp > XB_SPIN_CAP) { atomicAdd(&(bar)[XB_TMO], 1u); break; } } } } while (0)
struct XcdBarrier { unsigned* bar; unsigned x; volatile LAS unsigned* st; };
__device__ __forceinline__ XcdBarrier xcd_barrier_post(unsigned* bar, volatile LAS unsigned* st) {
    XcdBarrier b; b.bar = bar; b.x = xb_xcc_id(); b.st = st;
    if (threadIdx.x == 0) (void)xb_add(&bar[XB_XCNT(b.x)], 1u);
    return b;
}
__device__ __forceinline__ void xcd_barrier_complete(unsigned* bar, unsigned x, unsigned& nloc, unsigned& nx) {
    const unsigned G = gridDim.x * gridDim.y * gridDim.z;
    unsigned sum, cnt, mine, sp = 0u;
    for (;;) {
        sum = 0u; cnt = 0u; mine = 0u;
#pragma unroll
        for (unsigned j = 0; j < 16; ++j) { const unsigned c = xb_ld(&bar[XB_XCNT(j)]); sum += c; cnt += (c > 0u) ? 1u : 0u; mine = (j == x) ? c : mine; }
        if (sum == G) break;
        __builtin_amdgcn_s_sleep(1);
        if ((++sp & 255u) == 0u) { if (xb_ld(&bar[XB_TMO])) break; if (sp > XB_SPIN_CAP) { atomicAdd(&bar[XB_TMO], 1u); break; } }
    }
    nloc = mine > 0u ? mine : 1u; nx = cnt > 0u ? cnt : 1u;
}
__device__ __forceinline__ void xcd_barrier(const XcdBarrier& b) {
    asm volatile("s_waitcnt vmcnt(0)" ::: "memory");
    __syncthreads();
    if (threadIdx.x == 0) {
        unsigned* bar = b.bar;
        __builtin_amdgcn_s_waitcnt(0);
        unsigned nloc = b.st[0], nx = b.st[1];
        if (nloc == 0u) { xcd_barrier_complete(bar, b.x, nloc, nx); b.st[0] = nloc; b.st[1] = nx; }
        const unsigned old = xb_add(&bar[XB_XSUB(b.x)], 1u);
        const unsigned gen = old / nloc;
        if (old + 1u == (gen + 1u) * nloc) {
            __builtin_amdgcn_fence(__ATOMIC_RELEASE, "agent");
            asm volatile("s_waitcnt vmcnt(0)" ::: "memory");
            const unsigned og = xb_add(&bar[XB_TOP], 1u);
            const unsigned tg = og / nx;
            if (og + 1u == (tg + 1u) * nx) xb_add(&bar[XB_TOPGEN], 1u);
            else XB_SPIN(xb_ld(&bar[XB_TOPGEN]) == tg, bar);
            __builtin_amdgcn_fence(__ATOMIC_ACQUIRE, "agent");
            xb_add(&bar[XB_XGEN(b.x)], 1u);
            asm volatile("s_waitcnt vmcnt(0)" ::: "memory");
        } else {
            XB_SPIN(xb_ld(&bar[XB_XGEN(b.x)]) == gen, bar);
            __builtin_amdgcn_fence(__ATOMIC_ACQUIRE, "agent");
            asm volatile("s_waitcnt vmcnt(0)" ::: "memory");
        }
    }
    __syncthreads();
}

__device__ void conv_tile(const float* __restrict__ src, int N, bf16_t* __restrict__ dst, int K, int kt, int nt, float* tile) {
    const int tid = TID();
    { const int r = tid >> 4, c4 = (tid & 15) * 4;
#pragma unroll
      for (int i = 0; i < 2; ++i) { const int k = r + 32 * i; const f32x4 v = *(const f32x4*)(src + (size_t)(kt * 64 + k) * N + nt * 64 + c4);
          tile[k * 65 + c4 + 0] = v[0]; tile[k * 65 + c4 + 1] = v[1]; tile[k * 65 + c4 + 2] = v[2]; tile[k * 65 + c4 + 3] = v[3]; } }
    __syncthreads();
    { const int n = tid >> 3, kc = (tid & 7) * 8; u32x4 w;
      w[0] = cvt_pk_bf16(tile[(kc + 0) * 65 + n], tile[(kc + 1) * 65 + n]); w[1] = cvt_pk_bf16(tile[(kc + 2) * 65 + n], tile[(kc + 3) * 65 + n]);
      w[2] = cvt_pk_bf16(tile[(kc + 4) * 65 + n], tile[(kc + 5) * 65 + n]); w[3] = cvt_pk_bf16(tile[(kc + 6) * 65 + n], tile[(kc + 7) * 65 + n]);
      *(u32x4*)(dst + (size_t)(nt * 64 + n) * K + kt * 64 + kc) = w; }
    __syncthreads();
}

__device__ void mod_item(const Params& p, int l, int cc, float* lds) {
    const int tid = TID();
    float* sc = lds;
    float* red = lds + 5120;
    for (int i = tid; i < 5120; i += NTHREADS) { const int r = i >> 10, k = i & 1023; const float v = (r == 0) ? p.in[6][k] : p.in[5][(r - 1) * 1024 + k]; sc[i] = siluf_(v); }
    __syncthreads();
    const int kg = tid >> 5, c = tid & 31, col = cc * 32 + c;
    float a[5] = {0.f, 0.f, 0.f, 0.f, 0.f};
    const float* w = p.in[7] + (size_t)l * 1024 * 3072 + col;
    for (int k = kg * 64; k < kg * 64 + 64; ++k) { const float wv = w[(size_t)k * 3072];
#pragma unroll
        for (int r = 0; r < 5; ++r) a[r] += sc[r * 1024 + k] * wv; }
#pragma unroll
    for (int r = 0; r < 5; ++r) red[(kg * 5 + r) * 32 + c] = a[r];
    __syncthreads();
    if (tid < 160) { const int r = tid >> 5, c2 = tid & 31; float s = p.in[8][l * 3072 + cc * 32 + c2];
        for (int g = 0; g < 16; ++g) s += red[(g * 5 + r) * 32 + c2];
        ((float*)(p.ws + WS_MOD))[(l * 5 + r) * 3072 + cc * 32 + c2] = s; }
    __syncthreads();
}

__device__ void phase0(const Params& p, unsigned char* lds) {
    const int NCONV_IN = 2 * 16 * 114, NCONV_UP = 8 * 64, NCONV_O = 2 * 256, NMOD = 192;
    const int total = NCONV_IN + NCONV_UP + NCONV_O + NMOD + 1;
    for (int it = blockIdx.x; it < total; it += gridDim.x) {
        int i = it;
        if (i < NCONV_IN) { const int l = i / 1824, r = i % 1824, nt = r / 16, kt = r % 16;
            conv_tile(p.in[10] + (size_t)l * 1024 * INW, INW, (bf16_t*)(p.ws + WS_WTIN) + (size_t)l * INW * 1024, 1024, kt, nt, (float*)lds); continue; }
        i -= NCONV_IN;
        if (i < NCONV_UP) { const int mtx = i / 64, r = i % 64, nt = r / 4, kt = r % 4;
            conv_tile(p.in[25] + (size_t)mtx * 256 * 1024, 1024, (bf16_t*)(p.ws + WS_WTUP) + (size_t)mtx * 1024 * 256, 256, kt, nt, (float*)lds); continue; }
        i -= NCONV_UP;
        if (i < NCONV_O) { const int l = i / 256, r = i % 256, nt = r / 16, kt = r % 16;
            conv_tile(p.in[26] + (size_t)l * 1024 * 1024, 1024, (bf16_t*)(p.ws + WS_WTO) + (size_t)l * 1024 * 1024, 1024, kt, nt, (float*)lds); continue; }
        i -= NCONV_O;
        if (i < NMOD) { mod_item(p, i / 96, i % 96, (float*)lds); continue; }
        for (int e = TID(); e < 1024; e += NTHREADS) { const int pos = e >> 4, f = e & 15;
            const float inv = exp2f(-(float)f * (13.287712379549449f / 16.0f)); const float ang = (float)pos * inv;
            float sn, cs; sn = sinf(ang); cs = cosf(ang);
            ((f32x2*)(p.ws + WS_ROPE))[e] = (f32x2){cs, sn}; }
        if (TID() < 64) ((unsigned*)(p.ws + WS_CTR))[TID()] = 0u;
    }
}

__device__ __forceinline__ const float* xrow_ptr(const Params& p, int l, int row) {
    if (l == 0) return row < NTP ? p.in[0] + (size_t)row * DM : p.in[1] + (size_t)(row - NTP) * DM;
    return p.out + (size_t)row * DM;
}
__device__ void phaseA0(const Params& p, int l) {
    const int lane = TID() & 63, gw = blockIdx.x * 8 + (TID() >> 6), W = gridDim.x * 8;
    const float* g = p.in[9] + l * DM;
    bf16_t* H = (bf16_t*)(p.ws + WS_H);
    for (int row = gw; row < NT; row += W) {
        const float* x = xrow_ptr(p, l, row);
        f32x4 v[4]; float ss = 0.f;
#pragma unroll
        for (int i = 0; i < 4; ++i) { v[i] = *(const f32x4*)(x + i * 256 + lane * 4); ss += v[i][0] * v[i][0] + v[i][1] * v[i][1] + v[i][2] * v[i][2] + v[i][3] * v[i][3]; }
        ss = wave_sum(ss);
        const float rs = rsqrtf(ss * (1.0f / 1024.0f) + 1e-6f);
        const float* mod = (const float*)(p.ws + WS_MOD) + (size_t)(l * 5 + modrow_of(row)) * 3072;
#pragma unroll
        for (int i = 0; i < 4; ++i) { const int c = i * 256 + lane * 4;
            const f32x4 gg = *(const f32x4*)(g + c), sh = *(const f32x4*)(mod + c), scl = *(const f32x4*)(mod + 1024 + c);
            f32x4 h = v[i] * rs * gg * (1.0f + scl) + sh;
            u32x2 w; w[0] = cvt_pk_bf16(h[0], h[1]); w[1] = cvt_pk_bf16(h[2], h[3]);
            *(u32x2*)(H + (size_t)row * DM + c) = w; }
    }
}

template <int MT>
__device__ __forceinline__ void gemm_acc(const bf16_t* __restrict__ A, int lda, const bf16_t* __restrict__ B, int ldb, int K, f32x4 (&acc)[MT][4], unsigned char* lds) {
    constexpr int BM = MT * 64, LDT = 72, A_BYTES = BM * LDT * 2, B_BYTES = 128 * LDT * 2, BUF = A_BYTES + B_BYTES;
    const int tid = TID(), lane = tid & 63, wid = tid >> 6, wr = wid >> 1, wc = wid & 1, fr = lane & 15, fq = lane >> 4;
    u32x4 ra[MT], rb[2];
    const int srow = tid >> 3, skc = tid & 7;
    const bf16_t* Ag = A + (size_t)srow * lda + skc * 8;
    const bf16_t* Bg = B + (size_t)srow * ldb + skc * 8;
    const int soff = (srow * LDT + skc * 8) * 2;
    const int nt = K >> 6;
    __syncthreads();
#pragma unroll
    for (int i = 0; i < MT; ++i) ra[i] = *(const u32x4*)(Ag + (size_t)i * 64 * lda);
#pragma unroll
    for (int i = 0; i < 2; ++i) rb[i] = *(const u32x4*)(Bg + (size_t)i * 64 * ldb);
#pragma unroll
    for (int i = 0; i < MT; ++i) *(u32x4*)(lds + soff + i * 64 * LDT * 2) = ra[i];
#pragma unroll
    for (int i = 0; i < 2; ++i) *(u32x4*)(lds + A_BYTES + soff + i * 64 * LDT * 2) = rb[i];
    __syncthreads();
    const int aoff = ((wr * MT * 16 + fr) * LDT + fq * 8) * 2, boff = A_BYTES + ((wc * 64 + fr) * LDT + fq * 8) * 2;
    for (int t = 0; t < nt; ++t) {
        if (t + 1 < nt) {
#pragma unroll
            for (int i = 0; i < MT; ++i) ra[i] = *(const u32x4*)(Ag + (size_t)i * 64 * lda + (t + 1) * 64);
#pragma unroll
            for (int i = 0; i < 2; ++i) rb[i] = *(const u32x4*)(Bg + (size_t)i * 64 * ldb + (t + 1) * 64);
        }
        const unsigned char* base = lds + (t & 1) * BUF;
#pragma unroll
        for (int kk = 0; kk < 2; ++kk) {
            bf16x8 af[MT], bfr[4];
#pragma unroll
            for (int m = 0; m < MT; ++m) af[m] = *(const bf16x8*)(base + aoff + m * 16 * LDT * 2 + kk * 64);
#pragma unroll
            for (int n = 0; n < 4; ++n) bfr[n] = *(const bf16x8*)(base + boff + n * 16 * LDT * 2 + kk * 64);
#pragma unroll
            for (int m = 0; m < MT; ++m)
#pragma unroll
                for (int n = 0; n < 4; ++n) acc[m][n] = __builtin_amdgcn_mfma_f32_16x16x32_bf16(bfr[n], af[m], acc[m][n], 0, 0, 0);
        }
        if (t + 1 < nt) {
            unsigned char* nb = lds + ((t + 1) & 1) * BUF;
#pragma unroll
            for (int i = 0; i < MT; ++i) *(u32x4*)(nb + soff + i * 64 * LDT * 2) = ra[i];
#pragma unroll
            for (int i = 0; i < 2; ++i) *(u32x4*)(nb + A_BYTES + soff + i * 64 * LDT * 2) = rb[i];
        }
        __syncthreads();
    }
}
template <int MT> __device__ __forceinline__ void zero_acc(f32x4 (&acc)[MT][4]) {
#pragma unroll
    for (int m = 0; m < MT; ++m)
#pragma unroll
        for (int n = 0; n < 4; ++n) acc[m][n] = (f32x4){0.f, 0.f, 0.f, 0.f};
}

__device__ void phaseA(const Params& p, int l, unsigned char* lds) {
    const int tid = TID(), lane = tid & 63, wid = tid >> 6, wr = wid >> 1, wc = wid & 1, fr = lane & 15, fq = lane >> 4;
    const bf16_t* H = (const bf16_t*)(p.ws + WS_H);
    const bf16_t* Wt = (const bf16_t*)(p.ws + WS_WTIN) + (size_t)l * INW * 1024;
    float* P = (float*)(p.ws + WS_P);
    bf16_t* Z = (bf16_t*)(p.ws + WS_Z);
    const int NU = 32 * 25;
    for (int u = blockIdx.x; u < NU; u += gridDim.x) {
        const int pn = u / 32, pm = u % 32;
        f32x4 acc[4][4]; zero_acc<4>(acc);
        gemm_acc<4>(H + (size_t)pm * 256 * 1024, 1024, Wt + (size_t)pn * 128 * 1024, 1024, 1024, acc, lds);
        const int cbase = pn * 128 + wc * 64;
#pragma unroll
        for (int m = 0; m < 4; ++m) {
            const int row = pm * 256 + wr * 64 + m * 16 + fr;
#pragma unroll
            for (int n = 0; n < 4; ++n) {
                const int col = cbase + n * 16 + fq * 4;
                const f32x4 v = acc[m][n];
                if (cbase < PW) {
                    *(f32x4*)(P + (size_t)row * PW + col) = v;
                    if (cbase >= C_CK && cbase < C_DP && row < NTP) {
                        const int b = row >> 8, s = row & 255;
                        const size_t o = (cbase < C_CV ? O_NK : O_NV) + ((size_t)((b * 2 + l) * 256 + s)) * 128 + (col - (cbase < C_CV ? C_CK : C_CV));
                        *(f32x4*)(p.out + o) = v;
                    }
                } else {
                    u32x2 w; w[0] = cvt_pk_bf16(siluf_(v[0]), siluf_(v[1])); w[1] = cvt_pk_bf16(siluf_(v[2]), siluf_(v[3]));
                    *(u32x2*)(Z + (size_t)row * DM + (col - PW)) = w;
                }
            }
        }
    }
}

__device__ void phaseB0(const Params& p, int l, unsigned char* ldsb) {
    const int tid = TID(), lane = tid & 63, half = tid >> 8, c = tid & 255, h = c >> 6, j6 = c & 63;
    float* wdt = (float*)ldsb;
    float* adv = wdt + 1024;
    const float* P = (const float*)(p.ws + WS_P);
    float* recS = (float*)(p.ws + WS_RECS);
    float* recD = (float*)(p.ws + WS_RECD);
    float* BC = (float*)(p.ws + WS_BC);
    const float* w_up = p.in[14] + (size_t)l * 2 * 64 * 256;
    const float* a_up = p.in[16] + (size_t)l * 2 * 64 * 256;
    const float kkc = p.in[17][l * 256 + c], kac = p.in[18][l * 256 + c], rkc = p.in[19][l * 256 + c];
    float w0c[2], a0c[2];
    w0c[0] = p.in[13][(l * 2 + 0) * 256 + c]; w0c[1] = p.in[13][(l * 2 + 1) * 256 + c];
    a0c[0] = p.in[15][(l * 2 + 0) * 256 + c]; a0c[1] = p.in[15][(l * 2 + 1) * 256 + c];
    for (int it = blockIdx.x; it < NT / 16; it += gridDim.x) {
        const int tb = it * 16;
        __syncthreads();
#pragma unroll
        for (int i = 0; i < 4; ++i) { const int idx = tid + i * 512, tk = idx >> 7, j = idx & 127; const float v = P[(size_t)(tb + tk) * PW + C_WD + j];
            if (j < 64) wdt[tk * 64 + j] = tanhf(v); else adv[tk * 64 + j - 64] = v; }
        __syncthreads();
        float aw[2][8], aa[2][8];
#pragma unroll
        for (int i = 0; i < 8; ++i) { aw[0][i] = 0.f; aw[1][i] = 0.f; aa[0][i] = 0.f; aa[1][i] = 0.f; }
        for (int j = 0; j < 64; j += 4) {
            float wu[2][4], au[2][4];
#pragma unroll
            for (int jj = 0; jj < 4; ++jj) { wu[0][jj] = w_up[(size_t)(0 * 64 + j + jj) * 256 + c]; wu[1][jj] = w_up[(size_t)(1 * 64 + j + jj) * 256 + c];
                au[0][jj] = a_up[(size_t)(0 * 64 + j + jj) * 256 + c]; au[1][jj] = a_up[(size_t)(1 * 64 + j + jj) * 256 + c]; }
#pragma unroll
            for (int i = 0; i < 8; ++i) { const f32x4 wv = *(const f32x4*)(wdt + (half * 8 + i) * 64 + j), av = *(const f32x4*)(adv + (half * 8 + i) * 64 + j);
#pragma unroll
                for (int jj = 0; jj < 4; ++jj) { aw[0][i] += wv[jj] * wu[0][jj]; aw[1][i] += wv[jj] * wu[1][jj]; aa[0][i] += av[jj] * au[0][jj]; aa[1][i] += av[jj] * au[1][jj]; } }
        }
#pragma unroll
        for (int i = 0; i < 8; ++i) {
            const int tok = tb + half * 8 + i; int seqbase, L, pos; seq_of(tok, seqbase, L, pos);
            const float* pr = P + (size_t)tok * PW;
            const float r = pr[C_BR + c], k = pr[C_BK + c], v = pr[C_BV + c];
            const float kkr = k * kkc; const float ss = wave_sum(kkr * kkr); const float kk = kkr * rsqrtf(ss + 1e-12f);
            const size_t ridx = ((size_t)seqbase * 4 + (size_t)h * L + pos) * 192 + j6;
            recS[ridx] = r; recS[ridx + 64] = kk; recS[ridx + 128] = v;
            float bsum = 0.f;
#pragma unroll
            for (int d = 0; d < 2; ++d) {
                const float wl = w0c[d] + aw[d][i];
                const float nx = -wl; const float sp = fmaxf(nx, 0.f) + log1pf(expf(-fabsf(nx)));
                const float wlog = -sp - 0.5f; const float dec = expf(-expf(wlog));
                const float a = 1.0f / (1.0f + expf(-(a0c[d] + aa[d][i])));
                const float kd = k * (1.0f + (a - 1.0f) * kac);
                float* rd = recD + (size_t)d * RECD_STRIDE + ridx;
                rd[0] = dec; rd[64] = kk * a; rd[128] = kd;
                bsum += r * kd * rkc;
            }
            bsum = wave_sum(bsum);
            if (lane == 0) BC[tok * 4 + h] = bsum;
        }
    }
}

__device__ void scan_item(const Params& p, int l, int item, float* wl  ) {
    const int lane = TID() & 63, rl = lane >> 4, kl = lane & 15;
    int b, h, dir, rg, L, seqbase; bool sample;
    if (item < 512) { sample = true; rg = item & 15; const int q = item >> 4; dir = q & 1; h = (q >> 1) & 3; b = q >> 3; L = 1024; seqbase = NTP + b * 1024; }
    else { sample = false; const int idx = item - 512; rg = idx & 15; const int q = idx >> 4; dir = q & 1; h = (q >> 1) & 3; b = q >> 3; L = 256; seqbase = b * 256; }
    const int row = rg * 4 + rl;
    f32x4 S;
    const size_t sidx = ((size_t)(((b * 2 + l) * 2 + dir) * 4 + h)) * 4096 + row * 64 + kl * 4;
    if (sample) S = *(const f32x4*)(p.in[4] + sidx); else S = (f32x4){0.f, 0.f, 0.f, 0.f};
    const float* gS = (const float*)(p.ws + WS_RECS) + ((size_t)seqbase * 4 + (size_t)h * L) * 192;
    const float* gD = (const float*)(p.ws + WS_RECD) + (size_t)dir * RECD_STRIDE + ((size_t)seqbase * 4 + (size_t)h * L) * 192;
    float* O = (float*)(p.ws + WS_O) + (size_t)dir * NT * 256 + (size_t)seqbase * 256 + h * 64 + row;
    const int nch = L >> 2;
    f32x4 rA[6], rB[6];
    auto gl = [&](f32x4 (&r)[6], int c) {
        const int pos0 = dir ? (L - 4 * (c + 1)) : 4 * c;
        const float* s = gS + (size_t)pos0 * 192 + lane * 4; const float* d = gD + (size_t)pos0 * 192 + lane * 4;
#pragma unroll
        for (int i = 0; i < 3; ++i) { r[i] = *(const f32x4*)(s + i * 256); r[3 + i] = *(const f32x4*)(d + i * 256); }
    };
    auto st = [&](const f32x4 (&r)[6], float* buf) {
#pragma unroll
        for (int i = 0; i < 3; ++i) { *(f32x4*)(buf + i * 256 + lane * 4) = r[i]; *(f32x4*)(buf + 768 + i * 256 + lane * 4) = r[3 + i]; }
    };
    auto compute = [&](const float* buf, int c) {
        __builtin_amdgcn_wave_barrier();
#pragma unroll
        for (int s = 0; s < 4; ++s) {
            const int tc = dir ? 3 - s : s;
            const int pos = dir ? (L - 1 - (4 * c + s)) : (4 * c + s);
            const float* bs = buf + tc * 192; const float* bd = buf + 768 + tc * 192;
            const f32x4 r4 = *(const f32x4*)(bs + kl * 4), kk4 = *(const f32x4*)(bs + 64 + kl * 4);
            const float vv = bs[128 + row];
            const f32x4 w4 = *(const f32x4*)(bd + kl * 4), ka4 = *(const f32x4*)(bd + 64 + kl * 4), kd4 = *(const f32x4*)(bd + 128 + kl * 4);
            float sa = (S[0] * kk4[0] + S[1] * kk4[1]) + (S[2] * kk4[2] + S[3] * kk4[3]);
            sa = row16_sum(sa);
            S = S * w4 - sa * ka4 + vv * kd4;
            float o = (S[0] * r4[0] + S[1] * r4[1]) + (S[2] * r4[2] + S[3] * r4[3]);
            o = row16_sum(o);
            if (kl == 0) O[(size_t)pos * 256] = o;
        }
        __builtin_amdgcn_wave_barrier();
    };
    gl(rA, 0); gl(rB, 1);
    for (int c = 0; c < nch; c += 2) {
        st(rA, wl); if (c + 2 < nch) gl(rA, c + 2); compute(wl, c);
        st(rB, wl + 1536); if (c + 3 < nch) gl(rB, c + 3); compute(wl + 1536, c + 1);
    }
    if (!sample) *(f32x4*)(p.out + O_NS + sidx) = S;
}

__device__ __forceinline__ void stage_qk(const float* __restrict__ src, int stride, bf16_t* dst, bool rope, int pos0, float scale, const f32x2* __restrict__ rt) {
    const int tid = TID();
#pragma unroll
    for (int i = 0; i < 2; ++i) {
        const int task = tid + i * 512, row = task >> 3, half = (task >> 2) & 1, quad = task & 3;
        const float* s = src + (size_t)row * stride + half * 32 + quad * 4;
        f32x4 x1 = *(const f32x4*)s, x2 = *(const f32x4*)(s + 16);
        if (rope) { const int pos = pos0 + row; const int pi = half ? (pos & 63) : (pos >> 6);
#pragma unroll
            for (int j = 0; j < 4; ++j) { const f32x2 cs = rt[pi * 16 + quad * 4 + j]; const float a = x1[j], b = x2[j]; x1[j] = a * cs[0] - b * cs[1]; x2[j] = b * cs[0] + a * cs[1]; } }
        x1 *= scale; x2 *= scale;
        u32x2 w1, w2; w1[0] = cvt_pk_bf16(x1[0], x1[1]); w1[1] = cvt_pk_bf16(x1[2], x1[3]); w2[0] = cvt_pk_bf16(x2[0], x2[1]); w2[1] = cvt_pk_bf16(x2[2], x2[3]);
        *(u32x2*)(dst + row * 72 + half * 32 + quad * 4) = w1; *(u32x2*)(dst + row * 72 + half * 32 + 16 + quad * 4) = w2;
    }
}
__device__ __forceinline__ void stage_vt(const float* __restrict__ src, int stride, bf16_t* vt) {
    const int tid = TID();
#pragma unroll
    for (int i = 0; i < 4; ++i) { const int task = tid + i * 512, key = task >> 4, dq = task & 15;
        const f32x4 v = *(const f32x4*)(src + (size_t)key * stride + dq * 4);
#pragma unroll
        for (int j = 0; j < 4; ++j) vt[(dq * 4 + j) * 136 + key] = f2bf(v[j]); }
}
__device__ void attn_item(const Params& p, int l, int ai, unsigned char* lds) {
    const int tid = TID(), lane = tid & 63, wid = tid >> 6, fr = lane & 15, fq = lane >> 4;
    bf16_t* Qs = (bf16_t*)lds; bf16_t* Ks = Qs + 128 * 72; bf16_t* Vt = Ks + 128 * 72;
    const float* P = (const float*)(p.ws + WS_P);
    const bf16_t* Z = (const bf16_t*)(p.ws + WS_Z);
    bf16_t* YS = (bf16_t*)(p.ws + WS_YS);
    const f32x2* rt = (const f32x2*)(p.ws + WS_ROPE);
    bool sample; int b, head, qt, seqbase;
    if (ai < 128) { sample = true; b = ai >> 5; head = (ai >> 3) & 3; qt = ai & 7; seqbase = NTP + b * 1024; }
    else { const int j = ai - 128; sample = false; b = j >> 3; head = (j >> 1) & 3; qt = j & 1; seqbase = b * 256; }
    const int kh = head >> 1, qbase = seqbase + qt * 128;
    __syncthreads();
    stage_qk(P + (size_t)qbase * PW + C_CQ + head * 64, PW, Qs, sample, qt * 128, 0.125f, rt);
    __syncthreads();
    bf16x8 qf[2];
    qf[0] = *(const bf16x8*)(Qs + (wid * 16 + fr) * 72 + fq * 8); qf[1] = *(const bf16x8*)(Qs + (wid * 16 + fr) * 72 + 32 + fq * 8);
    float m = p.in[22][l * 4 + head], lsum = 1.0f;
    f32x4 oacc[4];
#pragma unroll
    for (int i = 0; i < 4; ++i) oacc[i] = (f32x4){0.f, 0.f, 0.f, 0.f};
    const int nkb = sample ? 7 : 2;
    const int qpos = qt * 128 + wid * 16 + fr;
    for (int kb = 0; kb < nkb; ++kb) {
        const float* ksrc; const float* vsrc; int stride; bool rope = false, mask = false; int kpos0 = 0;
        if (!sample) { ksrc = P + (size_t)(seqbase + kb * 128) * PW + C_CK + kh * 64; vsrc = ksrc + (C_CV - C_CK); stride = PW; }
        else if (kb < 3) { const int nbk = qt - 1 + kb; if (nbk < 0 || nbk >= 8) continue; kpos0 = nbk * 128;
            ksrc = P + (size_t)(seqbase + kpos0) * PW + C_CK + kh * 64; vsrc = ksrc + (C_CV - C_CK); stride = PW; rope = true; mask = (kb != 1); }
        else { const size_t o = ((size_t)((b * 2 + l) * 512 + (kb - 3) * 128) * 2 + kh) * 64; ksrc = p.in[2] + o; vsrc = p.in[3] + o; stride = 128; }
        __syncthreads();
        stage_qk(ksrc, stride, Ks, rope, kpos0, 1.0f, rt);
        stage_vt(vsrc, stride, Vt);
        __syncthreads();
#pragma unroll
        for (int sb = 0; sb < 4; ++sb) {
            f32x4 s0 = (f32x4){0.f, 0.f, 0.f, 0.f}, s1 = s0;
#pragma unroll
            for (int dh = 0; dh < 2; ++dh) {
                const bf16x8 k0 = *(const bf16x8*)(Ks + (sb * 32 + fr) * 72 + dh * 32 + fq * 8), k1 = *(const bf16x8*)(Ks + (sb * 32 + 16 + fr) * 72 + dh * 32 + fq * 8);
                s0 = __builtin_amdgcn_mfma_f32_16x16x32_bf16(k0, qf[dh], s0, 0, 0, 0);
                s1 = __builtin_amdgcn_mfma_f32_16x16x32_bf16(k1, qf[dh], s1, 0, 0, 0);
            }
            if (mask) {
#pragma unroll
                for (int j = 0; j < 4; ++j) { const int k0p = kpos0 + sb * 32 + fq * 4 + j, k1p = k0p + 16; int d0 = qpos - k0p, d1 = qpos - k1p; d0 = d0 < 0 ? -d0 : d0; d1 = d1 < 0 ? -d1 : d1;
                    if (d0 > 128) s0[j] = -1e30f; if (d1 > 128) s1[j] = -1e30f; }
            }
            float mx = fmaxf(fmaxf(fmaxf(s0[0], s0[1]), fmaxf(s0[2], s0[3])), fmaxf(fmaxf(s1[0], s1[1]), fmaxf(s1[2], s1[3])));
            mx = fmaxf(mx, __shfl_xor(mx, 16)); mx = fmaxf(mx, __shfl_xor(mx, 32));
            const float mn = fmaxf(m, mx), alpha = __expf(m - mn);
            float rs = 0.f;
#pragma unroll
            for (int j = 0; j < 4; ++j) { s0[j] = __expf(s0[j] - mn); s1[j] = __expf(s1[j] - mn); rs += s0[j] + s1[j]; }
            rs += __shfl_xor(rs, 16); rs += __shfl_xor(rs, 32);
            lsum = lsum * alpha + rs; m = mn;
            u32x4 pw; pw[0] = cvt_pk_bf16(s0[0], s0[1]); pw[1] = cvt_pk_bf16(s0[2], s0[3]); pw[2] = cvt_pk_bf16(s1[0], s1[1]); pw[3] = cvt_pk_bf16(s1[2], s1[3]);
            bf16x8 pf; __builtin_memcpy(&pf, &pw, 16);
#pragma unroll
            for (int dt = 0; dt < 4; ++dt) {
                const bf16_t* vp = Vt + (dt * 16 + fr) * 136 + sb * 32 + fq * 4;
                u32x4 vw; const u32x2 va = *(const u32x2*)vp, vb = *(const u32x2*)(vp + 16); vw[0] = va[0]; vw[1] = va[1]; vw[2] = vb[0]; vw[3] = vb[1];
                bf16x8 vf; __builtin_memcpy(&vf, &vw, 16);
                oacc[dt] = oacc[dt] * alpha;
                oacc[dt] = __builtin_amdgcn_mfma_f32_16x16x32_bf16(vf, pf, oacc[dt], 0, 0, 0);
            }
        }
    }
    const float inv = 1.0f / lsum;
    const size_t t = (size_t)(qbase + wid * 16 + fr);
#pragma unroll
    for (int dt = 0; dt < 4; ++dt) {
        const int col = 512 + head * 64 + dt * 16 + fq * 4;
        const bf16x4 z = *(const bf16x4*)(Z + t * DM + col);
        u32x2 w; w[0] = cvt_pk_bf16(oacc[dt][0] * inv * bf2f((bf16_t)z[0]), oacc[dt][1] * inv * bf2f((bf16_t)z[1]));
        w[1] = cvt_pk_bf16(oacc[dt][2] * inv * bf2f((bf16_t)z[2]), oacc[dt][3] * inv * bf2f((bf16_t)z[3]));
        *(u32x2*)(YS + t * DM + col) = w;
    }
}

__device__ void chunk_item(const Params& p, int l, int ci, unsigned char* ldsb) {
    const int tid = TID(), d = tid & 63, ig = tid >> 6;
    const int chunk = ci >> 2, g = ci & 3, base = chunk * 128;
    float* ws = (float*)ldsb;
    float* vt = ws + 128 * 128;
    const float* P = (const float*)(p.ws + WS_P);
    const bf16_t* Z = (const bf16_t*)(p.ws + WS_Z);
    bf16_t* YS = (bf16_t*)(p.ws + WS_YS);
    const float* wsrc = p.in[11] + (size_t)(l * 4 + g) * 128 * 128;
    __syncthreads();
#pragma unroll
    for (int i = 0; i < 8; ++i) { const int idx = tid + i * 512; *(f32x4*)(ws + idx * 4) = *(const f32x4*)(wsrc + idx * 4); }
#pragma unroll
    for (int i = 0; i < 4; ++i) { const int idx = tid + i * 512, j = idx >> 4, d4 = (idx & 15) * 4; *(f32x4*)(vt + j * 64 + d4) = *(const f32x4*)(P + (size_t)(base + j) * PW + C_AV + g * 64 + d4); }
    __syncthreads();
    float acc[16];
#pragma unroll
    for (int ii = 0; ii < 16; ++ii) acc[ii] = 0.f;
    for (int j = 0; j < 128; j += 4) {
        const float v0 = vt[(j + 0) * 64 + d], v1 = vt[(j + 1) * 64 + d], v2 = vt[(j + 2) * 64 + d], v3 = vt[(j + 3) * 64 + d];
#pragma unroll
        for (int ii = 0; ii < 16; ++ii) { const f32x4 w4 = *(const f32x4*)(ws + (ig * 16 + ii) * 128 + j); acc[ii] += (w4[0] * v0 + w4[1] * v1) + (w4[2] * v2 + w4[3] * v3); }
    }
    const float* bs = p.in[12] + (l * 4 + g) * 128;
#pragma unroll
    for (int ii = 0; ii < 16; ++ii) { const int i = ig * 16 + ii; const size_t t = base + i;
        const float u = P[t * PW + C_AU + g * 64 + d];
        const float y = u * (acc[ii] + bs[i]);
        YS[t * DM + g * 64 + d] = f2bf(y * bf2f(Z[t * DM + g * 64 + d])); }
}

__device__ void pool_item(const Params& p, int l, int pi, unsigned char* ldsb) {
    const int tid = TID(), half = tid >> 8, ch = tid & 255, g = ch >> 6;
    const int tb = pi * 32; int seqbase, L, pos0; seq_of(tb, seqbase, L, pos0);
    float* pt = (float*)ldsb;
    float* dl = pt + 48 * 256;
    const float* P = (const float*)(p.ws + WS_P);
    const bf16_t* Z = (const bf16_t*)(p.ws + WS_Z);
    bf16_t* YS = (bf16_t*)(p.ws + WS_YS);
    __syncthreads();
#pragma unroll
    for (int i = 0; i < 6; ++i) { const int idx = tid + i * 512, rr = idx >> 6, c4 = (idx & 63) * 4; const int pos = pos0 - 8 + rr;
        f32x4 v = (f32x4){0.f, 0.f, 0.f, 0.f};
        if (pos >= 0 && pos < L) v = *(const f32x4*)(P + (size_t)(seqbase + pos) * PW + C_DP + c4);
        *(f32x4*)(pt + rr * 256 + c4) = v; }
    __syncthreads();
    const int w = 2 << g;
    for (int i = 0; i < 16; ++i) { const int tk = half * 16 + i, pos = pos0 + tk;
        int lo = pos - (w >> 1), hi = lo + w; lo = lo < 0 ? 0 : lo; hi = hi > L ? L : hi;
        float s = 0.f;
        for (int q = lo; q < hi; ++q) s += pt[(q - pos0 + 8) * 256 + ch];
        dl[tk * 256 + ch] = s / (float)(hi - lo) - pt[(tk + 8) * 256 + ch]; }
    __syncthreads();
    float acc[16];
#pragma unroll
    for (int i = 0; i < 16; ++i) acc[i] = 0.f;
    const float* pw = p.in[23] + (size_t)(l * 4 + g) * 64 * 64 + (ch & 63);
    for (int c = 0; c < 64; c += 4) {
        const float w0 = pw[(c + 0) * 64], w1 = pw[(c + 1) * 64], w2 = pw[(c + 2) * 64], w3 = pw[(c + 3) * 64];
#pragma unroll
        for (int i = 0; i < 16; ++i) { const f32x4 dv = *(const f32x4*)(dl + (half * 16 + i) * 256 + g * 64 + c); acc[i] += (dv[0] * w0 + dv[1] * w1) + (dv[2] * w2 + dv[3] * w3); }
    }
    const float sc = p.in[24][l * 256 + ch];
#pragma unroll
    for (int i = 0; i < 16; ++i) { const size_t t = tb + half * 16 + i;
        YS[t * DM + 768 + ch] = f2bf(acc[i] * sc * bf2f(Z[t * DM + 768 + ch])); }
}

__device__ void phaseB1(const Params& p, int l, unsigned char* lds, int slot = 0) {
    const int tid = TID(), wid = tid >> 6;
    float* wl = (float*)lds + wid * 3072;
    if (wid < 2) { for (int it = blockIdx.x * 2 + wid; it < 512; it += gridDim.x * 2) scan_item(p, l, it, wl); }
    else if (wid != 4 && wid != 5) { const int pw = (wid < 4) ? wid - 2 : wid - 4;
        for (int it = blockIdx.x * 4 + pw; it < 2048; it += gridDim.x * 4) scan_item(p, l, 512 + it, wl); }
    __syncthreads();
    __shared__ int s_item;
    unsigned* ctr = (unsigned*)(p.ws + WS_CTR) + l + 2 * slot;
    for (;;) {
        if (tid == 0) s_item = (int)atomicAdd(ctr, 1u);
        __syncthreads();
        const int item = s_item;
        __syncthreads();
        if (item >= 768) break;
        if (item < 256) attn_item(p, l, item, lds);
        else if (item < 512) chunk_item(p, l, item - 256, lds);
        else pool_item(p, l, item - 512, lds);
    }
}

__device__ void phaseB2(const Params& p, int l) {
    const int lane = TID() & 63, gw = blockIdx.x * 8 + (TID() >> 6), W = gridDim.x * 8;
    const float* O = (const float*)(p.ws + WS_O);
    const float* P = (const float*)(p.ws + WS_P);
    const float* BC = (const float*)(p.ws + WS_BC);
    const bf16_t* Z = (const bf16_t*)(p.ws + WS_Z);
    bf16_t* YS = (bf16_t*)(p.ws + WS_YS);
    for (int it = gw; it < NT * 4; it += W) {
        const int tok = it >> 2, h = it & 3, c = h * 64 + lane;
        const float o = O[(size_t)tok * 256 + c] + O[(size_t)NT * 256 + (size_t)tok * 256 + c];
        const float mu = wave_sum(o) * (1.0f / 64.0f);
        const float dlt = o - mu;
        const float var = wave_sum(dlt * dlt) * (1.0f / 64.0f);
        const float on = dlt * rsqrtf(var + 64e-5f);
        const float y = on * p.in[20][l * 256 + c] + p.in[21][l * 256 + c] + BC[tok * 4 + h] * P[(size_t)tok * PW + C_BV + c];
        YS[(size_t)tok * DM + 256 + c] = f2bf(y * bf2f(Z[(size_t)tok * DM + 256 + c]));
    }
}

__device__ void phaseC(const Params& p, int l, unsigned char* lds) {
    const int tid = TID(), lane = tid & 63, wid = tid >> 6, wr = wid >> 1, wc = wid & 1, fr = lane & 15, fq = lane >> 4;
    const bf16_t* H = (const bf16_t*)(p.ws + WS_H);
    const bf16_t* YS = (const bf16_t*)(p.ws + WS_YS);
    const bf16_t* Wt = (const bf16_t*)(p.ws + WS_WTIN) + (size_t)l * INW * 1024 + (size_t)NA_COLS * 1024;
    const bf16_t* Wu = (const bf16_t*)(p.ws + WS_WTUP) + (size_t)l * 4 * 1024 * 256;
    bf16_t* MG = (bf16_t*)(p.ws + WS_MERGED);
    const int NU = 64 * 8;
    for (int u = blockIdx.x; u < NU; u += gridDim.x) {
        const int pn = u / 64, pm = u % 64;
        f32x4 mg[2][4]; zero_acc<2>(mg);
#pragma unroll 1
        for (int n = 0; n < 4; ++n) {
            f32x4 a1[2][4]; zero_acc<2>(a1);
            gemm_acc<2>(H + (size_t)pm * 128 * 1024, 1024, Wt + (size_t)(n * 1024 + pn * 128) * 1024, 1024, 1024, a1, lds);
#pragma unroll
            for (int m = 0; m < 2; ++m)
#pragma unroll
                for (int q = 0; q < 4; ++q)
#pragma unroll
                    for (int j = 0; j < 4; ++j) a1[m][q][j] = sigmoidf_(a1[m][q][j]);
            f32x4 a2[2][4]; zero_acc<2>(a2);
            gemm_acc<2>(YS + (size_t)pm * 128 * 1024 + n * 256, 1024, Wu + (size_t)(n * 1024 + pn * 128) * 256, 256, 256, a2, lds);
#pragma unroll
            for (int m = 0; m < 2; ++m)
#pragma unroll
                for (int q = 0; q < 4; ++q) mg[m][q] += a1[m][q] * a2[m][q];
        }
#pragma unroll
        for (int m = 0; m < 2; ++m) { const size_t row = (size_t)pm * 128 + wr * 32 + m * 16 + fr;
#pragma unroll
            for (int q = 0; q < 4; ++q) { const int col = pn * 128 + wc * 64 + q * 16 + fq * 4;
                u32x2 w; w[0] = cvt_pk_bf16(mg[m][q][0], mg[m][q][1]); w[1] = cvt_pk_bf16(mg[m][q][2], mg[m][q][3]);
                *(u32x2*)(MG + row * DM + col) = w; } }
    }
}

__device__ void phaseD(const Params& p, int l, unsigned char* lds) {
    const int tid = TID(), lane = tid & 63, wid = tid >> 6, wr = wid >> 1, wc = wid & 1, fr = lane & 15, fq = lane >> 4;
    const bf16_t* MG = (const bf16_t*)(p.ws + WS_MERGED);
    const bf16_t* Wo = (const bf16_t*)(p.ws + WS_WTO) + (size_t)l * 1024 * 1024;
    const int NU = 64 * 8;
    for (int u = blockIdx.x; u < NU; u += gridDim.x) {
        const int pn = u / 64, pm = u % 64;
        f32x4 acc[2][4]; zero_acc<2>(acc);
        gemm_acc<2>(MG + (size_t)pm * 128 * 1024, 1024, Wo + (size_t)pn * 128 * 1024, 1024, 1024, acc, lds);
#pragma unroll
        for (int m = 0; m < 2; ++m) { const int row = pm * 128 + wr * 32 + m * 16 + fr;
            const float* xr = xrow_ptr(p, l, row);
            const float* gate = (const float*)(p.ws + WS_MOD) + (size_t)(l * 5 + modrow_of(row)) * 3072 + 2048;
#pragma unroll
            for (int q = 0; q < 4; ++q) { const int col = pn * 128 + wc * 64 + q * 16 + fq * 4;
                const f32x4 xo = *(const f32x4*)(xr + col), gt = *(const f32x4*)(gate + col);
                *(f32x4*)(p.out + (size_t)row * DM + col) = xo + gt * acc[m][q]; } }
    }
}

__device__ void phaseF(const Params& p) {
    const int lane = TID() & 63, gw = blockIdx.x * 8 + (TID() >> 6), W = gridDim.x * 8;
    const float* g = p.in[27];
    for (int row = gw; row < NT; row += W) {
        float* x = p.out + (size_t)row * DM;
        f32x4 v[4]; float ss = 0.f;
#pragma unroll
        for (int i = 0; i < 4; ++i) { v[i] = *(const f32x4*)(x + i * 256 + lane * 4); ss += v[i][0] * v[i][0] + v[i][1] * v[i][1] + v[i][2] * v[i][2] + v[i][3] * v[i][3]; }
        ss = wave_sum(ss);
        const float rs = rsqrtf(ss * (1.0f / 1024.0f) + 1e-6f);
#pragma unroll
        for (int i = 0; i < 4; ++i) { const int c = i * 256 + lane * 4; *(f32x4*)(x + c) = v[i] * rs * *(const f32x4*)(g + c); }
    }
}

__global__ void __launch_bounds__(NTHREADS) fwd_megakernel(Params p) {
    extern __shared__ __attribute__((aligned(16))) unsigned char lds[];
    cg::grid_group grid = cg::this_grid();
    volatile LAS unsigned* st = (volatile LAS unsigned*)(lds + LDS_MAIN);
    if (threadIdx.x < 2) st[threadIdx.x] = 0u;
    __syncthreads();
    const XcdBarrier xb = xcd_barrier_post((unsigned*)(p.ws + WS_BAR), st);
    phase0(p, lds);
    grid.sync();
#define GSYNC() xcd_barrier(xb)
#pragma unroll 1
    for (int l = 0; l < 2; ++l) {
        phaseA0(p, l);
        GSYNC();
        phaseA(p, l, lds);
        GSYNC();
#if DUP == 1
        phaseA(p, l, lds);
        GSYNC();
#endif
        phaseB0(p, l, lds);
        GSYNC();
#if DUP == 2
        phaseB0(p, l, lds);
        GSYNC();
#endif
        phaseB1(p, l, lds);
        GSYNC();
#if DUP == 3
        phaseB1(p, l, lds, 1);
        GSYNC();
#endif
        phaseB2(p, l);
        GSYNC();
        phaseC(p, l, lds);
        GSYNC();
#if DUP == 4
        phaseC(p, l, lds);
        GSYNC();
#endif
#if DUP == 5
        for (int r = 0; r < 8; ++r) GSYNC();
#endif
        phaseD(p, l, lds);
        GSYNC();
    }
    phaseF(p);
}

extern "C" void kernel_launch(void* const* d_in, const int* in_sizes, int n_in, void* d_out, int out_size, void* d_ws, size_t ws_size, hipStream_t stream) {
    static int grid_blocks = 0;
    if (!grid_blocks) {
        int dev = 0, cus = 0, per_cu = 0;
        hipGetDevice(&dev);
        hipDeviceGetAttribute(&cus, hipDeviceAttributeMultiprocessorCount, dev);
        hipFuncSetAttribute((const void*)fwd_megakernel, hipFuncAttributeMaxDynamicSharedMemorySize, LDS_BYTES);
        hipOccupancyMaxActiveBlocksPerMultiprocessor(&per_cu, (const void*)fwd_megakernel, NTHREADS, LDS_BYTES);
        if (per_cu < 1) { fprintf(stderr, "occupancy query returned %d\n", per_cu); per_cu = 1; }
        if (per_cu > 1) per_cu = 1;
        grid_blocks = cus * per_cu;
        if (ws_size < WS_END) fprintf(stderr, "workspace too small: %zu < %zu\n", ws_size, (size_t)WS_END);
    }
    Params p{};
    for (int i = 0; i < 28; ++i) p.in[i] = (const float*)d_in[i];
    p.out = (float*)d_out; p.ws = (unsigned char*)d_ws;
    hipMemsetAsync((char*)d_ws + WS_BAR, 0, 3456 * 4, stream);
    void* args[] = {&p};
    hipError_t e = hipLaunchCooperativeKernel((const void*)fwd_megakernel, dim3(grid_blocks), dim3(NTHREADS), args, LDS_BYTES, stream);
    if (e != hipSuccess) fprintf(stderr, "cooperative launch failed: %s (grid %d)\n", hipGetErrorString(e), grid_blocks);
}
```

```cpp
#include <hip/hip_runtime.h>
#include <hip/hip_cooperative_groups.h>
#include <cstdio>
namespace cg = cooperative_groups;

typedef unsigned short bf16_t;
typedef short bf16x8 __attribute__((ext_vector_type(8)));
typedef short bf16x4 __attribute__((ext_vector_type(4)));
typedef float f32x4 __attribute__((ext_vector_type(4)));
typedef float f32x2 __attribute__((ext_vector_type(2)));
typedef unsigned u32x4 __attribute__((ext_vector_type(4)));
typedef unsigned u32x2 __attribute__((ext_vector_type(2)));

constexpr int NT = 8192, NTP = 4096, DM = 1024, INW = 7296, NA_COLS = 3200, PW = 2176;
constexpr int NTHREADS = 512;
constexpr int C_AU = 0, C_AV = 256, C_BR = 512, C_BK = 768, C_BV = 1024, C_WD = 1280, C_AD = 1344, C_CQ = 1408, C_CK = 1664, C_CV = 1792, C_DP = 1920;
constexpr size_t O_YP = 0, O_YS = 4194304, O_NK = 8388608, O_NV = 9437184, O_NS = 10485760;
constexpr size_t WS_WTIN = 0;
constexpr size_t WS_WTUP = WS_WTIN + (size_t)2 * INW * DM * 2;
constexpr size_t WS_WTO  = WS_WTUP + (size_t)2 * 4 * 1024 * 256 * 2;
constexpr size_t WS_MOD  = WS_WTO + (size_t)2 * 1024 * 1024 * 2;
constexpr size_t WS_ROPE = WS_MOD + (size_t)2 * 5 * 3072 * 4;
constexpr size_t WS_CTR  = WS_ROPE + 64 * 16 * 8;
constexpr size_t WS_BAR  = WS_CTR + 256;
constexpr size_t WS_H    = WS_BAR + 3456 * 4;
constexpr size_t WS_P    = WS_H + (size_t)NT * DM * 2;
constexpr size_t WS_Z    = WS_P + (size_t)NT * PW * 4;
constexpr size_t WS_RECS = WS_Z + (size_t)NT * DM * 2;
constexpr size_t WS_RECD = WS_RECS + (size_t)NT * 4 * 192 * 4;
constexpr size_t WS_O    = WS_RECD + (size_t)2 * NT * 4 * 192 * 4;
constexpr size_t WS_BC   = WS_O + (size_t)2 * NT * 256 * 4;
constexpr size_t WS_YS   = WS_BC + (size_t)NT * 4 * 4;
constexpr size_t WS_LORAT = WS_YS + (size_t)NT * DM * 2;
constexpr size_t WS_END  = WS_LORAT + (size_t)2 * 4 * 256 * 64 * 2;
constexpr size_t WS_G = WS_P;
constexpr size_t WS_MERGED = WS_RECS;
constexpr size_t RECD_STRIDE = (size_t)NT * 4 * 192;

constexpr int LDS_MAIN = 131072;
constexpr int LDS_BYTES = LDS_MAIN + 16;

struct Params {
    const float* in[28];
    float* out;
    unsigned char* ws;
};
__shared__ unsigned long long s_ptab[28];
__device__ __forceinline__ const float* ld_inptr(int k) {
    const unsigned long long v = s_ptab[k];
    const unsigned lo = __builtin_amdgcn_readfirstlane((unsigned)v), hi = __builtin_amdgcn_readfirstlane((unsigned)(v >> 32));
    return (const float*)(((unsigned long long)hi << 32) | lo);
}
#define PIN(k) (ld_inptr(k))
#define POUT (p.out)
#define PWS (p.ws)

__device__ __forceinline__ int TID() { int t = threadIdx.x; asm volatile("" : "+v"(t)); return t; }
__device__ __forceinline__ unsigned cvt_pk_bf16(float lo, float hi) { unsigned r; asm volatile("v_cvt_pk_bf16_f32 %0, %1, %2" : "=v"(r) : "v"(lo), "v"(hi)); return r; }
__device__ __forceinline__ bf16_t f2bf(float f) { return (bf16_t)(cvt_pk_bf16(f, 0.f) & 0xffffu); }
__device__ __forceinline__ float bf2f(bf16_t b) { return __uint_as_float(((unsigned)b) << 16); }
__device__ __forceinline__ float sigmoidf_(float x) { return 1.0f / (1.0f + __expf(-x)); }
__device__ __forceinline__ float siluf_(float x) { return x / (1.0f + __expf(-x)); }
template <int CTRL> __device__ __forceinline__ float dpp_f(float x) { return __int_as_float(__builtin_amdgcn_update_dpp(0, __float_as_int(x), CTRL, 0xF, 0xF, false)); }
__device__ __forceinline__ float row16_sum(float x) {
    x += dpp_f<0x128>(x); x += dpp_f<0x124>(x); x += dpp_f<0x122>(x); x += dpp_f<0x121>(x); return x;
}
__device__ __forceinline__ float wave_sum(float v) { v = row16_sum(v); v += __shfl_xor(v, 16); v += __shfl_xor(v, 32); return v; }
__device__ __forceinline__ void seq_of(int tok, int& seqbase, int& L, int& pos) {
    if (tok < NTP) { seqbase = tok & ~255; L = 256; pos = tok & 255; }
    else { int t2 = tok - NTP; seqbase = NTP + (t2 & ~1023); L = 1024; pos = t2 & 1023; }
}
__device__ __forceinline__ int modrow_of(int tok) { return tok < NTP ? 0 : 1 + ((tok - NTP) >> 10); }


#define XB_TMO      128
#define XB_XCNT(j)  (256  + 64 * (j))
#define XB_XSUB(j)  (1280 + 64 * (j))
#define XB_XGEN(j)  (2304 + 64 * (j))
#define XB_TOP      3328
#define XB_TOPGEN   3392
#define XCD_BAR_WORDS 3456
#define XB_SPIN_CAP (1u << 18)
#define LAS __attribute__((address_space(3)))
__device__ __forceinline__ unsigned xb_ld(unsigned* p)              { return __hip_atomic_load(p, __ATOMIC_RELAXED, __HIP_MEMORY_SCOPE_AGENT); }
__device__ __forceinline__ unsigned xb_add(unsigned* p, unsigned v) { return __hip_atomic_fetch_add(p, v, __ATOMIC_RELAXED, __HIP_MEMORY_SCOPE_AGENT); }
__device__ __forceinline__ unsigned xb_xcc_id() { return (unsigned)__builtin_amdgcn_s_getreg((3 << 11) | 20) & 0xFu; }
#define XB_SPIN(cond, bar) do { unsigned _sp = 0; while (cond) { __builtin_amdgcn_s_sleep(1); \
    if ((++_sp & 255u) == 0u) { if (xb_ld(&(bar)[XB_TMO])) break; if (_sp > XB_SPIN_CAP) { atomicAdd(&(bar)[XB_TMO], 1u); break; } } } } while (0)
struct XcdBarrier { unsigned* bar; unsigned x; volatile LAS unsigned* st; };
__device__ __forceinline__ XcdBarrier xcd_barrier_post(unsigned* bar, volatile LAS unsigned* st) {
    XcdBarrier b; b.bar = bar; b.x = xb_xcc_id(); b.st = st;
    if (threadIdx.x == 0) (void)xb_add(&bar[XB_XCNT(b.x)], 1u);
    return b;
}
__device__ __forceinline__ void xcd_barrier_complete(unsigned* bar, unsigned x, unsigned& nloc, unsigned& nx) {
    const unsigned G = gridDim.x * gridDim.y * gridDim.z;
    unsigned sum, cnt, mine, sp = 0u;
    for (;;) {
        sum = 0u; cnt = 0u; mine = 0u;
#pragma unroll
        for (unsigned j = 0; j < 16; ++j) { const unsigned c = xb_ld(&bar[XB_XCNT(j)]); sum += c; cnt += (c > 0u) ? 1u : 0u; mine = (j == x) ? c : mine; }
        if (sum == G) break;
        __builtin_amdgcn_s_sleep(1);
        if ((++sp & 255u) == 0u) { if (xb_ld(&bar[XB_TMO])) break; if (sp > XB_SPIN_CAP) { atomicAdd(&bar[XB_TMO], 1u); break; } }
    }
    nloc = mine > 0u ? mine : 1u; nx = cnt > 0u ? cnt : 1u;
}
__device__ __forceinline__ void xcd_barrier(const XcdBarrier& b0) {
    asm volatile("s_waitcnt vmcnt(0)" ::: "memory");
    __syncthreads();
    if (threadIdx.x == 0) {
        XcdBarrier b = b0;
        { unsigned xx = xb_xcc_id(); asm volatile("" : "+s"(xx)); b.x = xx; }
        unsigned* bar = b.bar;
        __builtin_amdgcn_s_waitcnt(0);
        unsigned nloc = b.st[0], nx = b.st[1];
        if (nloc == 0u) { xcd_barrier_complete(bar, b.x, nloc, nx); b.st[0] = nloc; b.st[1] = nx; }
        const unsigned old = xb_add(&bar[XB_XSUB(b.x)], 1u);
        const unsigned gen = old / nloc;
        if (old + 1u == (gen + 1u) * nloc) {
            __builtin_amdgcn_fence(__ATOMIC_RELEASE, "agent");
            asm volatile("s_waitcnt vmcnt(0)" ::: "memory");
            const unsigned og = xb_add(&bar[XB_TOP], 1u);
            const unsigned tg = og / nx;
            if (og + 1u == (tg + 1u) * nx) xb_add(&bar[XB_TOPGEN], 1u);
            else XB_SPIN(xb_ld(&bar[XB_TOPGEN]) == tg, bar);
            __builtin_amdgcn_fence(__ATOMIC_ACQUIRE, "agent");
            xb_add(&bar[XB_XGEN(b.x)], 1u);
            asm volatile("s_waitcnt vmcnt(0)" ::: "memory");
        } else {
            XB_SPIN(xb_ld(&bar[XB_XGEN(b.x)]) == gen, bar);
            __builtin_amdgcn_fence(__ATOMIC_ACQUIRE, "agent");
            asm volatile("s_waitcnt vmcnt(0)" ::: "memory");
        }
    }
    __syncthreads();
}

__device__ void conv_tile(const float* __restrict__ src, int N, bf16_t* __restrict__ dst, int K, int kt, int nt, float* tile) {
    const int tid = TID();
    { const int r = tid >> 4, c4 = (tid & 15) * 4;
#pragma unroll
      for (int i = 0; i < 2; ++i) { const int k = r + 32 * i; const f32x4 v = *(const f32x4*)(src + (size_t)(kt * 64 + k) * N + nt * 64 + c4);
          tile[k * 65 + c4 + 0] = v[0]; tile[k * 65 + c4 + 1] = v[1]; tile[k * 65 + c4 + 2] = v[2]; tile[k * 65 + c4 + 3] = v[3]; } }
    __syncthreads();
    { const int n = tid >> 3, kc = (tid & 7) * 8; u32x4 w;
      w[0] = cvt_pk_bf16(tile[(kc + 0) * 65 + n], tile[(kc + 1) * 65 + n]); w[1] = cvt_pk_bf16(tile[(kc + 2) * 65 + n], tile[(kc + 3) * 65 + n]);
      w[2] = cvt_pk_bf16(tile[(kc + 4) * 65 + n], tile[(kc + 5) * 65 + n]); w[3] = cvt_pk_bf16(tile[(kc + 6) * 65 + n], tile[(kc + 7) * 65 + n]);
      *(u32x4*)(dst + (size_t)(nt * 64 + n) * K + kt * 64 + kc) = w; }
    __syncthreads();
}

__device__ void mod_item(const Params& p, int l, int cc, float* lds) {
    const int tid = TID();
    float* sc = lds;
    float* red = lds + 5120;
    for (int i = tid; i < 5120; i += NTHREADS) { const int r = i >> 10, k = i & 1023; const float v = (r == 0) ? PIN(6)[k] : PIN(5)[(r - 1) * 1024 + k]; sc[i] = siluf_(v); }
    __syncthreads();
    const int kg = tid >> 5, c = tid & 31, col = cc * 32 + c;
    float a[5] = {0.f, 0.f, 0.f, 0.f, 0.f};
    const float* w = PIN(7) + (size_t)l * 1024 * 3072 + col;
    for (int k = kg * 64; k < kg * 64 + 64; ++k) { const float wv = w[(size_t)k * 3072];
#pragma unroll
        for (int r = 0; r < 5; ++r) a[r] += sc[r * 1024 + k] * wv; }
#pragma unroll
    for (int r = 0; r < 5; ++r) red[(kg * 5 + r) * 32 + c] = a[r];
    __syncthreads();
    if (tid < 160) { const int r = tid >> 5, c2 = tid & 31; float s = PIN(8)[l * 3072 + cc * 32 + c2];
        for (int g = 0; g < 16; ++g) s += red[(g * 5 + r) * 32 + c2];
        ((float*)(PWS + WS_MOD))[(l * 5 + r) * 3072 + cc * 32 + c2] = s; }
    __syncthreads();
}

__device__ void phase0(const Params& p, unsigned char* lds) {
    const int NCONV_IN = 2 * 16 * 114, NCONV_UP = 8 * 64, NCONV_O = 2 * 256, NCONV_L = 32, NMOD = 192;
    const int total = NCONV_IN + NCONV_UP + NCONV_O + NCONV_L + NMOD + 1;
    for (int it = blockIdx.x; it < total; it += gridDim.x) {
        int i = it;
        if (i < NCONV_IN) { const int l = i / 1824, r = i % 1824, nt = r / 16, kt = r % 16;
            conv_tile(PIN(10) + (size_t)l * 1024 * INW, INW, (bf16_t*)(PWS + WS_WTIN) + (size_t)l * INW * 1024, 1024, kt, nt, (float*)lds); continue; }
        i -= NCONV_IN;
        if (i < NCONV_UP) { const int mtx = i / 64, r = i % 64, nt = r / 4, kt = r % 4;
            conv_tile(PIN(25) + (size_t)mtx * 256 * 1024, 1024, (bf16_t*)(PWS + WS_WTUP) + (size_t)mtx * 1024 * 256, 256, kt, nt, (float*)lds); continue; }
        i -= NCONV_UP;
        if (i < NCONV_O) { const int l = i / 256, r = i % 256, nt = r / 16, kt = r % 16;
            conv_tile(PIN(26) + (size_t)l * 1024 * 1024, 1024, (bf16_t*)(PWS + WS_WTO) + (size_t)l * 1024 * 1024, 1024, kt, nt, (float*)lds); continue; }
        i -= NCONV_O;
        if (i < NCONV_L) { const int l = i >> 4, m = (i >> 2) & 3, nt = i & 3;
            conv_tile((m < 2 ? PIN(14) : PIN(16)) + (size_t)(l * 2 + (m & 1)) * 64 * 256, 256, (bf16_t*)(PWS + WS_LORAT) + (size_t)(l * 4 + m) * 256 * 64, 64, 0, nt, (float*)lds); continue; }
        i -= NCONV_L;
        if (i < NMOD) { mod_item(p, i / 96, i % 96, (float*)lds); continue; }
        for (int e = TID(); e < 1024; e += NTHREADS) { const int pos = e >> 4, f = e & 15;
            const float inv = exp2f(-(float)f * (13.287712379549449f / 16.0f)); const float ang = (float)pos * inv;
            float sn, cs; sn = sinf(ang); cs = cosf(ang);
            ((f32x2*)(PWS + WS_ROPE))[e] = (f32x2){cs, sn}; }
        if (TID() < 64) ((unsigned*)(PWS + WS_CTR))[TID()] = 0u;
    }
}

__device__ __forceinline__ const float* xrow_ptr(const Params& p, int l, int row) {
    if (l == 0) return row < NTP ? PIN(0) + (size_t)row * DM : PIN(1) + (size_t)(row - NTP) * DM;
    return POUT + (size_t)row * DM;
}
__device__ void phaseA0(const Params& p, int l) {
    const int lane = TID() & 63, gw = blockIdx.x * 8 + (TID() >> 6), W = gridDim.x * 8;
    const float* g = PIN(9) + l * DM;
    bf16_t* H = (bf16_t*)(PWS + WS_H);
    for (int row = gw; row < NT; row += W) {
        const float* x = xrow_ptr(p, l, row);
        f32x4 v[4]; float ss = 0.f;
#pragma unroll
        for (int i = 0; i < 4; ++i) { v[i] = *(const f32x4*)(x + i * 256 + lane * 4); ss += v[i][0] * v[i][0] + v[i][1] * v[i][1] + v[i][2] * v[i][2] + v[i][3] * v[i][3]; }
        ss = wave_sum(ss);
        const float rs = rsqrtf(ss * (1.0f / 1024.0f) + 1e-6f);
        const float* mod = (const float*)(PWS + WS_MOD) + (size_t)(l * 5 + modrow_of(row)) * 3072;
#pragma unroll
        for (int i = 0; i < 4; ++i) { const int c = i * 256 + lane * 4;
            const f32x4 gg = *(const f32x4*)(g + c), sh = *(const f32x4*)(mod + c), scl = *(const f32x4*)(mod + 1024 + c);
            f32x4 h = v[i] * rs * gg * (1.0f + scl) + sh;
            u32x2 w; w[0] = cvt_pk_bf16(h[0], h[1]); w[1] = cvt_pk_bf16(h[2], h[3]);
            *(u32x2*)(H + (size_t)row * DM + c) = w; }
    }
}

template <int MT>
__device__ __forceinline__ void gemm_acc(const bf16_t* __restrict__ A, int lda, const bf16_t* __restrict__ B, int ldb, int K, f32x4 (&acc)[MT][4], unsigned char* lds) {
    constexpr int BM = MT * 64, LDT = 72, A_BYTES = BM * LDT * 2, B_BYTES = 128 * LDT * 2, BUF = A_BYTES + B_BYTES;
    const int tid = TID(), lane = tid & 63, wid = tid >> 6, wr = wid >> 1, wc = wid & 1, fr = lane & 15, fq = lane >> 4;
    u32x4 ra[MT], rb[2];
    const int srow = tid >> 3, skc = tid & 7;
    const bf16_t* Ag = A + (size_t)srow * lda + skc * 8;
    const bf16_t* Bg = B + (size_t)srow * ldb + skc * 8;
    const int soff = (srow * LDT + skc * 8) * 2;
    const int nt = K >> 6;
    __syncthreads();
#pragma unroll
    for (int i = 0; i < MT; ++i) ra[i] = *(const u32x4*)(Ag + (size_t)i * 64 * lda);
#pragma unroll
    for (int i = 0; i < 2; ++i) rb[i] = *(const u32x4*)(Bg + (size_t)i * 64 * ldb);
#pragma unroll
    for (int i = 0; i < MT; ++i) *(u32x4*)(lds + soff + i * 64 * LDT * 2) = ra[i];
#pragma unroll
    for (int i = 0; i < 2; ++i) *(u32x4*)(lds + A_BYTES + soff + i * 64 * LDT * 2) = rb[i];
    __syncthreads();
    const int aoff = ((wr * MT * 16 + fr) * LDT + fq * 8) * 2, boff = A_BYTES + ((wc * 64 + fr) * LDT + fq * 8) * 2;
    for (int t = 0; t < nt; ++t) {
        if (t + 1 < nt) {
#pragma unroll
            for (int i = 0; i < MT; ++i) ra[i] = *(const u32x4*)(Ag + (size_t)i * 64 * lda + (t + 1) * 64);
#pragma unroll
            for (int i = 0; i < 2; ++i) rb[i] = *(const u32x4*)(Bg + (size_t)i * 64 * ldb + (t + 1) * 64);
        }
        const unsigned char* base = lds + (t & 1) * BUF;
#pragma unroll
        for (int kk = 0; kk < 2; ++kk) {
            bf16x8 af[MT], bfr[4];
#pragma unroll
            for (int m = 0; m < MT; ++m) af[m] = *(const bf16x8*)(base + aoff + m * 16 * LDT * 2 + kk * 64);
#pragma unroll
            for (int n = 0; n < 4; ++n) bfr[n] = *(const bf16x8*)(base + boff + n * 16 * LDT * 2 + kk * 64);
#pragma unroll
            for (int m = 0; m < MT; ++m)
#pragma unroll
                for (int n = 0; n < 4; ++n) acc[m][n] = __builtin_amdgcn_mfma_f32_16x16x32_bf16(bfr[n], af[m], acc[m][n], 0, 0, 0);
        }
        if (t + 1 < nt) {
            unsigned char* nb = lds + ((t + 1) & 1) * BUF;
#pragma unroll
            for (int i = 0; i < MT; ++i) *(u32x4*)(nb + soff + i * 64 * LDT * 2) = ra[i];
#pragma unroll
            for (int i = 0; i < 2; ++i) *(u32x4*)(nb + A_BYTES + soff + i * 64 * LDT * 2) = rb[i];
        }
        __syncthreads();
    }
}
template <int MT> __device__ __forceinline__ void zero_acc(f32x4 (&acc)[MT][4]) {
#pragma unroll
    for (int m = 0; m < MT; ++m)
#pragma unroll
        for (int n = 0; n < 4; ++n) acc[m][n] = (f32x4){0.f, 0.f, 0.f, 0.f};
}

namespace pg8 {
#define PG8_LAS __attribute__((address_space(3)))
typedef unsigned short bf16_t;
typedef short bf16x8 __attribute__((ext_vector_type(8)));
typedef float f32x4 __attribute__((ext_vector_type(4)));
typedef unsigned u32x4 __attribute__((ext_vector_type(4)));
constexpr int BM = 256, BK = 64, HALF = 128, HTB = HALF * BK * 2  , STAGE_BYTES = 8 * HTB, NXCD = 8, WGM = 8;

__host__ __device__ __forceinline__ int lds_byte(int r, int c) { const int st = (r >> 4) * 2 + (c >> 5), rr = r & 15, cc = c & 31, ob = rr * 64 + cc * 2; return st * 1024 + (ob ^ (((ob >> 9) & 1) << 5)); }
__host__ __device__ __forceinline__ void stage_rc(int b, int& R, int& C) { const int st = b / 1024, sb = b % 1024, swz = sb ^ (((sb >> 9) & 1) << 5); R = (st >> 1) * 16 + swz / 64; C = (st & 1) * 32 + (swz % 64) / 2; }
__host__ __device__ __forceinline__ int perm32(int rho) { const int n = rho >> 4, i = rho & 15; return 8 * (i >> 2) + 4 * n + (i & 3); }

struct Unit { int pm, pn; };
struct Gemm { const bf16_t* A; const bf16_t* Bt; int M, N, K; };

struct StaticOrder {
    int nM, nN, nwg, G, c;
    __host__ __device__ void init(int M, int N, int G_, int c_) { nM = M / BM; nN = N / BM; nwg = nM * nN; G = G_; c = c_; }
    __host__ __device__ bool next(int i, Unit& u) const {
        const long L = (long)i * G + c; if (L >= nwg) return false;
        int wgid = (int)L; { const int q = nwg / NXCD, r = nwg % NXCD, xcd = wgid % NXCD, off = wgid / NXCD; wgid = (xcd < r ? xcd * (q + 1) : r * (q + 1) + (xcd - r) * q) + off; }
        const int nig = WGM * nN, gid = wgid / nig, fm = gid * WGM, gsz = (nM - fm) < WGM ? (nM - fm) : WGM;
        u.pm = fm + ((wgid % nig) % gsz); u.pn = (wgid % nig) / gsz; return true;
    }
    __device__ __forceinline__ void a_ready(const Unit&) const {}
    __device__ __forceinline__ void done(const Unit&) const {}
};
template <class Epi, class Sched, bool STAMP = false>
__device__ __forceinline__ void gemm_phase(PG8_LAS unsigned char* lds, const Gemm g, const Sched& S, const Epi& E, unsigned long long* stamps) {
    const int tid = ::TID(), wid = __builtin_amdgcn_readfirstlane(tid >> 6), lane = tid & 63, wr = wid >> 2, wc = wid & 3, fr = lane & 15, fq = lane >> 4;
    const int K = g.K, nt = K / BK;
    int ts_lo = 0, ts_hi = 0, nts = 0; const unsigned long long rt_entry = STAMP ? (unsigned long long)wall_clock64() : 0ull;
#define PG8_STAMP() do { if (STAMP && wid == 0 && nts < 64) { const unsigned long long _c = (unsigned long long)clock64(); \
        ts_lo = (lane == nts) ? (int)(unsigned)_c : ts_lo; ts_hi = (lane == nts) ? (int)(unsigned)(_c >> 32) : ts_hi; ++nts; } } while (0)
    PG8_STAMP();
    unsigned voffA[2], voffB[2];
#pragma unroll
    for (int i = 0; i < 2; ++i) { int R, C; stage_rc(tid * 16 + i * 8192, R, C); const int Rb = Epi::PERM ? ((R & ~31) + perm32(R & 31)) : R;
        voffA[i] = (unsigned)(R * K + C) * 2u; voffB[i] = (unsigned)(Rb * K + C) * 2u; }
    const size_t kstep = (size_t)(BK * 2);
    const size_t hstep = (size_t)HALF * K * 2;
    const size_t tstep = 2 * hstep;
    const unsigned ldsw = (unsigned)wid * 1024u;
    const int aoff = lds_byte(wr * 64 + fr, fq * 8), boff = lds_byte(wc * 32 + fr, fq * 8);
#define PG8_SA(b, h) (((b) * 2 + (h)) * HTB)
#define PG8_SB(b, h) ((4 + (b) * 2 + (h)) * HTB)
#define PG8_STAGE(bufoff, gbase, voff) do { _Pragma("unroll") for (int _i = 0; _i < 2; ++_i) \
        __builtin_amdgcn_global_load_lds((const unsigned*)((const char*)(gbase) + (voff)[_i]), (PG8_LAS unsigned*)(lds + (bufoff) + ldsw + _i * 8192), 16, 0, 0); } while (0)
#define PG8_LDA(dst, b, h) do { _Pragma("unroll") for (int m = 0; m < 4; ++m) _Pragma("unroll") for (int k = 0; k < 2; ++k) dst[m][k] = *(const PG8_LAS bf16x8*)(lds + PG8_SA(b, h) + aoff + m * 2048 + k * 1024); } while (0)
#define PG8_LDB(dst, b, h) do { _Pragma("unroll") for (int n = 0; n < 2; ++n) _Pragma("unroll") for (int k = 0; k < 2; ++k) dst[n][k] = *(const PG8_LAS bf16x8*)(lds + PG8_SB(b, h) + boff + n * 2048 + k * 1024); } while (0)
#define PG8_MMA(ai, bj, At, Bt) do { __builtin_amdgcn_s_setprio(1); _Pragma("unroll") for (int m = 0; m < 4; ++m) _Pragma("unroll") for (int n = 0; n < 2; ++n) _Pragma("unroll") for (int k = 0; k < 2; ++k) \
        acc[ai][bj][m][n] = __builtin_amdgcn_mfma_f32_16x16x32_bf16(Bt[n][k], At[m][k], acc[ai][bj][m][n], 0, 0, 0); __builtin_amdgcn_s_setprio(0); } while (0)
#define PG8_WAIT_V(n) asm volatile("s_waitcnt vmcnt(" #n ")" ::: "memory")
#define PG8_WAIT_L(n) asm volatile("s_waitcnt lgkmcnt(" #n ")" ::: "memory")
#define PG8_BAR __builtin_amdgcn_s_barrier()
#define PG8_SCHED __builtin_amdgcn_sched_barrier(0)
    Unit cur, nxt; int ui = 0;
    if (!S.next(0, cur)) return;
    f32x4 acc[2][2][4][2];
#pragma unroll
    for (int a = 0; a < 2; ++a)
#pragma unroll
        for (int b = 0; b < 2; ++b)
#pragma unroll
            for (int m = 0; m < 4; ++m)
#pragma unroll
                for (int n = 0; n < 2; ++n) acc[a][b][m][n] = (f32x4){0.f, 0.f, 0.f, 0.f};
    bf16x8 At[4][2], B0[2][2], B1[2][2];
    const char* cA = (const char*)g.A + (size_t)cur.pm * tstep; const char* cB = (const char*)g.Bt + (size_t)cur.pn * tstep;
    S.a_ready(cur);
    PG8_STAGE(PG8_SB(0, 0), cB, voffB); PG8_STAGE(PG8_SA(0, 0), cA, voffA); PG8_STAGE(PG8_SB(0, 1), cB + hstep, voffB); PG8_STAGE(PG8_SA(0, 1), cA + hstep, voffA);
    if (wr == 1) PG8_BAR;
    PG8_WAIT_V(4); PG8_BAR;
    PG8_STAGE(PG8_SB(1, 0), cB + kstep, voffB); PG8_STAGE(PG8_SA(1, 0), cA + kstep, voffA); PG8_STAGE(PG8_SB(1, 1), cB + hstep + kstep, voffB);
    PG8_WAIT_V(6); PG8_BAR;
    PG8_STAMP();
    for (;;) {
        const bool has_next = S.next(ui + 1, nxt);
        const char* nA = has_next ? (const char*)g.A + (size_t)nxt.pm * tstep : cA; const char* nB = has_next ? (const char*)g.Bt + (size_t)nxt.pn * tstep : cB;
        for (int t = 0; t < nt; t += 2) {
            const bool last = (t == nt - 2);
            const char* a1 = cA + (size_t)(t + 1) * kstep;
            const char* a2 = last ? nA : cA + (size_t)(t + 2) * kstep; const char* b2 = last ? nB : cB + (size_t)(t + 2) * kstep;
            const char* a3 = a2 + kstep; const char* b3 = b2 + kstep;
            if (last && has_next) S.a_ready(nxt);
            PG8_LDB(B0, 0, 0); PG8_SCHED; PG8_LDA(At, 0, 0); PG8_STAGE(PG8_SA(1, 1), a1 + hstep, voffA);
            PG8_WAIT_L(8); PG8_BAR; PG8_WAIT_L(0); PG8_MMA(0, 0, At, B0); PG8_BAR; PG8_SCHED;
            PG8_LDB(B1, 0, 1); PG8_STAGE(PG8_SB(0, 0), b2, voffB);
            PG8_BAR; PG8_WAIT_L(0); PG8_MMA(0, 1, At, B1); PG8_BAR;
            PG8_LDA(At, 0, 1); PG8_STAGE(PG8_SA(0, 0), a2, voffA);
            PG8_BAR; PG8_WAIT_L(0); PG8_MMA(1, 0, At, B0); PG8_BAR; PG8_SCHED;
            PG8_STAGE(PG8_SB(0, 1), b2 + hstep, voffB);
            PG8_WAIT_V(6); PG8_BAR; PG8_MMA(1, 1, At, B1); PG8_BAR;
            PG8_LDB(B0, 1, 0); PG8_SCHED; PG8_LDA(At, 1, 0); PG8_STAGE(PG8_SA(0, 1), a2 + hstep, voffA);
            PG8_WAIT_L(8); PG8_BAR; PG8_WAIT_L(0); PG8_MMA(0, 0, At, B0); PG8_BAR; PG8_SCHED;
            PG8_LDB(B1, 1, 1); PG8_STAGE(PG8_SB(1, 0), b3, voffB);
            PG8_BAR; PG8_WAIT_L(0); PG8_MMA(0, 1, At, B1); PG8_BAR;
            PG8_LDA(At, 1, 1); PG8_STAGE(PG8_SA(1, 0), a3, voffA);
            PG8_BAR; PG8_WAIT_L(0); PG8_MMA(1, 0, At, B0); PG8_BAR; PG8_SCHED;
            PG8_STAGE(PG8_SB(1, 1), b3 + hstep, voffB);
            PG8_WAIT_V(6); PG8_BAR; PG8_MMA(1, 1, At, B1); PG8_BAR;
        }
        PG8_STAMP();
        if constexpr (!Epi::AFTER_DRAIN) { E(acc, cur, wr, wc, fr, fq); S.done(cur); }
        PG8_STAMP();
        if (!has_next) break;
#pragma unroll
        for (int a = 0; a < 2; ++a)
#pragma unroll
            for (int b = 0; b < 2; ++b)
#pragma unroll
                for (int m = 0; m < 4; ++m)
#pragma unroll
                    for (int n = 0; n < 2; ++n) acc[a][b][m][n] = (f32x4){0.f, 0.f, 0.f, 0.f};
        cur = nxt; cA = nA; cB = nB; ++ui;
    }
    PG8_WAIT_V(0);
    if (wr == 0) PG8_BAR;
    PG8_BAR;
    if constexpr (Epi::AFTER_DRAIN) { E.fused(acc, cur, wr, wc, fr, fq, lds, wid, lane); S.done(cur); }
    PG8_STAMP();
    if (STAMP && wid == 0) { stamps[lane] = lane < nts ? (((unsigned long long)(unsigned)ts_hi << 32) | (unsigned)ts_lo) : 0ull;
        if (lane == 62) stamps[62] = rt_entry; if (lane == 63) stamps[63] = (unsigned long long)wall_clock64(); }
#undef PG8_STAMP
#undef PG8_SA
#undef PG8_SB
#undef PG8_STAGE
#undef PG8_LDA
#undef PG8_LDB
#undef PG8_MMA
#undef PG8_WAIT_V
#undef PG8_WAIT_L
#undef PG8_BAR
#undef PG8_SCHED
}
}

struct EpiA {
    static constexpr bool PERM = false, AFTER_DRAIN = false;
    float* P; bf16_t* Z; float* out; int l;
    __device__ __forceinline__ void operator()(const pg8::f32x4 (&acc)[2][2][4][2], const pg8::Unit& u, int wr, int wc, int fr, int fq) const {
#pragma unroll
        for (int ai = 0; ai < 2; ++ai)
#pragma unroll
            for (int m = 0; m < 4; ++m) { const int row = u.pm * 256 + ai * 128 + wr * 64 + m * 16 + fr;
#pragma unroll
                for (int bj = 0; bj < 2; ++bj)
#pragma unroll
                    for (int n = 0; n < 2; ++n) { const int col = u.pn * 256 + bj * 128 + wc * 32 + n * 16 + fq * 4; const f32x4 v = acc[ai][bj][m][n];
                        if (col < PW) { *(f32x4*)(P + (size_t)row * PW + col) = v;
                            if (col >= C_CK && col < C_DP && row < NTP) { const int b = row >> 8, s_ = row & 255; const bool isk = col < C_CV;
                                *(f32x4*)(out + (isk ? O_NK : O_NV) + ((size_t)((b * 2 + l) * 256 + s_)) * 128 + (col - (isk ? C_CK : C_CV))) = v; } }
                        else if (col < NA_COLS) { u32x2 w; w[0] = cvt_pk_bf16(siluf_(v[0]), siluf_(v[1])); w[1] = cvt_pk_bf16(siluf_(v[2]), siluf_(v[3])); *(u32x2*)(Z + (size_t)row * DM + (col - PW)) = w; } } }
    }
};
__device__ __forceinline__ size_t g_off(int row, int cg) {
    const int n = cg >> 10, c = cg & 1023;
    const int pm = row >> 8, wr2 = (row >> 6) & 3, m = (row >> 4) & 3, fr = row & 15;
    const int pn = c >> 7, wc2 = (c >> 6) & 1, q = (c >> 4) & 3, fq2 = (c >> 2) & 3;
    size_t o = (size_t)(n * 32 + pm); o = o * 8 + pn; o = o * 4 + wr2; o = o * 2 + wc2; o = o * 4 + m; o = o * 16 + fr; o = o * 4 + fq2; o = o * 16 + q * 4;
    return o;
}
struct EpiG {
    static constexpr bool PERM = true, AFTER_DRAIN = false;
    bf16_t* G;
    __device__ __forceinline__ void operator()(const pg8::f32x4 (&acc)[2][2][4][2], const pg8::Unit& u, int wr, int wc, int fr, int fq) const {
#pragma unroll
        for (int ai = 0; ai < 2; ++ai)
#pragma unroll
            for (int m = 0; m < 4; ++m) { const int row = u.pm * 256 + ai * 128 + wr * 64 + m * 16 + fr;
#pragma unroll
                for (int bj = 0; bj < 2; ++bj) { const int col = u.pn * 256 + bj * 128 + wc * 32 + 8 * fq; const f32x4 v0 = acc[ai][bj][m][0], v1 = acc[ai][bj][m][1];
                    u32x4 w; w[0] = cvt_pk_bf16(sigmoidf_(v0[0]), sigmoidf_(v0[1])); w[1] = cvt_pk_bf16(sigmoidf_(v0[2]), sigmoidf_(v0[3]));
                    w[2] = cvt_pk_bf16(sigmoidf_(v1[0]), sigmoidf_(v1[1])); w[3] = cvt_pk_bf16(sigmoidf_(v1[2]), sigmoidf_(v1[3]));
                    u32x2 wa, wb; wa[0] = w[0]; wa[1] = w[1]; wb[0] = w[2]; wb[1] = w[3];
                    *(u32x2*)(G + g_off(row, col)) = wa; *(u32x2*)(G + g_off(row, col + 4)) = wb; } }
    }
};

__device__ void phaseA(const Params& p, int l, unsigned char* lds) {
    pg8::Gemm g; g.A = (const bf16_t*)(PWS + WS_H); g.Bt = (const bf16_t*)(PWS + WS_WTIN) + (size_t)l * INW * 1024; g.M = NT; g.N = 13 * 256; g.K = 1024;
    pg8::StaticOrder S; S.init(g.M, g.N, (int)gridDim.x, (int)blockIdx.x);
    EpiA E; E.P = (float*)(PWS + WS_P); E.Z = (bf16_t*)(PWS + WS_Z); E.out = POUT; E.l = l;
    pg8::gemm_phase<EpiA, pg8::StaticOrder, false>((PG8_LAS unsigned char*)lds, g, S, E, nullptr);
    __syncthreads();
}

__device__ void phaseB0(const Params& p, int l, unsigned char* ldsb) {
    const int tid = TID(), lane = tid & 63, wid = tid >> 6, fr = lane & 15, fq = lane >> 4;
    const int h = wid >> 1, mt = wid & 1;
    bf16_t* Awd = (bf16_t*)ldsb;
    bf16_t* Aad = Awd + 32 * 72;
    const float* P = (const float*)(PWS + WS_P);
    float* recS = (float*)(PWS + WS_RECS);
    float* recD = (float*)(PWS + WS_RECD);
    float* BC = (float*)(PWS + WS_BC);
    const bf16_t* LT = (const bf16_t*)(PWS + WS_LORAT) + (size_t)l * 4 * 256 * 64;
    const float* pkk = PIN(17) + l * 256; const float* pka = PIN(18) + l * 256; const float* prk = PIN(19) + l * 256;
    const float* pw0 = PIN(13) + l * 512; const float* pa0 = PIN(15) + l * 512;
    for (int it = blockIdx.x; it < NT / 32; it += gridDim.x) {
        const int tb = it * 32;
        __syncthreads();
#pragma unroll
        for (int i = 0; i < 8; ++i) { const int idx = tid + i * 512, tk = idx >> 7, j = idx & 127; const float v = P[(size_t)(tb + tk) * PW + C_WD + j];
            if (j < 64) Awd[tk * 72 + j] = f2bf(1.0f - 2.0f / (1.0f + __expf(2.0f * v))); else Aad[tk * 72 + j - 64] = f2bf(v); }
        __syncthreads();
        f32x4 acc[4][4];
#pragma unroll
        for (int m = 0; m < 4; ++m)
#pragma unroll
            for (int n = 0; n < 4; ++n) acc[m][n] = (f32x4){0.f, 0.f, 0.f, 0.f};
#pragma unroll
        for (int ks = 0; ks < 2; ++ks) {
            const bf16x8 awf = *(const bf16x8*)(Awd + (mt * 16 + fr) * 72 + ks * 32 + fq * 8), aaf = *(const bf16x8*)(Aad + (mt * 16 + fr) * 72 + ks * 32 + fq * 8);
#pragma unroll
            for (int n = 0; n < 4; ++n) { const int cb = h * 64 + n * 16 + fr;
#pragma unroll
                for (int m = 0; m < 4; ++m) { const bf16x8 bfr = *(const bf16x8*)(LT + ((size_t)m * 256 + cb) * 64 + ks * 32 + fq * 8);
                    acc[m][n] = __builtin_amdgcn_mfma_f32_16x16x32_bf16(bfr, m < 2 ? awf : aaf, acc[m][n], 0, 0, 0); } }
        }
        const int tok = tb + mt * 16 + fr; int seqbase, L, pos; seq_of(tok, seqbase, L, pos);
        const float* pr = P + (size_t)tok * PW;
        const size_t ridx = ((size_t)seqbase * 4 + (size_t)h * L + pos) * 192;
        f32x4 k4[4], kk4[4]; float ss = 0.f;
#pragma unroll
        for (int n = 0; n < 4; ++n) { const int c4 = h * 64 + n * 16 + fq * 4;
            k4[n] = *(const f32x4*)(pr + C_BK + c4); kk4[n] = k4[n] * *(const f32x4*)(pkk + c4);
            ss += (kk4[n][0] * kk4[n][0] + kk4[n][1] * kk4[n][1]) + (kk4[n][2] * kk4[n][2] + kk4[n][3] * kk4[n][3]); }
        ss += __shfl_xor(ss, 16); ss += __shfl_xor(ss, 32);
        const float rn = rsqrtf(ss + 1e-12f);
        float bsum = 0.f;
#pragma unroll
        for (int n = 0; n < 4; ++n) { const int c4 = h * 64 + n * 16 + fq * 4, j4 = n * 16 + fq * 4;
            const f32x4 r4 = *(const f32x4*)(pr + C_BR + c4), v4 = *(const f32x4*)(pr + C_BV + c4);
            const f32x4 kk = kk4[n] * rn, ka4 = *(const f32x4*)(pka + c4), rk4 = *(const f32x4*)(prk + c4);
            *(f32x4*)(recS + ridx + j4) = r4; *(f32x4*)(recS + ridx + 64 + j4) = kk; *(f32x4*)(recS + ridx + 128 + j4) = v4;
#pragma unroll
            for (int d = 0; d < 2; ++d) {
                const f32x4 w0 = *(const f32x4*)(pw0 + d * 256 + c4), a0 = *(const f32x4*)(pa0 + d * 256 + c4);
                f32x4 dec, nka, kd;
#pragma unroll
                for (int j = 0; j < 4; ++j) {
                    const float wl = w0[j] + acc[d][n][j];
                    dec[j] = __expf(-0.6065306597126334f / (1.0f + __expf(-wl)));
                    const float a = 1.0f / (1.0f + __expf(-(a0[j] + acc[2 + d][n][j])));
                    kd[j] = k4[n][j] * (1.0f + (a - 1.0f) * ka4[j]); nka[j] = -(kk[j] * a);
                    bsum += r4[j] * kd[j] * rk4[j]; }
                float* rd = recD + (size_t)d * RECD_STRIDE + ridx + j4;
                *(f32x4*)(rd) = dec; *(f32x4*)(rd + 64) = nka; *(f32x4*)(rd + 128) = kd;
            }
        }
        bsum += __shfl_xor(bsum, 16); bsum += __shfl_xor(bsum, 32);
        if (fq == 0) BC[tok * 4 + h] = bsum;
    }
}

template <int NS>
__device__ __forceinline__ void scan_run(const Params& p, int l, bool sample, int b, int h, int dir, int rg, int L, int seqbase, float* wl) {
    const int lane = TID() & 63, rl = lane >> 4, kl = lane & 15;
    int row[NS]; f32x4 S[NS]; size_t sidx[NS];
#pragma unroll
    for (int q = 0; q < NS; ++q) { row[q] = (rg * NS + q) * 4 + rl;
        sidx[q] = ((size_t)(((b * 2 + l) * 2 + dir) * 4 + h)) * 4096 + row[q] * 64 + kl * 4;
        if (sample) S[q] = *(const f32x4*)(PIN(4) + sidx[q]); else S[q] = (f32x4){0.f, 0.f, 0.f, 0.f}; }
    const float* gS = (const float*)(PWS + WS_RECS) + ((size_t)seqbase * 4 + (size_t)h * L) * 192 + lane * 4;
    const float* gD = (const float*)(PWS + WS_RECD) + (size_t)dir * RECD_STRIDE + ((size_t)seqbase * 4 + (size_t)h * L) * 192 + lane * 4;
    float* O = (float*)(PWS + WS_O) + (size_t)dir * NT * 256 + (size_t)seqbase * 256 + h * 64;
    const int nch = L >> 2;
    f32x4 rA[6], rB[6];
    auto gl = [&](f32x4 (&r)[6], int c) {
        c = c < nch ? c : nch - 1;
        const int pos0 = dir ? (L - 4 * (c + 1)) : 4 * c;
        const float* s_ = gS + (size_t)pos0 * 192; const float* d_ = gD + (size_t)pos0 * 192;
#pragma unroll
        for (int i = 0; i < 3; ++i) { r[i] = *(const f32x4*)(s_ + i * 256); r[3 + i] = *(const f32x4*)(d_ + i * 256); }
    };
    auto st = [&](const f32x4 (&r)[6], float* buf) {
#pragma unroll
        for (int i = 0; i < 3; ++i) { *(f32x4*)(buf + i * 256 + lane * 4) = r[i]; *(f32x4*)(buf + 768 + i * 256 + lane * 4) = r[3 + i]; }
    };
    struct Ops { f32x4 r, kk, w, ka, kd; float v[NS]; };
    auto ldsread = [&](const float* buf, int s) -> Ops {
        const int tc = dir ? 3 - s : s;
        const float* bs = buf + tc * 192; const float* bd = buf + 768 + tc * 192;
        Ops o; o.r = *(const f32x4*)(bs + kl * 4); o.kk = *(const f32x4*)(bs + 64 + kl * 4);
        o.w = *(const f32x4*)(bd + kl * 4); o.ka = *(const f32x4*)(bd + 64 + kl * 4); o.kd = *(const f32x4*)(bd + 128 + kl * 4);
#pragma unroll
        for (int q = 0; q < NS; ++q) o.v[q] = bs[128 + row[q]];
        return o;
    };
    float opart[NS];
#pragma unroll
    for (int q = 0; q < NS; ++q) opart[q] = 0.f;
    auto chunk = [&](const float* cur, const float* nxtbuf, Ops& ops, int c) {
        float oval[NS];
#pragma unroll
        for (int q = 0; q < NS; ++q) oval[q] = 0.f;
#pragma unroll
        for (int s = 0; s < 4; ++s) {
            const Ops nx = (s < 3) ? ldsread(cur, s + 1) : ldsread(nxtbuf, 0);
            __builtin_amdgcn_sched_barrier(0);
            float sa[NS], opr[NS]; f32x2 ta[NS], tb[NS];
            const f32x2 kka = __builtin_shufflevector(ops.kk, ops.kk, 0, 1), kkb = __builtin_shufflevector(ops.kk, ops.kk, 2, 3);
            const f32x2 wa = __builtin_shufflevector(ops.w, ops.w, 0, 1), wb = __builtin_shufflevector(ops.w, ops.w, 2, 3);
            const f32x2 na = __builtin_shufflevector(ops.ka, ops.ka, 0, 1), nb = __builtin_shufflevector(ops.ka, ops.ka, 2, 3);
            const f32x2 da = __builtin_shufflevector(ops.kd, ops.kd, 0, 1), db = __builtin_shufflevector(ops.kd, ops.kd, 2, 3);
            const f32x2 ra = __builtin_shufflevector(ops.r, ops.r, 0, 1), rb = __builtin_shufflevector(ops.r, ops.r, 2, 3);
#pragma unroll
            for (int q = 0; q < NS; ++q) { const f32x2 Sa = __builtin_shufflevector(S[q], S[q], 0, 1), Sb = __builtin_shufflevector(S[q], S[q], 2, 3);
                f32x2 pp = Sa * kka; pp = Sb * kkb + pp; sa[q] = pp[0] + pp[1];
                const f32x2 v2 = (f32x2){ops.v[q], ops.v[q]};
                ta[q] = Sa * wa + v2 * da; tb[q] = Sb * wb + v2 * db; }
#pragma unroll
            for (int q = 0; q < NS; ++q) { sa[q] = row16_sum(sa[q]); opr[q] = row16_sum(opart[q]); oval[q] = (kl == s) ? opr[q] : oval[q]; }
#pragma unroll
            for (int q = 0; q < NS; ++q) { const f32x2 s2 = (f32x2){sa[q], sa[q]};
                const f32x2 Sa = s2 * na + ta[q], Sb = s2 * nb + tb[q];
                f32x2 qq = Sa * ra; qq = Sb * rb + qq; opart[q] = qq[0] + qq[1];
                S[q] = (f32x4){Sa[0], Sa[1], Sb[0], Sb[1]}; }
            ops = nx;
        }
        const int stp = 4 * c - 1 + (kl & 3);
        const int pos = dir ? (L - 1 - stp) : stp;
#pragma unroll
        for (int q = 0; q < NS; ++q) { if (kl < 4 && stp >= 0) O[(size_t)pos * 256 + row[q]] = oval[q]; }
    };
    float* buf0 = wl; float* buf1 = wl + 1536;
    gl(rA, 0); gl(rB, 1);
    st(rA, buf0); gl(rA, 2);
    __builtin_amdgcn_wave_barrier();
    Ops ops = ldsread(buf0, 0);
    for (int c = 0; c < nch; c += 2) {
        st(rB, buf1); gl(rB, c + 3);
        __builtin_amdgcn_wave_barrier();
        chunk(buf0, buf1, ops, c);
        st(rA, buf0); gl(rA, c + 4);
        __builtin_amdgcn_wave_barrier();
        chunk(buf1, buf0, ops, c + 1);
    }
#pragma unroll
    for (int q = 0; q < NS; ++q) { const float ol = row16_sum(opart[q]); if (kl == 0) O[(size_t)(dir ? 0 : L - 1) * 256 + row[q]] = ol; }
    if (!sample) {
#pragma unroll
        for (int q = 0; q < NS; ++q) *(f32x4*)(POUT + O_NS + sidx[q]) = S[q];
    }
}

__device__ __forceinline__ void stage_qk(const float* __restrict__ src, int stride, bf16_t* dst, bool rope, int pos0, float scale, const f32x2* __restrict__ rt) {
    const int tid = TID();
#pragma unroll
    for (int i = 0; i < 2; ++i) {
        const int task = tid + i * 512, row = task >> 3, half = (task >> 2) & 1, quad = task & 3;
        const float* s = src + (size_t)row * stride + half * 32 + quad * 4;
        f32x4 x1 = *(const f32x4*)s, x2 = *(const f32x4*)(s + 16);
        if (rope) { const int pos = pos0 + row; const int pi = half ? (pos & 63) : (pos >> 6);
#pragma unroll
            for (int j = 0; j < 4; ++j) { const f32x2 cs = rt[pi * 16 + quad * 4 + j]; const float a = x1[j], b = x2[j]; x1[j] = a * cs[0] - b * cs[1]; x2[j] = b * cs[0] + a * cs[1]; } }
        x1 *= scale; x2 *= scale;
        u32x2 w1, w2; w1[0] = cvt_pk_bf16(x1[0], x1[1]); w1[1] = cvt_pk_bf16(x1[2], x1[3]); w2[0] = cvt_pk_bf16(x2[0], x2[1]); w2[1] = cvt_pk_bf16(x2[2], x2[3]);
        *(u32x2*)(dst + row * 72 + half * 32 + quad * 4) = w1; *(u32x2*)(dst + row * 72 + half * 32 + 16 + quad * 4) = w2;
    }
}
__device__ __forceinline__ void stage_vt(const float* __restrict__ src, int stride, bf16_t* vt, int nkeys = 128, int pitch = 136) {
    const int tid = TID();
    for (int task = tid; task < nkeys * 16; task += 512) { const int key = task >> 4, dq = task & 15;
        const f32x4 v = *(const f32x4*)(src + (size_t)key * stride + dq * 4);
#pragma unroll
        for (int j = 0; j < 4; ++j) vt[(dq * 4 + j) * pitch + key] = f2bf(v[j]); }
}
__device__ void attn_item(const Params& p, int l, int ai, unsigned char* lds) {
    const int tid = TID(), lane = tid & 63, wid = tid >> 6, fr = lane & 15, fq = lane >> 4;
    bf16_t* Qs = (bf16_t*)lds; bf16_t* Ks = Qs + 128 * 72; bf16_t* Vt = Ks + 128 * 72;
    const float* P = (const float*)(PWS + WS_P);
    const bf16_t* Z = (const bf16_t*)(PWS + WS_Z);
    bf16_t* YS = (bf16_t*)(PWS + WS_YS);
    const f32x2* rt = (const f32x2*)(PWS + WS_ROPE);
    bool sample; int b, head, qt, seqbase;
    if (ai < 128) { sample = true; b = ai >> 5; head = (ai >> 3) & 3; qt = ai & 7; seqbase = NTP + b * 1024; }
    else { const int j = ai - 128; sample = false; b = j >> 3; head = (j >> 1) & 3; qt = j & 1; seqbase = b * 256; }
    const int kh = head >> 1, qbase = seqbase + qt * 128;
    __syncthreads();
    stage_qk(P + (size_t)qbase * PW + C_CQ + head * 64, PW, Qs, sample, qt * 128, 0.125f, rt);
    __syncthreads();
    bf16x8 qf[2];
    qf[0] = *(const bf16x8*)(Qs + (wid * 16 + fr) * 72 + fq * 8); qf[1] = *(const bf16x8*)(Qs + (wid * 16 + fr) * 72 + 32 + fq * 8);
    float m = PIN(22)[l * 4 + head], lsum = 1.0f;
    f32x4 oacc[4];
#pragma unroll
    for (int i = 0; i < 4; ++i) oacc[i] = (f32x4){0.f, 0.f, 0.f, 0.f};
    const int nkb = sample ? 7 : 2;
    const int qpos = qt * 128 + wid * 16 + fr;
    const float* ck = PIN(2); const float* cv = PIN(3);
    auto kinfo = [&](int kb, const float*& ks, const float*& vs, int& stride, bool& rope, bool& mask, int& kpos0) -> bool {
        if (!sample) { ks = P + (size_t)(seqbase + kb * 128) * PW + C_CK + kh * 64; vs = ks + (C_CV - C_CK); stride = PW; rope = false; mask = false; kpos0 = 0; return true; }
        if (kb < 3) { const int nbk = qt - 1 + kb; if (nbk < 0 || nbk >= 8) return false; kpos0 = nbk * 128;
            ks = P + (size_t)(seqbase + kpos0) * PW + C_CK + kh * 64; vs = ks + (C_CV - C_CK); stride = PW; rope = true; mask = (kb != 1); return true; }
        const size_t o = ((size_t)((b * 2 + l) * 512 + (kb - 3) * 128) * 2 + kh) * 64; ks = ck + o; vs = cv + o; stride = 128; rope = false; mask = false; kpos0 = 0; return true;
    };
    f32x4 kx1[2], kx2[2], vx[2][2];
    auto kload = [&](const float* ks, const float* vs, int stride) {
#pragma unroll
        for (int i = 0; i < 2; ++i) { const int task = tid + i * 512, row = task >> 3, half = (task >> 2) & 1, quad = task & 3;
            const float* s_ = ks + (size_t)row * stride + half * 32 + quad * 4; kx1[i] = *(const f32x4*)s_; kx2[i] = *(const f32x4*)(s_ + 16); }
#pragma unroll
        for (int i = 0; i < 2; ++i) { const int task = tid + i * 512, kp = task >> 4, dq = task & 15;
            vx[i][0] = *(const f32x4*)(vs + (size_t)(2 * kp) * stride + dq * 4); vx[i][1] = *(const f32x4*)(vs + (size_t)(2 * kp + 1) * stride + dq * 4); }
    };
    auto kstore = [&](bool rope, int kpos0) {
#pragma unroll
        for (int i = 0; i < 2; ++i) { const int task = tid + i * 512, row = task >> 3, half = (task >> 2) & 1, quad = task & 3;
            f32x4 x1 = kx1[i], x2 = kx2[i];
            if (rope) { const int pos = kpos0 + row; const int pi = half ? (pos & 63) : (pos >> 6);
#pragma unroll
                for (int j = 0; j < 4; ++j) { const f32x2 cs = rt[pi * 16 + quad * 4 + j]; const float a_ = x1[j], b_ = x2[j]; x1[j] = a_ * cs[0] - b_ * cs[1]; x2[j] = b_ * cs[0] + a_ * cs[1]; } }
            u32x2 w1, w2; w1[0] = cvt_pk_bf16(x1[0], x1[1]); w1[1] = cvt_pk_bf16(x1[2], x1[3]); w2[0] = cvt_pk_bf16(x2[0], x2[1]); w2[1] = cvt_pk_bf16(x2[2], x2[3]);
            *(u32x2*)(Ks + row * 72 + half * 32 + quad * 4) = w1; *(u32x2*)(Ks + row * 72 + half * 32 + 16 + quad * 4) = w2; }
#pragma unroll
        for (int i = 0; i < 2; ++i) { const int task = tid + i * 512, kp = task >> 4, dq = task & 15;
#pragma unroll
            for (int j = 0; j < 4; ++j) *(unsigned*)(Vt + (dq * 4 + j) * 136 + 2 * kp) = cvt_pk_bf16(vx[i][0][j], vx[i][1][j]); }
    };
    const float* ksrc = nullptr; const float* vsrc = nullptr; int stride = 0, kpos0n = 0; bool ropen = false, maskn = false;
    int kb = 0;
    while (kb < nkb && !kinfo(kb, ksrc, vsrc, stride, ropen, maskn, kpos0n)) ++kb;
    if (kb < nkb) kload(ksrc, vsrc, stride);
    while (kb < nkb) {
        const bool mask = maskn; const int kpos0 = kpos0n; const bool rope = ropen;
        __syncthreads();
        kstore(rope, kpos0);
        __syncthreads();
        int nk = kb + 1;
        while (nk < nkb && !kinfo(nk, ksrc, vsrc, stride, ropen, maskn, kpos0n)) ++nk;
        if (nk < nkb) kload(ksrc, vsrc, stride);
        kb = nk;
#pragma unroll
        for (int sb = 0; sb < 4; ++sb) {
            f32x4 s0 = (f32x4){0.f, 0.f, 0.f, 0.f}, s1 = s0;
#pragma unroll
            for (int dh = 0; dh < 2; ++dh) {
                const bf16x8 k0 = *(const bf16x8*)(Ks + (sb * 32 + fr) * 72 + dh * 32 + fq * 8), k1 = *(const bf16x8*)(Ks + (sb * 32 + 16 + fr) * 72 + dh * 32 + fq * 8);
                s0 = __builtin_amdgcn_mfma_f32_16x16x32_bf16(k0, qf[dh], s0, 0, 0, 0);
                s1 = __builtin_amdgcn_mfma_f32_16x16x32_bf16(k1, qf[dh], s1, 0, 0, 0);
            }
            if (mask) {
#pragma unroll
                for (int j = 0; j < 4; ++j) { const int k0p = kpos0 + sb * 32 + fq * 4 + j, k1p = k0p + 16; int d0 = qpos - k0p, d1 = qpos - k1p; d0 = d0 < 0 ? -d0 : d0; d1 = d1 < 0 ? -d1 : d1;
                    if (d0 > 128) s0[j] = -1e30f; if (d1 > 128) s1[j] = -1e30f; }
            }
            float mx = fmaxf(fmaxf(fmaxf(s0[0], s0[1]), fmaxf(s0[2], s0[3])), fmaxf(fmaxf(s1[0], s1[1]), fmaxf(s1[2], s1[3])));
            mx = fmaxf(mx, __shfl_xor(mx, 16)); mx = fmaxf(mx, __shfl_xor(mx, 32));
            const float mn = fmaxf(m, mx), alpha = __expf(m - mn);
            float rs = 0.f;
#pragma unroll
            for (int j = 0; j < 4; ++j) { s0[j] = __expf(s0[j] - mn); s1[j] = __expf(s1[j] - mn); rs += s0[j] + s1[j]; }
            rs += __shfl_xor(rs, 16); rs += __shfl_xor(rs, 32);
            lsum = lsum * alpha + rs; m = mn;
            u32x4 pw; pw[0] = cvt_pk_bf16(s0[0], s0[1]); pw[1] = cvt_pk_bf16(s0[2], s0[3]); pw[2] = cvt_pk_bf16(s1[0], s1[1]); pw[3] = cvt_pk_bf16(s1[2], s1[3]);
            bf16x8 pf; __builtin_memcpy(&pf, &pw, 16);
#pragma unroll
            for (int dt = 0; dt < 4; ++dt) {
                const bf16_t* vp = Vt + (dt * 16 + fr) * 136 + sb * 32 + fq * 4;
                u32x4 vw; const u32x2 va = *(const u32x2*)vp, vb = *(const u32x2*)(vp + 16); vw[0] = va[0]; vw[1] = va[1]; vw[2] = vb[0]; vw[3] = vb[1];
                bf16x8 vf; __builtin_memcpy(&vf, &vw, 16);
                oacc[dt] = oacc[dt] * alpha;
                oacc[dt] = __builtin_amdgcn_mfma_f32_16x16x32_bf16(vf, pf, oacc[dt], 0, 0, 0);
            }
        }
    }
    const float inv = 1.0f / lsum;
    const size_t t = (size_t)(qbase + wid * 16 + fr);
#pragma unroll
    for (int dt = 0; dt < 4; ++dt) {
        const int col = 512 + head * 64 + dt * 16 + fq * 4;
        const bf16x4 z = *(const bf16x4*)(Z + t * DM + col);
        u32x2 w; w[0] = cvt_pk_bf16(oacc[dt][0] * inv * bf2f((bf16_t)z[0]), oacc[dt][1] * inv * bf2f((bf16_t)z[1]));
        w[1] = cvt_pk_bf16(oacc[dt][2] * inv * bf2f((bf16_t)z[2]), oacc[dt][3] * inv * bf2f((bf16_t)z[3]));
        *(u32x2*)(YS + t * DM + col) = w;
    }
}

__device__ void chunk_item(const Params& p, int l, int ci, unsigned char* ldsb) {
    const int tid = TID(), lane = tid & 63, wid = tid >> 6, fr = lane & 15, fq = lane >> 4;
    const int chunk = ci >> 2, g = ci & 3, base = chunk * 128;
    bf16_t* wsb = (bf16_t*)ldsb;
    bf16_t* vt = wsb + 128 * 136;
    const float* P = (const float*)(PWS + WS_P);
    const bf16_t* Z = (const bf16_t*)(PWS + WS_Z);
    bf16_t* YS = (bf16_t*)(PWS + WS_YS);
    const float* wsrc = PIN(11) + (size_t)(l * 4 + g) * 128 * 128;
    __syncthreads();
#pragma unroll
    for (int i = 0; i < 8; ++i) { const int idx = tid + i * 512, r = idx >> 5, c4 = (idx & 31) * 4; const f32x4 v = *(const f32x4*)(wsrc + r * 128 + c4);
        u32x2 w; w[0] = cvt_pk_bf16(v[0], v[1]); w[1] = cvt_pk_bf16(v[2], v[3]); *(u32x2*)(wsb + r * 136 + c4) = w; }
    stage_vt(P + (size_t)base * PW + C_AV + g * 64, PW, vt, 128);
    __syncthreads();
    f32x4 acc[4];
#pragma unroll
    for (int n = 0; n < 4; ++n) acc[n] = (f32x4){0.f, 0.f, 0.f, 0.f};
#pragma unroll
    for (int k = 0; k < 4; ++k) {
        const bf16x8 af = *(const bf16x8*)(wsb + (wid * 16 + fr) * 136 + k * 32 + fq * 8);
#pragma unroll
        for (int n = 0; n < 4; ++n) { const bf16x8 bfv = *(const bf16x8*)(vt + (n * 16 + fr) * 136 + k * 32 + fq * 8);
            acc[n] = __builtin_amdgcn_mfma_f32_16x16x32_bf16(bfv, af, acc[n], 0, 0, 0); }
    }
    const int i = wid * 16 + fr; const size_t t = base + i;
    const float bsi = PIN(12)[(l * 4 + g) * 128 + i];
#pragma unroll
    for (int n = 0; n < 4; ++n) { const int col = g * 64 + n * 16 + fq * 4;
        const f32x4 u = *(const f32x4*)(P + t * PW + C_AU + col);
        const bf16x4 z = *(const bf16x4*)(Z + t * DM + col);
        u32x2 w; w[0] = cvt_pk_bf16(u[0] * (acc[n][0] + bsi) * bf2f((bf16_t)z[0]), u[1] * (acc[n][1] + bsi) * bf2f((bf16_t)z[1]));
        w[1] = cvt_pk_bf16(u[2] * (acc[n][2] + bsi) * bf2f((bf16_t)z[2]), u[3] * (acc[n][3] + bsi) * bf2f((bf16_t)z[3]));
        *(u32x2*)(YS + t * DM + col) = w; }
}

__device__ void pool_item(const Params& p, int l, int pi, unsigned char* ldsb) {
    const int tid = TID(), lane = tid & 63, wid = tid >> 6, fr = lane & 15, fq = lane >> 4, half = tid >> 8, ch = tid & 255, g = ch >> 6;
    const int tb = pi * 32; int seqbase, L, pos0; seq_of(tb, seqbase, L, pos0);
    float* pt = (float*)ldsb;
    bf16_t* dl = (bf16_t*)(pt + 48 * 256);
    bf16_t* wt = dl + 32 * 264;
    const float* P = (const float*)(PWS + WS_P);
    const bf16_t* Z = (const bf16_t*)(PWS + WS_Z);
    bf16_t* YS = (bf16_t*)(PWS + WS_YS);
    __syncthreads();
#pragma unroll
    for (int i = 0; i < 6; ++i) { const int idx = tid + i * 512, rr = idx >> 6, c4 = (idx & 63) * 4; const int pos = pos0 - 8 + rr;
        f32x4 v = (f32x4){0.f, 0.f, 0.f, 0.f};
        if (pos >= 0 && pos < L) v = *(const f32x4*)(P + (size_t)(seqbase + pos) * PW + C_DP + c4);
        *(f32x4*)(pt + rr * 256 + c4) = v; }
    { const float* pwsrc = PIN(23) + (size_t)l * 4 * 64 * 64;
#pragma unroll
      for (int gg = 0; gg < 4; ++gg) stage_vt(pwsrc + gg * 4096, 64, wt + gg * 64 * 72, 64, 72); }
    __syncthreads();
    const int w = 2 << g;
    for (int i = 0; i < 16; ++i) { const int tk = half * 16 + i, pos = pos0 + tk;
        int lo = pos - (w >> 1), hi = lo + w; lo = lo < 0 ? 0 : lo; hi = hi > L ? L : hi;
        float sm = 0.f;
        for (int q = lo; q < hi; ++q) sm += pt[(q - pos0 + 8) * 256 + ch];
        dl[tk * 264 + ch] = f2bf(sm / (float)(hi - lo) - pt[(tk + 8) * 256 + ch]); }
    __syncthreads();
    const int gw = wid >> 1, th = wid & 1;
    f32x4 acc[4];
#pragma unroll
    for (int n = 0; n < 4; ++n) acc[n] = (f32x4){0.f, 0.f, 0.f, 0.f};
#pragma unroll
    for (int k = 0; k < 2; ++k) {
        const bf16x8 af = *(const bf16x8*)(dl + (th * 16 + fr) * 264 + gw * 64 + k * 32 + fq * 8);
#pragma unroll
        for (int n = 0; n < 4; ++n) { const bf16x8 bfv = *(const bf16x8*)(wt + (gw * 64 + n * 16 + fr) * 72 + k * 32 + fq * 8);
            acc[n] = __builtin_amdgcn_mfma_f32_16x16x32_bf16(bfv, af, acc[n], 0, 0, 0); }
    }
    const size_t t = tb + th * 16 + fr;
#pragma unroll
    for (int n = 0; n < 4; ++n) { const int oc = gw * 64 + n * 16 + fq * 4;
        const f32x4 sc = *(const f32x4*)(PIN(24) + l * 256 + oc);
        const bf16x4 z = *(const bf16x4*)(Z + t * DM + 768 + oc);
        u32x2 wv; wv[0] = cvt_pk_bf16(acc[n][0] * sc[0] * bf2f((bf16_t)z[0]), acc[n][1] * sc[1] * bf2f((bf16_t)z[1]));
        wv[1] = cvt_pk_bf16(acc[n][2] * sc[2] * bf2f((bf16_t)z[2]), acc[n][3] * sc[3] * bf2f((bf16_t)z[3]));
        *(u32x2*)(YS + t * DM + 768 + oc) = wv; }
}

__device__ void phaseB1(const Params& p, int l, unsigned char* lds, int slot = 0, int part = 127) {
    const int tid = TID(), wid = tid >> 6;
    float* wl = (float*)lds + wid * 3072;
    if (!(part & 1)) {} else
    { const int nbh = (int)gridDim.x >> 1;
      if ((int)blockIdx.x < nbh) { if (wid < 4 && (part & 4)) for (int it = blockIdx.x * 4 + wid; it < 512; it += nbh * 4) { const int q = it >> 4, b = q >> 3;
            scan_run<1>(p, l, true, b, (q >> 1) & 3, q & 1, it & 15, 1024, NTP + b * 1024, wl); } }
      else { const int nb2 = (int)gridDim.x - nbh; if (part & 8) for (int it = ((int)blockIdx.x - nbh) * 8 + wid; it < 1024; it += nb2 * 8) { const int q = it >> 3, b = q >> 3;
            scan_run<2>(p, l, false, b, (q >> 1) & 3, q & 1, it & 7, 256, b * 256, wl); } } }
    __syncthreads();
    __shared__ int s_item;
    unsigned* ctr = (unsigned*)(PWS + WS_CTR) + l + 2 * slot;
    if (part & 2)
    for (;;) {
        if (tid == 0) s_item = (int)atomicAdd(ctr, 1u);
        __syncthreads();
        const int item = s_item;
        __syncthreads();
        if (item >= 768) break;
        if (item < 256) { if (part & 16) attn_item(p, l, item, lds); }
        else if (item < 512) { if (part & 32) chunk_item(p, l, item - 256, lds); }
        else { if (part & 64) pool_item(p, l, item - 512, lds); }
    }
}

__device__ void phaseB2(const Params& p, int l) {
    const int lane = TID() & 63, gw = blockIdx.x * 8 + (TID() >> 6), W = gridDim.x * 8;
    const float* O = (const float*)(PWS + WS_O);
    const float* recS = (const float*)(PWS + WS_RECS);
    const float* BC = (const float*)(PWS + WS_BC);
    const bf16_t* Z = (const bf16_t*)(PWS + WS_Z);
    bf16_t* YS = (bf16_t*)(PWS + WS_YS);
    const float* lng = PIN(20) + l * 256; const float* lnb = PIN(21) + l * 256;
    float g4[4], b4[4];
#pragma unroll
    for (int h = 0; h < 4; ++h) { g4[h] = lng[h * 64 + lane]; b4[h] = lnb[h * 64 + lane]; }
    for (int tok = gw; tok < NT; tok += W) {
        int seqbase, L, pos; seq_of(tok, seqbase, L, pos);
        float o[4], vv[4], z[4], mu[4], var[4];
        const f32x4 bc = *(const f32x4*)(BC + tok * 4);
#pragma unroll
        for (int h = 0; h < 4; ++h) { const int c = h * 64 + lane;
            o[h] = O[(size_t)tok * 256 + c] + O[(size_t)NT * 256 + (size_t)tok * 256 + c];
            vv[h] = recS[((size_t)seqbase * 4 + (size_t)h * L + pos) * 192 + 128 + lane];
            z[h] = bf2f(Z[(size_t)tok * DM + 256 + c]); }
#pragma unroll
        for (int h = 0; h < 4; ++h) mu[h] = wave_sum(o[h]) * (1.0f / 64.0f);
#pragma unroll
        for (int h = 0; h < 4; ++h) { o[h] -= mu[h]; var[h] = wave_sum(o[h] * o[h]) * (1.0f / 64.0f); }
#pragma unroll
        for (int h = 0; h < 4; ++h) { const float on = o[h] * rsqrtf(var[h] + 64e-5f);
            const float y = on * g4[h] + b4[h] + bc[h] * vv[h];
            YS[(size_t)tok * DM + 256 + h * 64 + lane] = f2bf(y * z[h]); }
    }
}

__device__ void phaseC1(const Params& p, int l, unsigned char* lds) {
    pg8::Gemm g; g.A = (const bf16_t*)(PWS + WS_H); g.Bt = (const bf16_t*)(PWS + WS_WTIN) + (size_t)l * INW * 1024 + (size_t)NA_COLS * 1024; g.M = NT; g.N = 4096; g.K = 1024;
    pg8::StaticOrder S; S.init(g.M, g.N, (int)gridDim.x, (int)blockIdx.x);
    EpiG E; E.G = (bf16_t*)(PWS + WS_G);
    pg8::gemm_phase<EpiG, pg8::StaticOrder, false>((PG8_LAS unsigned char*)lds, g, S, E, nullptr);
    __syncthreads();
}
__device__ void phaseC2(const Params& p, int l, unsigned char* lds) {
    constexpr int MT = 4, LDT = 72, A_BYTES = 256 * LDT * 2, B_BYTES = 128 * LDT * 2, BUF = A_BYTES + B_BYTES;
    const int tid = TID(), lane = tid & 63, wid = tid >> 6, wr = wid >> 1, wc = wid & 1, fr = lane & 15, fq = lane >> 4;
    const bf16_t* YS = (const bf16_t*)(PWS + WS_YS);
    const bf16_t* G = (const bf16_t*)(PWS + WS_G);
    const bf16_t* Wu = (const bf16_t*)(PWS + WS_WTUP) + (size_t)l * 4 * 1024 * 256;
    bf16_t* MG = (bf16_t*)(PWS + WS_MERGED);
    const int srow = tid >> 3, skc = tid & 7, soff = (srow * LDT + skc * 8) * 2;
    const int aoff = ((wr * MT * 16 + fr) * LDT + fq * 8) * 2, boff = A_BYTES + ((wc * 64 + fr) * LDT + fq * 8) * 2;
    const int NU = 32 * 8;
    for (int u = blockIdx.x; u < NU; u += gridDim.x) {
        const int pn = u / 32, pm = u % 32;
        const bf16_t* Ag = YS + ((size_t)pm * 256 + srow) * 1024 + skc * 8;
        const bf16_t* Bg = Wu + ((size_t)pn * 128 + srow) * 256 + skc * 8;
        f32x4 mg[4][4], acc[4][4]; zero_acc<4>(mg); zero_acc<4>(acc);
        u32x4 ra[MT], rb[2];
        auto gload = [&](int kt) {
#pragma unroll
            for (int i = 0; i < MT; ++i) ra[i] = *(const u32x4*)(Ag + (size_t)i * 64 * 1024 + kt * 64);
            const bf16_t* bb = Bg + (size_t)(kt >> 2) * 1024 * 256 + (kt & 3) * 64;
#pragma unroll
            for (int i = 0; i < 2; ++i) rb[i] = *(const u32x4*)(bb + (size_t)i * 64 * 256);
        };
        auto sstore = [&](int buf) { unsigned char* nb = lds + buf * BUF;
#pragma unroll
            for (int i = 0; i < MT; ++i) *(u32x4*)(nb + soff + i * 64 * LDT * 2) = ra[i];
#pragma unroll
            for (int i = 0; i < 2; ++i) *(u32x4*)(nb + A_BYTES + soff + i * 64 * LDT * 2) = rb[i];
        };
        __syncthreads();
        gload(0); sstore(0);
        __syncthreads();
        for (int t = 0; t < 16; ++t) {
            if (t + 1 < 16) gload(t + 1);
            const unsigned char* base = lds + (t & 1) * BUF;
#pragma unroll
            for (int kk = 0; kk < 2; ++kk) {
                bf16x8 af[MT], bfr[4];
#pragma unroll
                for (int m = 0; m < MT; ++m) af[m] = *(const bf16x8*)(base + aoff + m * 16 * LDT * 2 + kk * 64);
#pragma unroll
                for (int n = 0; n < 4; ++n) bfr[n] = *(const bf16x8*)(base + boff + n * 16 * LDT * 2 + kk * 64);
#pragma unroll
                for (int m = 0; m < MT; ++m)
#pragma unroll
                    for (int n = 0; n < 4; ++n) acc[m][n] = __builtin_amdgcn_mfma_f32_16x16x32_bf16(bfr[n], af[m], acc[m][n], 0, 0, 0);
            }
            if (t + 1 < 16) sstore((t + 1) & 1);
            if ((t & 3) == 3) {
                const int n = t >> 2;
#pragma unroll
                for (int m = 0; m < 4; ++m) { const int row = pm * 256 + wr * 64 + m * 16 + fr;
                    const bf16_t* gp = G + g_off(row, n * 1024 + pn * 128 + wc * 64 + fq * 4);
                    const bf16x8 ga = *(const bf16x8*)gp, gb = *(const bf16x8*)(gp + 8);
#pragma unroll
                    for (int q = 0; q < 4; ++q) {
#pragma unroll
                        for (int j = 0; j < 4; ++j) { const bf16_t gv = (bf16_t)(q < 2 ? ga[q * 4 + j] : gb[(q - 2) * 4 + j]); mg[m][q][j] += bf2f(gv) * acc[m][q][j]; }
                        acc[m][q] = (f32x4){0.f, 0.f, 0.f, 0.f}; } }
            }
            __syncthreads();
        }
#pragma unroll
        for (int m = 0; m < 4; ++m) { const size_t row = (size_t)pm * 256 + wr * 64 + m * 16 + fr;
#pragma unroll
            for (int q = 0; q < 4; ++q) { const int col = pn * 128 + wc * 64 + q * 16 + fq * 4;
                u32x2 w; w[0] = cvt_pk_bf16(mg[m][q][0], mg[m][q][1]); w[1] = cvt_pk_bf16(mg[m][q][2], mg[m][q][3]);
                *(u32x2*)(MG + row * DM + col) = w; } }
    }
}

__device__ void phaseD(const Params& p, int l, unsigned char* lds) {
    const int tid = TID(), lane = tid & 63, wid = tid >> 6, wr = wid >> 1, wc = wid & 1, fr = lane & 15, fq = lane >> 4;
    const bf16_t* MG = (const bf16_t*)(PWS + WS_MERGED);
    const bf16_t* Wo = (const bf16_t*)(PWS + WS_WTO) + (size_t)l * 1024 * 1024;
    const int NU = 32 * 8;
    for (int u = blockIdx.x; u < NU; u += gridDim.x) {
        const int pn = u / 32, pm = u % 32;
        f32x4 acc[4][4]; zero_acc<4>(acc);
        gemm_acc<4>(MG + (size_t)pm * 256 * 1024, 1024, Wo + (size_t)pn * 128 * 1024, 1024, 1024, acc, lds);
#pragma unroll
        for (int m = 0; m < 4; ++m) { const int row = pm * 256 + wr * 64 + m * 16 + fr;
            const float* xr = xrow_ptr(p, l, row);
            const float* gate = (const float*)(PWS + WS_MOD) + (size_t)(l * 5 + modrow_of(row)) * 3072 + 2048;
#pragma unroll
            for (int q = 0; q < 4; ++q) { const int col = pn * 128 + wc * 64 + q * 16 + fq * 4;
                const f32x4 xo = *(const f32x4*)(xr + col), gt = *(const f32x4*)(gate + col);
                *(f32x4*)(POUT + (size_t)row * DM + col) = xo + gt * acc[m][q]; } }
    }
}

__device__ void phaseF(const Params& p) {
    const int lane = TID() & 63, gw = blockIdx.x * 8 + (TID() >> 6), W = gridDim.x * 8;
    const float* g = PIN(27);
    for (int row = gw; row < NT; row += W) {
        float* x = POUT + (size_t)row * DM;
        f32x4 v[4]; float ss = 0.f;
#pragma unroll
        for (int i = 0; i < 4; ++i) { v[i] = *(const f32x4*)(x + i * 256 + lane * 4); ss += v[i][0] * v[i][0] + v[i][1] * v[i][1] + v[i][2] * v[i][2] + v[i][3] * v[i][3]; }
        ss = wave_sum(ss);
        const float rs = rsqrtf(ss * (1.0f / 1024.0f) + 1e-6f);
#pragma unroll
        for (int i = 0; i < 4; ++i) { const int c = i * 256 + lane * 4; *(f32x4*)(x + c) = v[i] * rs * *(const f32x4*)(g + c); }
    }
}

__global__ void __launch_bounds__(NTHREADS) fwd_megakernel(Params p) {
    extern __shared__ __attribute__((aligned(16))) unsigned char lds[];
    volatile LAS unsigned* st = (volatile LAS unsigned*)(lds + LDS_MAIN);
    if (threadIdx.x < 2) st[threadIdx.x] = 0u;
    if (threadIdx.x == 0) {
#pragma unroll
        for (int i = 0; i < 28; ++i) s_ptab[i] = (unsigned long long)p.in[i];
    }
    __syncthreads();
    const XcdBarrier xb = xcd_barrier_post((unsigned*)(PWS + WS_BAR), st);
#define GSYNC() xcd_barrier(xb)
    phase0(p, lds);
    GSYNC();
#pragma unroll 1
    for (int l = 0; l < 2; ++l) {
        phaseA0(p, l);
        GSYNC();
        phaseA(p, l, lds);
        GSYNC();
        phaseB0(p, l, lds);
        GSYNC();
        phaseB1(p, l, lds);
        GSYNC();
        phaseB2(p, l);
        phaseC1(p, l, lds);
        GSYNC();
        phaseC2(p, l, lds);
        GSYNC();
        phaseD(p, l, lds);
        GSYNC();
    }
    phaseF(p);
}

extern "C" void kernel_launch(void* const* d_in, const int* in_sizes, int n_in, void* d_out, int out_size, void* d_ws, size_t ws_size, hipStream_t stream) {
    static int grid_blocks = 0;
    if (!grid_blocks) {
        int dev = 0, cus = 0, per_cu = 0;
        hipGetDevice(&dev);
        hipDeviceGetAttribute(&cus, hipDeviceAttributeMultiprocessorCount, dev);
        hipFuncSetAttribute((const void*)fwd_megakernel, hipFuncAttributeMaxDynamicSharedMemorySize, LDS_BYTES);
        hipOccupancyMaxActiveBlocksPerMultiprocessor(&per_cu, (const void*)fwd_megakernel, NTHREADS, LDS_BYTES);
        if (per_cu < 1) { fprintf(stderr, "occupancy query returned %d\n", per_cu); per_cu = 1; }
        if (per_cu > 1) per_cu = 1;
        grid_blocks = cus * per_cu;
        if (ws_size < WS_END) fprintf(stderr, "workspace too small: %zu < %zu\n", ws_size, (size_t)WS_END);
    }
    Params p{};
    for (int i = 0; i < 28; ++i) p.in[i] = (const float*)d_in[i];
    p.out = (float*)d_out; p.ws = (unsigned char*)d_ws;
    hipMemsetAsync((char*)d_ws + WS_BAR, 0, 3456 * 4, stream);
    void* args[] = {&p};
    hipError_t e = hipLaunchCooperativeKernel((const void*)fwd_megakernel, dim3(grid_blocks), dim3(NTHREADS), args, LDS_BYTES, stream);
    if (e != hipSuccess) fprintf(stderr, "cooperative launch failed: %s (grid %d)\n", hipGetErrorString(e), grid_blocks);
}
```

```cpp
#include <hip/hip_runtime.h>
#include <hip/hip_cooperative_groups.h>
#include <cstdio>
namespace cg = cooperative_groups;

typedef unsigned short bf16_t;
typedef short bf16x8 __attribute__((ext_vector_type(8)));
typedef short bf16x4 __attribute__((ext_vector_type(4)));
typedef float f32x4 __attribute__((ext_vector_type(4)));
typedef float f32x2 __attribute__((ext_vector_type(2)));
typedef unsigned u32x4 __attribute__((ext_vector_type(4)));
typedef unsigned u32x2 __attribute__((ext_vector_type(2)));

constexpr int NT = 8192, NTP = 4096, DM = 1024, INW = 7296, NA_COLS = 3200, PW = 2176;
constexpr int NTHREADS = 512;
constexpr int C_AU = 0, C_AV = 256, C_BR = 512, C_BK = 768, C_BV = 1024, C_WD = 1280, C_AD = 1344, C_CQ = 1408, C_CK = 1664, C_CV = 1792, C_DP = 1920;
constexpr size_t O_YP = 0, O_YS = 4194304, O_NK = 8388608, O_NV = 9437184, O_NS = 10485760;
constexpr size_t WS_WTIN = 0;
constexpr size_t WS_WTUP = WS_WTIN + (size_t)2 * INW * DM * 2;
constexpr size_t WS_WTO  = WS_WTUP + (size_t)2 * 4 * 1024 * 256 * 2;
constexpr size_t WS_MOD  = WS_WTO + (size_t)2 * 1024 * 1024 * 2;
constexpr size_t WS_ROPE = WS_MOD + (size_t)2 * 5 * 3072 * 4;
constexpr size_t WS_CTR  = WS_ROPE + 64 * 16 * 8;
constexpr size_t WS_BAR  = WS_CTR + 256;
constexpr size_t WS_H    = WS_BAR + 3456 * 4;
constexpr size_t WS_P    = WS_H + (size_t)NT * DM * 2;
constexpr size_t WS_Z    = WS_P + (size_t)NT * PW * 4;
constexpr size_t WS_RECS = WS_Z + (size_t)NT * DM * 2;
constexpr size_t WS_RECD = WS_RECS + (size_t)NT * 4 * 192 * 4;
constexpr size_t WS_O    = WS_RECD + (size_t)2 * NT * 4 * 192 * 4;
constexpr size_t WS_BC   = WS_O + (size_t)2 * NT * 256 * 4;
constexpr size_t WS_YS   = WS_BC + (size_t)NT * 4 * 4;
constexpr size_t WS_LORAT = WS_YS + (size_t)NT * DM * 2;
constexpr size_t WS_END  = WS_LORAT + (size_t)2 * 4 * 256 * 64 * 2;
constexpr size_t WS_G = WS_P;
constexpr size_t WS_MERGED = WS_RECS;
constexpr size_t RECD_STRIDE = (size_t)NT * 4 * 192;

constexpr int LDS_MAIN = 131072;
constexpr int LDS_BYTES = LDS_MAIN + 16;

struct Params {
    const float* in[28];
    float* out;
    unsigned char* ws;
};
__shared__ unsigned long long s_ptab[28];
__device__ __forceinline__ const float* ld_inptr(int k) {
    const unsigned long long v = s_ptab[k];
    const unsigned lo = __builtin_amdgcn_readfirstlane((unsigned)v), hi = __builtin_amdgcn_readfirstlane((unsigned)(v >> 32));
    return (const float*)(((unsigned long long)hi << 32) | lo);
}
#define PIN(k) (ld_inptr(k))
#define POUT (p.out)
#define PWS (p.ws)

__device__ __forceinline__ int TID() { int t = threadIdx.x; asm volatile("" : "+v"(t)); return t; }
__device__ __forceinline__ unsigned cvt_pk_bf16(float lo, float hi) { unsigned r; asm volatile("v_cvt_pk_bf16_f32 %0, %1, %2" : "=v"(r) : "v"(lo), "v"(hi)); return r; }
__device__ __forceinline__ bf16_t f2bf(float f) { return (bf16_t)(cvt_pk_bf16(f, 0.f) & 0xffffu); }
__device__ __forceinline__ float bf2f(bf16_t b) { return __uint_as_float(((unsigned)b) << 16); }
__device__ __forceinline__ float sigmoidf_(float x) { return 1.0f / (1.0f + __expf(-x)); }
__device__ __forceinline__ float siluf_(float x) { return x / (1.0f + __expf(-x)); }
template <int CTRL> __device__ __forceinline__ float dpp_f(float x) { return __int_as_float(__builtin_amdgcn_update_dpp(0, __float_as_int(x), CTRL, 0xF, 0xF, false)); }
__device__ __forceinline__ float row16_sum(float x) {
    x += dpp_f<0x128>(x); x += dpp_f<0x124>(x); x += dpp_f<0x122>(x); x += dpp_f<0x121>(x); return x;
}
__device__ __forceinline__ float wave_sum(float v) { v = row16_sum(v); v += __shfl_xor(v, 16); v += __shfl_xor(v, 32); return v; }
__device__ __forceinline__ void seq_of(int tok, int& seqbase, int& L, int& pos) {
    if (tok < NTP) { seqbase = tok & ~255; L = 256; pos = tok & 255; }
    else { int t2 = tok - NTP; seqbase = NTP + (t2 & ~1023); L = 1024; pos = t2 & 1023; }
}
__device__ __forceinline__ int modrow_of(int tok) { return tok < NTP ? 0 : 1 + ((tok - NTP) >> 10); }


#define XB_TMO      128
#define XB_XCNT(j)  (256  + 64 * (j))
#define XB_XSUB(j)  (1280 + 64 * (j))
#define XB_XGEN(j)  (2304 + 64 * (j))
#define XB_TOP      3328
#define XB_TOPGEN   3392
#define XCD_BAR_WORDS 3456
#define XB_SPIN_CAP (1u << 18)
#define LAS __attribute__((address_space(3)))
__device__ __forceinline__ unsigned xb_ld(unsigned* p)              { return __hip_atomic_load(p, __ATOMIC_RELAXED, __HIP_MEMORY_SCOPE_AGENT); }
__device__ __forceinline__ unsigned xb_add(unsigned* p, unsigned v) { return __hip_atomic_fetch_add(p, v, __ATOMIC_RELAXED, __HIP_MEMORY_SCOPE_AGENT); }
__device__ __forceinline__ unsigned xb_xcc_id() { return (unsigned)__builtin_amdgcn_s_getreg((3 << 11) | 20) & 0xFu; }
#define XB_SPIN(cond, bar) do { unsigned _sp = 0; while (cond) { __builtin_amdgcn_s_sleep(1); \
    if ((++_sp & 255u) == 0u) { if (xb_ld(&(bar)[XB_TMO])) break; if (_sp > XB_SPIN_CAP) { atomicAdd(&(bar)[XB_TMO], 1u); break; } } } } while (0)
struct XcdBarrier { unsigned* bar; unsigned x; volatile LAS unsigned* st; };
__device__ __forceinline__ XcdBarrier xcd_barrier_post(unsigned* bar, volatile LAS unsigned* st) {
    XcdBarrier b; b.bar = bar; b.x = xb_xcc_id(); b.st = st;
    if (threadIdx.x == 0) (void)xb_add(&bar[XB_XCNT(b.x)], 1u);
    return b;
}
__device__ __forceinline__ void xcd_barrier_complete(unsigned* bar, unsigned x, unsigned& nloc, unsigned& nx) {
    const unsigned G = gridDim.x * gridDim.y * gridDim.z;
    unsigned sum, cnt, mine, sp = 0u;
    for (;;) {
        sum = 0u; cnt = 0u; mine = 0u;
#pragma unroll
        for (unsigned j = 0; j < 16; ++j) { const unsigned c = xb_ld(&bar[XB_XCNT(j)]); sum += c; cnt += (c > 0u) ? 1u : 0u; mine = (j == x) ? c : mine; }
        if (sum == G) break;
        __builtin_amdgcn_s_sleep(1);
        if ((++sp & 255u) == 0u) { if (xb_ld(&bar[XB_TMO])) break; if (sp > XB_SPIN_CAP) { atomicAdd(&bar[XB_TMO], 1u); break; } }
    }
    nloc = mine > 0u ? mine : 1u; nx = cnt > 0u ? cnt : 1u;
}
__device__ __forceinline__ void xcd_barrier(const XcdBarrier& b0) {
    asm volatile("s_waitcnt vmcnt(0)" ::: "memory");
    __syncthreads();
    if (threadIdx.x == 0) {
        XcdBarrier b = b0;
        { unsigned xx = xb_xcc_id(); asm volatile("" : "+s"(xx)); b.x = xx; }
        unsigned* bar = b.bar;
        __builtin_amdgcn_s_waitcnt(0);
        unsigned nloc = b.st[0], nx = b.st[1];
        if (nloc == 0u) { xcd_barrier_complete(bar, b.x, nloc, nx); b.st[0] = nloc; b.st[1] = nx; }
        const unsigned old = xb_add(&bar[XB_XSUB(b.x)], 1u);
        const unsigned gen = old / nloc;
        if (old + 1u == (gen + 1u) * nloc) {
            __builtin_amdgcn_fence(__ATOMIC_RELEASE, "agent");
            asm volatile("s_waitcnt vmcnt(0)" ::: "memory");
            const unsigned og = xb_add(&bar[XB_TOP], 1u);
            const unsigned tg = og / nx;
            if (og + 1u == (tg + 1u) * nx) xb_add(&bar[XB_TOPGEN], 1u);
            else XB_SPIN(xb_ld(&bar[XB_TOPGEN]) == tg, bar);
            __builtin_amdgcn_fence(__ATOMIC_ACQUIRE, "agent");
            xb_add(&bar[XB_XGEN(b.x)], 1u);
            asm volatile("s_waitcnt vmcnt(0)" ::: "memory");
        } else {
            XB_SPIN(xb_ld(&bar[XB_XGEN(b.x)]) == gen, bar);
            __builtin_amdgcn_fence(__ATOMIC_ACQUIRE, "agent");
            asm volatile("s_waitcnt vmcnt(0)" ::: "memory");
        }
    }
    __syncthreads();
}

__device__ void conv_tile(const float* __restrict__ src, int N, bf16_t* __restrict__ dst, int K, int kt, int nt, float* tile) {
    const int tid = TID();
    { const int r = tid >> 4, c4 = (tid & 15) * 4;
#pragma unroll
      for (int i = 0; i < 2; ++i) { const int k = r + 32 * i; const f32x4 v = *(const f32x4*)(src + (size_t)(kt * 64 + k) * N + nt * 64 + c4);
          tile[k * 65 + c4 + 0] = v[0]; tile[k * 65 + c4 + 1] = v[1]; tile[k * 65 + c4 + 2] = v[2]; tile[k * 65 + c4 + 3] = v[3]; } }
    __syncthreads();
    { const int n = tid >> 3, kc = (tid & 7) * 8; u32x4 w;
      w[0] = cvt_pk_bf16(tile[(kc + 0) * 65 + n], tile[(kc + 1) * 65 + n]); w[1] = cvt_pk_bf16(tile[(kc + 2) * 65 + n], tile[(kc + 3) * 65 + n]);
      w[2] = cvt_pk_bf16(tile[(kc + 4) * 65 + n], tile[(kc + 5) * 65 + n]); w[3] = cvt_pk_bf16(tile[(kc + 6) * 65 + n], tile[(kc + 7) * 65 + n]);
      *(u32x4*)(dst + (size_t)(nt * 64 + n) * K + kt * 64 + kc) = w; }
    __syncthreads();
}

__device__ void mod_item(const Params& p, int l, int cc, float* lds) {
    const int tid = TID();
    float* sc = lds;
    float* red = lds + 5120;
    for (int i = tid; i < 5120; i += NTHREADS) { const int r = i >> 10, k = i & 1023; const float v = (r == 0) ? PIN(6)[k] : PIN(5)[(r - 1) * 1024 + k]; sc[i] = siluf_(v); }
    __syncthreads();
    const int kg = tid >> 5, c = tid & 31, col = cc * 32 + c;
    float a[5] = {0.f, 0.f, 0.f, 0.f, 0.f};
    const float* w = PIN(7) + (size_t)l * 1024 * 3072 + col;
    for (int k = kg * 64; k < kg * 64 + 64; ++k) { const float wv = w[(size_t)k * 3072];
#pragma unroll
        for (int r = 0; r < 5; ++r) a[r] += sc[r * 1024 + k] * wv; }
#pragma unroll
    for (int r = 0; r < 5; ++r) red[(kg * 5 + r) * 32 + c] = a[r];
    __syncthreads();
    if (tid < 160) { const int r = tid >> 5, c2 = tid & 31; float s = PIN(8)[l * 3072 + cc * 32 + c2];
        for (int g = 0; g < 16; ++g) s += red[(g * 5 + r) * 32 + c2];
        ((float*)(PWS + WS_MOD))[(l * 5 + r) * 3072 + cc * 32 + c2] = s; }
    __syncthreads();
}

__device__ void phase0(const Params& p, unsigned char* lds) {
    const int NCONV_IN = 2 * 16 * 114, NCONV_UP = 8 * 64, NCONV_O = 2 * 256, NCONV_L = 32, NMOD = 192;
    const int total = NCONV_IN + NCONV_UP + NCONV_O + NCONV_L + NMOD + 1;
    for (int it = blockIdx.x; it < total; it += gridDim.x) {
        int i = it;
        if (i < NCONV_IN) { const int l = i / 1824, r = i % 1824, nt = r / 16, kt = r % 16;
            conv_tile(PIN(10) + (size_t)l * 1024 * INW, INW, (bf16_t*)(PWS + WS_WTIN) + (size_t)l * INW * 1024, 1024, kt, nt, (float*)lds); continue; }
        i -= NCONV_IN;
        if (i < NCONV_UP) { const int mtx = i / 64, r = i % 64, nt = r / 4, kt = r % 4;
            conv_tile(PIN(25) + (size_t)mtx * 256 * 1024, 1024, (bf16_t*)(PWS + WS_WTUP) + (size_t)mtx * 1024 * 256, 256, kt, nt, (float*)lds); continue; }
        i -= NCONV_UP;
        if (i < NCONV_O) { const int l = i / 256, r = i % 256, nt = r / 16, kt = r % 16;
            conv_tile(PIN(26) + (size_t)l * 1024 * 1024, 1024, (bf16_t*)(PWS + WS_WTO) + (size_t)l * 1024 * 1024, 1024, kt, nt, (float*)lds); continue; }
        i -= NCONV_O;
        if (i < NCONV_L) { const int l = i >> 4, m = (i >> 2) & 3, nt = i & 3;
            conv_tile((m < 2 ? PIN(14) : PIN(16)) + (size_t)(l * 2 + (m & 1)) * 64 * 256, 256, (bf16_t*)(PWS + WS_LORAT) + (size_t)(l * 4 + m) * 256 * 64, 64, 0, nt, (float*)lds); continue; }
        i -= NCONV_L;
        if (i < NMOD) { mod_item(p, i / 96, i % 96, (float*)lds); continue; }
        for (int e = TID(); e < 1024; e += NTHREADS) { const int pos = e >> 4, f = e & 15;
            const float inv = exp2f(-(float)f * (13.287712379549449f / 16.0f)); const float ang = (float)pos * inv;
            float sn, cs; sn = sinf(ang); cs = cosf(ang);
            ((f32x2*)(PWS + WS_ROPE))[e] = (f32x2){cs, sn}; }
        if (TID() < 64) ((unsigned*)(PWS + WS_CTR))[TID()] = 0u;
    }
}

__device__ __forceinline__ const float* xrow_ptr(const Params& p, int l, int row) {
    if (l == 0) return row < NTP ? PIN(0) + (size_t)row * DM : PIN(1) + (size_t)(row - NTP) * DM;
    return POUT + (size_t)row * DM;
}
__device__ void phaseA0(const Params& p, int l) {
    const int lane = TID() & 63, gw = blockIdx.x * 8 + (TID() >> 6), W = gridDim.x * 8;
    const float* g = PIN(9) + l * DM;
    bf16_t* H = (bf16_t*)(PWS + WS_H);
    for (int row = gw; row < NT; row += W) {
        const float* x = xrow_ptr(p, l, row);
        f32x4 v[4]; float ss = 0.f;
#pragma unroll
        for (int i = 0; i < 4; ++i) { v[i] = *(const f32x4*)(x + i * 256 + lane * 4); ss += v[i][0] * v[i][0] + v[i][1] * v[i][1] + v[i][2] * v[i][2] + v[i][3] * v[i][3]; }
        ss = wave_sum(ss);
        const float rs = rsqrtf(ss * (1.0f / 1024.0f) + 1e-6f);
        const float* mod = (const float*)(PWS + WS_MOD) + (size_t)(l * 5 + modrow_of(row)) * 3072;
#pragma unroll
        for (int i = 0; i < 4; ++i) { const int c = i * 256 + lane * 4;
            const f32x4 gg = *(const f32x4*)(g + c), sh = *(const f32x4*)(mod + c), scl = *(const f32x4*)(mod + 1024 + c);
            f32x4 h = v[i] * rs * gg * (1.0f + scl) + sh;
            u32x2 w; w[0] = cvt_pk_bf16(h[0], h[1]); w[1] = cvt_pk_bf16(h[2], h[3]);
            *(u32x2*)(H + (size_t)row * DM + c) = w; }
    }
}

template <int MT>
__device__ __forceinline__ void gemm_acc(const bf16_t* __restrict__ A, int lda, const bf16_t* __restrict__ B, int ldb, int K, f32x4 (&acc)[MT][4], unsigned char* lds) {
    constexpr int BM = MT * 64, LDT = 72, A_BYTES = BM * LDT * 2, B_BYTES = 128 * LDT * 2, BUF = A_BYTES + B_BYTES;
    const int tid = TID(), lane = tid & 63, wid = tid >> 6, wr = wid >> 1, wc = wid & 1, fr = lane & 15, fq = lane >> 4;
    u32x4 ra[MT], rb[2];
    const int srow = tid >> 3, skc = tid & 7;
    const bf16_t* Ag = A + (size_t)srow * lda + skc * 8;
    const bf16_t* Bg = B + (size_t)srow * ldb + skc * 8;
    const int soff = (srow * LDT + skc * 8) * 2;
    const int nt = K >> 6;
    __syncthreads();
#pragma unroll
    for (int i = 0; i < MT; ++i) ra[i] = *(const u32x4*)(Ag + (size_t)i * 64 * lda);
#pragma unroll
    for (int i = 0; i < 2; ++i) rb[i] = *(const u32x4*)(Bg + (size_t)i * 64 * ldb);
#pragma unroll
    for (int i = 0; i < MT; ++i) *(u32x4*)(lds + soff + i * 64 * LDT * 2) = ra[i];
#pragma unroll
    for (int i = 0; i < 2; ++i) *(u32x4*)(lds + A_BYTES + soff + i * 64 * LDT * 2) = rb[i];
    __syncthreads();
    const int aoff = ((wr * MT * 16 + fr) * LDT + fq * 8) * 2, boff = A_BYTES + ((wc * 64 + fr) * LDT + fq * 8) * 2;
    for (int t = 0; t < nt; ++t) {
        if (t + 1 < nt) {
#pragma unroll
            for (int i = 0; i < MT; ++i) ra[i] = *(const u32x4*)(Ag + (size_t)i * 64 * lda + (t + 1) * 64);
#pragma unroll
            for (int i = 0; i < 2; ++i) rb[i] = *(const u32x4*)(Bg + (size_t)i * 64 * ldb + (t + 1) * 64);
        }
        const unsigned char* base = lds + (t & 1) * BUF;
#pragma unroll
        for (int kk = 0; kk < 2; ++kk) {
            bf16x8 af[MT], bfr[4];
#pragma unroll
            for (int m = 0; m < MT; ++m) af[m] = *(const bf16x8*)(base + aoff + m * 16 * LDT * 2 + kk * 64);
#pragma unroll
            for (int n = 0; n < 4; ++n) bfr[n] = *(const bf16x8*)(base + boff + n * 16 * LDT * 2 + kk * 64);
#pragma unroll
            for (int m = 0; m < MT; ++m)
#pragma unroll
                for (int n = 0; n < 4; ++n) acc[m][n] = __builtin_amdgcn_mfma_f32_16x16x32_bf16(bfr[n], af[m], acc[m][n], 0, 0, 0);
        }
        if (t + 1 < nt) {
            unsigned char* nb = lds + ((t + 1) & 1) * BUF;
#pragma unroll
            for (int i = 0; i < MT; ++i) *(u32x4*)(nb + soff + i * 64 * LDT * 2) = ra[i];
#pragma unroll
            for (int i = 0; i < 2; ++i) *(u32x4*)(nb + A_BYTES + soff + i * 64 * LDT * 2) = rb[i];
        }
        __syncthreads();
    }
}
template <int MT> __device__ __forceinline__ void zero_acc(f32x4 (&acc)[MT][4]) {
#pragma unroll
    for (int m = 0; m < MT; ++m)
#pragma unroll
        for (int n = 0; n < 4; ++n) acc[m][n] = (f32x4){0.f, 0.f, 0.f, 0.f};
}

namespace pg8 {
#define PG8_LAS __attribute__((address_space(3)))
typedef unsigned short bf16_t;
typedef short bf16x8 __attribute__((ext_vector_type(8)));
typedef float f32x4 __attribute__((ext_vector_type(4)));
typedef unsigned u32x4 __attribute__((ext_vector_type(4)));
constexpr int BM = 256, BK = 64, HALF = 128, HTB = HALF * BK * 2  , STAGE_BYTES = 8 * HTB, NXCD = 8, WGM = 8;

__host__ __device__ __forceinline__ int lds_byte(int r, int c) { const int st = (r >> 4) * 2 + (c >> 5), rr = r & 15, cc = c & 31, ob = rr * 64 + cc * 2; return st * 1024 + (ob ^ (((ob >> 9) & 1) << 5)); }
__host__ __device__ __forceinline__ void stage_rc(int b, int& R, int& C) { const int st = b / 1024, sb = b % 1024, swz = sb ^ (((sb >> 9) & 1) << 5); R = (st >> 1) * 16 + swz / 64; C = (st & 1) * 32 + (swz % 64) / 2; }
__host__ __device__ __forceinline__ int perm32(int rho) { const int n = rho >> 4, i = rho & 15; return 8 * (i >> 2) + 4 * n + (i & 3); }

struct Unit { int pm, pn; };
struct Gemm { const bf16_t* A; const bf16_t* Bt; int M, N, K; };

struct StaticOrder {
    int nM, nN, nwg, G, c;
    __host__ __device__ void init(int M, int N, int G_, int c_) { nM = M / BM; nN = N / BM; nwg = nM * nN; G = G_; c = c_; }
    __host__ __device__ bool next(int i, Unit& u) const {
        const long L = (long)i * G + c; if (L >= nwg) return false;
        int wgid = (int)L; { const int q = nwg / NXCD, r = nwg % NXCD, xcd = wgid % NXCD, off = wgid / NXCD; wgid = (xcd < r ? xcd * (q + 1) : r * (q + 1) + (xcd - r) * q) + off; }
        const int nig = WGM * nN, gid = wgid / nig, fm = gid * WGM, gsz = (nM - fm) < WGM ? (nM - fm) : WGM;
        u.pm = fm + ((wgid % nig) % gsz); u.pn = (wgid % nig) / gsz; return true;
    }
    __device__ __forceinline__ void a_ready(const Unit&) const {}
    __device__ __forceinline__ void done(const Unit&) const {}
};
template <class Epi, class Sched, bool STAMP = false>
__device__ __forceinline__ void gemm_phase(PG8_LAS unsigned char* lds, const Gemm g, const Sched& S, const Epi& E, unsigned long long* stamps) {
    const int tid = ::TID(), wid = __builtin_amdgcn_readfirstlane(tid >> 6), lane = tid & 63, wr = wid >> 2, wc = wid & 3, fr = lane & 15, fq = lane >> 4;
    const int K = g.K, nt = K / BK;
    int ts_lo = 0, ts_hi = 0, nts = 0; const unsigned long long rt_entry = STAMP ? (unsigned long long)wall_clock64() : 0ull;
#define PG8_STAMP() do { if (STAMP && wid == 0 && nts < 64) { const unsigned long long _c = (unsigned long long)clock64(); \
        ts_lo = (lane == nts) ? (int)(unsigned)_c : ts_lo; ts_hi = (lane == nts) ? (int)(unsigned)(_c >> 32) : ts_hi; ++nts; } } while (0)
    PG8_STAMP();
    unsigned voffA[2], voffB[2];
#pragma unroll
    for (int i = 0; i < 2; ++i) { int R, C; stage_rc(tid * 16 + i * 8192, R, C); const int Rb = Epi::PERM ? ((R & ~31) + perm32(R & 31)) : R;
        voffA[i] = (unsigned)(R * K + C) * 2u; voffB[i] = (unsigned)(Rb * K + C) * 2u; }
    const size_t kstep = (size_t)(BK * 2);
    const size_t hstep = (size_t)HALF * K * 2;
    const size_t tstep = 2 * hstep;
    const unsigned ldsw = (unsigned)wid * 1024u;
    const int aoff = lds_byte(wr * 64 + fr, fq * 8), boff = lds_byte(wc * 32 + fr, fq * 8);
#define PG8_SA(b, h) (((b) * 2 + (h)) * HTB)
#define PG8_SB(b, h) ((4 + (b) * 2 + (h)) * HTB)
#define PG8_STAGE(bufoff, gbase, voff) do { _Pragma("unroll") for (int _i = 0; _i < 2; ++_i) \
        __builtin_amdgcn_global_load_lds((const unsigned*)((const char*)(gbase) + (voff)[_i]), (PG8_LAS unsigned*)(lds + (bufoff) + ldsw + _i * 8192), 16, 0, 0); } while (0)
#define PG8_LDA(dst, b, h) do { _Pragma("unroll") for (int m = 0; m < 4; ++m) _Pragma("unroll") for (int k = 0; k < 2; ++k) dst[m][k] = *(const PG8_LAS bf16x8*)(lds + PG8_SA(b, h) + aoff + m * 2048 + k * 1024); } while (0)
#define PG8_LDB(dst, b, h) do { _Pragma("unroll") for (int n = 0; n < 2; ++n) _Pragma("unroll") for (int k = 0; k < 2; ++k) dst[n][k] = *(const PG8_LAS bf16x8*)(lds + PG8_SB(b, h) + boff + n * 2048 + k * 1024); } while (0)
#define PG8_MMA(ai, bj, At, Bt) do { __builtin_amdgcn_s_setprio(1); _Pragma("unroll") for (int m = 0; m < 4; ++m) _Pragma("unroll") for (int n = 0; n < 2; ++n) _Pragma("unroll") for (int k = 0; k < 2; ++k) \
        acc[ai][bj][m][n] = __builtin_amdgcn_mfma_f32_16x16x32_bf16(Bt[n][k], At[m][k], acc[ai][bj][m][n], 0, 0, 0); __builtin_amdgcn_s_setprio(0); } while (0)
#define PG8_WAIT_V(n) asm volatile("s_waitcnt vmcnt(" #n ")" ::: "memory")
#define PG8_WAIT_L(n) asm volatile("s_waitcnt lgkmcnt(" #n ")" ::: "memory")
#define PG8_BAR __builtin_amdgcn_s_barrier()
#define PG8_SCHED __builtin_amdgcn_sched_barrier(0)
    Unit cur, nxt; int ui = 0;
    if (!S.next(0, cur)) return;
    f32x4 acc[2][2][4][2];
#pragma unroll
    for (int a = 0; a < 2; ++a)
#pragma unroll
        for (int b = 0; b < 2; ++b)
#pragma unroll
            for (int m = 0; m < 4; ++m)
#pragma unroll
                for (int n = 0; n < 2; ++n) acc[a][b][m][n] = (f32x4){0.f, 0.f, 0.f, 0.f};
    bf16x8 At[4][2], B0[2][2], B1[2][2];
    const char* cA = (const char*)g.A + (size_t)cur.pm * tstep; const char* cB = (const char*)g.Bt + (size_t)cur.pn * tstep;
    S.a_ready(cur);
    PG8_STAGE(PG8_SB(0, 0), cB, voffB); PG8_STAGE(PG8_SA(0, 0), cA, voffA); PG8_STAGE(PG8_SB(0, 1), cB + hstep, voffB); PG8_STAGE(PG8_SA(0, 1), cA + hstep, voffA);
    if (wr == 1) PG8_BAR;
    PG8_WAIT_V(4); PG8_BAR;
    PG8_STAGE(PG8_SB(1, 0), cB + kstep, voffB); PG8_STAGE(PG8_SA(1, 0), cA + kstep, voffA); PG8_STAGE(PG8_SB(1, 1), cB + hstep + kstep, voffB);
    PG8_WAIT_V(6); PG8_BAR;
    PG8_STAMP();
    for (;;) {
        const bool has_next = S.next(ui + 1, nxt);
        const char* nA = has_next ? (const char*)g.A + (size_t)nxt.pm * tstep : cA; const char* nB = has_next ? (const char*)g.Bt + (size_t)nxt.pn * tstep : cB;
        for (int t = 0; t < nt; t += 2) {
            const bool last = (t == nt - 2);
            const char* a1 = cA + (size_t)(t + 1) * kstep;
            const char* a2 = last ? nA : cA + (size_t)(t + 2) * kstep; const char* b2 = last ? nB : cB + (size_t)(t + 2) * kstep;
            const char* a3 = a2 + kstep; const char* b3 = b2 + kstep;
            if (last && has_next) S.a_ready(nxt);
            PG8_LDB(B0, 0, 0); PG8_SCHED; PG8_LDA(At, 0, 0); PG8_STAGE(PG8_SA(1, 1), a1 + hstep, voffA);
            PG8_WAIT_L(8); PG8_BAR; PG8_WAIT_L(0); PG8_MMA(0, 0, At, B0); PG8_BAR; PG8_SCHED;
            PG8_LDB(B1, 0, 1); PG8_STAGE(PG8_SB(0, 0), b2, voffB);
            PG8_BAR; PG8_WAIT_L(0); PG8_MMA(0, 1, At, B1); PG8_BAR;
            PG8_LDA(At, 0, 1); PG8_STAGE(PG8_SA(0, 0), a2, voffA);
            PG8_BAR; PG8_WAIT_L(0); PG8_MMA(1, 0, At, B0); PG8_BAR; PG8_SCHED;
            PG8_STAGE(PG8_SB(0, 1), b2 + hstep, voffB);
            PG8_WAIT_V(6); PG8_BAR; PG8_MMA(1, 1, At, B1); PG8_BAR;
            PG8_LDB(B0, 1, 0); PG8_SCHED; PG8_LDA(At, 1, 0); PG8_STAGE(PG8_SA(0, 1), a2 + hstep, voffA);
            PG8_WAIT_L(8); PG8_BAR; PG8_WAIT_L(0); PG8_MMA(0, 0, At, B0); PG8_BAR; PG8_SCHED;
            PG8_LDB(B1, 1, 1); PG8_STAGE(PG8_SB(1, 0), b3, voffB);
            PG8_BAR; PG8_WAIT_L(0); PG8_MMA(0, 1, At, B1); PG8_BAR;
            PG8_LDA(At, 1, 1); PG8_STAGE(PG8_SA(1, 0), a3, voffA);
            PG8_BAR; PG8_WAIT_L(0); PG8_MMA(1, 0, At, B0); PG8_BAR; PG8_SCHED;
            PG8_STAGE(PG8_SB(1, 1), b3 + hstep, voffB);
            PG8_WAIT_V(6); PG8_BAR; PG8_MMA(1, 1, At, B1); PG8_BAR;
        }
        PG8_STAMP();
        if constexpr (!Epi::AFTER_DRAIN) { E(acc, cur, wr, wc, fr, fq); S.done(cur); }
        PG8_STAMP();
        if (!has_next) break;
#pragma unroll
        for (int a = 0; a < 2; ++a)
#pragma unroll
            for (int b = 0; b < 2; ++b)
#pragma unroll
                for (int m = 0; m < 4; ++m)
#pragma unroll
                    for (int n = 0; n < 2; ++n) acc[a][b][m][n] = (f32x4){0.f, 0.f, 0.f, 0.f};
        cur = nxt; cA = nA; cB = nB; ++ui;
    }
    PG8_WAIT_V(0);
    if (wr == 0) PG8_BAR;
    PG8_BAR;
    if constexpr (Epi::AFTER_DRAIN) { E.fused(acc, cur, wr, wc, fr, fq, lds, wid, lane); S.done(cur); }
    PG8_STAMP();
    if (STAMP && wid == 0) { stamps[lane] = lane < nts ? (((unsigned long long)(unsigned)ts_hi << 32) | (unsigned)ts_lo) : 0ull;
        if (lane == 62) stamps[62] = rt_entry; if (lane == 63) stamps[63] = (unsigned long long)wall_clock64(); }
#undef PG8_STAMP
#undef PG8_SA
#undef PG8_SB
#undef PG8_STAGE
#undef PG8_LDA
#undef PG8_LDB
#undef PG8_MMA
#undef PG8_WAIT_V
#undef PG8_WAIT_L
#undef PG8_BAR
#undef PG8_SCHED
}
}

struct EpiA {
    static constexpr bool PERM = false, AFTER_DRAIN = false;
    float* P; bf16_t* Z; float* out; int l;
    __device__ __forceinline__ void operator()(const pg8::f32x4 (&acc)[2][2][4][2], const pg8::Unit& u, int wr, int wc, int fr, int fq) const {
#pragma unroll
        for (int ai = 0; ai < 2; ++ai)
#pragma unroll
            for (int m = 0; m < 4; ++m) { const int row = u.pm * 256 + ai * 128 + wr * 64 + m * 16 + fr;
#pragma unroll
                for (int bj = 0; bj < 2; ++bj)
#pragma unroll
                    for (int n = 0; n < 2; ++n) { const int col = u.pn * 256 + bj * 128 + wc * 32 + n * 16 + fq * 4; const f32x4 v = acc[ai][bj][m][n];
                        if (col < PW) { *(f32x4*)(P + (size_t)row * PW + col) = v;
                            if (col >= C_CK && col < C_DP && row < NTP) { const int b = row >> 8, s_ = row & 255; const bool isk = col < C_CV;
                                *(f32x4*)(out + (isk ? O_NK : O_NV) + ((size_t)((b * 2 + l) * 256 + s_)) * 128 + (col - (isk ? C_CK : C_CV))) = v; } }
                        else if (col < NA_COLS) { u32x2 w; w[0] = cvt_pk_bf16(siluf_(v[0]), siluf_(v[1])); w[1] = cvt_pk_bf16(siluf_(v[2]), siluf_(v[3])); *(u32x2*)(Z + (size_t)row * DM + (col - PW)) = w; } } }
    }
};
__device__ __forceinline__ size_t g_off(int row, int cg) {
    const int n = cg >> 10, c = cg & 1023;
    const int pm = row >> 8, wr2 = (row >> 6) & 3, m = (row >> 4) & 3, fr = row & 15;
    const int pn = c >> 7, wc2 = (c >> 6) & 1, q = (c >> 4) & 3, fq2 = (c >> 2) & 3;
    size_t o = (size_t)(n * 32 + pm); o = o * 8 + pn; o = o * 4 + wr2; o = o * 2 + wc2; o = o * 4 + m; o = o * 16 + fr; o = o * 4 + fq2; o = o * 16 + q * 4;
    return o;
}
struct EpiG {
    static constexpr bool PERM = true, AFTER_DRAIN = false;
    bf16_t* G;
    __device__ __forceinline__ void operator()(const pg8::f32x4 (&acc)[2][2][4][2], const pg8::Unit& u, int wr, int wc, int fr, int fq) const {
#pragma unroll
        for (int ai = 0; ai < 2; ++ai)
#pragma unroll
            for (int m = 0; m < 4; ++m) { const int row = u.pm * 256 + ai * 128 + wr * 64 + m * 16 + fr;
#pragma unroll
                for (int bj = 0; bj < 2; ++bj) { const int col = u.pn * 256 + bj * 128 + wc * 32 + 8 * fq; const f32x4 v0 = acc[ai][bj][m][0], v1 = acc[ai][bj][m][1];
                    u32x4 w; w[0] = cvt_pk_bf16(sigmoidf_(v0[0]), sigmoidf_(v0[1])); w[1] = cvt_pk_bf16(sigmoidf_(v0[2]), sigmoidf_(v0[3]));
                    w[2] = cvt_pk_bf16(sigmoidf_(v1[0]), sigmoidf_(v1[1])); w[3] = cvt_pk_bf16(sigmoidf_(v1[2]), sigmoidf_(v1[3]));
                    u32x2 wa, wb; wa[0] = w[0]; wa[1] = w[1]; wb[0] = w[2]; wb[1] = w[3];
                    *(u32x2*)(G + g_off(row, col)) = wa; *(u32x2*)(G + g_off(row, col + 4)) = wb; } }
    }
};

__device__ void phaseA(const Params& p, int l, unsigned char* lds) {
    pg8::Gemm g; g.A = (const bf16_t*)(PWS + WS_H); g.Bt = (const bf16_t*)(PWS + WS_WTIN) + (size_t)l * INW * 1024; g.M = NT; g.N = 13 * 256; g.K = 1024;
    pg8::StaticOrder S; S.init(g.M, g.N, (int)gridDim.x, (int)blockIdx.x);
    EpiA E; E.P = (float*)(PWS + WS_P); E.Z = (bf16_t*)(PWS + WS_Z); E.out = POUT; E.l = l;
    pg8::gemm_phase<EpiA, pg8::StaticOrder, false>((PG8_LAS unsigned char*)lds, g, S, E, nullptr);
    __syncthreads();
}

__device__ void phaseB0(const Params& p, int l, unsigned char* ldsb) {
    const int tid = TID(), lane = tid & 63, wid = tid >> 6, fr = lane & 15, fq = lane >> 4;
    const int h = wid >> 1, mt = wid & 1;
    bf16_t* Awd = (bf16_t*)ldsb;
    bf16_t* Aad = Awd + 32 * 72;
    const float* P = (const float*)(PWS + WS_P);
    float* recS = (float*)(PWS + WS_RECS);
    float* recD = (float*)(PWS + WS_RECD);
    float* BC = (float*)(PWS + WS_BC);
    const bf16_t* LT = (const bf16_t*)(PWS + WS_LORAT) + (size_t)l * 4 * 256 * 64;
    const float* pkk = PIN(17) + l * 256; const float* pka = PIN(18) + l * 256; const float* prk = PIN(19) + l * 256;
    const float* pw0 = PIN(13) + l * 512; const float* pa0 = PIN(15) + l * 512;
    for (int it = blockIdx.x; it < NT / 32; it += gridDim.x) {
        const int tb = it * 32;
        __syncthreads();
#pragma unroll
        for (int i = 0; i < 8; ++i) { const int idx = tid + i * 512, tk = idx >> 7, j = idx & 127; const float v = P[(size_t)(tb + tk) * PW + C_WD + j];
            if (j < 64) Awd[tk * 72 + j] = f2bf(1.0f - 2.0f / (1.0f + __expf(2.0f * v))); else Aad[tk * 72 + j - 64] = f2bf(v); }
        __syncthreads();
        f32x4 acc[4][4];
#pragma unroll
        for (int m = 0; m < 4; ++m)
#pragma unroll
            for (int n = 0; n < 4; ++n) acc[m][n] = (f32x4){0.f, 0.f, 0.f, 0.f};
#pragma unroll
        for (int ks = 0; ks < 2; ++ks) {
            const bf16x8 awf = *(const bf16x8*)(Awd + (mt * 16 + fr) * 72 + ks * 32 + fq * 8), aaf = *(const bf16x8*)(Aad + (mt * 16 + fr) * 72 + ks * 32 + fq * 8);
#pragma unroll
            for (int n = 0; n < 4; ++n) { const int cb = h * 64 + n * 16 + fr;
#pragma unroll
                for (int m = 0; m < 4; ++m) { const bf16x8 bfr = *(const bf16x8*)(LT + ((size_t)m * 256 + cb) * 64 + ks * 32 + fq * 8);
                    acc[m][n] = __builtin_amdgcn_mfma_f32_16x16x32_bf16(bfr, m < 2 ? awf : aaf, acc[m][n], 0, 0, 0); } }
        }
        const int tok = tb + mt * 16 + fr; int seqbase, L, pos; seq_of(tok, seqbase, L, pos);
        const float* pr = P + (size_t)tok * PW;
        const size_t ridx = ((size_t)seqbase * 4 + (size_t)h * L + pos) * 192;
        f32x4 k4[4], kk4[4]; float ss = 0.f;
#pragma unroll
        for (int n = 0; n < 4; ++n) { const int c4 = h * 64 + n * 16 + fq * 4;
            k4[n] = *(const f32x4*)(pr + C_BK + c4); kk4[n] = k4[n] * *(const f32x4*)(pkk + c4);
            ss += (kk4[n][0] * kk4[n][0] + kk4[n][1] * kk4[n][1]) + (kk4[n][2] * kk4[n][2] + kk4[n][3] * kk4[n][3]); }
        ss += __shfl_xor(ss, 16); ss += __shfl_xor(ss, 32);
        const float rn = rsqrtf(ss + 1e-12f);
        float bsum = 0.f;
#pragma unroll
        for (int n = 0; n < 4; ++n) { const int c4 = h * 64 + n * 16 + fq * 4, j4 = n * 16 + fq * 4;
            const f32x4 r4 = *(const f32x4*)(pr + C_BR + c4), v4 = *(const f32x4*)(pr + C_BV + c4);
            const f32x4 kk = kk4[n] * rn, ka4 = *(const f32x4*)(pka + c4), rk4 = *(const f32x4*)(prk + c4);
            *(f32x4*)(recS + ridx + j4) = r4; *(f32x4*)(recS + ridx + 64 + j4) = kk; *(f32x4*)(recS + ridx + 128 + j4) = v4;
#pragma unroll
            for (int d = 0; d < 2; ++d) {
                const f32x4 w0 = *(const f32x4*)(pw0 + d * 256 + c4), a0 = *(const f32x4*)(pa0 + d * 256 + c4);
                f32x4 dec, nka, kd;
#pragma unroll
                for (int j = 0; j < 4; ++j) {
                    const float wl = w0[j] + acc[d][n][j];
                    dec[j] = __expf(-0.6065306597126334f / (1.0f + __expf(-wl)));
                    const float a = 1.0f / (1.0f + __expf(-(a0[j] + acc[2 + d][n][j])));
                    kd[j] = k4[n][j] * (1.0f + (a - 1.0f) * ka4[j]); nka[j] = -(kk[j] * a);
                    bsum += r4[j] * kd[j] * rk4[j]; }
                float* rd = recD + (size_t)d * RECD_STRIDE + ridx + j4;
                *(f32x4*)(rd) = dec; *(f32x4*)(rd + 64) = nka; *(f32x4*)(rd + 128) = kd;
            }
        }
        bsum += __shfl_xor(bsum, 16); bsum += __shfl_xor(bsum, 32);
        if (fq == 0) BC[tok * 4 + h] = bsum;
    }
}

template <int NS>
__device__ __forceinline__ void scan_run(const Params& p, int l, bool sample, int b, int h, int dir, int rg, int L, int seqbase, float* wl) {
    const int lane = TID() & 63, rl = lane >> 4, kl = lane & 15;
    int row[NS]; f32x4 S[NS]; size_t sidx[NS];
#pragma unroll
    for (int q = 0; q < NS; ++q) { row[q] = (rg * NS + q) * 4 + rl;
        sidx[q] = ((size_t)(((b * 2 + l) * 2 + dir) * 4 + h)) * 4096 + row[q] * 64 + kl * 4;
        if (sample) S[q] = *(const f32x4*)(PIN(4) + sidx[q]); else S[q] = (f32x4){0.f, 0.f, 0.f, 0.f}; }
    const float* gS = (const float*)(PWS + WS_RECS) + ((size_t)seqbase * 4 + (size_t)h * L) * 192 + lane * 4;
    const float* gD = (const float*)(PWS + WS_RECD) + (size_t)dir * RECD_STRIDE + ((size_t)seqbase * 4 + (size_t)h * L) * 192 + lane * 4;
    float* O = (float*)(PWS + WS_O) + (size_t)dir * NT * 256 + (size_t)seqbase * 256 + h * 64;
    const int nch = L >> 2;
    f32x4 rA[6], rB[6];
    auto gl = [&](f32x4 (&r)[6], int c) {
        c = c < nch ? c : nch - 1;
        const int pos0 = dir ? (L - 4 * (c + 1)) : 4 * c;
        const float* s_ = gS + (size_t)pos0 * 192; const float* d_ = gD + (size_t)pos0 * 192;
#pragma unroll
        for (int i = 0; i < 3; ++i) { r[i] = *(const f32x4*)(s_ + i * 256); r[3 + i] = *(const f32x4*)(d_ + i * 256); }
    };
    auto st = [&](const f32x4 (&r)[6], float* buf) {
#pragma unroll
        for (int i = 0; i < 3; ++i) { *(f32x4*)(buf + i * 256 + lane * 4) = r[i]; *(f32x4*)(buf + 768 + i * 256 + lane * 4) = r[3 + i]; }
    };
    struct Ops { f32x4 r, kk, w, ka, kd; float v[NS]; };
    auto ldsread = [&](const float* buf, int s) -> Ops {
        const int tc = dir ? 3 - s : s;
        const float* bs = buf + tc * 192; const float* bd = buf + 768 + tc * 192;
        Ops o; o.r = *(const f32x4*)(bs + kl * 4); o.kk = *(const f32x4*)(bs + 64 + kl * 4);
        o.w = *(const f32x4*)(bd + kl * 4); o.ka = *(const f32x4*)(bd + 64 + kl * 4); o.kd = *(const f32x4*)(bd + 128 + kl * 4);
#pragma unroll
        for (int q = 0; q < NS; ++q) o.v[q] = bs[128 + row[q]];
        return o;
    };
    float opart[NS];
#pragma unroll
    for (int q = 0; q < NS; ++q) opart[q] = 0.f;
    auto chunk = [&](const float* cur, const float* nxtbuf, Ops& ops, int c) {
        float oval[NS];
#pragma unroll
        for (int q = 0; q < NS; ++q) oval[q] = 0.f;
#pragma unroll
        for (int s = 0; s < 4; ++s) {
            const Ops nx = (s < 3) ? ldsread(cur, s + 1) : ldsread(nxtbuf, 0);
            __builtin_amdgcn_sched_barrier(0);
            float sa[NS], opr[NS]; f32x2 ta[NS], tb[NS];
            const f32x2 kka = __builtin_shufflevector(ops.kk, ops.kk, 0, 1), kkb = __builtin_shufflevector(ops.kk, ops.kk, 2, 3);
            const f32x2 wa = __builtin_shufflevector(ops.w, ops.w, 0, 1), wb = __builtin_shufflevector(ops.w, ops.w, 2, 3);
            const f32x2 na = __builtin_shufflevector(ops.ka, ops.ka, 0, 1), nb = __builtin_shufflevector(ops.ka, ops.ka, 2, 3);
            const f32x2 da = __builtin_shufflevector(ops.kd, ops.kd, 0, 1), db = __builtin_shufflevector(ops.kd, ops.kd, 2, 3);
            const f32x2 ra = __builtin_shufflevector(ops.r, ops.r, 0, 1), rb = __builtin_shufflevector(ops.r, ops.r, 2, 3);
#pragma unroll
            for (int q = 0; q < NS; ++q) { const f32x2 Sa = __builtin_shufflevector(S[q], S[q], 0, 1), Sb = __builtin_shufflevector(S[q], S[q], 2, 3);
                f32x2 pp = Sa * kka; pp = Sb * kkb + pp; sa[q] = pp[0] + pp[1];
                const f32x2 v2 = (f32x2){ops.v[q], ops.v[q]};
                ta[q] = Sa * wa + v2 * da; tb[q] = Sb * wb + v2 * db; }
#pragma unroll
            for (int q = 0; q < NS; ++q) { sa[q] = row16_sum(sa[q]); opr[q] = row16_sum(opart[q]); oval[q] = (kl == s) ? opr[q] : oval[q]; }
#pragma unroll
            for (int q = 0; q < NS; ++q) { const f32x2 s2 = (f32x2){sa[q], sa[q]};
                const f32x2 Sa = s2 * na + ta[q], Sb = s2 * nb + tb[q];
                f32x2 qq = Sa * ra; qq = Sb * rb + qq; opart[q] = qq[0] + qq[1];
                S[q] = (f32x4){Sa[0], Sa[1], Sb[0], Sb[1]}; }
            ops = nx;
        }
        const int stp = 4 * c - 1 + (kl & 3);
        const int pos = dir ? (L - 1 - stp) : stp;
#pragma unroll
        for (int q = 0; q < NS; ++q) { if (kl < 4 && stp >= 0) O[(size_t)pos * 256 + row[q]] = oval[q]; }
    };
    float* buf0 = wl; float* buf1 = wl + 1536;
    gl(rA, 0); gl(rB, 1);
    st(rA, buf0); gl(rA, 2);
    __builtin_amdgcn_wave_barrier();
    Ops ops = ldsread(buf0, 0);
    for (int c = 0; c < nch; c += 2) {
        st(rB, buf1); gl(rB, c + 3);
        __builtin_amdgcn_wave_barrier();
        chunk(buf0, buf1, ops, c);
        st(rA, buf0); gl(rA, c + 4);
        __builtin_amdgcn_wave_barrier();
        chunk(buf1, buf0, ops, c + 1);
    }
#pragma unroll
    for (int q = 0; q < NS; ++q) { const float ol = row16_sum(opart[q]); if (kl == 0) O[(size_t)(dir ? 0 : L - 1) * 256 + row[q]] = ol; }
    if (!sample) {
#pragma unroll
        for (int q = 0; q < NS; ++q) *(f32x4*)(POUT + O_NS + sidx[q]) = S[q];
    }
}

__device__ __forceinline__ void stage_qk(const float* __restrict__ src, int stride, bf16_t* dst, bool rope, int pos0, float scale, const f32x2* __restrict__ rt) {
    const int tid = TID();
#pragma unroll
    for (int i = 0; i < 2; ++i) {
        const int task = tid + i * 512, row = task >> 3, half = (task >> 2) & 1, quad = task & 3;
        const float* s = src + (size_t)row * stride + half * 32 + quad * 4;
        f32x4 x1 = *(const f32x4*)s, x2 = *(const f32x4*)(s + 16);
        if (rope) { const int pos = pos0 + row; const int pi = half ? (pos & 63) : (pos >> 6);
#pragma unroll
            for (int j = 0; j < 4; ++j) { const f32x2 cs = rt[pi * 16 + quad * 4 + j]; const float a = x1[j], b = x2[j]; x1[j] = a * cs[0] - b * cs[1]; x2[j] = b * cs[0] + a * cs[1]; } }
        x1 *= scale; x2 *= scale;
        u32x2 w1, w2; w1[0] = cvt_pk_bf16(x1[0], x1[1]); w1[1] = cvt_pk_bf16(x1[2], x1[3]); w2[0] = cvt_pk_bf16(x2[0], x2[1]); w2[1] = cvt_pk_bf16(x2[2], x2[3]);
        *(u32x2*)(dst + row * 72 + half * 32 + quad * 4) = w1; *(u32x2*)(dst + row * 72 + half * 32 + 16 + quad * 4) = w2;
    }
}
__device__ __forceinline__ void stage_vt(const float* __restrict__ src, int stride, bf16_t* vt, int nkeys = 128, int pitch = 136) {
    const int tid = TID();
    for (int task = tid; task < nkeys * 16; task += 512) { const int key = task >> 4, dq = task & 15;
        const f32x4 v = *(const f32x4*)(src + (size_t)key * stride + dq * 4);
#pragma unroll
        for (int j = 0; j < 4; ++j) vt[(dq * 4 + j) * pitch + key] = f2bf(v[j]); }
}
__device__ void attn_item(const Params& p, int l, int ai, unsigned char* lds) {
    const int tid = TID(), lane = tid & 63, wid = tid >> 6, fr = lane & 15, fq = lane >> 4;
    bf16_t* Qs = (bf16_t*)lds; bf16_t* Ks = Qs + 128 * 72; bf16_t* Vt = Ks + 128 * 72;
    const float* P = (const float*)(PWS + WS_P);
    const bf16_t* Z = (const bf16_t*)(PWS + WS_Z);
    bf16_t* YS = (bf16_t*)(PWS + WS_YS);
    const f32x2* rt = (const f32x2*)(PWS + WS_ROPE);
    bool sample; int b, head, qt, seqbase;
    if (ai < 128) { sample = true; b = ai >> 5; head = (ai >> 3) & 3; qt = ai & 7; seqbase = NTP + b * 1024; }
    else { const int j = ai - 128; sample = false; b = j >> 3; head = (j >> 1) & 3; qt = j & 1; seqbase = b * 256; }
    const int kh = head >> 1, qbase = seqbase + qt * 128;
    __syncthreads();
    stage_qk(P + (size_t)qbase * PW + C_CQ + head * 64, PW, Qs, sample, qt * 128, 0.125f, rt);
    __syncthreads();
    bf16x8 qf[2];
    qf[0] = *(const bf16x8*)(Qs + (wid * 16 + fr) * 72 + fq * 8); qf[1] = *(const bf16x8*)(Qs + (wid * 16 + fr) * 72 + 32 + fq * 8);
    float m = PIN(22)[l * 4 + head], lsum = 1.0f, lpart = 0.f;
    f32x4 oacc[4];
#pragma unroll
    for (int i = 0; i < 4; ++i) oacc[i] = (f32x4){0.f, 0.f, 0.f, 0.f};
    const int nkb = sample ? 7 : 2;
    const int qpos = qt * 128 + wid * 16 + fr;
    const float* ck = PIN(2); const float* cv = PIN(3);
    auto kinfo = [&](int kb, const float*& ks, const float*& vs, int& stride, bool& rope, bool& mask, int& kpos0) -> bool {
        if (!sample) { ks = P + (size_t)(seqbase + kb * 128) * PW + C_CK + kh * 64; vs = ks + (C_CV - C_CK); stride = PW; rope = false; mask = false; kpos0 = 0; return true; }
        if (kb < 3) { const int nbk = qt - 1 + kb; if (nbk < 0 || nbk >= 8) return false; kpos0 = nbk * 128;
            ks = P + (size_t)(seqbase + kpos0) * PW + C_CK + kh * 64; vs = ks + (C_CV - C_CK); stride = PW; rope = true; mask = (kb != 1); return true; }
        const size_t o = ((size_t)((b * 2 + l) * 512 + (kb - 3) * 128) * 2 + kh) * 64; ks = ck + o; vs = cv + o; stride = 128; rope = false; mask = false; kpos0 = 0; return true;
    };
    f32x4 kx1[2], kx2[2], vx[2][2];
    auto kload = [&](const float* ks, const float* vs, int stride) {
#pragma unroll
        for (int i = 0; i < 2; ++i) { const int task = tid + i * 512, row = task >> 3, half = (task >> 2) & 1, quad = task & 3;
            const float* s_ = ks + (size_t)row * stride + half * 32 + quad * 4; kx1[i] = *(const f32x4*)s_; kx2[i] = *(const f32x4*)(s_ + 16); }
#pragma unroll
        for (int i = 0; i < 2; ++i) { const int task = tid + i * 512, kp = task >> 4, dq = task & 15;
            vx[i][0] = *(const f32x4*)(vs + (size_t)(2 * kp) * stride + dq * 4); vx[i][1] = *(const f32x4*)(vs + (size_t)(2 * kp + 1) * stride + dq * 4); }
    };
    auto kstore = [&](bool rope, int kpos0) {
#pragma unroll
        for (int i = 0; i < 2; ++i) { const int task = tid + i * 512, row = task >> 3, half = (task >> 2) & 1, quad = task & 3;
            f32x4 x1 = kx1[i], x2 = kx2[i];
            if (rope) { const int pos = kpos0 + row; const int pi = half ? (pos & 63) : (pos >> 6);
#pragma unroll
                for (int j = 0; j < 4; ++j) { const f32x2 cs = rt[pi * 16 + quad * 4 + j]; const float a_ = x1[j], b_ = x2[j]; x1[j] = a_ * cs[0] - b_ * cs[1]; x2[j] = b_ * cs[0] + a_ * cs[1]; } }
            u32x2 w1, w2; w1[0] = cvt_pk_bf16(x1[0], x1[1]); w1[1] = cvt_pk_bf16(x1[2], x1[3]); w2[0] = cvt_pk_bf16(x2[0], x2[1]); w2[1] = cvt_pk_bf16(x2[2], x2[3]);
            *(u32x2*)(Ks + row * 72 + half * 32 + quad * 4) = w1; *(u32x2*)(Ks + row * 72 + half * 32 + 16 + quad * 4) = w2; }
#pragma unroll
        for (int i = 0; i < 2; ++i) { const int task = tid + i * 512, kp = task >> 4, dq = task & 15;
#pragma unroll
            for (int j = 0; j < 4; ++j) *(unsigned*)(Vt + (dq * 4 + j) * 136 + 2 * kp) = cvt_pk_bf16(vx[i][0][j], vx[i][1][j]); }
    };
    const float* ksrc = nullptr; const float* vsrc = nullptr; int stride = 0, kpos0n = 0; bool ropen = false, maskn = false;
    int kb = 0;
    while (kb < nkb && !kinfo(kb, ksrc, vsrc, stride, ropen, maskn, kpos0n)) ++kb;
    if (kb < nkb) kload(ksrc, vsrc, stride);
    while (kb < nkb) {
        const bool mask = maskn; const int kpos0 = kpos0n; const bool rope = ropen;
        __syncthreads();
        kstore(rope, kpos0);
        __syncthreads();
        int nk = kb + 1;
        while (nk < nkb && !kinfo(nk, ksrc, vsrc, stride, ropen, maskn, kpos0n)) ++nk;
        if (nk < nkb) kload(ksrc, vsrc, stride);
        kb = nk;
        f32x4 sc[4][2];
#pragma unroll
        for (int sb = 0; sb < 4; ++sb) {
            f32x4 s0 = (f32x4){0.f, 0.f, 0.f, 0.f}, s1 = s0;
#pragma unroll
            for (int dh = 0; dh < 2; ++dh) {
                const bf16x8 k0 = *(const bf16x8*)(Ks + (sb * 32 + fr) * 72 + dh * 32 + fq * 8), k1 = *(const bf16x8*)(Ks + (sb * 32 + 16 + fr) * 72 + dh * 32 + fq * 8);
                s0 = __builtin_amdgcn_mfma_f32_16x16x32_bf16(k0, qf[dh], s0, 0, 0, 0);
                s1 = __builtin_amdgcn_mfma_f32_16x16x32_bf16(k1, qf[dh], s1, 0, 0, 0);
            }
            if (mask) {
#pragma unroll
                for (int j = 0; j < 4; ++j) { const int k0p = kpos0 + sb * 32 + fq * 4 + j, k1p = k0p + 16; int d0 = qpos - k0p, d1 = qpos - k1p; d0 = d0 < 0 ? -d0 : d0; d1 = d1 < 0 ? -d1 : d1;
                    if (d0 > 128) s0[j] = -1e30f; if (d1 > 128) s1[j] = -1e30f; }
            }
            sc[sb][0] = s0; sc[sb][1] = s1;
        }
        float mx = -1e30f;
#pragma unroll
        for (int sb = 0; sb < 4; ++sb)
#pragma unroll
            for (int j = 0; j < 4; ++j) mx = fmaxf(mx, fmaxf(sc[sb][0][j], sc[sb][1][j]));
        mx = fmaxf(mx, __shfl_xor(mx, 16)); mx = fmaxf(mx, __shfl_xor(mx, 32));
        const float mn = fmaxf(m, mx), alpha = __expf(m - mn);
        m = mn; lsum *= alpha; lpart *= alpha;
#pragma unroll
        for (int dt = 0; dt < 4; ++dt) oacc[dt] = oacc[dt] * alpha;
#pragma unroll
        for (int sb = 0; sb < 4; ++sb) {
            f32x4 s0 = sc[sb][0], s1 = sc[sb][1];
#pragma unroll
            for (int j = 0; j < 4; ++j) { s0[j] = __expf(s0[j] - mn); s1[j] = __expf(s1[j] - mn); lpart += s0[j] + s1[j]; }
            u32x4 pw; pw[0] = cvt_pk_bf16(s0[0], s0[1]); pw[1] = cvt_pk_bf16(s0[2], s0[3]); pw[2] = cvt_pk_bf16(s1[0], s1[1]); pw[3] = cvt_pk_bf16(s1[2], s1[3]);
            bf16x8 pf; __builtin_memcpy(&pf, &pw, 16);
#pragma unroll
            for (int dt = 0; dt < 4; ++dt) {
                const bf16_t* vp = Vt + (dt * 16 + fr) * 136 + sb * 32 + fq * 4;
                u32x4 vw; const u32x2 va = *(const u32x2*)vp, vb = *(const u32x2*)(vp + 16); vw[0] = va[0]; vw[1] = va[1]; vw[2] = vb[0]; vw[3] = vb[1];
                bf16x8 vf; __builtin_memcpy(&vf, &vw, 16);
                oacc[dt] = __builtin_amdgcn_mfma_f32_16x16x32_bf16(vf, pf, oacc[dt], 0, 0, 0);
            }
        }
    }
    lpart += __shfl_xor(lpart, 16); lpart += __shfl_xor(lpart, 32);
    lsum += lpart;
    const float inv = 1.0f / lsum;
    const size_t t = (size_t)(qbase + wid * 16 + fr);
#pragma unroll
    for (int dt = 0; dt < 4; ++dt) {
        const int col = 512 + head * 64 + dt * 16 + fq * 4;
        const bf16x4 z = *(const bf16x4*)(Z + t * DM + col);
        u32x2 w; w[0] = cvt_pk_bf16(oacc[dt][0] * inv * bf2f((bf16_t)z[0]), oacc[dt][1] * inv * bf2f((bf16_t)z[1]));
        w[1] = cvt_pk_bf16(oacc[dt][2] * inv * bf2f((bf16_t)z[2]), oacc[dt][3] * inv * bf2f((bf16_t)z[3]));
        *(u32x2*)(YS + t * DM + col) = w;
    }
}

__device__ void chunk_item(const Params& p, int l, int ci, unsigned char* ldsb) {
    const int tid = TID(), lane = tid & 63, wid = tid >> 6, fr = lane & 15, fq = lane >> 4;
    const int chunk = ci >> 2, g = ci & 3, base = chunk * 128;
    bf16_t* wsb = (bf16_t*)ldsb;
    bf16_t* vt = wsb + 128 * 136;
    const float* P = (const float*)(PWS + WS_P);
    const bf16_t* Z = (const bf16_t*)(PWS + WS_Z);
    bf16_t* YS = (bf16_t*)(PWS + WS_YS);
    const float* wsrc = PIN(11) + (size_t)(l * 4 + g) * 128 * 128;
    __syncthreads();
#pragma unroll
    for (int i = 0; i < 8; ++i) { const int idx = tid + i * 512, r = idx >> 5, c4 = (idx & 31) * 4; const f32x4 v = *(const f32x4*)(wsrc + r * 128 + c4);
        u32x2 w; w[0] = cvt_pk_bf16(v[0], v[1]); w[1] = cvt_pk_bf16(v[2], v[3]); *(u32x2*)(wsb + r * 136 + c4) = w; }
    stage_vt(P + (size_t)base * PW + C_AV + g * 64, PW, vt, 128);
    __syncthreads();
    f32x4 acc[4];
#pragma unroll
    for (int n = 0; n < 4; ++n) acc[n] = (f32x4){0.f, 0.f, 0.f, 0.f};
#pragma unroll
    for (int k = 0; k < 4; ++k) {
        const bf16x8 af = *(const bf16x8*)(wsb + (wid * 16 + fr) * 136 + k * 32 + fq * 8);
#pragma unroll
        for (int n = 0; n < 4; ++n) { const bf16x8 bfv = *(const bf16x8*)(vt + (n * 16 + fr) * 136 + k * 32 + fq * 8);
            acc[n] = __builtin_amdgcn_mfma_f32_16x16x32_bf16(bfv, af, acc[n], 0, 0, 0); }
    }
    const int i = wid * 16 + fr; const size_t t = base + i;
    const float bsi = PIN(12)[(l * 4 + g) * 128 + i];
#pragma unroll
    for (int n = 0; n < 4; ++n) { const int col = g * 64 + n * 16 + fq * 4;
        const f32x4 u = *(const f32x4*)(P + t * PW + C_AU + col);
        const bf16x4 z = *(const bf16x4*)(Z + t * DM + col);
        u32x2 w; w[0] = cvt_pk_bf16(u[0] * (acc[n][0] + bsi) * bf2f((bf16_t)z[0]), u[1] * (acc[n][1] + bsi) * bf2f((bf16_t)z[1]));
        w[1] = cvt_pk_bf16(u[2] * (acc[n][2] + bsi) * bf2f((bf16_t)z[2]), u[3] * (acc[n][3] + bsi) * bf2f((bf16_t)z[3]));
        *(u32x2*)(YS + t * DM + col) = w; }
}

__device__ void pool_item(const Params& p, int l, int pi, unsigned char* ldsb) {
    const int tid = TID(), lane = tid & 63, wid = tid >> 6, fr = lane & 15, fq = lane >> 4, half = tid >> 8, ch = tid & 255, g = ch >> 6;
    const int tb = pi * 32; int seqbase, L, pos0; seq_of(tb, seqbase, L, pos0);
    float* pt = (float*)ldsb;
    bf16_t* dl = (bf16_t*)(pt + 48 * 256);
    bf16_t* wt = dl + 32 * 264;
    const float* P = (const float*)(PWS + WS_P);
    const bf16_t* Z = (const bf16_t*)(PWS + WS_Z);
    bf16_t* YS = (bf16_t*)(PWS + WS_YS);
    __syncthreads();
#pragma unroll
    for (int i = 0; i < 6; ++i) { const int idx = tid + i * 512, rr = idx >> 6, c4 = (idx & 63) * 4; const int pos = pos0 - 8 + rr;
        f32x4 v = (f32x4){0.f, 0.f, 0.f, 0.f};
        if (pos >= 0 && pos < L) v = *(const f32x4*)(P + (size_t)(seqbase + pos) * PW + C_DP + c4);
        *(f32x4*)(pt + rr * 256 + c4) = v; }
    { const float* pwsrc = PIN(23) + (size_t)l * 4 * 64 * 64;
#pragma unroll
      for (int gg = 0; gg < 4; ++gg) stage_vt(pwsrc + gg * 4096, 64, wt + gg * 64 * 72, 64, 72); }
    __syncthreads();
    const int w = 2 << g;
    for (int i = 0; i < 16; ++i) { const int tk = half * 16 + i, pos = pos0 + tk;
        int lo = pos - (w >> 1), hi = lo + w; lo = lo < 0 ? 0 : lo; hi = hi > L ? L : hi;
        float sm = 0.f;
        for (int q = lo; q < hi; ++q) sm += pt[(q - pos0 + 8) * 256 + ch];
        dl[tk * 264 + ch] = f2bf(sm / (float)(hi - lo) - pt[(tk + 8) * 256 + ch]); }
    __syncthreads();
    const int gw = wid >> 1, th = wid & 1;
    f32x4 acc[4];
#pragma unroll
    for (int n = 0; n < 4; ++n) acc[n] = (f32x4){0.f, 0.f, 0.f, 0.f};
#pragma unroll
    for (int k = 0; k < 2; ++k) {
        const bf16x8 af = *(const bf16x8*)(dl + (th * 16 + fr) * 264 + gw * 64 + k * 32 + fq * 8);
#pragma unroll
        for (int n = 0; n < 4; ++n) { const bf16x8 bfv = *(const bf16x8*)(wt + (gw * 64 + n * 16 + fr) * 72 + k * 32 + fq * 8);
            acc[n] = __builtin_amdgcn_mfma_f32_16x16x32_bf16(bfv, af, acc[n], 0, 0, 0); }
    }
    const size_t t = tb + th * 16 + fr;
#pragma unroll
    for (int n = 0; n < 4; ++n) { const int oc = gw * 64 + n * 16 + fq * 4;
        const f32x4 sc = *(const f32x4*)(PIN(24) + l * 256 + oc);
        const bf16x4 z = *(const bf16x4*)(Z + t * DM + 768 + oc);
        u32x2 wv; wv[0] = cvt_pk_bf16(acc[n][0] * sc[0] * bf2f((bf16_t)z[0]), acc[n][1] * sc[1] * bf2f((bf16_t)z[1]));
        wv[1] = cvt_pk_bf16(acc[n][2] * sc[2] * bf2f((bf16_t)z[2]), acc[n][3] * sc[3] * bf2f((bf16_t)z[3]));
        *(u32x2*)(YS + t * DM + 768 + oc) = wv; }
}

__device__ void phaseB1(const Params& p, int l, unsigned char* lds, int slot = 0, int part = 127) {
    const int tid = TID(), wid = tid >> 6;
    float* wl = (float*)lds + wid * 3072;
    if (!(part & 1)) {} else
    { const int nbh = (int)gridDim.x >> 1;
      if ((int)blockIdx.x < nbh) { if (wid < 4 && (part & 4)) for (int it = blockIdx.x * 4 + wid; it < 512; it += nbh * 4) { const int q = it >> 4, b = q >> 3;
            scan_run<1>(p, l, true, b, (q >> 1) & 3, q & 1, it & 15, 1024, NTP + b * 1024, wl); } }
      else { const int nb2 = (int)gridDim.x - nbh; if (part & 8) for (int it = ((int)blockIdx.x - nbh) * 8 + wid; it < 1024; it += nb2 * 8) { const int q = it >> 3, b = q >> 3;
            scan_run<2>(p, l, false, b, (q >> 1) & 3, q & 1, it & 7, 256, b * 256, wl); } } }
    __syncthreads();
    __shared__ int s_item;
    unsigned* ctr = (unsigned*)(PWS + WS_CTR) + l + 2 * slot;
    if (part & 2)
    for (;;) {
        if (tid == 0) s_item = (int)atomicAdd(ctr, 1u);
        __syncthreads();
        const int item = s_item;
        __syncthreads();
        if (item >= 768) break;
        if (item < 256) { if (part & 16) attn_item(p, l, item, lds); }
        else if (item < 512) { if (part & 32) chunk_item(p, l, item - 256, lds); }
        else { if (part & 64) pool_item(p, l, item - 512, lds); }
    }
}

__device__ void phaseB2(const Params& p, int l) {
    const int lane = TID() & 63, gw = blockIdx.x * 8 + (TID() >> 6), W = gridDim.x * 8;
    const float* O = (const float*)(PWS + WS_O);
    const float* recS = (const float*)(PWS + WS_RECS);
    const float* BC = (const float*)(PWS + WS_BC);
    const bf16_t* Z = (const bf16_t*)(PWS + WS_Z);
    bf16_t* YS = (bf16_t*)(PWS + WS_YS);
    const float* lng = PIN(20) + l * 256; const float* lnb = PIN(21) + l * 256;
    float g4[4], b4[4];
#pragma unroll
    for (int h = 0; h < 4; ++h) { g4[h] = lng[h * 64 + lane]; b4[h] = lnb[h * 64 + lane]; }
    for (int tok = gw; tok < NT; tok += W) {
        int seqbase, L, pos; seq_of(tok, seqbase, L, pos);
        float o[4], vv[4], z[4], mu[4], var[4];
        const f32x4 bc = *(const f32x4*)(BC + tok * 4);
#pragma unroll
        for (int h = 0; h < 4; ++h) { const int c = h * 64 + lane;
            o[h] = O[(size_t)tok * 256 + c] + O[(size_t)NT * 256 + (size_t)tok * 256 + c];
            vv[h] = recS[((size_t)seqbase * 4 + (size_t)h * L + pos) * 192 + 128 + lane];
            z[h] = bf2f(Z[(size_t)tok * DM + 256 + c]); }
#pragma unroll
        for (int h = 0; h < 4; ++h) mu[h] = wave_sum(o[h]) * (1.0f / 64.0f);
#pragma unroll
        for (int h = 0; h < 4; ++h) { o[h] -= mu[h]; var[h] = wave_sum(o[h] * o[h]) * (1.0f / 64.0f); }
#pragma unroll
        for (int h = 0; h < 4; ++h) { const float on = o[h] * rsqrtf(var[h] + 64e-5f);
            const float y = on * g4[h] + b4[h] + bc[h] * vv[h];
            YS[(size_t)tok * DM + 256 + h * 64 + lane] = f2bf(y * z[h]); }
    }
}

__device__ void phaseC1(const Params& p, int l, unsigned char* lds) {
    pg8::Gemm g; g.A = (const bf16_t*)(PWS + WS_H); g.Bt = (const bf16_t*)(PWS + WS_WTIN) + (size_t)l * INW * 1024 + (size_t)NA_COLS * 1024; g.M = NT; g.N = 4096; g.K = 1024;
    pg8::StaticOrder S; S.init(g.M, g.N, (int)gridDim.x, (int)blockIdx.x);
    EpiG E; E.G = (bf16_t*)(PWS + WS_G);
    pg8::gemm_phase<EpiG, pg8::StaticOrder, false>((PG8_LAS unsigned char*)lds, g, S, E, nullptr);
    __syncthreads();
}
__device__ void phaseC2(const Params& p, int l, unsigned char* lds) {
    constexpr int MT = 4, LDT = 72, A_BYTES = 256 * LDT * 2, B_BYTES = 128 * LDT * 2, BUF = A_BYTES + B_BYTES;
    const int tid = TID(), lane = tid & 63, wid = tid >> 6, wr = wid >> 1, wc = wid & 1, fr = lane & 15, fq = lane >> 4;
    const bf16_t* YS = (const bf16_t*)(PWS + WS_YS);
    const bf16_t* G = (const bf16_t*)(PWS + WS_G);
    const bf16_t* Wu = (const bf16_t*)(PWS + WS_WTUP) + (size_t)l * 4 * 1024 * 256;
    bf16_t* MG = (bf16_t*)(PWS + WS_MERGED);
    const int srow = tid >> 3, skc = tid & 7, soff = (srow * LDT + skc * 8) * 2;
    const int aoff = ((wr * MT * 16 + fr) * LDT + fq * 8) * 2, boff = A_BYTES + ((wc * 64 + fr) * LDT + fq * 8) * 2;
    const int NU = 32 * 8;
    for (int u = blockIdx.x; u < NU; u += gridDim.x) {
        const int pn = u / 32, pm = u % 32;
        const bf16_t* Ag = YS + ((size_t)pm * 256 + srow) * 1024 + skc * 8;
        const bf16_t* Bg = Wu + ((size_t)pn * 128 + srow) * 256 + skc * 8;
        f32x4 mg[4][4], acc[4][4]; zero_acc<4>(mg); zero_acc<4>(acc);
        u32x4 ra[MT], rb[2];
        auto gload = [&](int kt) {
#pragma unroll
            for (int i = 0; i < MT; ++i) ra[i] = *(const u32x4*)(Ag + (size_t)i * 64 * 1024 + kt * 64);
            const bf16_t* bb = Bg + (size_t)(kt >> 2) * 1024 * 256 + (kt & 3) * 64;
#pragma unroll
            for (int i = 0; i < 2; ++i) rb[i] = *(const u32x4*)(bb + (size_t)i * 64 * 256);
        };
        auto sstore = [&](int buf) { unsigned char* nb = lds + buf * BUF;
#pragma unroll
            for (int i = 0; i < MT; ++i) *(u32x4*)(nb + soff + i * 64 * LDT * 2) = ra[i];
#pragma unroll
            for (int i = 0; i < 2; ++i) *(u32x4*)(nb + A_BYTES + soff + i * 64 * LDT * 2) = rb[i];
        };
        __syncthreads();
        gload(0); sstore(0);
        __syncthreads();
        for (int t = 0; t < 16; ++t) {
            if (t + 1 < 16) gload(t + 1);
            const unsigned char* base = lds + (t & 1) * BUF;
#pragma unroll
            for (int kk = 0; kk < 2; ++kk) {
                bf16x8 af[MT], bfr[4];
#pragma unroll
                for (int m = 0; m < MT; ++m) af[m] = *(const bf16x8*)(base + aoff + m * 16 * LDT * 2 + kk * 64);
#pragma unroll
                for (int n = 0; n < 4; ++n) bfr[n] = *(const bf16x8*)(base + boff + n * 16 * LDT * 2 + kk * 64);
#pragma unroll
                for (int m = 0; m < MT; ++m)
#pragma unroll
                    for (int n = 0; n < 4; ++n) acc[m][n] = __builtin_amdgcn_mfma_f32_16x16x32_bf16(bfr[n], af[m], acc[m][n], 0, 0, 0);
            }
            if (t + 1 < 16) sstore((t + 1) & 1);
            if ((t & 3) == 3) {
                const int n = t >> 2;
#pragma unroll
                for (int m = 0; m < 4; ++m) { const int row = pm * 256 + wr * 64 + m * 16 + fr;
                    const bf16_t* gp = G + g_off(row, n * 1024 + pn * 128 + wc * 64 + fq * 4);
                    const bf16x8 ga = *(const bf16x8*)gp, gb = *(const bf16x8*)(gp + 8);
#pragma unroll
                    for (int q = 0; q < 4; ++q) {
#pragma unroll
                        for (int j = 0; j < 4; ++j) { const bf16_t gv = (bf16_t)(q < 2 ? ga[q * 4 + j] : gb[(q - 2) * 4 + j]); mg[m][q][j] += bf2f(gv) * acc[m][q][j]; }
                        acc[m][q] = (f32x4){0.f, 0.f, 0.f, 0.f}; } }
            }
            __syncthreads();
        }
#pragma unroll
        for (int m = 0; m < 4; ++m) { const size_t row = (size_t)pm * 256 + wr * 64 + m * 16 + fr;
#pragma unroll
            for (int q = 0; q < 4; ++q) { const int col = pn * 128 + wc * 64 + q * 16 + fq * 4;
                u32x2 w; w[0] = cvt_pk_bf16(mg[m][q][0], mg[m][q][1]); w[1] = cvt_pk_bf16(mg[m][q][2], mg[m][q][3]);
                *(u32x2*)(MG + row * DM + col) = w; } }
    }
}

__device__ void phaseD(const Params& p, int l, unsigned char* lds) {
    const int tid = TID(), lane = tid & 63, wid = tid >> 6, wr = wid >> 1, wc = wid & 1, fr = lane & 15, fq = lane >> 4;
    const bf16_t* MG = (const bf16_t*)(PWS + WS_MERGED);
    const bf16_t* Wo = (const bf16_t*)(PWS + WS_WTO) + (size_t)l * 1024 * 1024;
    const int NU = 32 * 8;
    for (int u = blockIdx.x; u < NU; u += gridDim.x) {
        const int pn = u / 32, pm = u % 32;
        f32x4 acc[4][4]; zero_acc<4>(acc);
        gemm_acc<4>(MG + (size_t)pm * 256 * 1024, 1024, Wo + (size_t)pn * 128 * 1024, 1024, 1024, acc, lds);
#pragma unroll
        for (int m = 0; m < 4; ++m) { const int row = pm * 256 + wr * 64 + m * 16 + fr;
            const float* xr = xrow_ptr(p, l, row);
            const float* gate = (const float*)(PWS + WS_MOD) + (size_t)(l * 5 + modrow_of(row)) * 3072 + 2048;
#pragma unroll
            for (int q = 0; q < 4; ++q) { const int col = pn * 128 + wc * 64 + q * 16 + fq * 4;
                const f32x4 xo = *(const f32x4*)(xr + col), gt = *(const f32x4*)(gate + col);
                *(f32x4*)(POUT + (size_t)row * DM + col) = xo + gt * acc[m][q]; } }
    }
}

__device__ void phaseF(const Params& p) {
    const int lane = TID() & 63, gw = blockIdx.x * 8 + (TID() >> 6), W = gridDim.x * 8;
    const float* g = PIN(27);
    for (int row = gw; row < NT; row += W) {
        float* x = POUT + (size_t)row * DM;
        f32x4 v[4]; float ss = 0.f;
#pragma unroll
        for (int i = 0; i < 4; ++i) { v[i] = *(const f32x4*)(x + i * 256 + lane * 4); ss += v[i][0] * v[i][0] + v[i][1] * v[i][1] + v[i][2] * v[i][2] + v[i][3] * v[i][3]; }
        ss = wave_sum(ss);
        const float rs = rsqrtf(ss * (1.0f / 1024.0f) + 1e-6f);
#pragma unroll
        for (int i = 0; i < 4; ++i) { const int c = i * 256 + lane * 4; *(f32x4*)(x + c) = v[i] * rs * *(const f32x4*)(g + c); }
    }
}

__global__ void __launch_bounds__(NTHREADS) fwd_megakernel(Params p) {
    extern __shared__ __attribute__((aligned(16))) unsigned char lds[];
    volatile LAS unsigned* st = (volatile LAS unsigned*)(lds + LDS_MAIN);
    if (threadIdx.x < 2) st[threadIdx.x] = 0u;
    if (threadIdx.x == 0) {
#pragma unroll
        for (int i = 0; i < 28; ++i) s_ptab[i] = (unsigned long long)p.in[i];
    }
    __syncthreads();
    const XcdBarrier xb = xcd_barrier_post((unsigned*)(PWS + WS_BAR), st);
#define GSYNC() xcd_barrier(xb)
    phase0(p, lds);
    GSYNC();
#pragma unroll 1
    for (int l = 0; l < 2; ++l) {
        phaseA0(p, l);
        GSYNC();
        phaseA(p, l, lds);
        GSYNC();
        phaseB0(p, l, lds);
        GSYNC();
        phaseB1(p, l, lds);
        GSYNC();
        phaseB2(p, l);
        phaseC1(p, l, lds);
        GSYNC();
        phaseC2(p, l, lds);
        GSYNC();
        phaseD(p, l, lds);
        GSYNC();
    }
    phaseF(p);
}

extern "C" void kernel_launch(void* const* d_in, const int* in_sizes, int n_in, void* d_out, int out_size, void* d_ws, size_t ws_size, hipStream_t stream) {
    static int grid_blocks = 0;
    if (!grid_blocks) {
        int dev = 0, cus = 0, per_cu = 0;
        hipGetDevice(&dev);
        hipDeviceGetAttribute(&cus, hipDeviceAttributeMultiprocessorCount, dev);
        hipFuncSetAttribute((const void*)fwd_megakernel, hipFuncAttributeMaxDynamicSharedMemorySize, LDS_BYTES);
        hipOccupancyMaxActiveBlocksPerMultiprocessor(&per_cu, (const void*)fwd_megakernel, NTHREADS, LDS_BYTES);
        if (per_cu < 1) { fprintf(stderr, "occupancy query returned %d\n", per_cu); per_cu = 1; }
        if (per_cu > 1) per_cu = 1;
        grid_blocks = cus * per_cu;
        if (ws_size < WS_END) fprintf(stderr, "workspace too small: %zu < %zu\n", ws_size, (size_t)WS_END);
    }
    Params p{};
    for (int i = 0; i < 28; ++i) p.in[i] = (const float*)d_in[i];
    p.out = (float*)d_out; p.ws = (unsigned char*)d_ws;
    hipMemsetAsync((char*)d_ws + WS_BAR, 0, 3456 * 4, stream);
    void* args[] = {&p};
    hipError_t e = hipLaunchCooperativeKernel((const void*)fwd_megakernel, dim3(grid_blocks), dim3(NTHREADS), args, LDS_BYTES, stream);
    if (e != hipSuccess) fprintf(stderr, "cooperative launch failed: %s (grid %d)\n", hipGetErrorString(e), grid_blocks);
}
```

```cpp
#include <hip/hip_runtime.h>
#include <hip/hip_cooperative_groups.h>
#include <cstdio>
namespace cg = cooperative_groups;

typedef unsigned short bf16_t;
typedef short bf16x8 __attribute__((ext_vector_type(8)));
typedef short bf16x4 __attribute__((ext_vector_type(4)));
typedef float f32x4 __attribute__((ext_vector_type(4)));
typedef float f32x2 __attribute__((ext_vector_type(2)));
typedef unsigned u32x4 __attribute__((ext_vector_type(4)));
typedef unsigned u32x2 __attribute__((ext_vector_type(2)));

constexpr int NT = 8192, NTP = 4096, DM = 1024, INW = 7296, NA_COLS = 3200, PW = 2176;
constexpr int NTHREADS = 512;
constexpr int C_AU = 0, C_AV = 256, C_BR = 512, C_BK = 768, C_BV = 1024, C_WD = 1280, C_AD = 1344, C_CQ = 1408, C_CK = 1664, C_CV = 1792, C_DP = 1920;
constexpr size_t O_YP = 0, O_YS = 4194304, O_NK = 8388608, O_NV = 9437184, O_NS = 10485760;
constexpr size_t WS_WTIN = 0;
constexpr size_t WS_WTUP = WS_WTIN + (size_t)2 * INW * DM * 2;
constexpr size_t WS_WTO  = WS_WTUP + (size_t)2 * 4 * 1024 * 256 * 2;
constexpr size_t WS_MOD  = WS_WTO + (size_t)2 * 1024 * 1024 * 2;
constexpr size_t WS_ROPE = WS_MOD + (size_t)2 * 5 * 3072 * 4;
constexpr size_t WS_CTR  = WS_ROPE + 64 * 16 * 8;
constexpr size_t WS_BAR  = WS_CTR + 256;
constexpr size_t WS_H    = WS_BAR + 3456 * 4;
constexpr size_t WS_P    = WS_H + (size_t)NT * DM * 2;
constexpr size_t WS_Z    = WS_P + (size_t)NT * PW * 4;
constexpr size_t WS_RECS = WS_Z + (size_t)NT * DM * 2;
constexpr size_t WS_RECD = WS_RECS + (size_t)NT * 4 * 192 * 4;
constexpr size_t WS_O    = WS_RECD + (size_t)2 * NT * 4 * 192 * 4;
constexpr size_t WS_BC   = WS_O + (size_t)2 * NT * 256 * 4;
constexpr size_t WS_YS   = WS_BC + (size_t)NT * 4 * 4;
constexpr size_t WS_LORAT = WS_YS + (size_t)NT * DM * 2;
constexpr size_t WS_END  = WS_LORAT + (size_t)2 * 4 * 256 * 64 * 2;
constexpr size_t WS_G = WS_P;
constexpr size_t WS_MERGED = WS_RECS;
constexpr size_t RECD_STRIDE = (size_t)NT * 4 * 192;

constexpr int LDS_MAIN = 131072;
constexpr int LDS_BYTES = LDS_MAIN + 16;

struct Params {
    const float* in[28];
    float* out;
    unsigned char* ws;
};
__shared__ unsigned long long s_ptab[28];
__device__ __forceinline__ const float* ld_inptr(int k) {
    const unsigned long long v = s_ptab[k];
    const unsigned lo = __builtin_amdgcn_readfirstlane((unsigned)v), hi = __builtin_amdgcn_readfirstlane((unsigned)(v >> 32));
    return (const float*)(((unsigned long long)hi << 32) | lo);
}
#define PIN(k) (ld_inptr(k))
#define POUT (p.out)
#define PWS (p.ws)

__device__ __forceinline__ int TID() { int t = threadIdx.x; asm volatile("" : "+v"(t)); return t; }
__device__ __forceinline__ unsigned cvt_pk_bf16(float lo, float hi) { unsigned r; asm volatile("v_cvt_pk_bf16_f32 %0, %1, %2" : "=v"(r) : "v"(lo), "v"(hi)); return r; }
__device__ __forceinline__ bf16_t f2bf(float f) { return (bf16_t)(cvt_pk_bf16(f, 0.f) & 0xffffu); }
__device__ __forceinline__ float bf2f(bf16_t b) { return __uint_as_float(((unsigned)b) << 16); }
__device__ __forceinline__ float sigmoidf_(float x) { return 1.0f / (1.0f + __expf(-x)); }
__device__ __forceinline__ float siluf_(float x) { return x / (1.0f + __expf(-x)); }
template <int CTRL> __device__ __forceinline__ float dpp_f(float x) { return __int_as_float(__builtin_amdgcn_update_dpp(0, __float_as_int(x), CTRL, 0xF, 0xF, false)); }
__device__ __forceinline__ float row16_sum(float x) {
    x += dpp_f<0x128>(x); x += dpp_f<0x124>(x); x += dpp_f<0x122>(x); x += dpp_f<0x121>(x); return x;
}
__device__ __forceinline__ float wave_sum(float v) { v = row16_sum(v); v += __shfl_xor(v, 16); v += __shfl_xor(v, 32); return v; }
__device__ __forceinline__ void seq_of(int tok, int& seqbase, int& L, int& pos) {
    if (tok < NTP) { seqbase = tok & ~255; L = 256; pos = tok & 255; }
    else { int t2 = tok - NTP; seqbase = NTP + (t2 & ~1023); L = 1024; pos = t2 & 1023; }
}
__device__ __forceinline__ int modrow_of(int tok) { return tok < NTP ? 0 : 1 + ((tok - NTP) >> 10); }


#define XB_TMO      128
#define XB_XCNT(j)  (256  + 64 * (j))
#define XB_XSUB(j)  (1280 + 64 * (j))
#define XB_XGEN(j)  (2304 + 64 * (j))
#define XB_TOP      3328
#define XB_TOPGEN   3392
#define XCD_BAR_WORDS 3456
#define XB_SPIN_CAP (1u << 18)
#define LAS __attribute__((address_space(3)))
__device__ __forceinline__ unsigned xb_ld(unsigned* p)              { return __hip_atomic_load(p, __ATOMIC_RELAXED, __HIP_MEMORY_SCOPE_AGENT); }
__device__ __forceinline__ unsigned xb_add(unsigned* p, unsigned v) { return __hip_atomic_fetch_add(p, v, __ATOMIC_RELAXED, __HIP_MEMORY_SCOPE_AGENT); }
__device__ __forceinline__ unsigned xb_xcc_id() { return (unsigned)__builtin_amdgcn_s_getreg((3 << 11) | 20) & 0xFu; }
#define XB_SPIN(cond, bar) do { unsigned _sp = 0; while (cond) { __builtin_amdgcn_s_sleep(1); \
    if ((++_sp & 255u) == 0u) { if (xb_ld(&(bar)[XB_TMO])) break; if (_sp > XB_SPIN_CAP) { atomicAdd(&(bar)[XB_TMO], 1u); break; } } } } while (0)
struct XcdBarrier { unsigned* bar; unsigned x; volatile LAS unsigned* st; };
__device__ __forceinline__ XcdBarrier xcd_barrier_post(unsigned* bar, volatile LAS unsigned* st) {
    XcdBarrier b; b.bar = bar; b.x = xb_xcc_id(); b.st = st;
    if (threadIdx.x == 0) (void)xb_add(&bar[XB_XCNT(b.x)], 1u);
    return b;
}
__device__ __forceinline__ void xcd_barrier_complete(unsigned* bar, unsigned x, unsigned& nloc, unsigned& nx) {
    const unsigned G = gridDim.x * gridDim.y * gridDim.z;
    unsigned sum, cnt, mine, sp = 0u;
    for (;;) {
        sum = 0u; cnt = 0u; mine = 0u;
#pragma unroll
        for (unsigned j = 0; j < 16; ++j) { const unsigned c = xb_ld(&bar[XB_XCNT(j)]); sum += c; cnt += (c > 0u) ? 1u : 0u; mine = (j == x) ? c : mine; }
        if (sum == G) break;
        __builtin_amdgcn_s_sleep(1);
        if ((++sp & 255u) == 0u) { if (xb_ld(&bar[XB_TMO])) break; if (sp > XB_SPIN_CAP) { atomicAdd(&bar[XB_TMO], 1u); break; } }
    }
    nloc = mine > 0u ? mine : 1u; nx = cnt > 0u ? cnt : 1u;
}
__device__ __forceinline__ void xcd_barrier(const XcdBarrier& b0) {
    asm volatile("s_waitcnt vmcnt(0)" ::: "memory");
    __syncthreads();
    if (threadIdx.x == 0) {
        XcdBarrier b = b0;
        { unsigned xx = xb_xcc_id(); asm volatile("" : "+s"(xx)); b.x = xx; }
        unsigned* bar = b.bar;
        __builtin_amdgcn_s_waitcnt(0);
        unsigned nloc = b.st[0], nx = b.st[1];
        if (nloc == 0u) { xcd_barrier_complete(bar, b.x, nloc, nx); b.st[0] = nloc; b.st[1] = nx; }
        const unsigned old = xb_add(&bar[XB_XSUB(b.x)], 1u);
        const unsigned gen = old / nloc;
        if (old + 1u == (gen + 1u) * nloc) {
            __builtin_amdgcn_fence(__ATOMIC_RELEASE, "agent");
            asm volatile("s_waitcnt vmcnt(0)" ::: "memory");
            const unsigned og = xb_add(&bar[XB_TOP], 1u);
            const unsigned tg = og / nx;
            if (og + 1u == (tg + 1u) * nx) xb_add(&bar[XB_TOPGEN], 1u);
            else XB_SPIN(xb_ld(&bar[XB_TOPGEN]) == tg, bar);
            __builtin_amdgcn_fence(__ATOMIC_ACQUIRE, "agent");
            xb_add(&bar[XB_XGEN(b.x)], 1u);
            asm volatile("s_waitcnt vmcnt(0)" ::: "memory");
        } else {
            XB_SPIN(xb_ld(&bar[XB_XGEN(b.x)]) == gen, bar);
            __builtin_amdgcn_fence(__ATOMIC_ACQUIRE, "agent");
            asm volatile("s_waitcnt vmcnt(0)" ::: "memory");
        }
    }
    __syncthreads();
}

__device__ void conv_tile(const float* __restrict__ src, int N, bf16_t* __restrict__ dst, int K, int kt, int nt, float* tile) {
    const int tid = TID();
    { const int r = tid >> 4, c4 = (tid & 15) * 4;
#pragma unroll
      for (int i = 0; i < 2; ++i) { const int k = r + 32 * i; const f32x4 v = *(const f32x4*)(src + (size_t)(kt * 64 + k) * N + nt * 64 + c4);
          tile[k * 65 + c4 + 0] = v[0]; tile[k * 65 + c4 + 1] = v[1]; tile[k * 65 + c4 + 2] = v[2]; tile[k * 65 + c4 + 3] = v[3]; } }
    __syncthreads();
    { const int n = tid >> 3, kc = (tid & 7) * 8; u32x4 w;
      w[0] = cvt_pk_bf16(tile[(kc + 0) * 65 + n], tile[(kc + 1) * 65 + n]); w[1] = cvt_pk_bf16(tile[(kc + 2) * 65 + n], tile[(kc + 3) * 65 + n]);
      w[2] = cvt_pk_bf16(tile[(kc + 4) * 65 + n], tile[(kc + 5) * 65 + n]); w[3] = cvt_pk_bf16(tile[(kc + 6) * 65 + n], tile[(kc + 7) * 65 + n]);
      *(u32x4*)(dst + (size_t)(nt * 64 + n) * K + kt * 64 + kc) = w; }
    __syncthreads();
}

__device__ void mod_item(const Params& p, int l, int cc, float* lds) {
    const int tid = TID();
    float* sc = lds;
    float* red = lds + 5120;
    for (int i = tid; i < 5120; i += NTHREADS) { const int r = i >> 10, k = i & 1023; const float v = (r == 0) ? PIN(6)[k] : PIN(5)[(r - 1) * 1024 + k]; sc[i] = siluf_(v); }
    __syncthreads();
    const int kg = tid >> 5, c = tid & 31, col = cc * 32 + c;
    float a[5] = {0.f, 0.f, 0.f, 0.f, 0.f};
    const float* w = PIN(7) + (size_t)l * 1024 * 3072 + col;
    for (int k = kg * 64; k < kg * 64 + 64; ++k) { const float wv = w[(size_t)k * 3072];
#pragma unroll
        for (int r = 0; r < 5; ++r) a[r] += sc[r * 1024 + k] * wv; }
#pragma unroll
    for (int r = 0; r < 5; ++r) red[(kg * 5 + r) * 32 + c] = a[r];
    __syncthreads();
    if (tid < 160) { const int r = tid >> 5, c2 = tid & 31; float s = PIN(8)[l * 3072 + cc * 32 + c2];
        for (int g = 0; g < 16; ++g) s += red[(g * 5 + r) * 32 + c2];
        ((float*)(PWS + WS_MOD))[(l * 5 + r) * 3072 + cc * 32 + c2] = s; }
    __syncthreads();
}

__device__ void phase0(const Params& p, unsigned char* lds) {
    const int NCONV_IN = 2 * 16 * 114, NCONV_UP = 8 * 64, NCONV_O = 2 * 256, NCONV_L = 32, NMOD = 192;
    const int total = NCONV_IN + NCONV_UP + NCONV_O + NCONV_L + NMOD + 1;
    for (int it = blockIdx.x; it < total; it += gridDim.x) {
        int i = it;
        if (i < NCONV_IN) { const int l = i / 1824, r = i % 1824, nt = r / 16, kt = r % 16;
            conv_tile(PIN(10) + (size_t)l * 1024 * INW, INW, (bf16_t*)(PWS + WS_WTIN) + (size_t)l * INW * 1024, 1024, kt, nt, (float*)lds); continue; }
        i -= NCONV_IN;
        if (i < NCONV_UP) { const int mtx = i / 64, r = i % 64, nt = r / 4, kt = r % 4;
            conv_tile(PIN(25) + (size_t)mtx * 256 * 1024, 1024, (bf16_t*)(PWS + WS_WTUP) + (size_t)mtx * 1024 * 256, 256, kt, nt, (float*)lds); continue; }
        i -= NCONV_UP;
        if (i < NCONV_O) { const int l = i / 256, r = i % 256, nt = r / 16, kt = r % 16;
            conv_tile(PIN(26) + (size_t)l * 1024 * 1024, 1024, (bf16_t*)(PWS + WS_WTO) + (size_t)l * 1024 * 1024, 1024, kt, nt, (float*)lds); continue; }
        i -= NCONV_O;
        if (i < NCONV_L) { const int l = i >> 4, m = (i >> 2) & 3, nt = i & 3;
            conv_tile((m < 2 ? PIN(14) : PIN(16)) + (size_t)(l * 2 + (m & 1)) * 64 * 256, 256, (bf16_t*)(PWS + WS_LORAT) + (size_t)(l * 4 + m) * 256 * 64, 64, 0, nt, (float*)lds); continue; }
        i -= NCONV_L;
        if (i < NMOD) { mod_item(p, i / 96, i % 96, (float*)lds); continue; }
        for (int e = TID(); e < 1024; e += NTHREADS) { const int pos = e >> 4, f = e & 15;
            const float inv = exp2f(-(float)f * (13.287712379549449f / 16.0f)); const float ang = (float)pos * inv;
            float sn, cs; sn = sinf(ang); cs = cosf(ang);
            ((f32x2*)(PWS + WS_ROPE))[e] = (f32x2){cs, sn}; }
        if (TID() < 64) ((unsigned*)(PWS + WS_CTR))[TID()] = 0u;
    }
}

__device__ __forceinline__ const float* xrow_ptr(const Params& p, int l, int row) {
    if (l == 0) return row < NTP ? PIN(0) + (size_t)row * DM : PIN(1) + (size_t)(row - NTP) * DM;
    return POUT + (size_t)row * DM;
}
__device__ void phaseA0(const Params& p, int l) {
    const int lane = TID() & 63, gw = blockIdx.x * 8 + (TID() >> 6), W = gridDim.x * 8;
    const float* g = PIN(9) + l * DM;
    bf16_t* H = (bf16_t*)(PWS + WS_H);
    for (int row = gw; row < NT; row += W) {
        const float* x = xrow_ptr(p, l, row);
        f32x4 v[4]; float ss = 0.f;
#pragma unroll
        for (int i = 0; i < 4; ++i) { v[i] = *(const f32x4*)(x + i * 256 + lane * 4); ss += v[i][0] * v[i][0] + v[i][1] * v[i][1] + v[i][2] * v[i][2] + v[i][3] * v[i][3]; }
        ss = wave_sum(ss);
        const float rs = rsqrtf(ss * (1.0f / 1024.0f) + 1e-6f);
        const float* mod = (const float*)(PWS + WS_MOD) + (size_t)(l * 5 + modrow_of(row)) * 3072;
#pragma unroll
        for (int i = 0; i < 4; ++i) { const int c = i * 256 + lane * 4;
            const f32x4 gg = *(const f32x4*)(g + c), sh = *(const f32x4*)(mod + c), scl = *(const f32x4*)(mod + 1024 + c);
            f32x4 h = v[i] * rs * gg * (1.0f + scl) + sh;
            u32x2 w; w[0] = cvt_pk_bf16(h[0], h[1]); w[1] = cvt_pk_bf16(h[2], h[3]);
            *(u32x2*)(H + (size_t)row * DM + c) = w; }
    }
}

template <int MT>
__device__ __forceinline__ void gemm_acc(const bf16_t* __restrict__ A, int lda, const bf16_t* __restrict__ B, int ldb, int K, f32x4 (&acc)[MT][4], unsigned char* lds) {
    constexpr int BM = MT * 64, LDT = 72, A_BYTES = BM * LDT * 2, B_BYTES = 128 * LDT * 2, BUF = A_BYTES + B_BYTES;
    const int tid = TID(), lane = tid & 63, wid = tid >> 6, wr = wid >> 1, wc = wid & 1, fr = lane & 15, fq = lane >> 4;
    u32x4 ra[MT], rb[2];
    const int srow = tid >> 3, skc = tid & 7;
    const bf16_t* Ag = A + (size_t)srow * lda + skc * 8;
    const bf16_t* Bg = B + (size_t)srow * ldb + skc * 8;
    const int soff = (srow * LDT + skc * 8) * 2;
    const int nt = K >> 6;
    __syncthreads();
#pragma unroll
    for (int i = 0; i < MT; ++i) ra[i] = *(const u32x4*)(Ag + (size_t)i * 64 * lda);
#pragma unroll
    for (int i = 0; i < 2; ++i) rb[i] = *(const u32x4*)(Bg + (size_t)i * 64 * ldb);
#pragma unroll
    for (int i = 0; i < MT; ++i) *(u32x4*)(lds + soff + i * 64 * LDT * 2) = ra[i];
#pragma unroll
    for (int i = 0; i < 2; ++i) *(u32x4*)(lds + A_BYTES + soff + i * 64 * LDT * 2) = rb[i];
    __syncthreads();
    const int aoff = ((wr * MT * 16 + fr) * LDT + fq * 8) * 2, boff = A_BYTES + ((wc * 64 + fr) * LDT + fq * 8) * 2;
    for (int t = 0; t < nt; ++t) {
        if (t + 1 < nt) {
#pragma unroll
            for (int i = 0; i < MT; ++i) ra[i] = *(const u32x4*)(Ag + (size_t)i * 64 * lda + (t + 1) * 64);
#pragma unroll
            for (int i = 0; i < 2; ++i) rb[i] = *(const u32x4*)(Bg + (size_t)i * 64 * ldb + (t + 1) * 64);
        }
        const unsigned char* base = lds + (t & 1) * BUF;
#pragma unroll
        for (int kk = 0; kk < 2; ++kk) {
            bf16x8 af[MT], bfr[4];
#pragma unroll
            for (int m = 0; m < MT; ++m) af[m] = *(const bf16x8*)(base + aoff + m * 16 * LDT * 2 + kk * 64);
#pragma unroll
            for (int n = 0; n < 4; ++n) bfr[n] = *(const bf16x8*)(base + boff + n * 16 * LDT * 2 + kk * 64);
#pragma unroll
            for (int m = 0; m < MT; ++m)
#pragma unroll
                for (int n = 0; n < 4; ++n) acc[m][n] = __builtin_amdgcn_mfma_f32_16x16x32_bf16(bfr[n], af[m], acc[m][n], 0, 0, 0);
        }
        if (t + 1 < nt) {
            unsigned char* nb = lds + ((t + 1) & 1) * BUF;
#pragma unroll
            for (int i = 0; i < MT; ++i) *(u32x4*)(nb + soff + i * 64 * LDT * 2) = ra[i];
#pragma unroll
            for (int i = 0; i < 2; ++i) *(u32x4*)(nb + A_BYTES + soff + i * 64 * LDT * 2) = rb[i];
        }
        __syncthreads();
    }
}
template <int MT> __device__ __forceinline__ void zero_acc(f32x4 (&acc)[MT][4]) {
#pragma unroll
    for (int m = 0; m < MT; ++m)
#pragma unroll
        for (int n = 0; n < 4; ++n) acc[m][n] = (f32x4){0.f, 0.f, 0.f, 0.f};
}

namespace pg8 {
#define PG8_LAS __attribute__((address_space(3)))
typedef unsigned short bf16_t;
typedef short bf16x8 __attribute__((ext_vector_type(8)));
typedef float f32x4 __attribute__((ext_vector_type(4)));
typedef unsigned u32x4 __attribute__((ext_vector_type(4)));
constexpr int BM = 256, BK = 64, HALF = 128, HTB = HALF * BK * 2  , STAGE_BYTES = 8 * HTB, NXCD = 8, WGM = 8;

__host__ __device__ __forceinline__ int lds_byte(int r, int c) { const int st = (r >> 4) * 2 + (c >> 5), rr = r & 15, cc = c & 31, ob = rr * 64 + cc * 2; return st * 1024 + (ob ^ (((ob >> 9) & 1) << 5)); }
__host__ __device__ __forceinline__ void stage_rc(int b, int& R, int& C) { const int st = b / 1024, sb = b % 1024, swz = sb ^ (((sb >> 9) & 1) << 5); R = (st >> 1) * 16 + swz / 64; C = (st & 1) * 32 + (swz % 64) / 2; }
__host__ __device__ __forceinline__ int perm32(int rho) { const int n = rho >> 4, i = rho & 15; return 8 * (i >> 2) + 4 * n + (i & 3); }

struct Unit { int pm, pn; };
struct Gemm { const bf16_t* A; const bf16_t* Bt; int M, N, K; };

struct StaticOrder {
    int nM, nN, nwg, G, c;
    __host__ __device__ void init(int M, int N, int G_, int c_) { nM = M / BM; nN = N / BM; nwg = nM * nN; G = G_; c = c_; }
    __host__ __device__ bool next(int i, Unit& u) const {
        const long L = (long)i * G + c; if (L >= nwg) return false;
        int wgid = (int)L; { const int q = nwg / NXCD, r = nwg % NXCD, xcd = wgid % NXCD, off = wgid / NXCD; wgid = (xcd < r ? xcd * (q + 1) : r * (q + 1) + (xcd - r) * q) + off; }
        const int nig = WGM * nN, gid = wgid / nig, fm = gid * WGM, gsz = (nM - fm) < WGM ? (nM - fm) : WGM;
        u.pm = fm + ((wgid % nig) % gsz); u.pn = (wgid % nig) / gsz; return true;
    }
    __device__ __forceinline__ void a_ready(const Unit&) const {}
    __device__ __forceinline__ void done(const Unit&) const {}
};
template <class Epi, class Sched, bool STAMP = false>
__device__ __forceinline__ void gemm_phase(PG8_LAS unsigned char* lds, const Gemm g, const Sched& S, const Epi& E, unsigned long long* stamps) {
    const int tid = ::TID(), wid = __builtin_amdgcn_readfirstlane(tid >> 6), lane = tid & 63, wr = wid >> 2, wc = wid & 3, fr = lane & 15, fq = lane >> 4;
    const int K = g.K, nt = K / BK;
    int ts_lo = 0, ts_hi = 0, nts = 0; const unsigned long long rt_entry = STAMP ? (unsigned long long)wall_clock64() : 0ull;
#define PG8_STAMP() do { if (STAMP && wid == 0 && nts < 64) { const unsigned long long _c = (unsigned long long)clock64(); \
        ts_lo = (lane == nts) ? (int)(unsigned)_c : ts_lo; ts_hi = (lane == nts) ? (int)(unsigned)(_c >> 32) : ts_hi; ++nts; } } while (0)
    PG8_STAMP();
    unsigned voffA[2], voffB[2];
#pragma unroll
    for (int i = 0; i < 2; ++i) { int R, C; stage_rc(tid * 16 + i * 8192, R, C); const int Rb = Epi::PERM ? ((R & ~31) + perm32(R & 31)) : R;
        voffA[i] = (unsigned)(R * K + C) * 2u; voffB[i] = (unsigned)(Rb * K + C) * 2u; }
    const size_t kstep = (size_t)(BK * 2);
    const size_t hstep = (size_t)HALF * K * 2;
    const size_t tstep = 2 * hstep;
    const unsigned ldsw = (unsigned)wid * 1024u;
    const int aoff = lds_byte(wr * 64 + fr, fq * 8), boff = lds_byte(wc * 32 + fr, fq * 8);
#define PG8_SA(b, h) (((b) * 2 + (h)) * HTB)
#define PG8_SB(b, h) ((4 + (b) * 2 + (h)) * HTB)
#define PG8_STAGE(bufoff, gbase, voff) do { _Pragma("unroll") for (int _i = 0; _i < 2; ++_i) \
        __builtin_amdgcn_global_load_lds((const unsigned*)((const char*)(gbase) + (voff)[_i]), (PG8_LAS unsigned*)(lds + (bufoff) + ldsw + _i * 8192), 16, 0, 0); } while (0)
#define PG8_LDA(dst, b, h) do { _Pragma("unroll") for (int m = 0; m < 4; ++m) _Pragma("unroll") for (int k = 0; k < 2; ++k) dst[m][k] = *(const PG8_LAS bf16x8*)(lds + PG8_SA(b, h) + aoff + m * 2048 + k * 1024); } while (0)
#define PG8_LDB(dst, b, h) do { _Pragma("unroll") for (int n = 0; n < 2; ++n) _Pragma("unroll") for (int k = 0; k < 2; ++k) dst[n][k] = *(const PG8_LAS bf16x8*)(lds + PG8_SB(b, h) + boff + n * 2048 + k * 1024); } while (0)
#define PG8_MMA(ai, bj, At, Bt) do { __builtin_amdgcn_s_setprio(1); _Pragma("unroll") for (int m = 0; m < 4; ++m) _Pragma("unroll") for (int n = 0; n < 2; ++n) _Pragma("unroll") for (int k = 0; k < 2; ++k) \
        acc[ai][bj][m][n] = __builtin_amdgcn_mfma_f32_16x16x32_bf16(Bt[n][k], At[m][k], acc[ai][bj][m][n], 0, 0, 0); __builtin_amdgcn_s_setprio(0); } while (0)
#define PG8_WAIT_V(n) asm volatile("s_waitcnt vmcnt(" #n ")" ::: "memory")
#define PG8_WAIT_L(n) asm volatile("s_waitcnt lgkmcnt(" #n ")" ::: "memory")
#define PG8_BAR __builtin_amdgcn_s_barrier()
#define PG8_SCHED __builtin_amdgcn_sched_barrier(0)
    Unit cur, nxt; int ui = 0;
    if (!S.next(0, cur)) return;
    f32x4 acc[2][2][4][2];
#pragma unroll
    for (int a = 0; a < 2; ++a)
#pragma unroll
        for (int b = 0; b < 2; ++b)
#pragma unroll
            for (int m = 0; m < 4; ++m)
#pragma unroll
                for (int n = 0; n < 2; ++n) acc[a][b][m][n] = (f32x4){0.f, 0.f, 0.f, 0.f};
    bf16x8 At[4][2], B0[2][2], B1[2][2];
    const char* cA = (const char*)g.A + (size_t)cur.pm * tstep; const char* cB = (const char*)g.Bt + (size_t)cur.pn * tstep;
    S.a_ready(cur);
    PG8_STAGE(PG8_SB(0, 0), cB, voffB); PG8_STAGE(PG8_SA(0, 0), cA, voffA); PG8_STAGE(PG8_SB(0, 1), cB + hstep, voffB); PG8_STAGE(PG8_SA(0, 1), cA + hstep, voffA);
    if (wr == 1) PG8_BAR;
    PG8_WAIT_V(4); PG8_BAR;
    PG8_STAGE(PG8_SB(1, 0), cB + kstep, voffB); PG8_STAGE(PG8_SA(1, 0), cA + kstep, voffA); PG8_STAGE(PG8_SB(1, 1), cB + hstep + kstep, voffB);
    PG8_WAIT_V(6); PG8_BAR;
    PG8_STAMP();
    for (;;) {
        const bool has_next = S.next(ui + 1, nxt);
        const char* nA = has_next ? (const char*)g.A + (size_t)nxt.pm * tstep : cA; const char* nB = has_next ? (const char*)g.Bt + (size_t)nxt.pn * tstep : cB;
        for (int t = 0; t < nt; t += 2) {
            const bool last = (t == nt - 2);
            const char* a1 = cA + (size_t)(t + 1) * kstep;
            const char* a2 = last ? nA : cA + (size_t)(t + 2) * kstep; const char* b2 = last ? nB : cB + (size_t)(t + 2) * kstep;
            const char* a3 = a2 + kstep; const char* b3 = b2 + kstep;
            if (last && has_next) S.a_ready(nxt);
            PG8_LDB(B0, 0, 0); PG8_SCHED; PG8_LDA(At, 0, 0); PG8_STAGE(PG8_SA(1, 1), a1 + hstep, voffA);
            PG8_WAIT_L(8); PG8_BAR; PG8_WAIT_L(0); PG8_MMA(0, 0, At, B0); PG8_BAR; PG8_SCHED;
            PG8_LDB(B1, 0, 1); PG8_STAGE(PG8_SB(0, 0), b2, voffB);
            PG8_BAR; PG8_WAIT_L(0); PG8_MMA(0, 1, At, B1); PG8_BAR;
            PG8_LDA(At, 0, 1); PG8_STAGE(PG8_SA(0, 0), a2, voffA);
            PG8_BAR; PG8_WAIT_L(0); PG8_MMA(1, 0, At, B0); PG8_BAR; PG8_SCHED;
            PG8_STAGE(PG8_SB(0, 1), b2 + hstep, voffB);
            PG8_WAIT_V(6); PG8_BAR; PG8_MMA(1, 1, At, B1); PG8_BAR;
            PG8_LDB(B0, 1, 0); PG8_SCHED; PG8_LDA(At, 1, 0); PG8_STAGE(PG8_SA(0, 1), a2 + hstep, voffA);
            PG8_WAIT_L(8); PG8_BAR; PG8_WAIT_L(0); PG8_MMA(0, 0, At, B0); PG8_BAR; PG8_SCHED;
            PG8_LDB(B1, 1, 1); PG8_STAGE(PG8_SB(1, 0), b3, voffB);
            PG8_BAR; PG8_WAIT_L(0); PG8_MMA(0, 1, At, B1); PG8_BAR;
            PG8_LDA(At, 1, 1); PG8_STAGE(PG8_SA(1, 0), a3, voffA);
            PG8_BAR; PG8_WAIT_L(0); PG8_MMA(1, 0, At, B0); PG8_BAR; PG8_SCHED;
            PG8_STAGE(PG8_SB(1, 1), b3 + hstep, voffB);
            PG8_WAIT_V(6); PG8_BAR; PG8_MMA(1, 1, At, B1); PG8_BAR;
        }
        PG8_STAMP();
        if constexpr (!Epi::AFTER_DRAIN) { E(acc, cur, wr, wc, fr, fq); S.done(cur); }
        PG8_STAMP();
        if (!has_next) break;
#pragma unroll
        for (int a = 0; a < 2; ++a)
#pragma unroll
            for (int b = 0; b < 2; ++b)
#pragma unroll
                for (int m = 0; m < 4; ++m)
#pragma unroll
                    for (int n = 0; n < 2; ++n) acc[a][b][m][n] = (f32x4){0.f, 0.f, 0.f, 0.f};
        cur = nxt; cA = nA; cB = nB; ++ui;
    }
    PG8_WAIT_V(0);
    if (wr == 0) PG8_BAR;
    PG8_BAR;
    if constexpr (Epi::AFTER_DRAIN) { E.fused(acc, cur, wr, wc, fr, fq, lds, wid, lane); S.done(cur); }
    PG8_STAMP();
    if (STAMP && wid == 0) { stamps[lane] = lane < nts ? (((unsigned long long)(unsigned)ts_hi << 32) | (unsigned)ts_lo) : 0ull;
        if (lane == 62) stamps[62] = rt_entry; if (lane == 63) stamps[63] = (unsigned long long)wall_clock64(); }
#undef PG8_STAMP
#undef PG8_SA
#undef PG8_SB
#undef PG8_STAGE
#undef PG8_LDA
#undef PG8_LDB
#undef PG8_MMA
#undef PG8_WAIT_V
#undef PG8_WAIT_L
#undef PG8_BAR
#undef PG8_SCHED
}
}

struct EpiA {
    static constexpr bool PERM = false, AFTER_DRAIN = false;
    float* P; bf16_t* Z; float* out; int l, cbase;
    __device__ __forceinline__ void operator()(const pg8::f32x4 (&acc)[2][2][4][2], const pg8::Unit& u, int wr, int wc, int fr, int fq) const {
#pragma unroll
        for (int ai = 0; ai < 2; ++ai)
#pragma unroll
            for (int m = 0; m < 4; ++m) { const int row = u.pm * 256 + ai * 128 + wr * 64 + m * 16 + fr;
#pragma unroll
                for (int bj = 0; bj < 2; ++bj)
#pragma unroll
                    for (int n = 0; n < 2; ++n) { const int col = cbase + u.pn * 256 + bj * 128 + wc * 32 + n * 16 + fq * 4; const f32x4 v = acc[ai][bj][m][n];
                        if (col < PW) { *(f32x4*)(P + (size_t)row * PW + col) = v;
                            if (col >= C_CK && col < C_DP && row < NTP) { const int b = row >> 8, s_ = row & 255; const bool isk = col < C_CV;
                                *(f32x4*)(out + (isk ? O_NK : O_NV) + ((size_t)((b * 2 + l) * 256 + s_)) * 128 + (col - (isk ? C_CK : C_CV))) = v; } }
                        else if (col < NA_COLS) { u32x2 w; w[0] = cvt_pk_bf16(siluf_(v[0]), siluf_(v[1])); w[1] = cvt_pk_bf16(siluf_(v[2]), siluf_(v[3])); *(u32x2*)(Z + (size_t)row * DM + (col - PW)) = w; } } }
    }
};
__device__ __forceinline__ size_t g_off(int row, int cg) {
    const int n = cg >> 10, c = cg & 1023;
    const int pm = row >> 8, wr2 = (row >> 6) & 3, m = (row >> 4) & 3, fr = row & 15;
    const int pn = c >> 7, wc2 = (c >> 6) & 1, q = (c >> 4) & 3, fq2 = (c >> 2) & 3;
    size_t o = (size_t)(n * 32 + pm); o = o * 8 + pn; o = o * 4 + wr2; o = o * 2 + wc2; o = o * 4 + m; o = o * 16 + fr; o = o * 4 + fq2; o = o * 16 + q * 4;
    return o;
}
struct EpiG {
    static constexpr bool PERM = true, AFTER_DRAIN = false;
    bf16_t* G;
    __device__ __forceinline__ void operator()(const pg8::f32x4 (&acc)[2][2][4][2], const pg8::Unit& u, int wr, int wc, int fr, int fq) const {
#pragma unroll
        for (int ai = 0; ai < 2; ++ai)
#pragma unroll
            for (int m = 0; m < 4; ++m) { const int row = u.pm * 256 + ai * 128 + wr * 64 + m * 16 + fr;
#pragma unroll
                for (int bj = 0; bj < 2; ++bj) { const int col = u.pn * 256 + bj * 128 + wc * 32 + 8 * fq; const f32x4 v0 = acc[ai][bj][m][0], v1 = acc[ai][bj][m][1];
                    u32x4 w; w[0] = cvt_pk_bf16(sigmoidf_(v0[0]), sigmoidf_(v0[1])); w[1] = cvt_pk_bf16(sigmoidf_(v0[2]), sigmoidf_(v0[3]));
                    w[2] = cvt_pk_bf16(sigmoidf_(v1[0]), sigmoidf_(v1[1])); w[3] = cvt_pk_bf16(sigmoidf_(v1[2]), sigmoidf_(v1[3]));
                    u32x2 wa, wb; wa[0] = w[0]; wa[1] = w[1]; wb[0] = w[2]; wb[1] = w[3];
                    *(u32x2*)(G + g_off(row, col)) = wa; *(u32x2*)(G + g_off(row, col + 4)) = wb; } }
    }
};

__device__ void phaseA(const Params& p, int l, unsigned char* lds, int part) {
    const int G = part ? ((int)gridDim.x < 160 ? (int)gridDim.x : 160) : (int)gridDim.x;
    if ((int)blockIdx.x < G) {
        pg8::Gemm g; g.A = (const bf16_t*)(PWS + WS_H); g.Bt = (const bf16_t*)(PWS + WS_WTIN) + (size_t)l * INW * 1024 + (size_t)(part ? 2048 : 0) * 1024; g.M = NT; g.N = part ? 5 * 256 : 8 * 256; g.K = 1024;
        pg8::StaticOrder S; S.init(g.M, g.N, G, (int)blockIdx.x);
        EpiA E; E.P = (float*)(PWS + WS_P); E.Z = (bf16_t*)(PWS + WS_Z); E.out = POUT; E.l = l; E.cbase = part ? 2048 : 0;
        pg8::gemm_phase<EpiA, pg8::StaticOrder, false>((PG8_LAS unsigned char*)lds, g, S, E, nullptr);
    }
    __syncthreads();
}

__device__ void phaseB0(const Params& p, int l, unsigned char* ldsb) {
    const int tid = TID(), lane = tid & 63, wid = tid >> 6, fr = lane & 15, fq = lane >> 4;
    const int h = wid >> 1, mt = wid & 1;
    bf16_t* Awd = (bf16_t*)ldsb;
    bf16_t* Aad = Awd + 32 * 72;
    const float* P = (const float*)(PWS + WS_P);
    float* recS = (float*)(PWS + WS_RECS);
    float* recD = (float*)(PWS + WS_RECD);
    float* BC = (float*)(PWS + WS_BC);
    const bf16_t* LT = (const bf16_t*)(PWS + WS_LORAT) + (size_t)l * 4 * 256 * 64;
    const float* pkk = PIN(17) + l * 256; const float* pka = PIN(18) + l * 256; const float* prk = PIN(19) + l * 256;
    const float* pw0 = PIN(13) + l * 512; const float* pa0 = PIN(15) + l * 512;
    __shared__ int s_b0;
    unsigned* ctr0 = (unsigned*)(PWS + WS_CTR) + 4 + l;
    for (;;) {
        if (tid == 0) s_b0 = (int)atomicAdd(ctr0, 1u);
        __syncthreads();
        const int it = s_b0;
        __syncthreads();
        if (it >= NT / 32) break;
        const int tb = it * 32;
        __syncthreads();
#pragma unroll
        for (int i = 0; i < 8; ++i) { const int idx = tid + i * 512, tk = idx >> 7, j = idx & 127; const float v = P[(size_t)(tb + tk) * PW + C_WD + j];
            if (j < 64) Awd[tk * 72 + j] = f2bf(1.0f - 2.0f / (1.0f + __expf(2.0f * v))); else Aad[tk * 72 + j - 64] = f2bf(v); }
        __syncthreads();
        f32x4 acc[4][4];
#pragma unroll
        for (int m = 0; m < 4; ++m)
#pragma unroll
            for (int n = 0; n < 4; ++n) acc[m][n] = (f32x4){0.f, 0.f, 0.f, 0.f};
#pragma unroll
        for (int ks = 0; ks < 2; ++ks) {
            const bf16x8 awf = *(const bf16x8*)(Awd + (mt * 16 + fr) * 72 + ks * 32 + fq * 8), aaf = *(const bf16x8*)(Aad + (mt * 16 + fr) * 72 + ks * 32 + fq * 8);
#pragma unroll
            for (int n = 0; n < 4; ++n) { const int cb = h * 64 + n * 16 + fr;
#pragma unroll
                for (int m = 0; m < 4; ++m) { const bf16x8 bfr = *(const bf16x8*)(LT + ((size_t)m * 256 + cb) * 64 + ks * 32 + fq * 8);
                    acc[m][n] = __builtin_amdgcn_mfma_f32_16x16x32_bf16(bfr, m < 2 ? awf : aaf, acc[m][n], 0, 0, 0); } }
        }
        const int tok = tb + mt * 16 + fr; int seqbase, L, pos; seq_of(tok, seqbase, L, pos);
        const float* pr = P + (size_t)tok * PW;
        const size_t ridx = ((size_t)seqbase * 4 + (size_t)h * L + pos) * 192;
        f32x4 k4[4], kk4[4]; float ss = 0.f;
#pragma unroll
        for (int n = 0; n < 4; ++n) { const int c4 = h * 64 + n * 16 + fq * 4;
            k4[n] = *(const f32x4*)(pr + C_BK + c4); kk4[n] = k4[n] * *(const f32x4*)(pkk + c4);
            ss += (kk4[n][0] * kk4[n][0] + kk4[n][1] * kk4[n][1]) + (kk4[n][2] * kk4[n][2] + kk4[n][3] * kk4[n][3]); }
        ss += __shfl_xor(ss, 16); ss += __shfl_xor(ss, 32);
        const float rn = rsqrtf(ss + 1e-12f);
        float bsum = 0.f;
#pragma unroll
        for (int n = 0; n < 4; ++n) { const int c4 = h * 64 + n * 16 + fq * 4, j4 = n * 16 + fq * 4;
            const f32x4 r4 = *(const f32x4*)(pr + C_BR + c4), v4 = *(const f32x4*)(pr + C_BV + c4);
            const f32x4 kk = kk4[n] * rn, ka4 = *(const f32x4*)(pka + c4), rk4 = *(const f32x4*)(prk + c4);
            *(f32x4*)(recS + ridx + j4) = r4; *(f32x4*)(recS + ridx + 64 + j4) = kk; *(f32x4*)(recS + ridx + 128 + j4) = v4;
#pragma unroll
            for (int d = 0; d < 2; ++d) {
                const f32x4 w0 = *(const f32x4*)(pw0 + d * 256 + c4), a0 = *(const f32x4*)(pa0 + d * 256 + c4);
                f32x4 dec, nka, kd;
#pragma unroll
                for (int j = 0; j < 4; ++j) {
                    const float wl = w0[j] + acc[d][n][j];
                    dec[j] = __expf(-0.6065306597126334f / (1.0f + __expf(-wl)));
                    const float a = 1.0f / (1.0f + __expf(-(a0[j] + acc[2 + d][n][j])));
                    kd[j] = k4[n][j] * (1.0f + (a - 1.0f) * ka4[j]); nka[j] = -(kk[j] * a);
                    bsum += r4[j] * kd[j] * rk4[j]; }
                float* rd = recD + (size_t)d * RECD_STRIDE + ridx + j4;
                *(f32x4*)(rd) = dec; *(f32x4*)(rd + 64) = nka; *(f32x4*)(rd + 128) = kd;
            }
        }
        bsum += __shfl_xor(bsum, 16); bsum += __shfl_xor(bsum, 32);
        if (fq == 0) BC[tok * 4 + h] = bsum;
    }
}

template <int NS>
__device__ __forceinline__ void scan_run(const Params& p, int l, bool sample, int b, int h, int dir, int rg, int L, int seqbase, float* wl) {
    const int lane = TID() & 63, rl = lane >> 4, kl = lane & 15;
    int row[NS]; f32x4 S[NS]; size_t sidx[NS];
#pragma unroll
    for (int q = 0; q < NS; ++q) { row[q] = (rg * NS + q) * 4 + rl;
        sidx[q] = ((size_t)(((b * 2 + l) * 2 + dir) * 4 + h)) * 4096 + row[q] * 64 + kl * 4;
        if (sample) S[q] = *(const f32x4*)(PIN(4) + sidx[q]); else S[q] = (f32x4){0.f, 0.f, 0.f, 0.f}; }
    const float* gS = (const float*)(PWS + WS_RECS) + ((size_t)seqbase * 4 + (size_t)h * L) * 192 + lane * 4;
    const float* gD = (const float*)(PWS + WS_RECD) + (size_t)dir * RECD_STRIDE + ((size_t)seqbase * 4 + (size_t)h * L) * 192 + lane * 4;
    float* O = (float*)(PWS + WS_O) + (size_t)dir * NT * 256 + (size_t)seqbase * 256 + h * 64;
    const int nch = L >> 2;
    f32x4 rA[6], rB[6];
    auto gl = [&](f32x4 (&r)[6], int c) {
        c = c < nch ? c : nch - 1;
        const int pos0 = dir ? (L - 4 * (c + 1)) : 4 * c;
        const float* s_ = gS + (size_t)pos0 * 192; const float* d_ = gD + (size_t)pos0 * 192;
#pragma unroll
        for (int i = 0; i < 3; ++i) { r[i] = *(const f32x4*)(s_ + i * 256); r[3 + i] = *(const f32x4*)(d_ + i * 256); }
    };
    auto st = [&](const f32x4 (&r)[6], float* buf) {
#pragma unroll
        for (int i = 0; i < 3; ++i) { *(f32x4*)(buf + i * 256 + lane * 4) = r[i]; *(f32x4*)(buf + 768 + i * 256 + lane * 4) = r[3 + i]; }
    };
    struct Ops { f32x4 r, kk, w, ka, kd; float v[NS]; };
    auto ldsread = [&](const float* buf, int s) -> Ops {
        const int tc = dir ? 3 - s : s;
        const float* bs = buf + tc * 192; const float* bd = buf + 768 + tc * 192;
        Ops o; o.r = *(const f32x4*)(bs + kl * 4); o.kk = *(const f32x4*)(bs + 64 + kl * 4);
        o.w = *(const f32x4*)(bd + kl * 4); o.ka = *(const f32x4*)(bd + 64 + kl * 4); o.kd = *(const f32x4*)(bd + 128 + kl * 4);
#pragma unroll
        for (int q = 0; q < NS; ++q) o.v[q] = bs[128 + row[q]];
        return o;
    };
    float opart[NS];
#pragma unroll
    for (int q = 0; q < NS; ++q) opart[q] = 0.f;
    auto chunk = [&](const float* cur, const float* nxtbuf, Ops& ops, int c) {
        float oval[NS];
#pragma unroll
        for (int q = 0; q < NS; ++q) oval[q] = 0.f;
#pragma unroll
        for (int s = 0; s < 4; ++s) {
            const Ops nx = (s < 3) ? ldsread(cur, s + 1) : ldsread(nxtbuf, 0);
            __builtin_amdgcn_sched_barrier(0);
            float sa[NS], opr[NS]; f32x2 ta[NS], tb[NS];
            const f32x2 kka = __builtin_shufflevector(ops.kk, ops.kk, 0, 1), kkb = __builtin_shufflevector(ops.kk, ops.kk, 2, 3);
            const f32x2 wa = __builtin_shufflevector(ops.w, ops.w, 0, 1), wb = __builtin_shufflevector(ops.w, ops.w, 2, 3);
            const f32x2 na = __builtin_shufflevector(ops.ka, ops.ka, 0, 1), nb = __builtin_shufflevector(ops.ka, ops.ka, 2, 3);
            const f32x2 da = __builtin_shufflevector(ops.kd, ops.kd, 0, 1), db = __builtin_shufflevector(ops.kd, ops.kd, 2, 3);
            const f32x2 ra = __builtin_shufflevector(ops.r, ops.r, 0, 1), rb = __builtin_shufflevector(ops.r, ops.r, 2, 3);
#pragma unroll
            for (int q = 0; q < NS; ++q) { const f32x2 Sa = __builtin_shufflevector(S[q], S[q], 0, 1), Sb = __builtin_shufflevector(S[q], S[q], 2, 3);
                f32x2 pp = Sa * kka; pp = Sb * kkb + pp; sa[q] = pp[0] + pp[1];
                const f32x2 v2 = (f32x2){ops.v[q], ops.v[q]};
                ta[q] = Sa * wa + v2 * da; tb[q] = Sb * wb + v2 * db; }
#pragma unroll
            for (int q = 0; q < NS; ++q) { sa[q] = row16_sum(sa[q]); opr[q] = row16_sum(opart[q]); oval[q] = (kl == s) ? opr[q] : oval[q]; }
#pragma unroll
            for (int q = 0; q < NS; ++q) { const f32x2 s2 = (f32x2){sa[q], sa[q]};
                const f32x2 Sa = s2 * na + ta[q], Sb = s2 * nb + tb[q];
                f32x2 qq = Sa * ra; qq = Sb * rb + qq; opart[q] = qq[0] + qq[1];
                S[q] = (f32x4){Sa[0], Sa[1], Sb[0], Sb[1]}; }
            ops = nx;
        }
        const int stp = 4 * c - 1 + (kl & 3);
        const int pos = dir ? (L - 1 - stp) : stp;
#pragma unroll
        for (int q = 0; q < NS; ++q) { if (kl < 4 && stp >= 0) O[(size_t)pos * 256 + row[q]] = oval[q]; }
    };
    float* buf0 = wl; float* buf1 = wl + 1536;
    gl(rA, 0); gl(rB, 1);
    st(rA, buf0); gl(rA, 2);
    __builtin_amdgcn_wave_barrier();
    Ops ops = ldsread(buf0, 0);
    for (int c = 0; c < nch; c += 2) {
        st(rB, buf1); gl(rB, c + 3);
        __builtin_amdgcn_wave_barrier();
        chunk(buf0, buf1, ops, c);
        st(rA, buf0); gl(rA, c + 4);
        __builtin_amdgcn_wave_barrier();
        chunk(buf1, buf0, ops, c + 1);
    }
#pragma unroll
    for (int q = 0; q < NS; ++q) { const float ol = row16_sum(opart[q]); if (kl == 0) O[(size_t)(dir ? 0 : L - 1) * 256 + row[q]] = ol; }
    if (!sample) {
#pragma unroll
        for (int q = 0; q < NS; ++q) *(f32x4*)(POUT + O_NS + sidx[q]) = S[q];
    }
}

__device__ __forceinline__ void stage_qk(const float* __restrict__ src, int stride, bf16_t* dst, bool rope, int pos0, float scale, const f32x2* __restrict__ rt) {
    const int tid = TID();
#pragma unroll
    for (int i = 0; i < 2; ++i) {
        const int task = tid + i * 512, row = task >> 3, half = (task >> 2) & 1, quad = task & 3;
        const float* s = src + (size_t)row * stride + half * 32 + quad * 4;
        f32x4 x1 = *(const f32x4*)s, x2 = *(const f32x4*)(s + 16);
        if (rope) { const int pos = pos0 + row; const int pi = half ? (pos & 63) : (pos >> 6);
#pragma unroll
            for (int j = 0; j < 4; ++j) { const f32x2 cs = rt[pi * 16 + quad * 4 + j]; const float a = x1[j], b = x2[j]; x1[j] = a * cs[0] - b * cs[1]; x2[j] = b * cs[0] + a * cs[1]; } }
        x1 *= scale; x2 *= scale;
        u32x2 w1, w2; w1[0] = cvt_pk_bf16(x1[0], x1[1]); w1[1] = cvt_pk_bf16(x1[2], x1[3]); w2[0] = cvt_pk_bf16(x2[0], x2[1]); w2[1] = cvt_pk_bf16(x2[2], x2[3]);
        *(u32x2*)(dst + row * 72 + half * 32 + quad * 4) = w1; *(u32x2*)(dst + row * 72 + half * 32 + 16 + quad * 4) = w2;
    }
}
__device__ __forceinline__ void stage_vt(const float* __restrict__ src, int stride, bf16_t* vt, int nkeys = 128, int pitch = 136) {
    const int tid = TID();
    for (int task = tid; task < nkeys * 16; task += 512) { const int key = task >> 4, dq = task & 15;
        const f32x4 v = *(const f32x4*)(src + (size_t)key * stride + dq * 4);
#pragma unroll
        for (int j = 0; j < 4; ++j) vt[(dq * 4 + j) * pitch + key] = f2bf(v[j]); }
}
__device__ void attn_item(const Params& p, int l, int ai, unsigned char* lds) {
    const int tid = TID(), lane = tid & 63, wid = tid >> 6, fr = lane & 15, fq = lane >> 4;
    bf16_t* Qs = (bf16_t*)lds; bf16_t* Ks = Qs + 128 * 72; bf16_t* Vt = Ks + 128 * 72;
    const float* P = (const float*)(PWS + WS_P);
    const bf16_t* Z = (const bf16_t*)(PWS + WS_Z);
    bf16_t* YS = (bf16_t*)(PWS + WS_YS);
    const f32x2* rt = (const f32x2*)(PWS + WS_ROPE);
    bool sample; int b, head, qt, seqbase;
    if (ai < 128) { sample = true; b = ai >> 5; head = (ai >> 3) & 3; qt = ai & 7; seqbase = NTP + b * 1024; }
    else { const int j = ai - 128; sample = false; b = j >> 3; head = (j >> 1) & 3; qt = j & 1; seqbase = b * 256; }
    const int kh = head >> 1, qbase = seqbase + qt * 128;
    __syncthreads();
    stage_qk(P + (size_t)qbase * PW + C_CQ + head * 64, PW, Qs, sample, qt * 128, 0.125f, rt);
    __syncthreads();
    bf16x8 qf[2];
    qf[0] = *(const bf16x8*)(Qs + (wid * 16 + fr) * 72 + fq * 8); qf[1] = *(const bf16x8*)(Qs + (wid * 16 + fr) * 72 + 32 + fq * 8);
    float m = PIN(22)[l * 4 + head], lsum = 1.0f, lpart = 0.f;
    f32x4 oacc[4];
#pragma unroll
    for (int i = 0; i < 4; ++i) oacc[i] = (f32x4){0.f, 0.f, 0.f, 0.f};
    const int nkb = sample ? 7 : 2;
    const int qpos = qt * 128 + wid * 16 + fr;
    const float* ck = PIN(2); const float* cv = PIN(3);
    auto kinfo = [&](int kb, const float*& ks, const float*& vs, int& stride, bool& rope, bool& mask, int& kpos0) -> bool {
        if (!sample) { ks = P + (size_t)(seqbase + kb * 128) * PW + C_CK + kh * 64; vs = ks + (C_CV - C_CK); stride = PW; rope = false; mask = false; kpos0 = 0; return true; }
        if (kb < 3) { const int nbk = qt - 1 + kb; if (nbk < 0 || nbk >= 8) return false; kpos0 = nbk * 128;
            ks = P + (size_t)(seqbase + kpos0) * PW + C_CK + kh * 64; vs = ks + (C_CV - C_CK); stride = PW; rope = true; mask = (kb != 1); return true; }
        const size_t o = ((size_t)((b * 2 + l) * 512 + (kb - 3) * 128) * 2 + kh) * 64; ks = ck + o; vs = cv + o; stride = 128; rope = false; mask = false; kpos0 = 0; return true;
    };
    f32x4 kx1[2], kx2[2], vx[2][2];
    auto kload = [&](const float* ks, const float* vs, int stride) {
#pragma unroll
        for (int i = 0; i < 2; ++i) { const int task = tid + i * 512, row = task >> 3, half = (task >> 2) & 1, quad = task & 3;
            const float* s_ = ks + (size_t)row * stride + half * 32 + quad * 4; kx1[i] = *(const f32x4*)s_; kx2[i] = *(const f32x4*)(s_ + 16); }
#pragma unroll
        for (int i = 0; i < 2; ++i) { const int task = tid + i * 512, kp = task >> 4, dq = task & 15;
            vx[i][0] = *(const f32x4*)(vs + (size_t)(2 * kp) * stride + dq * 4); vx[i][1] = *(const f32x4*)(vs + (size_t)(2 * kp + 1) * stride + dq * 4); }
    };
    auto kstore = [&](bool rope, int kpos0) {
#pragma unroll
        for (int i = 0; i < 2; ++i) { const int task = tid + i * 512, row = task >> 3, half = (task >> 2) & 1, quad = task & 3;
            f32x4 x1 = kx1[i], x2 = kx2[i];
            if (rope) { const int pos = kpos0 + row; const int pi = half ? (pos & 63) : (pos >> 6);
#pragma unroll
                for (int j = 0; j < 4; ++j) { const f32x2 cs = rt[pi * 16 + quad * 4 + j]; const float a_ = x1[j], b_ = x2[j]; x1[j] = a_ * cs[0] - b_ * cs[1]; x2[j] = b_ * cs[0] + a_ * cs[1]; } }
            u32x2 w1, w2; w1[0] = cvt_pk_bf16(x1[0], x1[1]); w1[1] = cvt_pk_bf16(x1[2], x1[3]); w2[0] = cvt_pk_bf16(x2[0], x2[1]); w2[1] = cvt_pk_bf16(x2[2], x2[3]);
            *(u32x2*)(Ks + row * 72 + half * 32 + quad * 4) = w1; *(u32x2*)(Ks + row * 72 + half * 32 + 16 + quad * 4) = w2; }
#pragma unroll
        for (int i = 0; i < 2; ++i) { const int task = tid + i * 512, kp = task >> 4, dq = task & 15;
#pragma unroll
            for (int j = 0; j < 4; ++j) *(unsigned*)(Vt + (dq * 4 + j) * 136 + 2 * kp) = cvt_pk_bf16(vx[i][0][j], vx[i][1][j]); }
    };
    const float* ksrc = nullptr; const float* vsrc = nullptr; int stride = 0, kpos0n = 0; bool ropen = false, maskn = false;
    int kb = 0;
    while (kb < nkb && !kinfo(kb, ksrc, vsrc, stride, ropen, maskn, kpos0n)) ++kb;
    if (kb < nkb) kload(ksrc, vsrc, stride);
    while (kb < nkb) {
        const bool mask = maskn; const int kpos0 = kpos0n; const bool rope = ropen;
        __syncthreads();
        kstore(rope, kpos0);
        __syncthreads();
        int nk = kb + 1;
        while (nk < nkb && !kinfo(nk, ksrc, vsrc, stride, ropen, maskn, kpos0n)) ++nk;
        if (nk < nkb) kload(ksrc, vsrc, stride);
        kb = nk;
        f32x4 sc[4][2];
#pragma unroll
        for (int sb = 0; sb < 4; ++sb) {
            f32x4 s0 = (f32x4){0.f, 0.f, 0.f, 0.f}, s1 = s0;
#pragma unroll
            for (int dh = 0; dh < 2; ++dh) {
                const bf16x8 k0 = *(const bf16x8*)(Ks + (sb * 32 + fr) * 72 + dh * 32 + fq * 8), k1 = *(const bf16x8*)(Ks + (sb * 32 + 16 + fr) * 72 + dh * 32 + fq * 8);
                s0 = __builtin_amdgcn_mfma_f32_16x16x32_bf16(k0, qf[dh], s0, 0, 0, 0);
                s1 = __builtin_amdgcn_mfma_f32_16x16x32_bf16(k1, qf[dh], s1, 0, 0, 0);
            }
            if (mask) {
#pragma unroll
                for (int j = 0; j < 4; ++j) { const int k0p = kpos0 + sb * 32 + fq * 4 + j, k1p = k0p + 16; int d0 = qpos - k0p, d1 = qpos - k1p; d0 = d0 < 0 ? -d0 : d0; d1 = d1 < 0 ? -d1 : d1;
                    if (d0 > 128) s0[j] = -1e30f; if (d1 > 128) s1[j] = -1e30f; }
            }
            sc[sb][0] = s0; sc[sb][1] = s1;
        }
        float mx = -1e30f;
#pragma unroll
        for (int sb = 0; sb < 4; ++sb)
#pragma unroll
            for (int j = 0; j < 4; ++j) mx = fmaxf(mx, fmaxf(sc[sb][0][j], sc[sb][1][j]));
        mx = fmaxf(mx, __shfl_xor(mx, 16)); mx = fmaxf(mx, __shfl_xor(mx, 32));
        const float mn = fmaxf(m, mx), alpha = __expf(m - mn);
        m = mn; lsum *= alpha; lpart *= alpha;
#pragma unroll
        for (int dt = 0; dt < 4; ++dt) oacc[dt] = oacc[dt] * alpha;
#pragma unroll
        for (int sb = 0; sb < 4; ++sb) {
            f32x4 s0 = sc[sb][0], s1 = sc[sb][1];
#pragma unroll
            for (int j = 0; j < 4; ++j) { s0[j] = __expf(s0[j] - mn); s1[j] = __expf(s1[j] - mn); lpart += s0[j] + s1[j]; }
            u32x4 pw; pw[0] = cvt_pk_bf16(s0[0], s0[1]); pw[1] = cvt_pk_bf16(s0[2], s0[3]); pw[2] = cvt_pk_bf16(s1[0], s1[1]); pw[3] = cvt_pk_bf16(s1[2], s1[3]);
            bf16x8 pf; __builtin_memcpy(&pf, &pw, 16);
#pragma unroll
            for (int dt = 0; dt < 4; ++dt) {
                const bf16_t* vp = Vt + (dt * 16 + fr) * 136 + sb * 32 + fq * 4;
                u32x4 vw; const u32x2 va = *(const u32x2*)vp, vb = *(const u32x2*)(vp + 16); vw[0] = va[0]; vw[1] = va[1]; vw[2] = vb[0]; vw[3] = vb[1];
                bf16x8 vf; __builtin_memcpy(&vf, &vw, 16);
                oacc[dt] = __builtin_amdgcn_mfma_f32_16x16x32_bf16(vf, pf, oacc[dt], 0, 0, 0);
            }
        }
    }
    lpart += __shfl_xor(lpart, 16); lpart += __shfl_xor(lpart, 32);
    lsum += lpart;
    const float inv = 1.0f / lsum;
    const size_t t = (size_t)(qbase + wid * 16 + fr);
#pragma unroll
    for (int dt = 0; dt < 4; ++dt) {
        const int col = 512 + head * 64 + dt * 16 + fq * 4;
        const bf16x4 z = *(const bf16x4*)(Z + t * DM + col);
        u32x2 w; w[0] = cvt_pk_bf16(oacc[dt][0] * inv * bf2f((bf16_t)z[0]), oacc[dt][1] * inv * bf2f((bf16_t)z[1]));
        w[1] = cvt_pk_bf16(oacc[dt][2] * inv * bf2f((bf16_t)z[2]), oacc[dt][3] * inv * bf2f((bf16_t)z[3]));
        *(u32x2*)(YS + t * DM + col) = w;
    }
}

__device__ void chunk_item(const Params& p, int l, int ci, unsigned char* ldsb) {
    const int tid = TID(), lane = tid & 63, wid = tid >> 6, fr = lane & 15, fq = lane >> 4;
    const int chunk = ci >> 2, g = ci & 3, base = chunk * 128;
    bf16_t* wsb = (bf16_t*)ldsb;
    bf16_t* vt = wsb + 128 * 136;
    const float* P = (const float*)(PWS + WS_P);
    const bf16_t* Z = (const bf16_t*)(PWS + WS_Z);
    bf16_t* YS = (bf16_t*)(PWS + WS_YS);
    const float* wsrc = PIN(11) + (size_t)(l * 4 + g) * 128 * 128;
    __syncthreads();
#pragma unroll
    for (int i = 0; i < 8; ++i) { const int idx = tid + i * 512, r = idx >> 5, c4 = (idx & 31) * 4; const f32x4 v = *(const f32x4*)(wsrc + r * 128 + c4);
        u32x2 w; w[0] = cvt_pk_bf16(v[0], v[1]); w[1] = cvt_pk_bf16(v[2], v[3]); *(u32x2*)(wsb + r * 136 + c4) = w; }
    stage_vt(P + (size_t)base * PW + C_AV + g * 64, PW, vt, 128);
    __syncthreads();
    f32x4 acc[4];
#pragma unroll
    for (int n = 0; n < 4; ++n) acc[n] = (f32x4){0.f, 0.f, 0.f, 0.f};
#pragma unroll
    for (int k = 0; k < 4; ++k) {
        const bf16x8 af = *(const bf16x8*)(wsb + (wid * 16 + fr) * 136 + k * 32 + fq * 8);
#pragma unroll
        for (int n = 0; n < 4; ++n) { const bf16x8 bfv = *(const bf16x8*)(vt + (n * 16 + fr) * 136 + k * 32 + fq * 8);
            acc[n] = __builtin_amdgcn_mfma_f32_16x16x32_bf16(bfv, af, acc[n], 0, 0, 0); }
    }
    const int i = wid * 16 + fr; const size_t t = base + i;
    const float bsi = PIN(12)[(l * 4 + g) * 128 + i];
#pragma unroll
    for (int n = 0; n < 4; ++n) { const int col = g * 64 + n * 16 + fq * 4;
        const f32x4 u = *(const f32x4*)(P + t * PW + C_AU + col);
        const bf16x4 z = *(const bf16x4*)(Z + t * DM + col);
        u32x2 w; w[0] = cvt_pk_bf16(u[0] * (acc[n][0] + bsi) * bf2f((bf16_t)z[0]), u[1] * (acc[n][1] + bsi) * bf2f((bf16_t)z[1]));
        w[1] = cvt_pk_bf16(u[2] * (acc[n][2] + bsi) * bf2f((bf16_t)z[2]), u[3] * (acc[n][3] + bsi) * bf2f((bf16_t)z[3]));
        *(u32x2*)(YS + t * DM + col) = w; }
}

__device__ void pool_item(const Params& p, int l, int pi, unsigned char* ldsb) {
    const int tid = TID(), lane = tid & 63, wid = tid >> 6, fr = lane & 15, fq = lane >> 4, half = tid >> 8, ch = tid & 255, g = ch >> 6;
    const int tb = pi * 32; int seqbase, L, pos0; seq_of(tb, seqbase, L, pos0);
    float* pt = (float*)ldsb;
    bf16_t* dl = (bf16_t*)(pt + 48 * 256);
    bf16_t* wt = dl + 32 * 264;
    const float* P = (const float*)(PWS + WS_P);
    const bf16_t* Z = (const bf16_t*)(PWS + WS_Z);
    bf16_t* YS = (bf16_t*)(PWS + WS_YS);
    __syncthreads();
#pragma unroll
    for (int i = 0; i < 6; ++i) { const int idx = tid + i * 512, rr = idx >> 6, c4 = (idx & 63) * 4; const int pos = pos0 - 8 + rr;
        f32x4 v = (f32x4){0.f, 0.f, 0.f, 0.f};
        if (pos >= 0 && pos < L) v = *(const f32x4*)(P + (size_t)(seqbase + pos) * PW + C_DP + c4);
        *(f32x4*)(pt + rr * 256 + c4) = v; }
    { const float* pwsrc = PIN(23) + (size_t)l * 4 * 64 * 64;
#pragma unroll
      for (int gg = 0; gg < 4; ++gg) stage_vt(pwsrc + gg * 4096, 64, wt + gg * 64 * 72, 64, 72); }
    __syncthreads();
    const int w = 2 << g;
    for (int i = 0; i < 16; ++i) { const int tk = half * 16 + i, pos = pos0 + tk;
        int lo = pos - (w >> 1), hi = lo + w; lo = lo < 0 ? 0 : lo; hi = hi > L ? L : hi;
        float sm = 0.f;
        for (int q = lo; q < hi; ++q) sm += pt[(q - pos0 + 8) * 256 + ch];
        dl[tk * 264 + ch] = f2bf(sm / (float)(hi - lo) - pt[(tk + 8) * 256 + ch]); }
    __syncthreads();
    const int gw = wid >> 1, th = wid & 1;
    f32x4 acc[4];
#pragma unroll
    for (int n = 0; n < 4; ++n) acc[n] = (f32x4){0.f, 0.f, 0.f, 0.f};
#pragma unroll
    for (int k = 0; k < 2; ++k) {
        const bf16x8 af = *(const bf16x8*)(dl + (th * 16 + fr) * 264 + gw * 64 + k * 32 + fq * 8);
#pragma unroll
        for (int n = 0; n < 4; ++n) { const bf16x8 bfv = *(const bf16x8*)(wt + (gw * 64 + n * 16 + fr) * 72 + k * 32 + fq * 8);
            acc[n] = __builtin_amdgcn_mfma_f32_16x16x32_bf16(bfv, af, acc[n], 0, 0, 0); }
    }
    const size_t t = tb + th * 16 + fr;
#pragma unroll
    for (int n = 0; n < 4; ++n) { const int oc = gw * 64 + n * 16 + fq * 4;
        const f32x4 sc = *(const f32x4*)(PIN(24) + l * 256 + oc);
        const bf16x4 z = *(const bf16x4*)(Z + t * DM + 768 + oc);
        u32x2 wv; wv[0] = cvt_pk_bf16(acc[n][0] * sc[0] * bf2f((bf16_t)z[0]), acc[n][1] * sc[1] * bf2f((bf16_t)z[1]));
        wv[1] = cvt_pk_bf16(acc[n][2] * sc[2] * bf2f((bf16_t)z[2]), acc[n][3] * sc[3] * bf2f((bf16_t)z[3]));
        *(u32x2*)(YS + t * DM + 768 + oc) = wv; }
}

__device__ void phaseB1(const Params& p, int l, unsigned char* lds, int slot = 0, int part = 127) {
    const int tid = TID(), wid = tid >> 6;
    float* wl = (float*)lds + wid * 3072;
    if (!(part & 1)) {} else
    { const int nbh = (int)gridDim.x >> 1;
      if ((int)blockIdx.x < nbh) { if (wid < 4 && (part & 4)) for (int it = blockIdx.x * 4 + wid; it < 512; it += nbh * 4) { const int q = it >> 4, b = q >> 3;
            scan_run<1>(p, l, true, b, (q >> 1) & 3, q & 1, it & 15, 1024, NTP + b * 1024, wl); } }
      else { const int nb2 = (int)gridDim.x - nbh; if (part & 8) for (int it = ((int)blockIdx.x - nbh) * 8 + wid; it < 1024; it += nb2 * 8) { const int q = it >> 3, b = q >> 3;
            scan_run<2>(p, l, false, b, (q >> 1) & 3, q & 1, it & 7, 256, b * 256, wl); } } }
    __syncthreads();
    __shared__ int s_item;
    unsigned* ctr = (unsigned*)(PWS + WS_CTR) + l + 2 * slot;
    if (part & 2)
    for (;;) {
        if (tid == 0) s_item = (int)atomicAdd(ctr, 1u);
        __syncthreads();
        const int item = s_item;
        __syncthreads();
        if (item >= 768) break;
        if (item < 256) { if (part & 16) attn_item(p, l, item, lds); }
        else if (item < 512) { if (part & 32) chunk_item(p, l, item - 256, lds); }
        else { if (part & 64) pool_item(p, l, item - 512, lds); }
    }
}

__device__ void phaseB2(const Params& p, int l) {
    const int lane = TID() & 63, gw = blockIdx.x * 8 + (TID() >> 6), W = gridDim.x * 8;
    const float* O = (const float*)(PWS + WS_O);
    const float* recS = (const float*)(PWS + WS_RECS);
    const float* BC = (const float*)(PWS + WS_BC);
    const bf16_t* Z = (const bf16_t*)(PWS + WS_Z);
    bf16_t* YS = (bf16_t*)(PWS + WS_YS);
    const float* lng = PIN(20) + l * 256; const float* lnb = PIN(21) + l * 256;
    float g4[4], b4[4];
#pragma unroll
    for (int h = 0; h < 4; ++h) { g4[h] = lng[h * 64 + lane]; b4[h] = lnb[h * 64 + lane]; }
    for (int tok = gw; tok < NT; tok += W) {
        int seqbase, L, pos; seq_of(tok, seqbase, L, pos);
        float o[4], vv[4], z[4], mu[4], var[4];
        const f32x4 bc = *(const f32x4*)(BC + tok * 4);
#pragma unroll
        for (int h = 0; h < 4; ++h) { const int c = h * 64 + lane;
            o[h] = O[(size_t)tok * 256 + c] + O[(size_t)NT * 256 + (size_t)tok * 256 + c];
            vv[h] = recS[((size_t)seqbase * 4 + (size_t)h * L + pos) * 192 + 128 + lane];
            z[h] = bf2f(Z[(size_t)tok * DM + 256 + c]); }
#pragma unroll
        for (int h = 0; h < 4; ++h) mu[h] = wave_sum(o[h]) * (1.0f / 64.0f);
#pragma unroll
        for (int h = 0; h < 4; ++h) { o[h] -= mu[h]; var[h] = wave_sum(o[h] * o[h]) * (1.0f / 64.0f); }
#pragma unroll
        for (int h = 0; h < 4; ++h) { const float on = o[h] * rsqrtf(var[h] + 64e-5f);
            const float y = on * g4[h] + b4[h] + bc[h] * vv[h];
            YS[(size_t)tok * DM + 256 + h * 64 + lane] = f2bf(y * z[h]); }
    }
}

__device__ void phaseC1(const Params& p, int l, unsigned char* lds) {
    pg8::Gemm g; g.A = (const bf16_t*)(PWS + WS_H); g.Bt = (const bf16_t*)(PWS + WS_WTIN) + (size_t)l * INW * 1024 + (size_t)NA_COLS * 1024; g.M = NT; g.N = 4096; g.K = 1024;
    pg8::StaticOrder S; S.init(g.M, g.N, (int)gridDim.x, (int)blockIdx.x);
    EpiG E; E.G = (bf16_t*)(PWS + WS_G);
    pg8::gemm_phase<EpiG, pg8::StaticOrder, false>((PG8_LAS unsigned char*)lds, g, S, E, nullptr);
    __syncthreads();
}
__device__ void phaseC2(const Params& p, int l, unsigned char* lds) {
    constexpr int MT = 4, LDT = 72, A_BYTES = 256 * LDT * 2, B_BYTES = 128 * LDT * 2, BUF = A_BYTES + B_BYTES;
    const int tid = TID(), lane = tid & 63, wid = tid >> 6, wr = wid >> 1, wc = wid & 1, fr = lane & 15, fq = lane >> 4;
    const bf16_t* YS = (const bf16_t*)(PWS + WS_YS);
    const bf16_t* G = (const bf16_t*)(PWS + WS_G);
    const bf16_t* Wu = (const bf16_t*)(PWS + WS_WTUP) + (size_t)l * 4 * 1024 * 256;
    bf16_t* MG = (bf16_t*)(PWS + WS_MERGED);
    const int srow = tid >> 3, skc = tid & 7, soff = (srow * LDT + skc * 8) * 2;
    const int aoff = ((wr * MT * 16 + fr) * LDT + fq * 8) * 2, boff = A_BYTES + ((wc * 64 + fr) * LDT + fq * 8) * 2;
    const int NU = 32 * 8;
    for (int u = blockIdx.x; u < NU; u += gridDim.x) {
        const int pn = u / 32, pm = u % 32;
        const bf16_t* Ag = YS + ((size_t)pm * 256 + srow) * 1024 + skc * 8;
        const bf16_t* Bg = Wu + ((size_t)pn * 128 + srow) * 256 + skc * 8;
        f32x4 mg[4][4], acc[4][4]; zero_acc<4>(mg); zero_acc<4>(acc);
        u32x4 ra[MT], rb[2];
        auto gload = [&](int kt) {
#pragma unroll
            for (int i = 0; i < MT; ++i) ra[i] = *(const u32x4*)(Ag + (size_t)i * 64 * 1024 + kt * 64);
            const bf16_t* bb = Bg + (size_t)(kt >> 2) * 1024 * 256 + (kt & 3) * 64;
#pragma unroll
            for (int i = 0; i < 2; ++i) rb[i] = *(const u32x4*)(bb + (size_t)i * 64 * 256);
        };
        auto sstore = [&](int buf) { unsigned char* nb = lds + buf * BUF;
#pragma unroll
            for (int i = 0; i < MT; ++i) *(u32x4*)(nb + soff + i * 64 * LDT * 2) = ra[i];
#pragma unroll
            for (int i = 0; i < 2; ++i) *(u32x4*)(nb + A_BYTES + soff + i * 64 * LDT * 2) = rb[i];
        };
        __syncthreads();
        gload(0); sstore(0);
        __syncthreads();
        for (int t = 0; t < 16; ++t) {
            if (t + 1 < 16) gload(t + 1);
            const unsigned char* base = lds + (t & 1) * BUF;
#pragma unroll
            for (int kk = 0; kk < 2; ++kk) {
                bf16x8 af[MT], bfr[4];
#pragma unroll
                for (int m = 0; m < MT; ++m) af[m] = *(const bf16x8*)(base + aoff + m * 16 * LDT * 2 + kk * 64);
#pragma unroll
                for (int n = 0; n < 4; ++n) bfr[n] = *(const bf16x8*)(base + boff + n * 16 * LDT * 2 + kk * 64);
#pragma unroll
                for (int m = 0; m < MT; ++m)
#pragma unroll
                    for (int n = 0; n < 4; ++n) acc[m][n] = __builtin_amdgcn_mfma_f32_16x16x32_bf16(bfr[n], af[m], acc[m][n], 0, 0, 0);
            }
            if (t + 1 < 16) sstore((t + 1) & 1);
            if ((t & 3) == 3) {
                const int n = t >> 2;
#pragma unroll
                for (int m = 0; m < 4; ++m) { const int row = pm * 256 + wr * 64 + m * 16 + fr;
                    const bf16_t* gp = G + g_off(row, n * 1024 + pn * 128 + wc * 64 + fq * 4);
                    const bf16x8 ga = *(const bf16x8*)gp, gb = *(const bf16x8*)(gp + 8);
#pragma unroll
                    for (int q = 0; q < 4; ++q) {
#pragma unroll
                        for (int j = 0; j < 4; ++j) { const bf16_t gv = (bf16_t)(q < 2 ? ga[q * 4 + j] : gb[(q - 2) * 4 + j]); mg[m][q][j] += bf2f(gv) * acc[m][q][j]; }
                        acc[m][q] = (f32x4){0.f, 0.f, 0.f, 0.f}; } }
            }
            __syncthreads();
        }
#pragma unroll
        for (int m = 0; m < 4; ++m) { const size_t row = (size_t)pm * 256 + wr * 64 + m * 16 + fr;
#pragma unroll
            for (int q = 0; q < 4; ++q) { const int col = pn * 128 + wc * 64 + q * 16 + fq * 4;
                u32x2 w; w[0] = cvt_pk_bf16(mg[m][q][0], mg[m][q][1]); w[1] = cvt_pk_bf16(mg[m][q][2], mg[m][q][3]);
                *(u32x2*)(MG + row * DM + col) = w; } }
    }
}

__device__ void phaseD(const Params& p, int l, unsigned char* lds) {
    const int tid = TID(), lane = tid & 63, wid = tid >> 6, wr = wid >> 1, wc = wid & 1, fr = lane & 15, fq = lane >> 4;
    const bf16_t* MG = (const bf16_t*)(PWS + WS_MERGED);
    const bf16_t* Wo = (const bf16_t*)(PWS + WS_WTO) + (size_t)l * 1024 * 1024;
    const int NU = 32 * 8;
    for (int u = blockIdx.x; u < NU; u += gridDim.x) {
        const int pn = u / 32, pm = u % 32;
        f32x4 acc[4][4]; zero_acc<4>(acc);
        gemm_acc<4>(MG + (size_t)pm * 256 * 1024, 1024, Wo + (size_t)pn * 128 * 1024, 1024, 1024, acc, lds);
#pragma unroll
        for (int m = 0; m < 4; ++m) { const int row = pm * 256 + wr * 64 + m * 16 + fr;
            const float* xr = xrow_ptr(p, l, row);
            const float* gate = (const float*)(PWS + WS_MOD) + (size_t)(l * 5 + modrow_of(row)) * 3072 + 2048;
#pragma unroll
            for (int q = 0; q < 4; ++q) { const int col = pn * 128 + wc * 64 + q * 16 + fq * 4;
                const f32x4 xo = *(const f32x4*)(xr + col), gt = *(const f32x4*)(gate + col);
                *(f32x4*)(POUT + (size_t)row * DM + col) = xo + gt * acc[m][q]; } }
    }
}

__device__ void phaseF(const Params& p) {
    const int lane = TID() & 63, gw = blockIdx.x * 8 + (TID() >> 6), W = gridDim.x * 8;
    const float* g = PIN(27);
    for (int row = gw; row < NT; row += W) {
        float* x = POUT + (size_t)row * DM;
        f32x4 v[4]; float ss = 0.f;
#pragma unroll
        for (int i = 0; i < 4; ++i) { v[i] = *(const f32x4*)(x + i * 256 + lane * 4); ss += v[i][0] * v[i][0] + v[i][1] * v[i][1] + v[i][2] * v[i][2] + v[i][3] * v[i][3]; }
        ss = wave_sum(ss);
        const float rs = rsqrtf(ss * (1.0f / 1024.0f) + 1e-6f);
#pragma unroll
        for (int i = 0; i < 4; ++i) { const int c = i * 256 + lane * 4; *(f32x4*)(x + c) = v[i] * rs * *(const f32x4*)(g + c); }
    }
}

__global__ void __launch_bounds__(NTHREADS) fwd_megakernel(Params p) {
    extern __shared__ __attribute__((aligned(16))) unsigned char lds[];
    volatile LAS unsigned* st = (volatile LAS unsigned*)(lds + LDS_MAIN);
    if (threadIdx.x < 2) st[threadIdx.x] = 0u;
    if (threadIdx.x == 0) {
#pragma unroll
        for (int i = 0; i < 28; ++i) s_ptab[i] = (unsigned long long)p.in[i];
    }
    __syncthreads();
    const XcdBarrier xb = xcd_barrier_post((unsigned*)(PWS + WS_BAR), st);
#define GSYNC() xcd_barrier(xb)
    phase0(p, lds);
    GSYNC();
#pragma unroll 1
    for (int l = 0; l < 2; ++l) {
        phaseA0(p, l);
        GSYNC();
#pragma unroll 1
        for (int ap = 0; ap < 2; ++ap) { phaseA(p, l, lds, ap); if (ap == 0) GSYNC(); }
        phaseB0(p, l, lds);
        GSYNC();
        phaseB1(p, l, lds);
        GSYNC();
        phaseB2(p, l);
        phaseC1(p, l, lds);
        GSYNC();
        phaseC2(p, l, lds);
        GSYNC();
        phaseD(p, l, lds);
        GSYNC();
    }
    phaseF(p);
}

extern "C" void kernel_launch(void* const* d_in, const int* in_sizes, int n_in, void* d_out, int out_size, void* d_ws, size_t ws_size, hipStream_t stream) {
    static int grid_blocks = 0;
    if (!grid_blocks) {
        int dev = 0, cus = 0, per_cu = 0;
        hipGetDevice(&dev);
        hipDeviceGetAttribute(&cus, hipDeviceAttributeMultiprocessorCount, dev);
        hipFuncSetAttribute((const void*)fwd_megakernel, hipFuncAttributeMaxDynamicSharedMemorySize, LDS_BYTES);
        hipOccupancyMaxActiveBlocksPerMultiprocessor(&per_cu, (const void*)fwd_megakernel, NTHREADS, LDS_BYTES);
        if (per_cu < 1) { fprintf(stderr, "occupancy query returned %d\n", per_cu); per_cu = 1; }
        if (per_cu > 1) per_cu = 1;
        grid_blocks = cus * per_cu;
        if (ws_size < WS_END) fprintf(stderr, "workspace too small: %zu < %zu\n", ws_size, (size_t)WS_END);
    }
    Params p{};
    for (int i = 0; i < 28; ++i) p.in[i] = (const float*)d_in[i];
    p.out = (float*)d_out; p.ws = (unsigned char*)d_ws;
    hipMemsetAsync((char*)d_ws + WS_BAR, 0, 3456 * 4, stream);
    void* args[] = {&p};
    hipError_t e = hipLaunchCooperativeKernel((const void*)fwd_megakernel, dim3(grid_blocks), dim3(NTHREADS), args, LDS_BYTES, stream);
    if (e != hipSuccess) fprintf(stderr, "cooperative launch failed: %s (grid %d)\n", hipGetErrorString(e), grid_blocks);
}
```

```cpp
#include <hip/hip_runtime.h>
#include <hip/hip_cooperative_groups.h>
#include <cstdio>
namespace cg = cooperative_groups;

typedef unsigned short bf16_t;
typedef short bf16x8 __attribute__((ext_vector_type(8)));
typedef short bf16x4 __attribute__((ext_vector_type(4)));
typedef float f32x4 __attribute__((ext_vector_type(4)));
typedef float f32x2 __attribute__((ext_vector_type(2)));
typedef unsigned u32x4 __attribute__((ext_vector_type(4)));
typedef unsigned u32x2 __attribute__((ext_vector_type(2)));

constexpr int NT = 8192, NTP = 4096, DM = 1024, INW = 7296, NA_COLS = 3200, PW = 2176;
constexpr int NTHREADS = 512;
constexpr int C_AU = 0, C_AV = 256, C_BR = 512, C_BK = 768, C_BV = 1024, C_WD = 1280, C_AD = 1344, C_CQ = 1408, C_CK = 1664, C_CV = 1792, C_DP = 1920;
constexpr size_t O_YP = 0, O_YS = 4194304, O_NK = 8388608, O_NV = 9437184, O_NS = 10485760;
constexpr size_t WS_WTIN = 0;
constexpr size_t WS_WTUP = WS_WTIN + (size_t)2 * INW * DM * 2;
constexpr size_t WS_WTO  = WS_WTUP + (size_t)2 * 4 * 1024 * 256 * 2;
constexpr size_t WS_MOD  = WS_WTO + (size_t)2 * 1024 * 1024 * 2;
constexpr size_t WS_ROPE = WS_MOD + (size_t)2 * 5 * 3072 * 4;
constexpr size_t WS_CTR  = WS_ROPE + 64 * 16 * 8;
constexpr size_t WS_BAR  = WS_CTR + 256;
constexpr size_t WS_H    = WS_BAR + 3456 * 4;
constexpr size_t WS_P    = WS_H + (size_t)NT * DM * 2;
constexpr size_t WS_Z    = WS_P + (size_t)NT * PW * 4;
constexpr size_t WS_RECS = WS_Z + (size_t)NT * DM * 2;
constexpr size_t WS_RECD = WS_RECS + (size_t)NT * 4 * 192 * 4;
constexpr size_t WS_O    = WS_RECD + (size_t)2 * NT * 4 * 192 * 4;
constexpr size_t WS_BC   = WS_O + (size_t)2 * NT * 256 * 4;
constexpr size_t WS_YS   = WS_BC + (size_t)NT * 4 * 4;
constexpr size_t WS_LORAT = WS_YS + (size_t)NT * DM * 2;
constexpr size_t WS_XP   = WS_LORAT + (size_t)2 * 4 * 256 * 64 * 2;
constexpr size_t WS_XCNT = WS_XP + (size_t)2 * 32 * 256 * 8 * 4;
constexpr size_t WS_END  = WS_XCNT + (size_t)2 * 32 * 256;
constexpr size_t WS_G = WS_P;
constexpr size_t WS_MERGED = WS_RECS;
constexpr size_t RECD_STRIDE = (size_t)NT * 4 * 192;

constexpr int LDS_MAIN = 131072;
constexpr int LDS_BYTES = LDS_MAIN + 16;

struct Params {
    const float* in[28];
    float* out;
    unsigned char* ws;
};
__shared__ unsigned long long s_ptab[28];
__device__ __forceinline__ const float* ld_inptr(int k) {
    const unsigned long long v = s_ptab[k];
    const unsigned lo = __builtin_amdgcn_readfirstlane((unsigned)v), hi = __builtin_amdgcn_readfirstlane((unsigned)(v >> 32));
    return (const float*)(((unsigned long long)hi << 32) | lo);
}
#define PIN(k) (ld_inptr(k))
#define POUT (p.out)
#define PWS (p.ws)

__device__ __forceinline__ int TID() { int t = threadIdx.x; asm volatile("" : "+v"(t)); return t; }
__device__ __forceinline__ unsigned cvt_pk_bf16(float lo, float hi) { unsigned r; asm volatile("v_cvt_pk_bf16_f32 %0, %1, %2" : "=v"(r) : "v"(lo), "v"(hi)); return r; }
__device__ __forceinline__ bf16_t f2bf(float f) { return (bf16_t)(cvt_pk_bf16(f, 0.f) & 0xffffu); }
__device__ __forceinline__ float bf2f(bf16_t b) { return __uint_as_float(((unsigned)b) << 16); }
__device__ __forceinline__ float sigmoidf_(float x) { return 1.0f / (1.0f + __expf(-x)); }
__device__ __forceinline__ float siluf_(float x) { return x / (1.0f + __expf(-x)); }
template <int CTRL> __device__ __forceinline__ float dpp_f(float x) { return __int_as_float(__builtin_amdgcn_update_dpp(0, __float_as_int(x), CTRL, 0xF, 0xF, false)); }
__device__ __forceinline__ float row16_sum(float x) {
    x += dpp_f<0x128>(x); x += dpp_f<0x124>(x); x += dpp_f<0x122>(x); x += dpp_f<0x121>(x); return x;
}
__device__ __forceinline__ float wave_sum(float v) { v = row16_sum(v); v += __shfl_xor(v, 16); v += __shfl_xor(v, 32); return v; }
__device__ __forceinline__ void seq_of(int tok, int& seqbase, int& L, int& pos) {
    if (tok < NTP) { seqbase = tok & ~255; L = 256; pos = tok & 255; }
    else { int t2 = tok - NTP; seqbase = NTP + (t2 & ~1023); L = 1024; pos = t2 & 1023; }
}
__device__ __forceinline__ int modrow_of(int tok) { return tok < NTP ? 0 : 1 + ((tok - NTP) >> 10); }


#define XB_TMO      128
#define XB_XCNT(j)  (256  + 64 * (j))
#define XB_XSUB(j)  (1280 + 64 * (j))
#define XB_XGEN(j)  (2304 + 64 * (j))
#define XB_TOP      3328
#define XB_TOPGEN   3392
#define XCD_BAR_WORDS 3456
#define XB_SPIN_CAP (1u << 18)
#define LAS __attribute__((address_space(3)))
__device__ __forceinline__ unsigned xb_ld(unsigned* p)              { return __hip_atomic_load(p, __ATOMIC_RELAXED, __HIP_MEMORY_SCOPE_AGENT); }
__device__ __forceinline__ unsigned xb_add(unsigned* p, unsigned v) { return __hip_atomic_fetch_add(p, v, __ATOMIC_RELAXED, __HIP_MEMORY_SCOPE_AGENT); }
__device__ __forceinline__ unsigned xb_xcc_id() { return (unsigned)__builtin_amdgcn_s_getreg((3 << 11) | 20) & 0xFu; }
#define XB_SPIN(cond, bar) do { unsigned _sp = 0; while (cond) { __builtin_amdgcn_s_sleep(1); \
    if ((++_sp & 255u) == 0u) { if (xb_ld(&(bar)[XB_TMO])) break; if (_sp > XB_SPIN_CAP) { atomicAdd(&(bar)[XB_TMO], 1u); break; } } } } while (0)
struct XcdBarrier { unsigned* bar; unsigned x; volatile LAS unsigned* st; };
__device__ __forceinline__ XcdBarrier xcd_barrier_post(unsigned* bar, volatile LAS unsigned* st) {
    XcdBarrier b; b.bar = bar; b.x = xb_xcc_id(); b.st = st;
    if (threadIdx.x == 0) (void)xb_add(&bar[XB_XCNT(b.x)], 1u);
    return b;
}
__device__ __forceinline__ void xcd_barrier_complete(unsigned* bar, unsigned x, unsigned& nloc, unsigned& nx) {
    const unsigned G = gridDim.x * gridDim.y * gridDim.z;
    unsigned sum, cnt, mine, sp = 0u;
    for (;;) {
        sum = 0u; cnt = 0u; mine = 0u;
#pragma unroll
        for (unsigned j = 0; j < 16; ++j) { const unsigned c = xb_ld(&bar[XB_XCNT(j)]); sum += c; cnt += (c > 0u) ? 1u : 0u; mine = (j == x) ? c : mine; }
        if (sum == G) break;
        __builtin_amdgcn_s_sleep(1);
        if ((++sp & 255u) == 0u) { if (xb_ld(&bar[XB_TMO])) break; if (sp > XB_SPIN_CAP) { atomicAdd(&bar[XB_TMO], 1u); break; } }
    }
    nloc = mine > 0u ? mine : 1u; nx = cnt > 0u ? cnt : 1u;
}
__device__ __forceinline__ void xcd_barrier(const XcdBarrier& b0) {
    asm volatile("s_waitcnt vmcnt(0)" ::: "memory");
    __syncthreads();
    if (threadIdx.x == 0) {
        XcdBarrier b = b0;
        { unsigned xx = xb_xcc_id(); asm volatile("" : "+s"(xx)); b.x = xx; }
        unsigned* bar = b.bar;
        __builtin_amdgcn_s_waitcnt(0);
        unsigned nloc = b.st[0], nx = b.st[1];
        if (nloc == 0u) { xcd_barrier_complete(bar, b.x, nloc, nx); b.st[0] = nloc; b.st[1] = nx; }
        const unsigned old = xb_add(&bar[XB_XSUB(b.x)], 1u);
        const unsigned gen = old / nloc;
        if (old + 1u == (gen + 1u) * nloc) {
            __builtin_amdgcn_fence(__ATOMIC_RELEASE, "agent");
            asm volatile("s_waitcnt vmcnt(0)" ::: "memory");
            const unsigned og = xb_add(&bar[XB_TOP], 1u);
            const unsigned tg = og / nx;
            if (og + 1u == (tg + 1u) * nx) xb_add(&bar[XB_TOPGEN], 1u);
            else XB_SPIN(xb_ld(&bar[XB_TOPGEN]) == tg, bar);
            __builtin_amdgcn_fence(__ATOMIC_ACQUIRE, "agent");
            xb_add(&bar[XB_XGEN(b.x)], 1u);
            asm volatile("s_waitcnt vmcnt(0)" ::: "memory");
        } else {
            XB_SPIN(xb_ld(&bar[XB_XGEN(b.x)]) == gen, bar);
            __builtin_amdgcn_fence(__ATOMIC_ACQUIRE, "agent");
            asm volatile("s_waitcnt vmcnt(0)" ::: "memory");
        }
    }
    __syncthreads();
}

__device__ void conv_tile(const float* __restrict__ src, int N, bf16_t* __restrict__ dst, int K, int kt, int nt, float* tile) {
    const int tid = TID();
    { const int r = tid >> 4, c4 = (tid & 15) * 4;
#pragma unroll
      for (int i = 0; i < 2; ++i) { const int k = r + 32 * i; const f32x4 v = *(const f32x4*)(src + (size_t)(kt * 64 + k) * N + nt * 64 + c4);
          tile[k * 65 + c4 + 0] = v[0]; tile[k * 65 + c4 + 1] = v[1]; tile[k * 65 + c4 + 2] = v[2]; tile[k * 65 + c4 + 3] = v[3]; } }
    __syncthreads();
    { const int n = tid >> 3, kc = (tid & 7) * 8; u32x4 w;
      w[0] = cvt_pk_bf16(tile[(kc + 0) * 65 + n], tile[(kc + 1) * 65 + n]); w[1] = cvt_pk_bf16(tile[(kc + 2) * 65 + n], tile[(kc + 3) * 65 + n]);
      w[2] = cvt_pk_bf16(tile[(kc + 4) * 65 + n], tile[(kc + 5) * 65 + n]); w[3] = cvt_pk_bf16(tile[(kc + 6) * 65 + n], tile[(kc + 7) * 65 + n]);
      *(u32x4*)(dst + (size_t)(nt * 64 + n) * K + kt * 64 + kc) = w; }
    __syncthreads();
}

__device__ void mod_item(const Params& p, int l, int cc, float* lds) {
    const int tid = TID();
    float* sc = lds;
    float* red = lds + 5120;
    for (int i = tid; i < 5120; i += NTHREADS) { const int r = i >> 10, k = i & 1023; const float v = (r == 0) ? PIN(6)[k] : PIN(5)[(r - 1) * 1024 + k]; sc[i] = siluf_(v); }
    __syncthreads();
    const int kg = tid >> 5, c = tid & 31, col = cc * 32 + c;
    float a[5] = {0.f, 0.f, 0.f, 0.f, 0.f};
    const float* w = PIN(7) + (size_t)l * 1024 * 3072 + col;
    for (int k = kg * 64; k < kg * 64 + 64; ++k) { const float wv = w[(size_t)k * 3072];
#pragma unroll
        for (int r = 0; r < 5; ++r) a[r] += sc[r * 1024 + k] * wv; }
#pragma unroll
    for (int r = 0; r < 5; ++r) red[(kg * 5 + r) * 32 + c] = a[r];
    __syncthreads();
    if (tid < 160) { const int r = tid >> 5, c2 = tid & 31; float s = PIN(8)[l * 3072 + cc * 32 + c2];
        for (int g = 0; g < 16; ++g) s += red[(g * 5 + r) * 32 + c2];
        ((float*)(PWS + WS_MOD))[(l * 5 + r) * 3072 + cc * 32 + c2] = s; }
    __syncthreads();
}

__device__ void phase0(const Params& p, unsigned char* lds) {
    const int NCONV_IN = 2 * 16 * 114, NCONV_UP = 8 * 64, NCONV_O = 2 * 256, NCONV_L = 32, NMOD = 192;
    const int total = NCONV_IN + NCONV_UP + NCONV_O + NCONV_L + NMOD + 1;
    for (int it = blockIdx.x; it < total; it += gridDim.x) {
        int i = it;
        if (i < NCONV_IN) { const int l = i / 1824, r = i % 1824, nt = r / 16, kt = r % 16;
            conv_tile(PIN(10) + (size_t)l * 1024 * INW, INW, (bf16_t*)(PWS + WS_WTIN) + (size_t)l * INW * 1024, 1024, kt, nt, (float*)lds); continue; }
        i -= NCONV_IN;
        if (i < NCONV_UP) { const int mtx = i / 64, r = i % 64, nt = r / 4, kt = r % 4;
            conv_tile(PIN(25) + (size_t)mtx * 256 * 1024, 1024, (bf16_t*)(PWS + WS_WTUP) + (size_t)mtx * 1024 * 256, 256, kt, nt, (float*)lds); continue; }
        i -= NCONV_UP;
        if (i < NCONV_O) { const int l = i / 256, r = i % 256, nt = r / 16, kt = r % 16;
            conv_tile(PIN(26) + (size_t)l * 1024 * 1024, 1024, (bf16_t*)(PWS + WS_WTO) + (size_t)l * 1024 * 1024, 1024, kt, nt, (float*)lds); continue; }
        i -= NCONV_O;
        if (i < NCONV_L) { const int l = i >> 4, m = (i >> 2) & 3, nt = i & 3;
            conv_tile((m < 2 ? PIN(14) : PIN(16)) + (size_t)(l * 2 + (m & 1)) * 64 * 256, 256, (bf16_t*)(PWS + WS_LORAT) + (size_t)(l * 4 + m) * 256 * 64, 64, 0, nt, (float*)lds); continue; }
        i -= NCONV_L;
        if (i < NMOD) { mod_item(p, i / 96, i % 96, (float*)lds); continue; }
        for (int e = TID(); e < 1024; e += NTHREADS) { const int pos = e >> 4, f = e & 15;
            const float inv = exp2f(-(float)f * (13.287712379549449f / 16.0f)); const float ang = (float)pos * inv;
            float sn, cs; sn = sinf(ang); cs = cosf(ang);
            ((f32x2*)(PWS + WS_ROPE))[e] = (f32x2){cs, sn}; }
        if (TID() < 64) ((unsigned*)(PWS + WS_CTR))[TID()] = 0u;
        for (int e = TID(); e < 2 * 32 * 64; e += NTHREADS) ((unsigned*)(PWS + WS_XCNT))[e] = 0u;
    }
}

__device__ __forceinline__ const float* xrow_ptr(const Params& p, int l, int row) {
    if (l == 0) return row < NTP ? PIN(0) + (size_t)row * DM : PIN(1) + (size_t)(row - NTP) * DM;
    return POUT + (size_t)row * DM;
}
__device__ void phaseA0(const Params& p, int l) {
    const int lane = TID() & 63, gw = blockIdx.x * 8 + (TID() >> 6), W = gridDim.x * 8;
    const float* g = PIN(9) + l * DM;
    bf16_t* H = (bf16_t*)(PWS + WS_H);
    for (int row = gw; row < NT; row += W) {
        const float* x = xrow_ptr(p, l, row);
        f32x4 v[4]; float ss = 0.f;
#pragma unroll
        for (int i = 0; i < 4; ++i) { v[i] = *(const f32x4*)(x + i * 256 + lane * 4); ss += v[i][0] * v[i][0] + v[i][1] * v[i][1] + v[i][2] * v[i][2] + v[i][3] * v[i][3]; }
        ss = wave_sum(ss);
        const float rs = rsqrtf(ss * (1.0f / 1024.0f) + 1e-6f);
        const float* mod = (const float*)(PWS + WS_MOD) + (size_t)(l * 5 + modrow_of(row)) * 3072;
#pragma unroll
        for (int i = 0; i < 4; ++i) { const int c = i * 256 + lane * 4;
            const f32x4 gg = *(const f32x4*)(g + c), sh = *(const f32x4*)(mod + c), scl = *(const f32x4*)(mod + 1024 + c);
            f32x4 h = v[i] * rs * gg * (1.0f + scl) + sh;
            u32x2 w; w[0] = cvt_pk_bf16(h[0], h[1]); w[1] = cvt_pk_bf16(h[2], h[3]);
            *(u32x2*)(H + (size_t)row * DM + c) = w; }
    }
}

template <int MT>
__device__ __forceinline__ void gemm_acc(const bf16_t* __restrict__ A, int lda, const bf16_t* __restrict__ B, int ldb, int K, f32x4 (&acc)[MT][4], unsigned char* lds) {
    constexpr int BM = MT * 64, LDT = 72, A_BYTES = BM * LDT * 2, B_BYTES = 128 * LDT * 2, BUF = A_BYTES + B_BYTES;
    const int tid = TID(), lane = tid & 63, wid = tid >> 6, wr = wid >> 1, wc = wid & 1, fr = lane & 15, fq = lane >> 4;
    u32x4 ra[MT], rb[2];
    const int srow = tid >> 3, skc = tid & 7;
    const bf16_t* Ag = A + (size_t)srow * lda + skc * 8;
    const bf16_t* Bg = B + (size_t)srow * ldb + skc * 8;
    const int soff = (srow * LDT + skc * 8) * 2;
    const int nt = K >> 6;
    __syncthreads();
#pragma unroll
    for (int i = 0; i < MT; ++i) ra[i] = *(const u32x4*)(Ag + (size_t)i * 64 * lda);
#pragma unroll
    for (int i = 0; i < 2; ++i) rb[i] = *(const u32x4*)(Bg + (size_t)i * 64 * ldb);
#pragma unroll
    for (int i = 0; i < MT; ++i) *(u32x4*)(lds + soff + i * 64 * LDT * 2) = ra[i];
#pragma unroll
    for (int i = 0; i < 2; ++i) *(u32x4*)(lds + A_BYTES + soff + i * 64 * LDT * 2) = rb[i];
    __syncthreads();
    const int aoff = ((wr * MT * 16 + fr) * LDT + fq * 8) * 2, boff = A_BYTES + ((wc * 64 + fr) * LDT + fq * 8) * 2;
    for (int t = 0; t < nt; ++t) {
        if (t + 1 < nt) {
#pragma unroll
            for (int i = 0; i < MT; ++i) ra[i] = *(const u32x4*)(Ag + (size_t)i * 64 * lda + (t + 1) * 64);
#pragma unroll
            for (int i = 0; i < 2; ++i) rb[i] = *(const u32x4*)(Bg + (size_t)i * 64 * ldb + (t + 1) * 64);
        }
        const unsigned char* base = lds + (t & 1) * BUF;
#pragma unroll
        for (int kk = 0; kk < 2; ++kk) {
            bf16x8 af[MT], bfr[4];
#pragma unroll
            for (int m = 0; m < MT; ++m) af[m] = *(const bf16x8*)(base + aoff + m * 16 * LDT * 2 + kk * 64);
#pragma unroll
            for (int n = 0; n < 4; ++n) bfr[n] = *(const bf16x8*)(base + boff + n * 16 * LDT * 2 + kk * 64);
#pragma unroll
            for (int m = 0; m < MT; ++m)
#pragma unroll
                for (int n = 0; n < 4; ++n) acc[m][n] = __builtin_amdgcn_mfma_f32_16x16x32_bf16(bfr[n], af[m], acc[m][n], 0, 0, 0);
        }
        if (t + 1 < nt) {
            unsigned char* nb = lds + ((t + 1) & 1) * BUF;
#pragma unroll
            for (int i = 0; i < MT; ++i) *(u32x4*)(nb + soff + i * 64 * LDT * 2) = ra[i];
#pragma unroll
            for (int i = 0; i < 2; ++i) *(u32x4*)(nb + A_BYTES + soff + i * 64 * LDT * 2) = rb[i];
        }
        __syncthreads();
    }
}
template <int MT> __device__ __forceinline__ void zero_acc(f32x4 (&acc)[MT][4]) {
#pragma unroll
    for (int m = 0; m < MT; ++m)
#pragma unroll
        for (int n = 0; n < 4; ++n) acc[m][n] = (f32x4){0.f, 0.f, 0.f, 0.f};
}

namespace pg8 {
#define PG8_LAS __attribute__((address_space(3)))
typedef unsigned short bf16_t;
typedef short bf16x8 __attribute__((ext_vector_type(8)));
typedef float f32x4 __attribute__((ext_vector_type(4)));
typedef unsigned u32x4 __attribute__((ext_vector_type(4)));
constexpr int BM = 256, BK = 64, HALF = 128, HTB = HALF * BK * 2  , STAGE_BYTES = 8 * HTB, NXCD = 8, WGM = 8;

__host__ __device__ __forceinline__ int lds_byte(int r, int c) { const int st = (r >> 4) * 2 + (c >> 5), rr = r & 15, cc = c & 31, ob = rr * 64 + cc * 2; return st * 1024 + (ob ^ (((ob >> 9) & 1) << 5)); }
__host__ __device__ __forceinline__ void stage_rc(int b, int& R, int& C) { const int st = b / 1024, sb = b % 1024, swz = sb ^ (((sb >> 9) & 1) << 5); R = (st >> 1) * 16 + swz / 64; C = (st & 1) * 32 + (swz % 64) / 2; }
__host__ __device__ __forceinline__ int perm32(int rho) { const int n = rho >> 4, i = rho & 15; return 8 * (i >> 2) + 4 * n + (i & 3); }

struct Unit { int pm, pn; };
struct Gemm { const bf16_t* A; const bf16_t* Bt; int M, N, K; };

struct StaticOrder {
    int nM, nN, nwg, G, c;
    __host__ __device__ void init(int M, int N, int G_, int c_) { nM = M / BM; nN = N / BM; nwg = nM * nN; G = G_; c = c_; }
    __host__ __device__ bool next(int i, Unit& u) const {
        const long L = (long)i * G + c; if (L >= nwg) return false;
        int wgid = (int)L; { const int q = nwg / NXCD, r = nwg % NXCD, xcd = wgid % NXCD, off = wgid / NXCD; wgid = (xcd < r ? xcd * (q + 1) : r * (q + 1) + (xcd - r) * q) + off; }
        const int nig = WGM * nN, gid = wgid / nig, fm = gid * WGM, gsz = (nM - fm) < WGM ? (nM - fm) : WGM;
        u.pm = fm + ((wgid % nig) % gsz); u.pn = (wgid % nig) / gsz; return true;
    }
    __device__ __forceinline__ void a_ready(const Unit&) const {}
    __device__ __forceinline__ void done(const Unit&) const {}
};
template <class Epi, class Sched, bool STAMP = false>
__device__ __forceinline__ void gemm_phase(PG8_LAS unsigned char* lds, const Gemm g, const Sched& S, const Epi& E, unsigned long long* stamps) {
    const int tid = ::TID(), wid = __builtin_amdgcn_readfirstlane(tid >> 6), lane = tid & 63, wr = wid >> 2, wc = wid & 3, fr = lane & 15, fq = lane >> 4;
    const int K = g.K, nt = K / BK;
    int ts_lo = 0, ts_hi = 0, nts = 0; const unsigned long long rt_entry = STAMP ? (unsigned long long)wall_clock64() : 0ull;
#define PG8_STAMP() do { if (STAMP && wid == 0 && nts < 64) { const unsigned long long _c = (unsigned long long)clock64(); \
        ts_lo = (lane == nts) ? (int)(unsigned)_c : ts_lo; ts_hi = (lane == nts) ? (int)(unsigned)(_c >> 32) : ts_hi; ++nts; } } while (0)
    PG8_STAMP();
    unsigned voffA[2], voffB[2];
#pragma unroll
    for (int i = 0; i < 2; ++i) { int R, C; stage_rc(tid * 16 + i * 8192, R, C); const int Rb = Epi::PERM ? ((R & ~31) + perm32(R & 31)) : R;
        voffA[i] = (unsigned)(R * K + C) * 2u; voffB[i] = (unsigned)(Rb * K + C) * 2u; }
    const size_t kstep = (size_t)(BK * 2);
    const size_t hstep = (size_t)HALF * K * 2;
    const size_t tstep = 2 * hstep;
    const unsigned ldsw = (unsigned)wid * 1024u;
    const int aoff = lds_byte(wr * 64 + fr, fq * 8), boff = lds_byte(wc * 32 + fr, fq * 8);
#define PG8_SA(b, h) (((b) * 2 + (h)) * HTB)
#define PG8_SB(b, h) ((4 + (b) * 2 + (h)) * HTB)
#define PG8_STAGE(bufoff, gbase, voff) do { _Pragma("unroll") for (int _i = 0; _i < 2; ++_i) \
        __builtin_amdgcn_global_load_lds((const unsigned*)((const char*)(gbase) + (voff)[_i]), (PG8_LAS unsigned*)(lds + (bufoff) + ldsw + _i * 8192), 16, 0, 0); } while (0)
#define PG8_LDA(dst, b, h) do { _Pragma("unroll") for (int m = 0; m < 4; ++m) _Pragma("unroll") for (int k = 0; k < 2; ++k) dst[m][k] = *(const PG8_LAS bf16x8*)(lds + PG8_SA(b, h) + aoff + m * 2048 + k * 1024); } while (0)
#define PG8_LDB(dst, b, h) do { _Pragma("unroll") for (int n = 0; n < 2; ++n) _Pragma("unroll") for (int k = 0; k < 2; ++k) dst[n][k] = *(const PG8_LAS bf16x8*)(lds + PG8_SB(b, h) + boff + n * 2048 + k * 1024); } while (0)
#define PG8_MMA(ai, bj, At, Bt) do { __builtin_amdgcn_s_setprio(1); _Pragma("unroll") for (int m = 0; m < 4; ++m) _Pragma("unroll") for (int n = 0; n < 2; ++n) _Pragma("unroll") for (int k = 0; k < 2; ++k) \
        acc[ai][bj][m][n] = __builtin_amdgcn_mfma_f32_16x16x32_bf16(Bt[n][k], At[m][k], acc[ai][bj][m][n], 0, 0, 0); __builtin_amdgcn_s_setprio(0); } while (0)
#define PG8_WAIT_V(n) asm volatile("s_waitcnt vmcnt(" #n ")" ::: "memory")
#define PG8_WAIT_L(n) asm volatile("s_waitcnt lgkmcnt(" #n ")" ::: "memory")
#define PG8_BAR __builtin_amdgcn_s_barrier()
#define PG8_SCHED __builtin_amdgcn_sched_barrier(0)
    Unit cur, nxt; int ui = 0;
    if (!S.next(0, cur)) return;
    f32x4 acc[2][2][4][2];
#pragma unroll
    for (int a = 0; a < 2; ++a)
#pragma unroll
        for (int b = 0; b < 2; ++b)
#pragma unroll
            for (int m = 0; m < 4; ++m)
#pragma unroll
                for (int n = 0; n < 2; ++n) acc[a][b][m][n] = (f32x4){0.f, 0.f, 0.f, 0.f};
    bf16x8 At[4][2], B0[2][2], B1[2][2];
    const char* cA = (const char*)g.A + (size_t)cur.pm * tstep; const char* cB = (const char*)g.Bt + (size_t)cur.pn * tstep;
    S.a_ready(cur);
    PG8_STAGE(PG8_SB(0, 0), cB, voffB); PG8_STAGE(PG8_SA(0, 0), cA, voffA); PG8_STAGE(PG8_SB(0, 1), cB + hstep, voffB); PG8_STAGE(PG8_SA(0, 1), cA + hstep, voffA);
    if (wr == 1) PG8_BAR;
    PG8_WAIT_V(4); PG8_BAR;
    PG8_STAGE(PG8_SB(1, 0), cB + kstep, voffB); PG8_STAGE(PG8_SA(1, 0), cA + kstep, voffA); PG8_STAGE(PG8_SB(1, 1), cB + hstep + kstep, voffB);
    PG8_WAIT_V(6); PG8_BAR;
    PG8_STAMP();
    for (;;) {
        const bool has_next = S.next(ui + 1, nxt);
        const char* nA = has_next ? (const char*)g.A + (size_t)nxt.pm * tstep : cA; const char* nB = has_next ? (const char*)g.Bt + (size_t)nxt.pn * tstep : cB;
        for (int t = 0; t < nt; t += 2) {
            const bool last = (t == nt - 2);
            const char* a1 = cA + (size_t)(t + 1) * kstep;
            const char* a2 = last ? nA : cA + (size_t)(t + 2) * kstep; const char* b2 = last ? nB : cB + (size_t)(t + 2) * kstep;
            const char* a3 = a2 + kstep; const char* b3 = b2 + kstep;
            if (last && has_next) S.a_ready(nxt);
            PG8_LDB(B0, 0, 0); PG8_SCHED; PG8_LDA(At, 0, 0); PG8_STAGE(PG8_SA(1, 1), a1 + hstep, voffA);
            PG8_WAIT_L(8); PG8_BAR; PG8_WAIT_L(0); PG8_MMA(0, 0, At, B0); PG8_BAR; PG8_SCHED;
            PG8_LDB(B1, 0, 1); PG8_STAGE(PG8_SB(0, 0), b2, voffB);
            PG8_BAR; PG8_WAIT_L(0); PG8_MMA(0, 1, At, B1); PG8_BAR;
            PG8_LDA(At, 0, 1); PG8_STAGE(PG8_SA(0, 0), a2, voffA);
            PG8_BAR; PG8_WAIT_L(0); PG8_MMA(1, 0, At, B0); PG8_BAR; PG8_SCHED;
            PG8_STAGE(PG8_SB(0, 1), b2 + hstep, voffB);
            PG8_WAIT_V(6); PG8_BAR; PG8_MMA(1, 1, At, B1); PG8_BAR;
            PG8_LDB(B0, 1, 0); PG8_SCHED; PG8_LDA(At, 1, 0); PG8_STAGE(PG8_SA(0, 1), a2 + hstep, voffA);
            PG8_WAIT_L(8); PG8_BAR; PG8_WAIT_L(0); PG8_MMA(0, 0, At, B0); PG8_BAR; PG8_SCHED;
            PG8_LDB(B1, 1, 1); PG8_STAGE(PG8_SB(1, 0), b3, voffB);
            PG8_BAR; PG8_WAIT_L(0); PG8_MMA(0, 1, At, B1); PG8_BAR;
            PG8_LDA(At, 1, 1); PG8_STAGE(PG8_SA(1, 0), a3, voffA);
            PG8_BAR; PG8_WAIT_L(0); PG8_MMA(1, 0, At, B0); PG8_BAR; PG8_SCHED;
            PG8_STAGE(PG8_SB(1, 1), b3 + hstep, voffB);
            PG8_WAIT_V(6); PG8_BAR; PG8_MMA(1, 1, At, B1); PG8_BAR;
        }
        PG8_STAMP();
        if constexpr (!Epi::AFTER_DRAIN) { E(acc, cur, wr, wc, fr, fq); S.done(cur); }
        PG8_STAMP();
        if (!has_next) break;
#pragma unroll
        for (int a = 0; a < 2; ++a)
#pragma unroll
            for (int b = 0; b < 2; ++b)
#pragma unroll
                for (int m = 0; m < 4; ++m)
#pragma unroll
                    for (int n = 0; n < 2; ++n) acc[a][b][m][n] = (f32x4){0.f, 0.f, 0.f, 0.f};
        cur = nxt; cA = nA; cB = nB; ++ui;
    }
    PG8_WAIT_V(0);
    if (wr == 0) PG8_BAR;
    PG8_BAR;
    if constexpr (Epi::AFTER_DRAIN) { E.fused(acc, cur, wr, wc, fr, fq, lds, wid, lane); S.done(cur); }
    PG8_STAMP();
    if (STAMP && wid == 0) { stamps[lane] = lane < nts ? (((unsigned long long)(unsigned)ts_hi << 32) | (unsigned)ts_lo) : 0ull;
        if (lane == 62) stamps[62] = rt_entry; if (lane == 63) stamps[63] = (unsigned long long)wall_clock64(); }
#undef PG8_STAMP
#undef PG8_SA
#undef PG8_SB
#undef PG8_STAGE
#undef PG8_LDA
#undef PG8_LDB
#undef PG8_MMA
#undef PG8_WAIT_V
#undef PG8_WAIT_L
#undef PG8_BAR
#undef PG8_SCHED
}
}

struct EpiA {
    static constexpr bool PERM = false, AFTER_DRAIN = false;
    float* P; bf16_t* Z; float* out; int l, cbase;
    __device__ __forceinline__ void operator()(const pg8::f32x4 (&acc)[2][2][4][2], const pg8::Unit& u, int wr, int wc, int fr, int fq) const {
#pragma unroll
        for (int ai = 0; ai < 2; ++ai)
#pragma unroll
            for (int m = 0; m < 4; ++m) { const int row = u.pm * 256 + ai * 128 + wr * 64 + m * 16 + fr;
#pragma unroll
                for (int bj = 0; bj < 2; ++bj)
#pragma unroll
                    for (int n = 0; n < 2; ++n) { const int col = cbase + u.pn * 256 + bj * 128 + wc * 32 + n * 16 + fq * 4; const f32x4 v = acc[ai][bj][m][n];
                        if (col < PW) { *(f32x4*)(P + (size_t)row * PW + col) = v;
                            if (col >= C_CK && col < C_DP && row < NTP) { const int b = row >> 8, s_ = row & 255; const bool isk = col < C_CV;
                                *(f32x4*)(out + (isk ? O_NK : O_NV) + ((size_t)((b * 2 + l) * 256 + s_)) * 128 + (col - (isk ? C_CK : C_CV))) = v; } }
                        else if (col < NA_COLS) { u32x2 w; w[0] = cvt_pk_bf16(siluf_(v[0]), siluf_(v[1])); w[1] = cvt_pk_bf16(siluf_(v[2]), siluf_(v[3])); *(u32x2*)(Z + (size_t)row * DM + (col - PW)) = w; } } }
    }
};
__device__ __forceinline__ size_t g_off(int row, int cg) {
    const int n = cg >> 10, c = cg & 1023;
    const int pm = row >> 8, wr2 = (row >> 6) & 3, m = (row >> 4) & 3, fr = row & 15;
    const int pn = c >> 7, wc2 = (c >> 6) & 1, q = (c >> 4) & 3, fq2 = (c >> 2) & 3;
    size_t o = (size_t)(n * 32 + pm); o = o * 8 + pn; o = o * 4 + wr2; o = o * 2 + wc2; o = o * 4 + m; o = o * 16 + fr; o = o * 4 + fq2; o = o * 16 + q * 4;
    return o;
}
struct EpiG {
    static constexpr bool PERM = true, AFTER_DRAIN = false;
    bf16_t* G;
    __device__ __forceinline__ void operator()(const pg8::f32x4 (&acc)[2][2][4][2], const pg8::Unit& u, int wr, int wc, int fr, int fq) const {
#pragma unroll
        for (int ai = 0; ai < 2; ++ai)
#pragma unroll
            for (int m = 0; m < 4; ++m) { const int row = u.pm * 256 + ai * 128 + wr * 64 + m * 16 + fr;
#pragma unroll
                for (int bj = 0; bj < 2; ++bj) { const int col = u.pn * 256 + bj * 128 + wc * 32 + 8 * fq; const f32x4 v0 = acc[ai][bj][m][0], v1 = acc[ai][bj][m][1];
                    u32x4 w; w[0] = cvt_pk_bf16(sigmoidf_(v0[0]), sigmoidf_(v0[1])); w[1] = cvt_pk_bf16(sigmoidf_(v0[2]), sigmoidf_(v0[3]));
                    w[2] = cvt_pk_bf16(sigmoidf_(v1[0]), sigmoidf_(v1[1])); w[3] = cvt_pk_bf16(sigmoidf_(v1[2]), sigmoidf_(v1[3]));
                    u32x2 wa, wb; wa[0] = w[0]; wa[1] = w[1]; wb[0] = w[2]; wb[1] = w[3];
                    *(u32x2*)(G + g_off(row, col)) = wa; *(u32x2*)(G + g_off(row, col + 4)) = wb; } }
    }
};

__device__ void phaseA(const Params& p, int l, unsigned char* lds, int part) {
    const int G = part ? ((int)gridDim.x < 160 ? (int)gridDim.x : 160) : (int)gridDim.x;
    if ((int)blockIdx.x < G) {
        pg8::Gemm g; g.A = (const bf16_t*)(PWS + WS_H); g.Bt = (const bf16_t*)(PWS + WS_WTIN) + (size_t)l * INW * 1024 + (size_t)(part ? 2048 : 0) * 1024; g.M = NT; g.N = part ? 5 * 256 : 8 * 256; g.K = 1024;
        pg8::StaticOrder S; S.init(g.M, g.N, G, (int)blockIdx.x);
        EpiA E; E.P = (float*)(PWS + WS_P); E.Z = (bf16_t*)(PWS + WS_Z); E.out = POUT; E.l = l; E.cbase = part ? 2048 : 0;
        pg8::gemm_phase<EpiA, pg8::StaticOrder, false>((PG8_LAS unsigned char*)lds, g, S, E, nullptr);
    }
    __syncthreads();
}

__device__ void phaseB0(const Params& p, int l, unsigned char* ldsb) {
    const int tid = TID(), lane = tid & 63, wid = tid >> 6, fr = lane & 15, fq = lane >> 4;
    const int h = wid >> 1, mt = wid & 1;
    bf16_t* Awd = (bf16_t*)ldsb;
    bf16_t* Aad = Awd + 32 * 72;
    const float* P = (const float*)(PWS + WS_P);
    float* recS = (float*)(PWS + WS_RECS);
    float* recD = (float*)(PWS + WS_RECD);
    float* BC = (float*)(PWS + WS_BC);
    const bf16_t* LT = (const bf16_t*)(PWS + WS_LORAT) + (size_t)l * 4 * 256 * 64;
    const float* pkk = PIN(17) + l * 256; const float* pka = PIN(18) + l * 256; const float* prk = PIN(19) + l * 256;
    const float* pw0 = PIN(13) + l * 512; const float* pa0 = PIN(15) + l * 512;
    __shared__ int s_b0;
    unsigned* ctr0 = (unsigned*)(PWS + WS_CTR) + 4 + l;
    for (;;) {
        if (tid == 0) s_b0 = (int)atomicAdd(ctr0, 1u);
        __syncthreads();
        const int it = s_b0;
        __syncthreads();
        if (it >= NT / 32) break;
        const int tb = it * 32;
        __syncthreads();
#pragma unroll
        for (int i = 0; i < 8; ++i) { const int idx = tid + i * 512, tk = idx >> 7, j = idx & 127; const float v = P[(size_t)(tb + tk) * PW + C_WD + j];
            if (j < 64) Awd[tk * 72 + j] = f2bf(1.0f - 2.0f / (1.0f + __expf(2.0f * v))); else Aad[tk * 72 + j - 64] = f2bf(v); }
        __syncthreads();
        f32x4 acc[4][4];
#pragma unroll
        for (int m = 0; m < 4; ++m)
#pragma unroll
            for (int n = 0; n < 4; ++n) acc[m][n] = (f32x4){0.f, 0.f, 0.f, 0.f};
#pragma unroll
        for (int ks = 0; ks < 2; ++ks) {
            const bf16x8 awf = *(const bf16x8*)(Awd + (mt * 16 + fr) * 72 + ks * 32 + fq * 8), aaf = *(const bf16x8*)(Aad + (mt * 16 + fr) * 72 + ks * 32 + fq * 8);
#pragma unroll
            for (int n = 0; n < 4; ++n) { const int cb = h * 64 + n * 16 + fr;
#pragma unroll
                for (int m = 0; m < 4; ++m) { const bf16x8 bfr = *(const bf16x8*)(LT + ((size_t)m * 256 + cb) * 64 + ks * 32 + fq * 8);
                    acc[m][n] = __builtin_amdgcn_mfma_f32_16x16x32_bf16(bfr, m < 2 ? awf : aaf, acc[m][n], 0, 0, 0); } }
        }
        const int tok = tb + mt * 16 + fr; int seqbase, L, pos; seq_of(tok, seqbase, L, pos);
        const float* pr = P + (size_t)tok * PW;
        const size_t ridx = ((size_t)seqbase * 4 + (size_t)h * L + pos) * 192;
        f32x4 k4[4], kk4[4]; float ss = 0.f;
#pragma unroll
        for (int n = 0; n < 4; ++n) { const int c4 = h * 64 + n * 16 + fq * 4;
            k4[n] = *(const f32x4*)(pr + C_BK + c4); kk4[n] = k4[n] * *(const f32x4*)(pkk + c4);
            ss += (kk4[n][0] * kk4[n][0] + kk4[n][1] * kk4[n][1]) + (kk4[n][2] * kk4[n][2] + kk4[n][3] * kk4[n][3]); }
        ss += __shfl_xor(ss, 16); ss += __shfl_xor(ss, 32);
        const float rn = rsqrtf(ss + 1e-12f);
        float bsum = 0.f;
#pragma unroll
        for (int n = 0; n < 4; ++n) { const int c4 = h * 64 + n * 16 + fq * 4, j4 = n * 16 + fq * 4;
            const f32x4 r4 = *(const f32x4*)(pr + C_BR + c4), v4 = *(const f32x4*)(pr + C_BV + c4);
            const f32x4 kk = kk4[n] * rn, ka4 = *(const f32x4*)(pka + c4), rk4 = *(const f32x4*)(prk + c4);
            *(f32x4*)(recS + ridx + j4) = r4; *(f32x4*)(recS + ridx + 64 + j4) = kk; *(f32x4*)(recS + ridx + 128 + j4) = v4;
#pragma unroll
            for (int d = 0; d < 2; ++d) {
                const f32x4 w0 = *(const f32x4*)(pw0 + d * 256 + c4), a0 = *(const f32x4*)(pa0 + d * 256 + c4);
                f32x4 dec, nka, kd;
#pragma unroll
                for (int j = 0; j < 4; ++j) {
                    const float wl = w0[j] + acc[d][n][j];
                    dec[j] = __expf(-0.6065306597126334f / (1.0f + __expf(-wl)));
                    const float a = 1.0f / (1.0f + __expf(-(a0[j] + acc[2 + d][n][j])));
                    kd[j] = k4[n][j] * (1.0f + (a - 1.0f) * ka4[j]); nka[j] = -(kk[j] * a);
                    bsum += r4[j] * kd[j] * rk4[j]; }
                float* rd = recD + (size_t)d * RECD_STRIDE + ridx + j4;
                *(f32x4*)(rd) = dec; *(f32x4*)(rd + 64) = nka; *(f32x4*)(rd + 128) = kd;
            }
        }
        bsum += __shfl_xor(bsum, 16); bsum += __shfl_xor(bsum, 32);
        if (fq == 0) BC[tok * 4 + h] = bsum;
    }
}

template <int NS>
__device__ __forceinline__ void scan_run(const Params& p, int l, bool sample, int b, int h, int dir, int rg, int L, int seqbase, float* wl) {
    const int lane = TID() & 63, rl = lane >> 4, kl = lane & 15;
    int row[NS]; f32x4 S[NS]; size_t sidx[NS];
#pragma unroll
    for (int q = 0; q < NS; ++q) { row[q] = (rg * NS + q) * 4 + rl;
        sidx[q] = ((size_t)(((b * 2 + l) * 2 + dir) * 4 + h)) * 4096 + row[q] * 64 + kl * 4;
        if (sample) S[q] = *(const f32x4*)(PIN(4) + sidx[q]); else S[q] = (f32x4){0.f, 0.f, 0.f, 0.f}; }
    const float* gS = (const float*)(PWS + WS_RECS) + ((size_t)seqbase * 4 + (size_t)h * L) * 192 + lane * 4;
    const float* gD = (const float*)(PWS + WS_RECD) + (size_t)dir * RECD_STRIDE + ((size_t)seqbase * 4 + (size_t)h * L) * 192 + lane * 4;
    float* O = (float*)(PWS + WS_O) + (size_t)dir * NT * 256 + (size_t)seqbase * 256 + h * 64;
    const int nch = L >> 2;
    f32x4 rA[6], rB[6];
    auto gl = [&](f32x4 (&r)[6], int c) {
        c = c < nch ? c : nch - 1;
        const int pos0 = dir ? (L - 4 * (c + 1)) : 4 * c;
        const float* s_ = gS + (size_t)pos0 * 192; const float* d_ = gD + (size_t)pos0 * 192;
#pragma unroll
        for (int i = 0; i < 3; ++i) { r[i] = *(const f32x4*)(s_ + i * 256); r[3 + i] = *(const f32x4*)(d_ + i * 256); }
    };
    auto st = [&](const f32x4 (&r)[6], float* buf) {
#pragma unroll
        for (int i = 0; i < 3; ++i) { *(f32x4*)(buf + i * 256 + lane * 4) = r[i]; *(f32x4*)(buf + 768 + i * 256 + lane * 4) = r[3 + i]; }
    };
    struct Ops { f32x4 r, kk, w, ka, kd; float v[NS]; };
    auto ldsread = [&](const float* buf, int s) -> Ops {
        const int tc = dir ? 3 - s : s;
        const float* bs = buf + tc * 192; const float* bd = buf + 768 + tc * 192;
        Ops o; o.r = *(const f32x4*)(bs + kl * 4); o.kk = *(const f32x4*)(bs + 64 + kl * 4);
        o.w = *(const f32x4*)(bd + kl * 4); o.ka = *(const f32x4*)(bd + 64 + kl * 4); o.kd = *(const f32x4*)(bd + 128 + kl * 4);
#pragma unroll
        for (int q = 0; q < NS; ++q) o.v[q] = bs[128 + row[q]];
        return o;
    };
    float opart[NS];
#pragma unroll
    for (int q = 0; q < NS; ++q) opart[q] = 0.f;
    auto chunk = [&](const float* cur, const float* nxtbuf, Ops& ops, int c) {
        float oval[NS];
#pragma unroll
        for (int q = 0; q < NS; ++q) oval[q] = 0.f;
#pragma unroll
        for (int s = 0; s < 4; ++s) {
            const Ops nx = (s < 3) ? ldsread(cur, s + 1) : ldsread(nxtbuf, 0);
            __builtin_amdgcn_sched_barrier(0);
            float sa[NS], opr[NS]; f32x2 ta[NS], tb[NS];
            const f32x2 kka = __builtin_shufflevector(ops.kk, ops.kk, 0, 1), kkb = __builtin_shufflevector(ops.kk, ops.kk, 2, 3);
            const f32x2 wa = __builtin_shufflevector(ops.w, ops.w, 0, 1), wb = __builtin_shufflevector(ops.w, ops.w, 2, 3);
            const f32x2 na = __builtin_shufflevector(ops.ka, ops.ka, 0, 1), nb = __builtin_shufflevector(ops.ka, ops.ka, 2, 3);
            const f32x2 da = __builtin_shufflevector(ops.kd, ops.kd, 0, 1), db = __builtin_shufflevector(ops.kd, ops.kd, 2, 3);
            const f32x2 ra = __builtin_shufflevector(ops.r, ops.r, 0, 1), rb = __builtin_shufflevector(ops.r, ops.r, 2, 3);
#pragma unroll
            for (int q = 0; q < NS; ++q) { const f32x2 Sa = __builtin_shufflevector(S[q], S[q], 0, 1), Sb = __builtin_shufflevector(S[q], S[q], 2, 3);
                f32x2 pp = Sa * kka; pp = Sb * kkb + pp; sa[q] = pp[0] + pp[1];
                const f32x2 v2 = (f32x2){ops.v[q], ops.v[q]};
                ta[q] = Sa * wa + v2 * da; tb[q] = Sb * wb + v2 * db; }
#pragma unroll
            for (int q = 0; q < NS; ++q) { sa[q] = row16_sum(sa[q]); opr[q] = row16_sum(opart[q]); oval[q] = (kl == s) ? opr[q] : oval[q]; }
#pragma unroll
            for (int q = 0; q < NS; ++q) { const f32x2 s2 = (f32x2){sa[q], sa[q]};
                const f32x2 Sa = s2 * na + ta[q], Sb = s2 * nb + tb[q];
                f32x2 qq = Sa * ra; qq = Sb * rb + qq; opart[q] = qq[0] + qq[1];
                S[q] = (f32x4){Sa[0], Sa[1], Sb[0], Sb[1]}; }
            ops = nx;
        }
        const int stp = 4 * c - 1 + (kl & 3);
        const int pos = dir ? (L - 1 - stp) : stp;
#pragma unroll
        for (int q = 0; q < NS; ++q) { if (kl < 4 && stp >= 0) O[(size_t)pos * 256 + row[q]] = oval[q]; }
    };
    float* buf0 = wl; float* buf1 = wl + 1536;
    gl(rA, 0); gl(rB, 1);
    st(rA, buf0); gl(rA, 2);
    __builtin_amdgcn_wave_barrier();
    Ops ops = ldsread(buf0, 0);
    for (int c = 0; c < nch; c += 2) {
        st(rB, buf1); gl(rB, c + 3);
        __builtin_amdgcn_wave_barrier();
        chunk(buf0, buf1, ops, c);
        st(rA, buf0); gl(rA, c + 4);
        __builtin_amdgcn_wave_barrier();
        chunk(buf1, buf0, ops, c + 1);
    }
#pragma unroll
    for (int q = 0; q < NS; ++q) { const float ol = row16_sum(opart[q]); if (kl == 0) O[(size_t)(dir ? 0 : L - 1) * 256 + row[q]] = ol; }
    if (!sample) {
#pragma unroll
        for (int q = 0; q < NS; ++q) *(f32x4*)(POUT + O_NS + sidx[q]) = S[q];
    }
}

__device__ __forceinline__ void stage_qk(const float* __restrict__ src, int stride, bf16_t* dst, bool rope, int pos0, float scale, const f32x2* __restrict__ rt) {
    const int tid = TID();
#pragma unroll
    for (int i = 0; i < 2; ++i) {
        const int task = tid + i * 512, row = task >> 3, half = (task >> 2) & 1, quad = task & 3;
        const float* s = src + (size_t)row * stride + half * 32 + quad * 4;
        f32x4 x1 = *(const f32x4*)s, x2 = *(const f32x4*)(s + 16);
        if (rope) { const int pos = pos0 + row; const int pi = half ? (pos & 63) : (pos >> 6);
#pragma unroll
            for (int j = 0; j < 4; ++j) { const f32x2 cs = rt[pi * 16 + quad * 4 + j]; const float a = x1[j], b = x2[j]; x1[j] = a * cs[0] - b * cs[1]; x2[j] = b * cs[0] + a * cs[1]; } }
        x1 *= scale; x2 *= scale;
        u32x2 w1, w2; w1[0] = cvt_pk_bf16(x1[0], x1[1]); w1[1] = cvt_pk_bf16(x1[2], x1[3]); w2[0] = cvt_pk_bf16(x2[0], x2[1]); w2[1] = cvt_pk_bf16(x2[2], x2[3]);
        *(u32x2*)(dst + row * 72 + half * 32 + quad * 4) = w1; *(u32x2*)(dst + row * 72 + half * 32 + 16 + quad * 4) = w2;
    }
}
__device__ __forceinline__ void stage_vt(const float* __restrict__ src, int stride, bf16_t* vt, int nkeys = 128, int pitch = 136) {
    const int tid = TID();
    for (int task = tid; task < nkeys * 16; task += 512) { const int key = task >> 4, dq = task & 15;
        const f32x4 v = *(const f32x4*)(src + (size_t)key * stride + dq * 4);
#pragma unroll
        for (int j = 0; j < 4; ++j) vt[(dq * 4 + j) * pitch + key] = f2bf(v[j]); }
}
__device__ void attn_item(const Params& p, int l, int ai, unsigned char* lds) {
    const int tid = TID(), lane = tid & 63, wid = tid >> 6, fr = lane & 15, fq = lane >> 4;
    bf16_t* Qs = (bf16_t*)lds; bf16_t* Ks = Qs + 128 * 72; bf16_t* Vt = Ks + 128 * 72;
    const float* P = (const float*)(PWS + WS_P);
    const bf16_t* Z = (const bf16_t*)(PWS + WS_Z);
    bf16_t* YS = (bf16_t*)(PWS + WS_YS);
    const f32x2* rt = (const f32x2*)(PWS + WS_ROPE);
    bool sample; int b, head, qt, seqbase;
    if (ai < 128) { sample = true; b = ai >> 5; head = (ai >> 3) & 3; qt = ai & 7; seqbase = NTP + b * 1024; }
    else { const int j = ai - 128; sample = false; b = j >> 3; head = (j >> 1) & 3; qt = j & 1; seqbase = b * 256; }
    const int kh = head >> 1, qbase = seqbase + qt * 128;
    __syncthreads();
    stage_qk(P + (size_t)qbase * PW + C_CQ + head * 64, PW, Qs, sample, qt * 128, 0.125f, rt);
    __syncthreads();
    bf16x8 qf[2];
    qf[0] = *(const bf16x8*)(Qs + (wid * 16 + fr) * 72 + fq * 8); qf[1] = *(const bf16x8*)(Qs + (wid * 16 + fr) * 72 + 32 + fq * 8);
    float m = PIN(22)[l * 4 + head], lsum = 1.0f, lpart = 0.f;
    f32x4 oacc[4];
#pragma unroll
    for (int i = 0; i < 4; ++i) oacc[i] = (f32x4){0.f, 0.f, 0.f, 0.f};
    const int nkb = sample ? 7 : 2;
    const int qpos = qt * 128 + wid * 16 + fr;
    const float* ck = PIN(2); const float* cv = PIN(3);
    auto kinfo = [&](int kb, const float*& ks, const float*& vs, int& stride, bool& rope, bool& mask, int& kpos0) -> bool {
        if (!sample) { ks = P + (size_t)(seqbase + kb * 128) * PW + C_CK + kh * 64; vs = ks + (C_CV - C_CK); stride = PW; rope = false; mask = false; kpos0 = 0; return true; }
        if (kb < 3) { const int nbk = qt - 1 + kb; if (nbk < 0 || nbk >= 8) return false; kpos0 = nbk * 128;
            ks = P + (size_t)(seqbase + kpos0) * PW + C_CK + kh * 64; vs = ks + (C_CV - C_CK); stride = PW; rope = true; mask = (kb != 1); return true; }
        const size_t o = ((size_t)((b * 2 + l) * 512 + (kb - 3) * 128) * 2 + kh) * 64; ks = ck + o; vs = cv + o; stride = 128; rope = false; mask = false; kpos0 = 0; return true;
    };
    f32x4 kx1[2], kx2[2], vx[2][2];
    auto kload = [&](const float* ks, const float* vs, int stride) {
#pragma unroll
        for (int i = 0; i < 2; ++i) { const int task = tid + i * 512, row = task >> 3, half = (task >> 2) & 1, quad = task & 3;
            const float* s_ = ks + (size_t)row * stride + half * 32 + quad * 4; kx1[i] = *(const f32x4*)s_; kx2[i] = *(const f32x4*)(s_ + 16); }
#pragma unroll
        for (int i = 0; i < 2; ++i) { const int task = tid + i * 512, kp = task >> 4, dq = task & 15;
            vx[i][0] = *(const f32x4*)(vs + (size_t)(2 * kp) * stride + dq * 4); vx[i][1] = *(const f32x4*)(vs + (size_t)(2 * kp + 1) * stride + dq * 4); }
    };
    auto kstore = [&](bool rope, int kpos0) {
#pragma unroll
        for (int i = 0; i < 2; ++i) { const int task = tid + i * 512, row = task >> 3, half = (task >> 2) & 1, quad = task & 3;
            f32x4 x1 = kx1[i], x2 = kx2[i];
            if (rope) { const int pos = kpos0 + row; const int pi = half ? (pos & 63) : (pos >> 6);
#pragma unroll
                for (int j = 0; j < 4; ++j) { const f32x2 cs = rt[pi * 16 + quad * 4 + j]; const float a_ = x1[j], b_ = x2[j]; x1[j] = a_ * cs[0] - b_ * cs[1]; x2[j] = b_ * cs[0] + a_ * cs[1]; } }
            u32x2 w1, w2; w1[0] = cvt_pk_bf16(x1[0], x1[1]); w1[1] = cvt_pk_bf16(x1[2], x1[3]); w2[0] = cvt_pk_bf16(x2[0], x2[1]); w2[1] = cvt_pk_bf16(x2[2], x2[3]);
            *(u32x2*)(Ks + row * 72 + half * 32 + quad * 4) = w1; *(u32x2*)(Ks + row * 72 + half * 32 + 16 + quad * 4) = w2; }
#pragma unroll
        for (int i = 0; i < 2; ++i) { const int task = tid + i * 512, kp = task >> 4, dq = task & 15;
#pragma unroll
            for (int j = 0; j < 4; ++j) *(unsigned*)(Vt + (dq * 4 + j) * 136 + 2 * kp) = cvt_pk_bf16(vx[i][0][j], vx[i][1][j]); }
    };
    const float* ksrc = nullptr; const float* vsrc = nullptr; int stride = 0, kpos0n = 0; bool ropen = false, maskn = false;
    int kb = 0;
    while (kb < nkb && !kinfo(kb, ksrc, vsrc, stride, ropen, maskn, kpos0n)) ++kb;
    if (kb < nkb) kload(ksrc, vsrc, stride);
    while (kb < nkb) {
        const bool mask = maskn; const int kpos0 = kpos0n; const bool rope = ropen;
        __syncthreads();
        kstore(rope, kpos0);
        __syncthreads();
        int nk = kb + 1;
        while (nk < nkb && !kinfo(nk, ksrc, vsrc, stride, ropen, maskn, kpos0n)) ++nk;
        if (nk < nkb) kload(ksrc, vsrc, stride);
        kb = nk;
        f32x4 sc[4][2];
#pragma unroll
        for (int sb = 0; sb < 4; ++sb) {
            f32x4 s0 = (f32x4){0.f, 0.f, 0.f, 0.f}, s1 = s0;
#pragma unroll
            for (int dh = 0; dh < 2; ++dh) {
                const bf16x8 k0 = *(const bf16x8*)(Ks + (sb * 32 + fr) * 72 + dh * 32 + fq * 8), k1 = *(const bf16x8*)(Ks + (sb * 32 + 16 + fr) * 72 + dh * 32 + fq * 8);
                s0 = __builtin_amdgcn_mfma_f32_16x16x32_bf16(k0, qf[dh], s0, 0, 0, 0);
                s1 = __builtin_amdgcn_mfma_f32_16x16x32_bf16(k1, qf[dh], s1, 0, 0, 0);
            }
            if (mask) {
#pragma unroll
                for (int j = 0; j < 4; ++j) { const int k0p = kpos0 + sb * 32 + fq * 4 + j, k1p = k0p + 16; int d0 = qpos - k0p, d1 = qpos - k1p; d0 = d0 < 0 ? -d0 : d0; d1 = d1 < 0 ? -d1 : d1;
                    if (d0 > 128) s0[j] = -1e30f; if (d1 > 128) s1[j] = -1e30f; }
            }
            sc[sb][0] = s0; sc[sb][1] = s1;
        }
        float mx = -1e30f;
#pragma unroll
        for (int sb = 0; sb < 4; ++sb)
#pragma unroll
            for (int j = 0; j < 4; ++j) mx = fmaxf(mx, fmaxf(sc[sb][0][j], sc[sb][1][j]));
        mx = fmaxf(mx, __shfl_xor(mx, 16)); mx = fmaxf(mx, __shfl_xor(mx, 32));
        const float mn = fmaxf(m, mx), alpha = __expf(m - mn);
        m = mn; lsum *= alpha; lpart *= alpha;
#pragma unroll
        for (int dt = 0; dt < 4; ++dt) oacc[dt] = oacc[dt] * alpha;
#pragma unroll
        for (int sb = 0; sb < 4; ++sb) {
            f32x4 s0 = sc[sb][0], s1 = sc[sb][1];
#pragma unroll
            for (int j = 0; j < 4; ++j) { s0[j] = __expf(s0[j] - mn); s1[j] = __expf(s1[j] - mn); lpart += s0[j] + s1[j]; }
            u32x4 pw; pw[0] = cvt_pk_bf16(s0[0], s0[1]); pw[1] = cvt_pk_bf16(s0[2], s0[3]); pw[2] = cvt_pk_bf16(s1[0], s1[1]); pw[3] = cvt_pk_bf16(s1[2], s1[3]);
            bf16x8 pf; __builtin_memcpy(&pf, &pw, 16);
#pragma unroll
            for (int dt = 0; dt < 4; ++dt) {
                const bf16_t* vp = Vt + (dt * 16 + fr) * 136 + sb * 32 + fq * 4;
                u32x4 vw; const u32x2 va = *(const u32x2*)vp, vb = *(const u32x2*)(vp + 16); vw[0] = va[0]; vw[1] = va[1]; vw[2] = vb[0]; vw[3] = vb[1];
                bf16x8 vf; __builtin_memcpy(&vf, &vw, 16);
                oacc[dt] = __builtin_amdgcn_mfma_f32_16x16x32_bf16(vf, pf, oacc[dt], 0, 0, 0);
            }
        }
    }
    lpart += __shfl_xor(lpart, 16); lpart += __shfl_xor(lpart, 32);
    lsum += lpart;
    const float inv = 1.0f / lsum;
    const size_t t = (size_t)(qbase + wid * 16 + fr);
#pragma unroll
    for (int dt = 0; dt < 4; ++dt) {
        const int col = 512 + head * 64 + dt * 16 + fq * 4;
        const bf16x4 z = *(const bf16x4*)(Z + t * DM + col);
        u32x2 w; w[0] = cvt_pk_bf16(oacc[dt][0] * inv * bf2f((bf16_t)z[0]), oacc[dt][1] * inv * bf2f((bf16_t)z[1]));
        w[1] = cvt_pk_bf16(oacc[dt][2] * inv * bf2f((bf16_t)z[2]), oacc[dt][3] * inv * bf2f((bf16_t)z[3]));
        *(u32x2*)(YS + t * DM + col) = w;
    }
}

__device__ void chunk_item(const Params& p, int l, int ci, unsigned char* ldsb) {
    const int tid = TID(), lane = tid & 63, wid = tid >> 6, fr = lane & 15, fq = lane >> 4;
    const int chunk = ci >> 2, g = ci & 3, base = chunk * 128;
    bf16_t* wsb = (bf16_t*)ldsb;
    bf16_t* vt = wsb + 128 * 136;
    const float* P = (const float*)(PWS + WS_P);
    const bf16_t* Z = (const bf16_t*)(PWS + WS_Z);
    bf16_t* YS = (bf16_t*)(PWS + WS_YS);
    const float* wsrc = PIN(11) + (size_t)(l * 4 + g) * 128 * 128;
    __syncthreads();
#pragma unroll
    for (int i = 0; i < 8; ++i) { const int idx = tid + i * 512, r = idx >> 5, c4 = (idx & 31) * 4; const f32x4 v = *(const f32x4*)(wsrc + r * 128 + c4);
        u32x2 w; w[0] = cvt_pk_bf16(v[0], v[1]); w[1] = cvt_pk_bf16(v[2], v[3]); *(u32x2*)(wsb + r * 136 + c4) = w; }
    stage_vt(P + (size_t)base * PW + C_AV + g * 64, PW, vt, 128);
    __syncthreads();
    f32x4 acc[4];
#pragma unroll
    for (int n = 0; n < 4; ++n) acc[n] = (f32x4){0.f, 0.f, 0.f, 0.f};
#pragma unroll
    for (int k = 0; k < 4; ++k) {
        const bf16x8 af = *(const bf16x8*)(wsb + (wid * 16 + fr) * 136 + k * 32 + fq * 8);
#pragma unroll
        for (int n = 0; n < 4; ++n) { const bf16x8 bfv = *(const bf16x8*)(vt + (n * 16 + fr) * 136 + k * 32 + fq * 8);
            acc[n] = __builtin_amdgcn_mfma_f32_16x16x32_bf16(bfv, af, acc[n], 0, 0, 0); }
    }
    const int i = wid * 16 + fr; const size_t t = base + i;
    const float bsi = PIN(12)[(l * 4 + g) * 128 + i];
#pragma unroll
    for (int n = 0; n < 4; ++n) { const int col = g * 64 + n * 16 + fq * 4;
        const f32x4 u = *(const f32x4*)(P + t * PW + C_AU + col);
        const bf16x4 z = *(const bf16x4*)(Z + t * DM + col);
        u32x2 w; w[0] = cvt_pk_bf16(u[0] * (acc[n][0] + bsi) * bf2f((bf16_t)z[0]), u[1] * (acc[n][1] + bsi) * bf2f((bf16_t)z[1]));
        w[1] = cvt_pk_bf16(u[2] * (acc[n][2] + bsi) * bf2f((bf16_t)z[2]), u[3] * (acc[n][3] + bsi) * bf2f((bf16_t)z[3]));
        *(u32x2*)(YS + t * DM + col) = w; }
}

__device__ void pool_item(const Params& p, int l, int pi, unsigned char* ldsb) {
    const int tid = TID(), lane = tid & 63, wid = tid >> 6, fr = lane & 15, fq = lane >> 4, half = tid >> 8, ch = tid & 255, g = ch >> 6;
    const int tb = pi * 32; int seqbase, L, pos0; seq_of(tb, seqbase, L, pos0);
    float* pt = (float*)ldsb;
    bf16_t* dl = (bf16_t*)(pt + 48 * 256);
    bf16_t* wt = dl + 32 * 264;
    const float* P = (const float*)(PWS + WS_P);
    const bf16_t* Z = (const bf16_t*)(PWS + WS_Z);
    bf16_t* YS = (bf16_t*)(PWS + WS_YS);
    __syncthreads();
#pragma unroll
    for (int i = 0; i < 6; ++i) { const int idx = tid + i * 512, rr = idx >> 6, c4 = (idx & 63) * 4; const int pos = pos0 - 8 + rr;
        f32x4 v = (f32x4){0.f, 0.f, 0.f, 0.f};
        if (pos >= 0 && pos < L) v = *(const f32x4*)(P + (size_t)(seqbase + pos) * PW + C_DP + c4);
        *(f32x4*)(pt + rr * 256 + c4) = v; }
    { const float* pwsrc = PIN(23) + (size_t)l * 4 * 64 * 64;
#pragma unroll
      for (int gg = 0; gg < 4; ++gg) stage_vt(pwsrc + gg * 4096, 64, wt + gg * 64 * 72, 64, 72); }
    __syncthreads();
    const int w = 2 << g;
    for (int i = 0; i < 16; ++i) { const int tk = half * 16 + i, pos = pos0 + tk;
        int lo = pos - (w >> 1), hi = lo + w; lo = lo < 0 ? 0 : lo; hi = hi > L ? L : hi;
        float sm = 0.f;
        for (int q = lo; q < hi; ++q) sm += pt[(q - pos0 + 8) * 256 + ch];
        dl[tk * 264 + ch] = f2bf(sm / (float)(hi - lo) - pt[(tk + 8) * 256 + ch]); }
    __syncthreads();
    const int gw = wid >> 1, th = wid & 1;
    f32x4 acc[4];
#pragma unroll
    for (int n = 0; n < 4; ++n) acc[n] = (f32x4){0.f, 0.f, 0.f, 0.f};
#pragma unroll
    for (int k = 0; k < 2; ++k) {
        const bf16x8 af = *(const bf16x8*)(dl + (th * 16 + fr) * 264 + gw * 64 + k * 32 + fq * 8);
#pragma unroll
        for (int n = 0; n < 4; ++n) { const bf16x8 bfv = *(const bf16x8*)(wt + (gw * 64 + n * 16 + fr) * 72 + k * 32 + fq * 8);
            acc[n] = __builtin_amdgcn_mfma_f32_16x16x32_bf16(bfv, af, acc[n], 0, 0, 0); }
    }
    const size_t t = tb + th * 16 + fr;
#pragma unroll
    for (int n = 0; n < 4; ++n) { const int oc = gw * 64 + n * 16 + fq * 4;
        const f32x4 sc = *(const f32x4*)(PIN(24) + l * 256 + oc);
        const bf16x4 z = *(const bf16x4*)(Z + t * DM + 768 + oc);
        u32x2 wv; wv[0] = cvt_pk_bf16(acc[n][0] * sc[0] * bf2f((bf16_t)z[0]), acc[n][1] * sc[1] * bf2f((bf16_t)z[1]));
        wv[1] = cvt_pk_bf16(acc[n][2] * sc[2] * bf2f((bf16_t)z[2]), acc[n][3] * sc[3] * bf2f((bf16_t)z[3]));
        *(u32x2*)(YS + t * DM + 768 + oc) = wv; }
}

__device__ void phaseB1(const Params& p, int l, unsigned char* lds, int slot = 0, int part = 127) {
    const int tid = TID(), wid = tid >> 6;
    float* wl = (float*)lds + wid * 3072;
    if (!(part & 1)) {} else
    { const int nbh = (int)gridDim.x >> 1;
      if ((int)blockIdx.x < nbh) { if (wid < 4 && (part & 4)) for (int it = blockIdx.x * 4 + wid; it < 512; it += nbh * 4) { const int q = it >> 4, b = q >> 3;
            scan_run<1>(p, l, true, b, (q >> 1) & 3, q & 1, it & 15, 1024, NTP + b * 1024, wl); } }
      else { const int nb2 = (int)gridDim.x - nbh; if (part & 8) for (int it = ((int)blockIdx.x - nbh) * 8 + wid; it < 1024; it += nb2 * 8) { const int q = it >> 3, b = q >> 3;
            scan_run<2>(p, l, false, b, (q >> 1) & 3, q & 1, it & 7, 256, b * 256, wl); } } }
    __syncthreads();
    __shared__ int s_item;
    unsigned* ctr = (unsigned*)(PWS + WS_CTR) + l + 2 * slot;
    if (part & 2)
    for (;;) {
        if (tid == 0) s_item = (int)atomicAdd(ctr, 1u);
        __syncthreads();
        const int item = s_item;
        __syncthreads();
        if (item >= 768) break;
        if (item < 256) { if (part & 16) attn_item(p, l, item, lds); }
        else if (item < 512) { if (part & 32) chunk_item(p, l, item - 256, lds); }
        else { if (part & 64) pool_item(p, l, item - 512, lds); }
    }
}

__device__ void phaseB2(const Params& p, int l) {
    const int lane = TID() & 63, gw = blockIdx.x * 8 + (TID() >> 6), W = gridDim.x * 8;
    const float* O = (const float*)(PWS + WS_O);
    const float* recS = (const float*)(PWS + WS_RECS);
    const float* BC = (const float*)(PWS + WS_BC);
    const bf16_t* Z = (const bf16_t*)(PWS + WS_Z);
    bf16_t* YS = (bf16_t*)(PWS + WS_YS);
    const float* lng = PIN(20) + l * 256; const float* lnb = PIN(21) + l * 256;
    float g4[4], b4[4];
#pragma unroll
    for (int h = 0; h < 4; ++h) { g4[h] = lng[h * 64 + lane]; b4[h] = lnb[h * 64 + lane]; }
    for (int tok = gw; tok < NT; tok += W) {
        int seqbase, L, pos; seq_of(tok, seqbase, L, pos);
        float o[4], vv[4], z[4], mu[4], var[4];
        const f32x4 bc = *(const f32x4*)(BC + tok * 4);
#pragma unroll
        for (int h = 0; h < 4; ++h) { const int c = h * 64 + lane;
            o[h] = O[(size_t)tok * 256 + c] + O[(size_t)NT * 256 + (size_t)tok * 256 + c];
            vv[h] = recS[((size_t)seqbase * 4 + (size_t)h * L + pos) * 192 + 128 + lane];
            z[h] = bf2f(Z[(size_t)tok * DM + 256 + c]); }
#pragma unroll
        for (int h = 0; h < 4; ++h) mu[h] = wave_sum(o[h]) * (1.0f / 64.0f);
#pragma unroll
        for (int h = 0; h < 4; ++h) { o[h] -= mu[h]; var[h] = wave_sum(o[h] * o[h]) * (1.0f / 64.0f); }
#pragma unroll
        for (int h = 0; h < 4; ++h) { const float on = o[h] * rsqrtf(var[h] + 64e-5f);
            const float y = on * g4[h] + b4[h] + bc[h] * vv[h];
            YS[(size_t)tok * DM + 256 + h * 64 + lane] = f2bf(y * z[h]); }
    }
}

__device__ void phaseC1(const Params& p, int l, unsigned char* lds) {
    pg8::Gemm g; g.A = (const bf16_t*)(PWS + WS_H); g.Bt = (const bf16_t*)(PWS + WS_WTIN) + (size_t)l * INW * 1024 + (size_t)NA_COLS * 1024; g.M = NT; g.N = 4096; g.K = 1024;
    pg8::StaticOrder S; S.init(g.M, g.N, (int)gridDim.x, (int)blockIdx.x);
    EpiG E; E.G = (bf16_t*)(PWS + WS_G);
    pg8::gemm_phase<EpiG, pg8::StaticOrder, false>((PG8_LAS unsigned char*)lds, g, S, E, nullptr);
    __syncthreads();
}
__device__ void phaseC2(const Params& p, int l, unsigned char* lds) {
    constexpr int MT = 4, LDT = 72, A_BYTES = 256 * LDT * 2, B_BYTES = 128 * LDT * 2, BUF = A_BYTES + B_BYTES;
    const int tid = TID(), lane = tid & 63, wid = tid >> 6, wr = wid >> 1, wc = wid & 1, fr = lane & 15, fq = lane >> 4;
    const bf16_t* YS = (const bf16_t*)(PWS + WS_YS);
    const bf16_t* G = (const bf16_t*)(PWS + WS_G);
    const bf16_t* Wu = (const bf16_t*)(PWS + WS_WTUP) + (size_t)l * 4 * 1024 * 256;
    bf16_t* MG = (bf16_t*)(PWS + WS_MERGED);
    const int srow = tid >> 3, skc = tid & 7, soff = (srow * LDT + skc * 8) * 2;
    const int aoff = ((wr * MT * 16 + fr) * LDT + fq * 8) * 2, boff = A_BYTES + ((wc * 64 + fr) * LDT + fq * 8) * 2;
    const int NU = 32 * 8;
    for (int u = blockIdx.x; u < NU; u += gridDim.x) {
        const int pn = u / 32, pm = u % 32;
        const bf16_t* Ag = YS + ((size_t)pm * 256 + srow) * 1024 + skc * 8;
        const bf16_t* Bg = Wu + ((size_t)pn * 128 + srow) * 256 + skc * 8;
        f32x4 mg[4][4], acc[4][4]; zero_acc<4>(mg); zero_acc<4>(acc);
        u32x4 ra[MT], rb[2];
        auto gload = [&](int kt) {
#pragma unroll
            for (int i = 0; i < MT; ++i) ra[i] = *(const u32x4*)(Ag + (size_t)i * 64 * 1024 + kt * 64);
            const bf16_t* bb = Bg + (size_t)(kt >> 2) * 1024 * 256 + (kt & 3) * 64;
#pragma unroll
            for (int i = 0; i < 2; ++i) rb[i] = *(const u32x4*)(bb + (size_t)i * 64 * 256);
        };
        auto sstore = [&](int buf) { unsigned char* nb = lds + buf * BUF;
#pragma unroll
            for (int i = 0; i < MT; ++i) *(u32x4*)(nb + soff + i * 64 * LDT * 2) = ra[i];
#pragma unroll
            for (int i = 0; i < 2; ++i) *(u32x4*)(nb + A_BYTES + soff + i * 64 * LDT * 2) = rb[i];
        };
        __syncthreads();
        gload(0); sstore(0);
        __syncthreads();
        for (int t = 0; t < 16; ++t) {
            if (t + 1 < 16) gload(t + 1);
            const unsigned char* base = lds + (t & 1) * BUF;
#pragma unroll
            for (int kk = 0; kk < 2; ++kk) {
                bf16x8 af[MT], bfr[4];
#pragma unroll
                for (int m = 0; m < MT; ++m) af[m] = *(const bf16x8*)(base + aoff + m * 16 * LDT * 2 + kk * 64);
#pragma unroll
                for (int n = 0; n < 4; ++n) bfr[n] = *(const bf16x8*)(base + boff + n * 16 * LDT * 2 + kk * 64);
#pragma unroll
                for (int m = 0; m < MT; ++m)
#pragma unroll
                    for (int n = 0; n < 4; ++n) acc[m][n] = __builtin_amdgcn_mfma_f32_16x16x32_bf16(bfr[n], af[m], acc[m][n], 0, 0, 0);
            }
            if (t + 1 < 16) sstore((t + 1) & 1);
            if ((t & 3) == 3) {
                const int n = t >> 2;
#pragma unroll
                for (int m = 0; m < 4; ++m) { const int row = pm * 256 + wr * 64 + m * 16 + fr;
                    const bf16_t* gp = G + g_off(row, n * 1024 + pn * 128 + wc * 64 + fq * 4);
                    const bf16x8 ga = *(const bf16x8*)gp, gb = *(const bf16x8*)(gp + 8);
#pragma unroll
                    for (int q = 0; q < 4; ++q) {
#pragma unroll
                        for (int j = 0; j < 4; ++j) { const bf16_t gv = (bf16_t)(q < 2 ? ga[q * 4 + j] : gb[(q - 2) * 4 + j]); mg[m][q][j] += bf2f(gv) * acc[m][q][j]; }
                        acc[m][q] = (f32x4){0.f, 0.f, 0.f, 0.f}; } }
            }
            __syncthreads();
        }
#pragma unroll
        for (int m = 0; m < 4; ++m) { const size_t row = (size_t)pm * 256 + wr * 64 + m * 16 + fr;
#pragma unroll
            for (int q = 0; q < 4; ++q) { const int col = pn * 128 + wc * 64 + q * 16 + fq * 4;
                u32x2 w; w[0] = cvt_pk_bf16(mg[m][q][0], mg[m][q][1]); w[1] = cvt_pk_bf16(mg[m][q][2], mg[m][q][3]);
                *(u32x2*)(MG + row * DM + col) = w; } }
    }
}

__device__ void phaseD(const Params& p, int l, unsigned char* lds) {
    const int tid = TID(), lane = tid & 63, wid = tid >> 6, wr = wid >> 1, wc = wid & 1, fr = lane & 15, fq = lane >> 4;
    const bf16_t* MG = (const bf16_t*)(PWS + WS_MERGED);
    const bf16_t* Wo = (const bf16_t*)(PWS + WS_WTO) + (size_t)l * 1024 * 1024;
    const int NU = 32 * 8;
    for (int u = blockIdx.x; u < NU; u += gridDim.x) {
        const int pn = u / 32, pm = u % 32;
        f32x4 acc[4][4]; zero_acc<4>(acc);
        gemm_acc<4>(MG + (size_t)pm * 256 * 1024, 1024, Wo + (size_t)pn * 128 * 1024, 1024, 1024, acc, lds);
        float ssq[4];
#pragma unroll
        for (int m = 0; m < 4; ++m) { const int row = pm * 256 + wr * 64 + m * 16 + fr;
            const float* xr = xrow_ptr(p, l, row);
            const float* gate = (const float*)(PWS + WS_MOD) + (size_t)(l * 5 + modrow_of(row)) * 3072 + 2048;
            float sm = 0.f;
#pragma unroll
            for (int q = 0; q < 4; ++q) { const int col = pn * 128 + wc * 64 + q * 16 + fq * 4;
                const f32x4 xo = *(const f32x4*)(xr + col), gt = *(const f32x4*)(gate + col);
                acc[m][q] = xo + gt * acc[m][q];
                sm += (acc[m][q][0] * acc[m][q][0] + acc[m][q][1] * acc[m][q][1]) + (acc[m][q][2] * acc[m][q][2] + acc[m][q][3] * acc[m][q][3]); }
            sm += __shfl_xor(sm, 16); sm += __shfl_xor(sm, 32);
            ssq[m] = sm; }
        float* Pt = (float*)lds;
        float* St = Pt + 512;
        if (fq == 0) {
#pragma unroll
            for (int m = 0; m < 4; ++m) Pt[(wr * 64 + m * 16 + fr) * 2 + wc] = ssq[m]; }
        __syncthreads();
        float* XP = (float*)(PWS + WS_XP) + ((size_t)(l * 32 + pm) * 256) * 8;
        unsigned* cnt = (unsigned*)(PWS + WS_XCNT) + (size_t)(l * 32 + pm) * 64;
        if (tid < 256) __hip_atomic_store(XP + tid * 8 + pn, Pt[tid * 2] + Pt[tid * 2 + 1], __ATOMIC_RELAXED, __HIP_MEMORY_SCOPE_AGENT);
        asm volatile("s_waitcnt vmcnt(0)" ::: "memory");
        __syncthreads();
        if (tid == 0) {
            __hip_atomic_fetch_add(cnt, 1u, __ATOMIC_RELAXED, __HIP_MEMORY_SCOPE_AGENT);
            unsigned spins = 0;
            while (__hip_atomic_load(cnt, __ATOMIC_RELAXED, __HIP_MEMORY_SCOPE_AGENT) < 8u) { __builtin_amdgcn_s_sleep(2); if (++spins > (1u << 22)) break; }
            __builtin_amdgcn_fence(__ATOMIC_ACQUIRE, "agent");
            asm volatile("s_waitcnt vmcnt(0)" ::: "memory");
        }
        __syncthreads();
        if (tid < 256) { float t = 0.f;
#pragma unroll
            for (int k = 0; k < 8; ++k) t += __hip_atomic_load(XP + tid * 8 + k, __ATOMIC_RELAXED, __HIP_MEMORY_SCOPE_AGENT);
            St[tid] = rsqrtf(t * (1.0f / 1024.0f) + 1e-6f); }
        __syncthreads();
        const float* gn = (l == 0) ? PIN(9) + DM : PIN(27);
        bf16_t* H = (bf16_t*)(PWS + WS_H);
#pragma unroll
        for (int m = 0; m < 4; ++m) { const int rl_ = wr * 64 + m * 16 + fr, row = pm * 256 + rl_;
            const float rs = St[rl_];
            const float* md = (const float*)(PWS + WS_MOD) + (size_t)(5 + modrow_of(row)) * 3072;
#pragma unroll
            for (int q = 0; q < 4; ++q) { const int col = pn * 128 + wc * 64 + q * 16 + fq * 4;
                const f32x4 gg = *(const f32x4*)(gn + col);
                if (l == 0) { *(f32x4*)(POUT + (size_t)row * DM + col) = acc[m][q];
                    const f32x4 sh = *(const f32x4*)(md + col), scl = *(const f32x4*)(md + 1024 + col);
                    const f32x4 h = acc[m][q] * rs * gg * (1.0f + scl) + sh;
                    u32x2 w; w[0] = cvt_pk_bf16(h[0], h[1]); w[1] = cvt_pk_bf16(h[2], h[3]); *(u32x2*)(H + (size_t)row * DM + col) = w; }
                else *(f32x4*)(POUT + (size_t)row * DM + col) = acc[m][q] * rs * gg; } }
    }
}

__device__ void phaseF(const Params& p) {
    const int lane = TID() & 63, gw = blockIdx.x * 8 + (TID() >> 6), W = gridDim.x * 8;
    const float* g = PIN(27);
    for (int row = gw; row < NT; row += W) {
        float* x = POUT + (size_t)row * DM;
        f32x4 v[4]; float ss = 0.f;
#pragma unroll
        for (int i = 0; i < 4; ++i) { v[i] = *(const f32x4*)(x + i * 256 + lane * 4); ss += v[i][0] * v[i][0] + v[i][1] * v[i][1] + v[i][2] * v[i][2] + v[i][3] * v[i][3]; }
        ss = wave_sum(ss);
        const float rs = rsqrtf(ss * (1.0f / 1024.0f) + 1e-6f);
#pragma unroll
        for (int i = 0; i < 4; ++i) { const int c = i * 256 + lane * 4; *(f32x4*)(x + c) = v[i] * rs * *(const f32x4*)(g + c); }
    }
}

__global__ void __launch_bounds__(NTHREADS) fwd_megakernel(Params p) {
    extern __shared__ __attribute__((aligned(16))) unsigned char lds[];
    volatile LAS unsigned* st = (volatile LAS unsigned*)(lds + LDS_MAIN);
    if (threadIdx.x < 2) st[threadIdx.x] = 0u;
    if (threadIdx.x == 0) {
#pragma unroll
        for (int i = 0; i < 28; ++i) s_ptab[i] = (unsigned long long)p.in[i];
    }
    __syncthreads();
    const XcdBarrier xb = xcd_barrier_post((unsigned*)(PWS + WS_BAR), st);
#define GSYNC() xcd_barrier(xb)
    phase0(p, lds);
    GSYNC();
#pragma unroll 1
    for (int l = 0; l < 2; ++l) {
        if (l == 0) { phaseA0(p, l); GSYNC(); }
#pragma unroll 1
        for (int ap = 0; ap < 2; ++ap) { phaseA(p, l, lds, ap); if (ap == 0) GSYNC(); }
        phaseB0(p, l, lds);
        GSYNC();
        phaseB1(p, l, lds);
        GSYNC();
        phaseB2(p, l);
        phaseC1(p, l, lds);
        GSYNC();
        phaseC2(p, l, lds);
        GSYNC();
        phaseD(p, l, lds);
        if (l == 0) GSYNC();
    }
}

extern "C" void kernel_launch(void* const* d_in, const int* in_sizes, int n_in, void* d_out, int out_size, void* d_ws, size_t ws_size, hipStream_t stream) {
    static int grid_blocks = 0;
    if (!grid_blocks) {
        int dev = 0, cus = 0, per_cu = 0;
        hipGetDevice(&dev);
        hipDeviceGetAttribute(&cus, hipDeviceAttributeMultiprocessorCount, dev);
        hipFuncSetAttribute((const void*)fwd_megakernel, hipFuncAttributeMaxDynamicSharedMemorySize, LDS_BYTES);
        hipOccupancyMaxActiveBlocksPerMultiprocessor(&per_cu, (const void*)fwd_megakernel, NTHREADS, LDS_BYTES);
        if (per_cu < 1) { fprintf(stderr, "occupancy query returned %d\n", per_cu); per_cu = 1; }
        if (per_cu > 1) per_cu = 1;
        grid_blocks = cus * per_cu;
        if (ws_size < WS_END) fprintf(stderr, "workspace too small: %zu < %zu\n", ws_size, (size_t)WS_END);
    }
    Params p{};
    for (int i = 0; i < 28; ++i) p.in[i] = (const float*)d_in[i];
    p.out = (float*)d_out; p.ws = (unsigned char*)d_ws;
    hipMemsetAsync((char*)d_ws + WS_BAR, 0, 3456 * 4, stream);
    void* args[] = {&p};
    hipError_t e = hipLaunchCooperativeKernel((const void*)fwd_megakernel, dim3(grid_blocks), dim3(NTHREADS), args, LDS_BYTES, stream);
    if (e != hipSuccess) fprintf(stderr, "cooperative launch failed: %s (grid %d)\n", hipGetErrorString(e), grid_blocks);
}
```

```cpp
#include <hip/hip_runtime.h>
#include <hip/hip_cooperative_groups.h>
#include <cstdio>
namespace cg = cooperative_groups;

typedef unsigned short bf16_t;
typedef short bf16x8 __attribute__((ext_vector_type(8)));
typedef short bf16x4 __attribute__((ext_vector_type(4)));
typedef float f32x4 __attribute__((ext_vector_type(4)));
typedef float f32x2 __attribute__((ext_vector_type(2)));
typedef unsigned u32x4 __attribute__((ext_vector_type(4)));
typedef unsigned u32x2 __attribute__((ext_vector_type(2)));

constexpr int NT = 8192, NTP = 4096, DM = 1024, INW = 7296, NA_COLS = 3200, PW = 2176;
constexpr int NTHREADS = 512;
constexpr int C_AU = 0, C_AV = 256, C_BR = 512, C_BK = 768, C_BV = 1024, C_WD = 1280, C_AD = 1344, C_CQ = 1408, C_CK = 1664, C_CV = 1792, C_DP = 1920;
constexpr size_t O_YP = 0, O_YS = 4194304, O_NK = 8388608, O_NV = 9437184, O_NS = 10485760;
constexpr size_t WS_WTIN = 0;
constexpr size_t WS_WTUP = WS_WTIN + (size_t)2 * INW * DM * 2;
constexpr size_t WS_WTO  = WS_WTUP + (size_t)2 * 4 * 1024 * 256 * 2;
constexpr size_t WS_MOD  = WS_WTO + (size_t)2 * 1024 * 1024 * 2;
constexpr size_t WS_ROPE = WS_MOD + (size_t)2 * 5 * 3072 * 4;
constexpr size_t WS_CTR  = WS_ROPE + 64 * 16 * 8;
constexpr size_t WS_BAR  = WS_CTR + 256;
constexpr size_t WS_H    = WS_BAR + 3456 * 4;
constexpr size_t WS_P    = WS_H + (size_t)NT * DM * 2;
constexpr size_t WS_Z    = WS_P + (size_t)NT * PW * 4;
constexpr size_t WS_RECS = WS_Z + (size_t)NT * DM * 2;
constexpr size_t WS_RECD = WS_RECS + (size_t)NT * 4 * 192 * 4;
constexpr size_t WS_O    = WS_RECD + (size_t)2 * NT * 4 * 192 * 4;
constexpr size_t WS_BC   = WS_O + (size_t)2 * NT * 256 * 4;
constexpr size_t WS_YS   = WS_BC + (size_t)NT * 4 * 4;
constexpr size_t WS_LORAT = WS_YS + (size_t)NT * DM * 2;
constexpr size_t WS_XP   = WS_LORAT + (size_t)2 * 4 * 256 * 64 * 2;
constexpr size_t WS_XCNT = WS_XP + (size_t)2 * 32 * 256 * 8 * 4;
constexpr size_t WS_END  = WS_XCNT + (size_t)2 * 32 * 256;
constexpr size_t WS_G = WS_P;
constexpr size_t WS_MERGED = WS_RECS;
constexpr size_t RECD_STRIDE = (size_t)NT * 4 * 192;

constexpr int LDS_MAIN = 131072;
constexpr int LDS_BYTES = LDS_MAIN + 16;

struct Params {
    const float* in[28];
    float* out;
    unsigned char* ws;
};
__shared__ unsigned long long s_ptab[28];
__device__ __forceinline__ const float* ld_inptr(int k) {
    const unsigned long long v = s_ptab[k];
    const unsigned lo = __builtin_amdgcn_readfirstlane((unsigned)v), hi = __builtin_amdgcn_readfirstlane((unsigned)(v >> 32));
    return (const float*)(((unsigned long long)hi << 32) | lo);
}
#define PIN(k) (ld_inptr(k))
#define POUT (p.out)
#define PWS (p.ws)

__device__ __forceinline__ int TID() { int t = threadIdx.x; asm volatile("" : "+v"(t)); return t; }
__device__ __forceinline__ unsigned cvt_pk_bf16(float lo, float hi) { unsigned r; asm volatile("v_cvt_pk_bf16_f32 %0, %1, %2" : "=v"(r) : "v"(lo), "v"(hi)); return r; }
__device__ __forceinline__ bf16_t f2bf(float f) { return (bf16_t)(cvt_pk_bf16(f, 0.f) & 0xffffu); }
__device__ __forceinline__ float bf2f(bf16_t b) { return __uint_as_float(((unsigned)b) << 16); }
__device__ __forceinline__ float sigmoidf_(float x) { return 1.0f / (1.0f + __expf(-x)); }
__device__ __forceinline__ float siluf_(float x) { return x / (1.0f + __expf(-x)); }
template <int CTRL> __device__ __forceinline__ float dpp_f(float x) { return __int_as_float(__builtin_amdgcn_update_dpp(0, __float_as_int(x), CTRL, 0xF, 0xF, false)); }
__device__ __forceinline__ float row16_sum(float x) {
    x += dpp_f<0x128>(x); x += dpp_f<0x124>(x); x += dpp_f<0x122>(x); x += dpp_f<0x121>(x); return x;
}
__device__ __forceinline__ float wave_sum(float v) { v = row16_sum(v); v += __shfl_xor(v, 16); v += __shfl_xor(v, 32); return v; }
__device__ __forceinline__ void seq_of(int tok, int& seqbase, int& L, int& pos) {
    if (tok < NTP) { seqbase = tok & ~255; L = 256; pos = tok & 255; }
    else { int t2 = tok - NTP; seqbase = NTP + (t2 & ~1023); L = 1024; pos = t2 & 1023; }
}
__device__ __forceinline__ int modrow_of(int tok) { return tok < NTP ? 0 : 1 + ((tok - NTP) >> 10); }


#define XB_TMO      128
#define XB_XCNT(j)  (256  + 64 * (j))
#define XB_XSUB(j)  (1280 + 64 * (j))
#define XB_XGEN(j)  (2304 + 64 * (j))
#define XB_TOP      3328
#define XB_TOPGEN   3392
#define XCD_BAR_WORDS 3456
#define XB_SPIN_CAP (1u << 18)
#define LAS __attribute__((address_space(3)))
__device__ __forceinline__ unsigned xb_ld(unsigned* p)              { return __hip_atomic_load(p, __ATOMIC_RELAXED, __HIP_MEMORY_SCOPE_AGENT); }
__device__ __forceinline__ unsigned xb_add(unsigned* p, unsigned v) { return __hip_atomic_fetch_add(p, v, __ATOMIC_RELAXED, __HIP_MEMORY_SCOPE_AGENT); }
__device__ __forceinline__ unsigned xb_xcc_id() { return (unsigned)__builtin_amdgcn_s_getreg((3 << 11) | 20) & 0xFu; }
#define XB_SPIN(cond, bar) do { unsigned _sp = 0; while (cond) { __builtin_amdgcn_s_sleep(1); \
    if ((++_sp & 255u) == 0u) { if (xb_ld(&(bar)[XB_TMO])) break; if (_sp > XB_SPIN_CAP) { atomicAdd(&(bar)[XB_TMO], 1u); break; } } } } while (0)
struct XcdBarrier { unsigned* bar; unsigned x; volatile LAS unsigned* st; };
__device__ __forceinline__ XcdBarrier xcd_barrier_post(unsigned* bar, volatile LAS unsigned* st) {
    XcdBarrier b; b.bar = bar; b.x = xb_xcc_id(); b.st = st;
    if (threadIdx.x == 0) (void)xb_add(&bar[XB_XCNT(b.x)], 1u);
    return b;
}
__device__ __forceinline__ void xcd_barrier_complete(unsigned* bar, unsigned x, unsigned& nloc, unsigned& nx) {
    const unsigned G = gridDim.x * gridDim.y * gridDim.z;
    unsigned sum, cnt, mine, sp = 0u;
    for (;;) {
        sum = 0u; cnt = 0u; mine = 0u;
#pragma unroll
        for (unsigned j = 0; j < 16; ++j) { const unsigned c = xb_ld(&bar[XB_XCNT(j)]); sum += c; cnt += (c > 0u) ? 1u : 0u; mine = (j == x) ? c : mine; }
        if (sum == G) break;
        __builtin_amdgcn_s_sleep(1);
        if ((++sp & 255u) == 0u) { if (xb_ld(&bar[XB_TMO])) break; if (sp > XB_SPIN_CAP) { atomicAdd(&bar[XB_TMO], 1u); break; } }
    }
    nloc = mine > 0u ? mine : 1u; nx = cnt > 0u ? cnt : 1u;
}
__device__ __forceinline__ void xcd_barrier(const XcdBarrier& b0) {
    asm volatile("s_waitcnt vmcnt(0)" ::: "memory");
    __syncthreads();
    if (threadIdx.x == 0) {
        XcdBarrier b = b0;
        { unsigned xx = xb_xcc_id(); asm volatile("" : "+s"(xx)); b.x = xx; }
        unsigned* bar = b.bar;
        __builtin_amdgcn_s_waitcnt(0);
        unsigned nloc = b.st[0], nx = b.st[1];
        if (nloc == 0u) { xcd_barrier_complete(bar, b.x, nloc, nx); b.st[0] = nloc; b.st[1] = nx; }
        const unsigned old = xb_add(&bar[XB_XSUB(b.x)], 1u);
        const unsigned gen = old / nloc;
        if (old + 1u == (gen + 1u) * nloc) {
            __builtin_amdgcn_fence(__ATOMIC_RELEASE, "agent");
            asm volatile("s_waitcnt vmcnt(0)" ::: "memory");
            const unsigned og = xb_add(&bar[XB_TOP], 1u);
            const unsigned tg = og / nx;
            if (og + 1u == (tg + 1u) * nx) xb_add(&bar[XB_TOPGEN], 1u);
            else XB_SPIN(xb_ld(&bar[XB_TOPGEN]) == tg, bar);
            __builtin_amdgcn_fence(__ATOMIC_ACQUIRE, "agent");
            xb_add(&bar[XB_XGEN(b.x)], 1u);
            asm volatile("s_waitcnt vmcnt(0)" ::: "memory");
        } else {
            XB_SPIN(xb_ld(&bar[XB_XGEN(b.x)]) == gen, bar);
            __builtin_amdgcn_fence(__ATOMIC_ACQUIRE, "agent");
            asm volatile("s_waitcnt vmcnt(0)" ::: "memory");
        }
    }
    __syncthreads();
}

__device__ void conv_tile(const float* __restrict__ src, int N, bf16_t* __restrict__ dst, int K, int kt, int nt, float* tile) {
    const int tid = TID();
    { const int r = tid >> 4, c4 = (tid & 15) * 4;
#pragma unroll
      for (int i = 0; i < 2; ++i) { const int k = r + 32 * i; const f32x4 v = *(const f32x4*)(src + (size_t)(kt * 64 + k) * N + nt * 64 + c4);
          tile[k * 65 + c4 + 0] = v[0]; tile[k * 65 + c4 + 1] = v[1]; tile[k * 65 + c4 + 2] = v[2]; tile[k * 65 + c4 + 3] = v[3]; } }
    __syncthreads();
    { const int n = tid >> 3, kc = (tid & 7) * 8; u32x4 w;
      w[0] = cvt_pk_bf16(tile[(kc + 0) * 65 + n], tile[(kc + 1) * 65 + n]); w[1] = cvt_pk_bf16(tile[(kc + 2) * 65 + n], tile[(kc + 3) * 65 + n]);
      w[2] = cvt_pk_bf16(tile[(kc + 4) * 65 + n], tile[(kc + 5) * 65 + n]); w[3] = cvt_pk_bf16(tile[(kc + 6) * 65 + n], tile[(kc + 7) * 65 + n]);
      *(u32x4*)(dst + (size_t)(nt * 64 + n) * K + kt * 64 + kc) = w; }
    __syncthreads();
}

__device__ void mod_item(const Params& p, int l, int cc, float* lds) {
    const int tid = TID();
    float* sc = lds;
    float* red = lds + 5120;
    for (int i = tid; i < 5120; i += NTHREADS) { const int r = i >> 10, k = i & 1023; const float v = (r == 0) ? PIN(6)[k] : PIN(5)[(r - 1) * 1024 + k]; sc[i] = siluf_(v); }
    __syncthreads();
    const int kg = tid >> 5, c = tid & 31, col = cc * 32 + c;
    float a[5] = {0.f, 0.f, 0.f, 0.f, 0.f};
    const float* w = PIN(7) + (size_t)l * 1024 * 3072 + col;
    for (int k = kg * 64; k < kg * 64 + 64; ++k) { const float wv = w[(size_t)k * 3072];
#pragma unroll
        for (int r = 0; r < 5; ++r) a[r] += sc[r * 1024 + k] * wv; }
#pragma unroll
    for (int r = 0; r < 5; ++r) red[(kg * 5 + r) * 32 + c] = a[r];
    __syncthreads();
    if (tid < 160) { const int r = tid >> 5, c2 = tid & 31; float s = PIN(8)[l * 3072 + cc * 32 + c2];
        for (int g = 0; g < 16; ++g) s += red[(g * 5 + r) * 32 + c2];
        __hip_atomic_store((float*)(PWS + WS_MOD) + (l * 5 + r) * 3072 + cc * 32 + c2, s, __ATOMIC_RELAXED, __HIP_MEMORY_SCOPE_AGENT); }
    asm volatile("s_waitcnt vmcnt(0)" ::: "memory");
    __syncthreads();
    if (tid == 0 && l == 0) __hip_atomic_fetch_add((unsigned*)(PWS + WS_CTR) + 16, 1u, __ATOMIC_RELAXED, __HIP_MEMORY_SCOPE_AGENT);
}

__device__ void phaseA0(const Params& p, int l);
__device__ void phase0(const Params& p, unsigned char* lds) {
    const int NCONV_IN = 2 * 16 * 114, NCONV_UP = 8 * 64, NCONV_O = 2 * 256, NCONV_L = 32, NMOD = 192;
    const int total = NCONV_IN + NCONV_UP + NCONV_O + NCONV_L + NMOD + 1;
    for (int it = blockIdx.x; it < total; it += gridDim.x) {
        int i = it;
        if (i < NMOD) { mod_item(p, i / 96, i % 96, (float*)lds); continue; }
        i -= NMOD;
        if (i < NCONV_IN) { const int l = i / 1824, r = i % 1824, nt = r / 16, kt = r % 16;
            conv_tile(PIN(10) + (size_t)l * 1024 * INW, INW, (bf16_t*)(PWS + WS_WTIN) + (size_t)l * INW * 1024, 1024, kt, nt, (float*)lds); continue; }
        i -= NCONV_IN;
        if (i < NCONV_UP) { const int mtx = i / 64, r = i % 64, nt = r / 4, kt = r % 4;
            conv_tile(PIN(25) + (size_t)mtx * 256 * 1024, 1024, (bf16_t*)(PWS + WS_WTUP) + (size_t)mtx * 1024 * 256, 256, kt, nt, (float*)lds); continue; }
        i -= NCONV_UP;
        if (i < NCONV_O) { const int l = i / 256, r = i % 256, nt = r / 16, kt = r % 16;
            conv_tile(PIN(26) + (size_t)l * 1024 * 1024, 1024, (bf16_t*)(PWS + WS_WTO) + (size_t)l * 1024 * 1024, 1024, kt, nt, (float*)lds); continue; }
        i -= NCONV_O;
        if (i < NCONV_L) { const int l = i >> 4, m = (i >> 2) & 3, nt = i & 3;
            conv_tile((m < 2 ? PIN(14) : PIN(16)) + (size_t)(l * 2 + (m & 1)) * 64 * 256, 256, (bf16_t*)(PWS + WS_LORAT) + (size_t)(l * 4 + m) * 256 * 64, 64, 0, nt, (float*)lds); continue; }
        for (int e = TID(); e < 1024; e += NTHREADS) { const int pos = e >> 4, f = e & 15;
            const float inv = exp2f(-(float)f * (13.287712379549449f / 16.0f)); const float ang = (float)pos * inv;
            float sn, cs; sn = sinf(ang); cs = cosf(ang);
            ((f32x2*)(PWS + WS_ROPE))[e] = (f32x2){cs, sn}; }
        for (int e = TID(); e < 2 * 32 * 64; e += NTHREADS) ((unsigned*)(PWS + WS_XCNT))[e] = 0u;
    }
    if (TID() == 0) { unsigned* mc = (unsigned*)(PWS + WS_CTR) + 16; unsigned spins = 0;
        while (__hip_atomic_load(mc, __ATOMIC_RELAXED, __HIP_MEMORY_SCOPE_AGENT) < 96u) { __builtin_amdgcn_s_sleep(2); if (++spins > (1u << 22)) break; }
        __builtin_amdgcn_fence(__ATOMIC_ACQUIRE, "agent");
        asm volatile("s_waitcnt vmcnt(0)" ::: "memory"); }
    __syncthreads();
    phaseA0(p, 0);
}

__device__ __forceinline__ const float* xrow_ptr(const Params& p, int l, int row) {
    if (l == 0) return row < NTP ? PIN(0) + (size_t)row * DM : PIN(1) + (size_t)(row - NTP) * DM;
    return POUT + (size_t)row * DM;
}
__device__ void phaseA0(const Params& p, int l) {
    const int lane = TID() & 63, gw = blockIdx.x * 8 + (TID() >> 6), W = gridDim.x * 8;
    const float* g = PIN(9) + l * DM;
    bf16_t* H = (bf16_t*)(PWS + WS_H);
    for (int row = gw; row < NT; row += W) {
        const float* x = xrow_ptr(p, l, row);
        f32x4 v[4]; float ss = 0.f;
#pragma unroll
        for (int i = 0; i < 4; ++i) { v[i] = *(const f32x4*)(x + i * 256 + lane * 4); ss += v[i][0] * v[i][0] + v[i][1] * v[i][1] + v[i][2] * v[i][2] + v[i][3] * v[i][3]; }
        ss = wave_sum(ss);
        const float rs = rsqrtf(ss * (1.0f / 1024.0f) + 1e-6f);
        const float* mod = (const float*)(PWS + WS_MOD) + (size_t)(l * 5 + modrow_of(row)) * 3072;
#pragma unroll
        for (int i = 0; i < 4; ++i) { const int c = i * 256 + lane * 4;
            const f32x4 gg = *(const f32x4*)(g + c), sh = *(const f32x4*)(mod + c), scl = *(const f32x4*)(mod + 1024 + c);
            f32x4 h = v[i] * rs * gg * (1.0f + scl) + sh;
            u32x2 w; w[0] = cvt_pk_bf16(h[0], h[1]); w[1] = cvt_pk_bf16(h[2], h[3]);
            *(u32x2*)(H + (size_t)row * DM + c) = w; }
    }
}

template <int MT>
__device__ __forceinline__ void gemm_acc(const bf16_t* __restrict__ A, int lda, const bf16_t* __restrict__ B, int ldb, int K, f32x4 (&acc)[MT][4], unsigned char* lds) {
    constexpr int BM = MT * 64, LDT = 72, A_BYTES = BM * LDT * 2, B_BYTES = 128 * LDT * 2, BUF = A_BYTES + B_BYTES;
    const int tid = TID(), lane = tid & 63, wid = tid >> 6, wr = wid >> 1, wc = wid & 1, fr = lane & 15, fq = lane >> 4;
    u32x4 ra[MT], rb[2];
    const int srow = tid >> 3, skc = tid & 7;
    const bf16_t* Ag = A + (size_t)srow * lda + skc * 8;
    const bf16_t* Bg = B + (size_t)srow * ldb + skc * 8;
    const int soff = (srow * LDT + skc * 8) * 2;
    const int nt = K >> 6;
    __syncthreads();
#pragma unroll
    for (int i = 0; i < MT; ++i) ra[i] = *(const u32x4*)(Ag + (size_t)i * 64 * lda);
#pragma unroll
    for (int i = 0; i < 2; ++i) rb[i] = *(const u32x4*)(Bg + (size_t)i * 64 * ldb);
#pragma unroll
    for (int i = 0; i < MT; ++i) *(u32x4*)(lds + soff + i * 64 * LDT * 2) = ra[i];
#pragma unroll
    for (int i = 0; i < 2; ++i) *(u32x4*)(lds + A_BYTES + soff + i * 64 * LDT * 2) = rb[i];
    __syncthreads();
    const int aoff = ((wr * MT * 16 + fr) * LDT + fq * 8) * 2, boff = A_BYTES + ((wc * 64 + fr) * LDT + fq * 8) * 2;
    for (int t = 0; t < nt; ++t) {
        if (t + 1 < nt) {
#pragma unroll
            for (int i = 0; i < MT; ++i) ra[i] = *(const u32x4*)(Ag + (size_t)i * 64 * lda + (t + 1) * 64);
#pragma unroll
            for (int i = 0; i < 2; ++i) rb[i] = *(const u32x4*)(Bg + (size_t)i * 64 * ldb + (t + 1) * 64);
        }
        const unsigned char* base = lds + (t & 1) * BUF;
#pragma unroll
        for (int kk = 0; kk < 2; ++kk) {
            bf16x8 af[MT], bfr[4];
#pragma unroll
            for (int m = 0; m < MT; ++m) af[m] = *(const bf16x8*)(base + aoff + m * 16 * LDT * 2 + kk * 64);
#pragma unroll
            for (int n = 0; n < 4; ++n) bfr[n] = *(const bf16x8*)(base + boff + n * 16 * LDT * 2 + kk * 64);
#pragma unroll
            for (int m = 0; m < MT; ++m)
#pragma unroll
                for (int n = 0; n < 4; ++n) acc[m][n] = __builtin_amdgcn_mfma_f32_16x16x32_bf16(bfr[n], af[m], acc[m][n], 0, 0, 0);
        }
        if (t + 1 < nt) {
            unsigned char* nb = lds + ((t + 1) & 1) * BUF;
#pragma unroll
            for (int i = 0; i < MT; ++i) *(u32x4*)(nb + soff + i * 64 * LDT * 2) = ra[i];
#pragma unroll
            for (int i = 0; i < 2; ++i) *(u32x4*)(nb + A_BYTES + soff + i * 64 * LDT * 2) = rb[i];
        }
        __syncthreads();
    }
}
template <int MT> __device__ __forceinline__ void zero_acc(f32x4 (&acc)[MT][4]) {
#pragma unroll
    for (int m = 0; m < MT; ++m)
#pragma unroll
        for (int n = 0; n < 4; ++n) acc[m][n] = (f32x4){0.f, 0.f, 0.f, 0.f};
}

namespace pg8 {
#define PG8_LAS __attribute__((address_space(3)))
typedef unsigned short bf16_t;
typedef short bf16x8 __attribute__((ext_vector_type(8)));
typedef float f32x4 __attribute__((ext_vector_type(4)));
typedef unsigned u32x4 __attribute__((ext_vector_type(4)));
constexpr int BM = 256, BK = 64, HALF = 128, HTB = HALF * BK * 2  , STAGE_BYTES = 8 * HTB, NXCD = 8, WGM = 8;

__host__ __device__ __forceinline__ int lds_byte(int r, int c) { const int st = (r >> 4) * 2 + (c >> 5), rr = r & 15, cc = c & 31, ob = rr * 64 + cc * 2; return st * 1024 + (ob ^ (((ob >> 9) & 1) << 5)); }
__host__ __device__ __forceinline__ void stage_rc(int b, int& R, int& C) { const int st = b / 1024, sb = b % 1024, swz = sb ^ (((sb >> 9) & 1) << 5); R = (st >> 1) * 16 + swz / 64; C = (st & 1) * 32 + (swz % 64) / 2; }
__host__ __device__ __forceinline__ int perm32(int rho) { const int n = rho >> 4, i = rho & 15; return 8 * (i >> 2) + 4 * n + (i & 3); }

struct Unit { int pm, pn; };
struct Gemm { const bf16_t* A; const bf16_t* Bt; int M, N, K; };

struct StaticOrder {
    int nM, nN, nwg, G, c;
    __host__ __device__ void init(int M, int N, int G_, int c_) { nM = M / BM; nN = N / BM; nwg = nM * nN; G = G_; c = c_; }
    __host__ __device__ bool next(int i, Unit& u) const {
        const long L = (long)i * G + c; if (L >= nwg) return false;
        int wgid = (int)L; { const int q = nwg / NXCD, r = nwg % NXCD, xcd = wgid % NXCD, off = wgid / NXCD; wgid = (xcd < r ? xcd * (q + 1) : r * (q + 1) + (xcd - r) * q) + off; }
        const int nig = WGM * nN, gid = wgid / nig, fm = gid * WGM, gsz = (nM - fm) < WGM ? (nM - fm) : WGM;
        u.pm = fm + ((wgid % nig) % gsz); u.pn = (wgid % nig) / gsz; return true;
    }
    __device__ __forceinline__ void a_ready(const Unit&) const {}
    __device__ __forceinline__ void done(const Unit&) const {}
};
template <class Epi, class Sched, bool STAMP = false>
__device__ __forceinline__ void gemm_phase(PG8_LAS unsigned char* lds, const Gemm g, const Sched& S, const Epi& E, unsigned long long* stamps) {
    const int tid = ::TID(), wid = __builtin_amdgcn_readfirstlane(tid >> 6), lane = tid & 63, wr = wid >> 2, wc = wid & 3, fr = lane & 15, fq = lane >> 4;
    const int K = g.K, nt = K / BK;
    int ts_lo = 0, ts_hi = 0, nts = 0; const unsigned long long rt_entry = STAMP ? (unsigned long long)wall_clock64() : 0ull;
#define PG8_STAMP() do { if (STAMP && wid == 0 && nts < 64) { const unsigned long long _c = (unsigned long long)clock64(); \
        ts_lo = (lane == nts) ? (int)(unsigned)_c : ts_lo; ts_hi = (lane == nts) ? (int)(unsigned)(_c >> 32) : ts_hi; ++nts; } } while (0)
    PG8_STAMP();
    unsigned voffA[2], voffB[2];
#pragma unroll
    for (int i = 0; i < 2; ++i) { int R, C; stage_rc(tid * 16 + i * 8192, R, C); const int Rb = Epi::PERM ? ((R & ~31) + perm32(R & 31)) : R;
        voffA[i] = (unsigned)(R * K + C) * 2u; voffB[i] = (unsigned)(Rb * K + C) * 2u; }
    const size_t kstep = (size_t)(BK * 2);
    const size_t hstep = (size_t)HALF * K * 2;
    const size_t tstep = 2 * hstep;
    const unsigned ldsw = (unsigned)wid * 1024u;
    const int aoff = lds_byte(wr * 64 + fr, fq * 8), boff = lds_byte(wc * 32 + fr, fq * 8);
#define PG8_SA(b, h) (((b) * 2 + (h)) * HTB)
#define PG8_SB(b, h) ((4 + (b) * 2 + (h)) * HTB)
#define PG8_STAGE(bufoff, gbase, voff) do { _Pragma("unroll") for (int _i = 0; _i < 2; ++_i) \
        __builtin_amdgcn_global_load_lds((const unsigned*)((const char*)(gbase) + (voff)[_i]), (PG8_LAS unsigned*)(lds + (bufoff) + ldsw + _i * 8192), 16, 0, 0); } while (0)
#define PG8_LDA(dst, b, h) do { _Pragma("unroll") for (int m = 0; m < 4; ++m) _Pragma("unroll") for (int k = 0; k < 2; ++k) dst[m][k] = *(const PG8_LAS bf16x8*)(lds + PG8_SA(b, h) + aoff + m * 2048 + k * 1024); } while (0)
#define PG8_LDB(dst, b, h) do { _Pragma("unroll") for (int n = 0; n < 2; ++n) _Pragma("unroll") for (int k = 0; k < 2; ++k) dst[n][k] = *(const PG8_LAS bf16x8*)(lds + PG8_SB(b, h) + boff + n * 2048 + k * 1024); } while (0)
#define PG8_MMA(ai, bj, At, Bt) do { __builtin_amdgcn_s_setprio(1); _Pragma("unroll") for (int m = 0; m < 4; ++m) _Pragma("unroll") for (int n = 0; n < 2; ++n) _Pragma("unroll") for (int k = 0; k < 2; ++k) \
        acc[ai][bj][m][n] = __builtin_amdgcn_mfma_f32_16x16x32_bf16(Bt[n][k], At[m][k], acc[ai][bj][m][n], 0, 0, 0); __builtin_amdgcn_s_setprio(0); } while (0)
#define PG8_WAIT_V(n) asm volatile("s_waitcnt vmcnt(" #n ")" ::: "memory")
#define PG8_WAIT_L(n) asm volatile("s_waitcnt lgkmcnt(" #n ")" ::: "memory")
#define PG8_BAR __builtin_amdgcn_s_barrier()
#define PG8_SCHED __builtin_amdgcn_sched_barrier(0)
    Unit cur, nxt; int ui = 0;
    if (!S.next(0, cur)) return;
    f32x4 acc[2][2][4][2];
#pragma unroll
    for (int a = 0; a < 2; ++a)
#pragma unroll
        for (int b = 0; b < 2; ++b)
#pragma unroll
            for (int m = 0; m < 4; ++m)
#pragma unroll
                for (int n = 0; n < 2; ++n) acc[a][b][m][n] = (f32x4){0.f, 0.f, 0.f, 0.f};
    bf16x8 At[4][2], B0[2][2], B1[2][2];
    const char* cA = (const char*)g.A + (size_t)cur.pm * tstep; const char* cB = (const char*)g.Bt + (size_t)cur.pn * tstep;
    S.a_ready(cur);
    PG8_STAGE(PG8_SB(0, 0), cB, voffB); PG8_STAGE(PG8_SA(0, 0), cA, voffA); PG8_STAGE(PG8_SB(0, 1), cB + hstep, voffB); PG8_STAGE(PG8_SA(0, 1), cA + hstep, voffA);
    if (wr == 1) PG8_BAR;
    PG8_WAIT_V(4); PG8_BAR;
    PG8_STAGE(PG8_SB(1, 0), cB + kstep, voffB); PG8_STAGE(PG8_SA(1, 0), cA + kstep, voffA); PG8_STAGE(PG8_SB(1, 1), cB + hstep + kstep, voffB);
    PG8_WAIT_V(6); PG8_BAR;
    PG8_STAMP();
    for (;;) {
        const bool has_next = S.next(ui + 1, nxt);
        const char* nA = has_next ? (const char*)g.A + (size_t)nxt.pm * tstep : cA; const char* nB = has_next ? (const char*)g.Bt + (size_t)nxt.pn * tstep : cB;
        for (int t = 0; t < nt; t += 2) {
            const bool last = (t == nt - 2);
            const char* a1 = cA + (size_t)(t + 1) * kstep;
            const char* a2 = last ? nA : cA + (size_t)(t + 2) * kstep; const char* b2 = last ? nB : cB + (size_t)(t + 2) * kstep;
            const char* a3 = a2 + kstep; const char* b3 = b2 + kstep;
            if (last && has_next) S.a_ready(nxt);
            PG8_LDB(B0, 0, 0); PG8_SCHED; PG8_LDA(At, 0, 0); PG8_STAGE(PG8_SA(1, 1), a1 + hstep, voffA);
            PG8_WAIT_L(8); PG8_BAR; PG8_WAIT_L(0); PG8_MMA(0, 0, At, B0); PG8_BAR; PG8_SCHED;
            PG8_LDB(B1, 0, 1); PG8_STAGE(PG8_SB(0, 0), b2, voffB);
            PG8_BAR; PG8_WAIT_L(0); PG8_MMA(0, 1, At, B1); PG8_BAR;
            PG8_LDA(At, 0, 1); PG8_STAGE(PG8_SA(0, 0), a2, voffA);
            PG8_BAR; PG8_WAIT_L(0); PG8_MMA(1, 0, At, B0); PG8_BAR; PG8_SCHED;
            PG8_STAGE(PG8_SB(0, 1), b2 + hstep, voffB);
            PG8_WAIT_V(6); PG8_BAR; PG8_MMA(1, 1, At, B1); PG8_BAR;
            PG8_LDB(B0, 1, 0); PG8_SCHED; PG8_LDA(At, 1, 0); PG8_STAGE(PG8_SA(0, 1), a2 + hstep, voffA);
            PG8_WAIT_L(8); PG8_BAR; PG8_WAIT_L(0); PG8_MMA(0, 0, At, B0); PG8_BAR; PG8_SCHED;
            PG8_LDB(B1, 1, 1); PG8_STAGE(PG8_SB(1, 0), b3, voffB);
            PG8_BAR; PG8_WAIT_L(0); PG8_MMA(0, 1, At, B1); PG8_BAR;
            PG8_LDA(At, 1, 1); PG8_STAGE(PG8_SA(1, 0), a3, voffA);
            PG8_BAR; PG8_WAIT_L(0); PG8_MMA(1, 0, At, B0); PG8_BAR; PG8_SCHED;
            PG8_STAGE(PG8_SB(1, 1), b3 + hstep, voffB);
            PG8_WAIT_V(6); PG8_BAR; PG8_MMA(1, 1, At, B1); PG8_BAR;
        }
        PG8_STAMP();
        if constexpr (!Epi::AFTER_DRAIN) { E(acc, cur, wr, wc, fr, fq); S.done(cur); }
        PG8_STAMP();
        if (!has_next) break;
#pragma unroll
        for (int a = 0; a < 2; ++a)
#pragma unroll
            for (int b = 0; b < 2; ++b)
#pragma unroll
                for (int m = 0; m < 4; ++m)
#pragma unroll
                    for (int n = 0; n < 2; ++n) acc[a][b][m][n] = (f32x4){0.f, 0.f, 0.f, 0.f};
        cur = nxt; cA = nA; cB = nB; ++ui;
    }
    PG8_WAIT_V(0);
    if (wr == 0) PG8_BAR;
    PG8_BAR;
    if constexpr (Epi::AFTER_DRAIN) { E.fused(acc, cur, wr, wc, fr, fq, lds, wid, lane); S.done(cur); }
    PG8_STAMP();
    if (STAMP && wid == 0) { stamps[lane] = lane < nts ? (((unsigned long long)(unsigned)ts_hi << 32) | (unsigned)ts_lo) : 0ull;
        if (lane == 62) stamps[62] = rt_entry; if (lane == 63) stamps[63] = (unsigned long long)wall_clock64(); }
#undef PG8_STAMP
#undef PG8_SA
#undef PG8_SB
#undef PG8_STAGE
#undef PG8_LDA
#undef PG8_LDB
#undef PG8_MMA
#undef PG8_WAIT_V
#undef PG8_WAIT_L
#undef PG8_BAR
#undef PG8_SCHED
}
}

struct EpiA {
    static constexpr bool PERM = false, AFTER_DRAIN = false;
    float* P; bf16_t* Z; float* out; int l, cbase;
    __device__ __forceinline__ void operator()(const pg8::f32x4 (&acc)[2][2][4][2], const pg8::Unit& u, int wr, int wc, int fr, int fq) const {
#pragma unroll
        for (int ai = 0; ai < 2; ++ai)
#pragma unroll
            for (int m = 0; m < 4; ++m) { const int row = u.pm * 256 + ai * 128 + wr * 64 + m * 16 + fr;
#pragma unroll
                for (int bj = 0; bj < 2; ++bj)
#pragma unroll
                    for (int n = 0; n < 2; ++n) { const int col = cbase + u.pn * 256 + bj * 128 + wc * 32 + n * 16 + fq * 4; const f32x4 v = acc[ai][bj][m][n];
                        if (col < PW) { *(f32x4*)(P + (size_t)row * PW + col) = v;
                            if (col >= C_CK && col < C_DP && row < NTP) { const int b = row >> 8, s_ = row & 255; const bool isk = col < C_CV;
                                *(f32x4*)(out + (isk ? O_NK : O_NV) + ((size_t)((b * 2 + l) * 256 + s_)) * 128 + (col - (isk ? C_CK : C_CV))) = v; } }
                        else if (col < NA_COLS) { u32x2 w; w[0] = cvt_pk_bf16(siluf_(v[0]), siluf_(v[1])); w[1] = cvt_pk_bf16(siluf_(v[2]), siluf_(v[3])); *(u32x2*)(Z + (size_t)row * DM + (col - PW)) = w; } } }
    }
};
__device__ __forceinline__ size_t g_off(int row, int cg) {
    const int n = cg >> 10, c = cg & 1023;
    const int pm = row >> 8, wr2 = (row >> 6) & 3, m = (row >> 4) & 3, fr = row & 15;
    const int pn = c >> 7, wc2 = (c >> 6) & 1, q = (c >> 4) & 3, fq2 = (c >> 2) & 3;
    size_t o = (size_t)(n * 32 + pm); o = o * 8 + pn; o = o * 4 + wr2; o = o * 2 + wc2; o = o * 4 + m; o = o * 16 + fr; o = o * 4 + fq2; o = o * 16 + q * 4;
    return o;
}
struct EpiG {
    static constexpr bool PERM = true, AFTER_DRAIN = false;
    bf16_t* G;
    __device__ __forceinline__ void operator()(const pg8::f32x4 (&acc)[2][2][4][2], const pg8::Unit& u, int wr, int wc, int fr, int fq) const {
#pragma unroll
        for (int ai = 0; ai < 2; ++ai)
#pragma unroll
            for (int m = 0; m < 4; ++m) { const int row = u.pm * 256 + ai * 128 + wr * 64 + m * 16 + fr;
#pragma unroll
                for (int bj = 0; bj < 2; ++bj) { const int col = u.pn * 256 + bj * 128 + wc * 32 + 8 * fq; const f32x4 v0 = acc[ai][bj][m][0], v1 = acc[ai][bj][m][1];
                    u32x4 w; w[0] = cvt_pk_bf16(sigmoidf_(v0[0]), sigmoidf_(v0[1])); w[1] = cvt_pk_bf16(sigmoidf_(v0[2]), sigmoidf_(v0[3]));
                    w[2] = cvt_pk_bf16(sigmoidf_(v1[0]), sigmoidf_(v1[1])); w[3] = cvt_pk_bf16(sigmoidf_(v1[2]), sigmoidf_(v1[3]));
                    u32x2 wa, wb; wa[0] = w[0]; wa[1] = w[1]; wb[0] = w[2]; wb[1] = w[3];
                    *(u32x2*)(G + g_off(row, col)) = wa; *(u32x2*)(G + g_off(row, col + 4)) = wb; } }
    }
};

__device__ void phaseA(const Params& p, int l, unsigned char* lds, int part) {
    const int G = part ? ((int)gridDim.x < 160 ? (int)gridDim.x : 160) : (int)gridDim.x;
    if ((int)blockIdx.x < G) {
        pg8::Gemm g; g.A = (const bf16_t*)(PWS + WS_H); g.Bt = (const bf16_t*)(PWS + WS_WTIN) + (size_t)l * INW * 1024 + (size_t)(part ? 2048 : 0) * 1024; g.M = NT; g.N = part ? 5 * 256 : 8 * 256; g.K = 1024;
        pg8::StaticOrder S; S.init(g.M, g.N, G, (int)blockIdx.x);
        EpiA E; E.P = (float*)(PWS + WS_P); E.Z = (bf16_t*)(PWS + WS_Z); E.out = POUT; E.l = l; E.cbase = part ? 2048 : 0;
        pg8::gemm_phase<EpiA, pg8::StaticOrder, false>((PG8_LAS unsigned char*)lds, g, S, E, nullptr);
    }
    __syncthreads();
}

__device__ void phaseB0(const Params& p, int l, unsigned char* ldsb) {
    const int tid = TID(), lane = tid & 63, wid = tid >> 6, fr = lane & 15, fq = lane >> 4;
    const int h = wid >> 1, mt = wid & 1;
    bf16_t* Awd = (bf16_t*)ldsb;
    bf16_t* Aad = Awd + 32 * 72;
    const float* P = (const float*)(PWS + WS_P);
    float* recS = (float*)(PWS + WS_RECS);
    float* recD = (float*)(PWS + WS_RECD);
    float* BC = (float*)(PWS + WS_BC);
    const bf16_t* LT = (const bf16_t*)(PWS + WS_LORAT) + (size_t)l * 4 * 256 * 64;
    const float* pkk = PIN(17) + l * 256; const float* pka = PIN(18) + l * 256; const float* prk = PIN(19) + l * 256;
    const float* pw0 = PIN(13) + l * 512; const float* pa0 = PIN(15) + l * 512;
    __shared__ int s_b0;
    unsigned* ctr0 = (unsigned*)(PWS + WS_CTR) + 4 + l;
    for (;;) {
        if (tid == 0) s_b0 = (int)atomicAdd(ctr0, 1u);
        __syncthreads();
        const int it = s_b0;
        __syncthreads();
        if (it >= NT / 32) break;
        const int tb = it * 32;
        __syncthreads();
#pragma unroll
        for (int i = 0; i < 8; ++i) { const int idx = tid + i * 512, tk = idx >> 7, j = idx & 127; const float v = P[(size_t)(tb + tk) * PW + C_WD + j];
            if (j < 64) Awd[tk * 72 + j] = f2bf(1.0f - 2.0f / (1.0f + __expf(2.0f * v))); else Aad[tk * 72 + j - 64] = f2bf(v); }
        __syncthreads();
        f32x4 acc[4][4];
#pragma unroll
        for (int m = 0; m < 4; ++m)
#pragma unroll
            for (int n = 0; n < 4; ++n) acc[m][n] = (f32x4){0.f, 0.f, 0.f, 0.f};
#pragma unroll
        for (int ks = 0; ks < 2; ++ks) {
            const bf16x8 awf = *(const bf16x8*)(Awd + (mt * 16 + fr) * 72 + ks * 32 + fq * 8), aaf = *(const bf16x8*)(Aad + (mt * 16 + fr) * 72 + ks * 32 + fq * 8);
#pragma unroll
            for (int n = 0; n < 4; ++n) { const int cb = h * 64 + n * 16 + fr;
#pragma unroll
                for (int m = 0; m < 4; ++m) { const bf16x8 bfr = *(const bf16x8*)(LT + ((size_t)m * 256 + cb) * 64 + ks * 32 + fq * 8);
                    acc[m][n] = __builtin_amdgcn_mfma_f32_16x16x32_bf16(bfr, m < 2 ? awf : aaf, acc[m][n], 0, 0, 0); } }
        }
        const int tok = tb + mt * 16 + fr; int seqbase, L, pos; seq_of(tok, seqbase, L, pos);
        const float* pr = P + (size_t)tok * PW;
        const size_t ridx = ((size_t)seqbase * 4 + (size_t)h * L + pos) * 192;
        f32x4 k4[4], kk4[4]; float ss = 0.f;
#pragma unroll
        for (int n = 0; n < 4; ++n) { const int c4 = h * 64 + n * 16 + fq * 4;
            k4[n] = *(const f32x4*)(pr + C_BK + c4); kk4[n] = k4[n] * *(const f32x4*)(pkk + c4);
            ss += (kk4[n][0] * kk4[n][0] + kk4[n][1] * kk4[n][1]) + (kk4[n][2] * kk4[n][2] + kk4[n][3] * kk4[n][3]); }
        ss += __shfl_xor(ss, 16); ss += __shfl_xor(ss, 32);
        const float rn = rsqrtf(ss + 1e-12f);
        float bsum = 0.f;
#pragma unroll
        for (int n = 0; n < 4; ++n) { const int c4 = h * 64 + n * 16 + fq * 4, j4 = n * 16 + fq * 4;
            const f32x4 r4 = *(const f32x4*)(pr + C_BR + c4), v4 = *(const f32x4*)(pr + C_BV + c4);
            const f32x4 kk = kk4[n] * rn, ka4 = *(const f32x4*)(pka + c4), rk4 = *(const f32x4*)(prk + c4);
            *(f32x4*)(recS + ridx + j4) = r4; *(f32x4*)(recS + ridx + 64 + j4) = kk; *(f32x4*)(recS + ridx + 128 + j4) = v4;
#pragma unroll
            for (int d = 0; d < 2; ++d) {
                const f32x4 w0 = *(const f32x4*)(pw0 + d * 256 + c4), a0 = *(const f32x4*)(pa0 + d * 256 + c4);
                f32x4 dec, nka, kd;
#pragma unroll
                for (int j = 0; j < 4; ++j) {
                    const float wl = w0[j] + acc[d][n][j];
                    dec[j] = __expf(-0.6065306597126334f / (1.0f + __expf(-wl)));
                    const float a = 1.0f / (1.0f + __expf(-(a0[j] + acc[2 + d][n][j])));
                    kd[j] = k4[n][j] * (1.0f + (a - 1.0f) * ka4[j]); nka[j] = -(kk[j] * a);
                    bsum += r4[j] * kd[j] * rk4[j]; }
                float* rd = recD + (size_t)d * RECD_STRIDE + ridx + j4;
                *(f32x4*)(rd) = dec; *(f32x4*)(rd + 64) = nka; *(f32x4*)(rd + 128) = kd;
            }
        }
        bsum += __shfl_xor(bsum, 16); bsum += __shfl_xor(bsum, 32);
        if (fq == 0) BC[tok * 4 + h] = bsum;
    }
}

template <int NS>
__device__ __forceinline__ void scan_run(const Params& p, int l, bool sample, int b, int h, int dir, int rg, int L, int seqbase, float* wl) {
    const int lane = TID() & 63, rl = lane >> 4, kl = lane & 15;
    int row[NS]; f32x4 S[NS]; size_t sidx[NS];
#pragma unroll
    for (int q = 0; q < NS; ++q) { row[q] = (rg * NS + q) * 4 + rl;
        sidx[q] = ((size_t)(((b * 2 + l) * 2 + dir) * 4 + h)) * 4096 + row[q] * 64 + kl * 4;
        if (sample) S[q] = *(const f32x4*)(PIN(4) + sidx[q]); else S[q] = (f32x4){0.f, 0.f, 0.f, 0.f}; }
    const float* gS = (const float*)(PWS + WS_RECS) + ((size_t)seqbase * 4 + (size_t)h * L) * 192 + lane * 4;
    const float* gD = (const float*)(PWS + WS_RECD) + (size_t)dir * RECD_STRIDE + ((size_t)seqbase * 4 + (size_t)h * L) * 192 + lane * 4;
    float* O = (float*)(PWS + WS_O) + (size_t)dir * NT * 256 + (size_t)seqbase * 256 + h * 64;
    const int nch = L >> 2;
    f32x4 rA[6], rB[6];
    auto gl = [&](f32x4 (&r)[6], int c) {
        c = c < nch ? c : nch - 1;
        const int pos0 = dir ? (L - 4 * (c + 1)) : 4 * c;
        const float* s_ = gS + (size_t)pos0 * 192; const float* d_ = gD + (size_t)pos0 * 192;
#pragma unroll
        for (int i = 0; i < 3; ++i) { r[i] = *(const f32x4*)(s_ + i * 256); r[3 + i] = *(const f32x4*)(d_ + i * 256); }
    };
    auto st = [&](const f32x4 (&r)[6], float* buf) {
#pragma unroll
        for (int i = 0; i < 3; ++i) { *(f32x4*)(buf + i * 256 + lane * 4) = r[i]; *(f32x4*)(buf + 768 + i * 256 + lane * 4) = r[3 + i]; }
    };
    struct Ops { f32x4 r, kk, w, ka, kd; float v[NS]; };
    auto ldsread = [&](const float* buf, int s) -> Ops {
        const int tc = dir ? 3 - s : s;
        const float* bs = buf + tc * 192; const float* bd = buf + 768 + tc * 192;
        Ops o; o.r = *(const f32x4*)(bs + kl * 4); o.kk = *(const f32x4*)(bs + 64 + kl * 4);
        o.w = *(const f32x4*)(bd + kl * 4); o.ka = *(const f32x4*)(bd + 64 + kl * 4); o.kd = *(const f32x4*)(bd + 128 + kl * 4);
#pragma unroll
        for (int q = 0; q < NS; ++q) o.v[q] = bs[128 + row[q]];
        return o;
    };
    float opart[NS];
#pragma unroll
    for (int q = 0; q < NS; ++q) opart[q] = 0.f;
    auto chunk = [&](const float* cur, const float* nxtbuf, Ops& ops, int c) {
        float oval[NS];
#pragma unroll
        for (int q = 0; q < NS; ++q) oval[q] = 0.f;
#pragma unroll
        for (int s = 0; s < 4; ++s) {
            const Ops nx = (s < 3) ? ldsread(cur, s + 1) : ldsread(nxtbuf, 0);
            __builtin_amdgcn_sched_barrier(0);
            float sa[NS], opr[NS]; f32x2 ta[NS], tb[NS];
            const f32x2 kka = __builtin_shufflevector(ops.kk, ops.kk, 0, 1), kkb = __builtin_shufflevector(ops.kk, ops.kk, 2, 3);
            const f32x2 wa = __builtin_shufflevector(ops.w, ops.w, 0, 1), wb = __builtin_shufflevector(ops.w, ops.w, 2, 3);
            const f32x2 na = __builtin_shufflevector(ops.ka, ops.ka, 0, 1), nb = __builtin_shufflevector(ops.ka, ops.ka, 2, 3);
            const f32x2 da = __builtin_shufflevector(ops.kd, ops.kd, 0, 1), db = __builtin_shufflevector(ops.kd, ops.kd, 2, 3);
            const f32x2 ra = __builtin_shufflevector(ops.r, ops.r, 0, 1), rb = __builtin_shufflevector(ops.r, ops.r, 2, 3);
#pragma unroll
            for (int q = 0; q < NS; ++q) { const f32x2 Sa = __builtin_shufflevector(S[q], S[q], 0, 1), Sb = __builtin_shufflevector(S[q], S[q], 2, 3);
                f32x2 pp = Sa * kka; pp = Sb * kkb + pp; sa[q] = pp[0] + pp[1];
                const f32x2 v2 = (f32x2){ops.v[q], ops.v[q]};
                ta[q] = Sa * wa + v2 * da; tb[q] = Sb * wb + v2 * db; }
#pragma unroll
            for (int q = 0; q < NS; ++q) { sa[q] = row16_sum(sa[q]); opr[q] = row16_sum(opart[q]); oval[q] = (kl == s) ? opr[q] : oval[q]; }
#pragma unroll
            for (int q = 0; q < NS; ++q) { const f32x2 s2 = (f32x2){sa[q], sa[q]};
                const f32x2 Sa = s2 * na + ta[q], Sb = s2 * nb + tb[q];
                f32x2 qq = Sa * ra; qq = Sb * rb + qq; opart[q] = qq[0] + qq[1];
                S[q] = (f32x4){Sa[0], Sa[1], Sb[0], Sb[1]}; }
            ops = nx;
        }
        const int stp = 4 * c - 1 + (kl & 3);
        const int pos = dir ? (L - 1 - stp) : stp;
#pragma unroll
        for (int q = 0; q < NS; ++q) { if (kl < 4 && stp >= 0) O[(size_t)pos * 256 + row[q]] = oval[q]; }
    };
    float* buf0 = wl; float* buf1 = wl + 1536;
    gl(rA, 0); gl(rB, 1);
    st(rA, buf0); gl(rA, 2);
    __builtin_amdgcn_wave_barrier();
    Ops ops = ldsread(buf0, 0);
    for (int c = 0; c < nch; c += 2) {
        st(rB, buf1); gl(rB, c + 3);
        __builtin_amdgcn_wave_barrier();
        chunk(buf0, buf1, ops, c);
        st(rA, buf0); gl(rA, c + 4);
        __builtin_amdgcn_wave_barrier();
        chunk(buf1, buf0, ops, c + 1);
    }
#pragma unroll
    for (int q = 0; q < NS; ++q) { const float ol = row16_sum(opart[q]); if (kl == 0) O[(size_t)(dir ? 0 : L - 1) * 256 + row[q]] = ol; }
    if (!sample) {
#pragma unroll
        for (int q = 0; q < NS; ++q) *(f32x4*)(POUT + O_NS + sidx[q]) = S[q];
    }
}

__device__ __forceinline__ void stage_qk(const float* __restrict__ src, int stride, bf16_t* dst, bool rope, int pos0, float scale, const f32x2* __restrict__ rt) {
    const int tid = TID();
#pragma unroll
    for (int i = 0; i < 2; ++i) {
        const int task = tid + i * 512, row = task >> 3, half = (task >> 2) & 1, quad = task & 3;
        const float* s = src + (size_t)row * stride + half * 32 + quad * 4;
        f32x4 x1 = *(const f32x4*)s, x2 = *(const f32x4*)(s + 16);
        if (rope) { const int pos = pos0 + row; const int pi = half ? (pos & 63) : (pos >> 6);
#pragma unroll
            for (int j = 0; j < 4; ++j) { const f32x2 cs = rt[pi * 16 + quad * 4 + j]; const float a = x1[j], b = x2[j]; x1[j] = a * cs[0] - b * cs[1]; x2[j] = b * cs[0] + a * cs[1]; } }
        x1 *= scale; x2 *= scale;
        u32x2 w1, w2; w1[0] = cvt_pk_bf16(x1[0], x1[1]); w1[1] = cvt_pk_bf16(x1[2], x1[3]); w2[0] = cvt_pk_bf16(x2[0], x2[1]); w2[1] = cvt_pk_bf16(x2[2], x2[3]);
        *(u32x2*)(dst + row * 72 + half * 32 + quad * 4) = w1; *(u32x2*)(dst + row * 72 + half * 32 + 16 + quad * 4) = w2;
    }
}
__device__ __forceinline__ void stage_vt(const float* __restrict__ src, int stride, bf16_t* vt, int nkeys = 128, int pitch = 136) {
    const int tid = TID();
    for (int task = tid; task < nkeys * 16; task += 512) { const int key = task >> 4, dq = task & 15;
        const f32x4 v = *(const f32x4*)(src + (size_t)key * stride + dq * 4);
#pragma unroll
        for (int j = 0; j < 4; ++j) vt[(dq * 4 + j) * pitch + key] = f2bf(v[j]); }
}
__device__ void attn_item(const Params& p, int l, int ai, unsigned char* lds) {
    const int tid = TID(), lane = tid & 63, wid = tid >> 6, fr = lane & 15, fq = lane >> 4;
    bf16_t* Qs = (bf16_t*)lds; bf16_t* Ks = Qs + 128 * 72; bf16_t* Vt = Ks + 128 * 72;
    const float* P = (const float*)(PWS + WS_P);
    const bf16_t* Z = (const bf16_t*)(PWS + WS_Z);
    bf16_t* YS = (bf16_t*)(PWS + WS_YS);
    const f32x2* rt = (const f32x2*)(PWS + WS_ROPE);
    bool sample; int b, head, qt, seqbase;
    if (ai < 128) { sample = true; b = ai >> 5; head = (ai >> 3) & 3; qt = ai & 7; seqbase = NTP + b * 1024; }
    else { const int j = ai - 128; sample = false; b = j >> 3; head = (j >> 1) & 3; qt = j & 1; seqbase = b * 256; }
    const int kh = head >> 1, qbase = seqbase + qt * 128;
    __syncthreads();
    stage_qk(P + (size_t)qbase * PW + C_CQ + head * 64, PW, Qs, sample, qt * 128, 0.125f, rt);
    __syncthreads();
    bf16x8 qf[2];
    qf[0] = *(const bf16x8*)(Qs + (wid * 16 + fr) * 72 + fq * 8); qf[1] = *(const bf16x8*)(Qs + (wid * 16 + fr) * 72 + 32 + fq * 8);
    float m = PIN(22)[l * 4 + head], lsum = 1.0f, lpart = 0.f;
    f32x4 oacc[4];
#pragma unroll
    for (int i = 0; i < 4; ++i) oacc[i] = (f32x4){0.f, 0.f, 0.f, 0.f};
    const int nkb = sample ? 7 : 2;
    const int qpos = qt * 128 + wid * 16 + fr;
    const float* ck = PIN(2); const float* cv = PIN(3);
    auto kinfo = [&](int kb, const float*& ks, const float*& vs, int& stride, bool& rope, bool& mask, int& kpos0) -> bool {
        if (!sample) { ks = P + (size_t)(seqbase + kb * 128) * PW + C_CK + kh * 64; vs = ks + (C_CV - C_CK); stride = PW; rope = false; mask = false; kpos0 = 0; return true; }
        if (kb < 3) { const int nbk = qt - 1 + kb; if (nbk < 0 || nbk >= 8) return false; kpos0 = nbk * 128;
            ks = P + (size_t)(seqbase + kpos0) * PW + C_CK + kh * 64; vs = ks + (C_CV - C_CK); stride = PW; rope = true; mask = (kb != 1); return true; }
        const size_t o = ((size_t)((b * 2 + l) * 512 + (kb - 3) * 128) * 2 + kh) * 64; ks = ck + o; vs = cv + o; stride = 128; rope = false; mask = false; kpos0 = 0; return true;
    };
    f32x4 kx1[2], kx2[2], vx[2][2];
    auto kload = [&](const float* ks, const float* vs, int stride) {
#pragma unroll
        for (int i = 0; i < 2; ++i) { const int task = tid + i * 512, row = task >> 3, half = (task >> 2) & 1, quad = task & 3;
            const float* s_ = ks + (size_t)row * stride + half * 32 + quad * 4; kx1[i] = *(const f32x4*)s_; kx2[i] = *(const f32x4*)(s_ + 16); }
#pragma unroll
        for (int i = 0; i < 2; ++i) { const int task = tid + i * 512, kp = task >> 4, dq = task & 15;
            vx[i][0] = *(const f32x4*)(vs + (size_t)(2 * kp) * stride + dq * 4); vx[i][1] = *(const f32x4*)(vs + (size_t)(2 * kp + 1) * stride + dq * 4); }
    };
    auto kstore = [&](bool rope, int kpos0) {
#pragma unroll
        for (int i = 0; i < 2; ++i) { const int task = tid + i * 512, row = task >> 3, half = (task >> 2) & 1, quad = task & 3;
            f32x4 x1 = kx1[i], x2 = kx2[i];
            if (rope) { const int pos = kpos0 + row; const int pi = half ? (pos & 63) : (pos >> 6);
#pragma unroll
                for (int j = 0; j < 4; ++j) { const f32x2 cs = rt[pi * 16 + quad * 4 + j]; const float a_ = x1[j], b_ = x2[j]; x1[j] = a_ * cs[0] - b_ * cs[1]; x2[j] = b_ * cs[0] + a_ * cs[1]; } }
            u32x2 w1, w2; w1[0] = cvt_pk_bf16(x1[0], x1[1]); w1[1] = cvt_pk_bf16(x1[2], x1[3]); w2[0] = cvt_pk_bf16(x2[0], x2[1]); w2[1] = cvt_pk_bf16(x2[2], x2[3]);
            *(u32x2*)(Ks + row * 72 + half * 32 + quad * 4) = w1; *(u32x2*)(Ks + row * 72 + half * 32 + 16 + quad * 4) = w2; }
#pragma unroll
        for (int i = 0; i < 2; ++i) { const int task = tid + i * 512, kp = task >> 4, dq = task & 15;
#pragma unroll
            for (int j = 0; j < 4; ++j) *(unsigned*)(Vt + (dq * 4 + j) * 136 + 2 * kp) = cvt_pk_bf16(vx[i][0][j], vx[i][1][j]); }
    };
    const float* ksrc = nullptr; const float* vsrc = nullptr; int stride = 0, kpos0n = 0; bool ropen = false, maskn = false;
    int kb = 0;
    while (kb < nkb && !kinfo(kb, ksrc, vsrc, stride, ropen, maskn, kpos0n)) ++kb;
    if (kb < nkb) kload(ksrc, vsrc, stride);
    while (kb < nkb) {
        const bool mask = maskn; const int kpos0 = kpos0n; const bool rope = ropen;
        __syncthreads();
        kstore(rope, kpos0);
        __syncthreads();
        int nk = kb + 1;
        while (nk < nkb && !kinfo(nk, ksrc, vsrc, stride, ropen, maskn, kpos0n)) ++nk;
        if (nk < nkb) kload(ksrc, vsrc, stride);
        kb = nk;
        f32x4 sc[4][2];
#pragma unroll
        for (int sb = 0; sb < 4; ++sb) {
            f32x4 s0 = (f32x4){0.f, 0.f, 0.f, 0.f}, s1 = s0;
#pragma unroll
            for (int dh = 0; dh < 2; ++dh) {
                const bf16x8 k0 = *(const bf16x8*)(Ks + (sb * 32 + fr) * 72 + dh * 32 + fq * 8), k1 = *(const bf16x8*)(Ks + (sb * 32 + 16 + fr) * 72 + dh * 32 + fq * 8);
                s0 = __builtin_amdgcn_mfma_f32_16x16x32_bf16(k0, qf[dh], s0, 0, 0, 0);
                s1 = __builtin_amdgcn_mfma_f32_16x16x32_bf16(k1, qf[dh], s1, 0, 0, 0);
            }
            if (mask) {
#pragma unroll
                for (int j = 0; j < 4; ++j) { const int k0p = kpos0 + sb * 32 + fq * 4 + j, k1p = k0p + 16; int d0 = qpos - k0p, d1 = qpos - k1p; d0 = d0 < 0 ? -d0 : d0; d1 = d1 < 0 ? -d1 : d1;
                    if (d0 > 128) s0[j] = -1e30f; if (d1 > 128) s1[j] = -1e30f; }
            }
            sc[sb][0] = s0; sc[sb][1] = s1;
        }
        float mx = -1e30f;
#pragma unroll
        for (int sb = 0; sb < 4; ++sb)
#pragma unroll
            for (int j = 0; j < 4; ++j) mx = fmaxf(mx, fmaxf(sc[sb][0][j], sc[sb][1][j]));
        mx = fmaxf(mx, __shfl_xor(mx, 16)); mx = fmaxf(mx, __shfl_xor(mx, 32));
        const float mn = fmaxf(m, mx), alpha = __expf(m - mn);
        m = mn; lsum *= alpha; lpart *= alpha;
#pragma unroll
        for (int dt = 0; dt < 4; ++dt) oacc[dt] = oacc[dt] * alpha;
#pragma unroll
        for (int sb = 0; sb < 4; ++sb) {
            f32x4 s0 = sc[sb][0], s1 = sc[sb][1];
#pragma unroll
            for (int j = 0; j < 4; ++j) { s0[j] = __expf(s0[j] - mn); s1[j] = __expf(s1[j] - mn); lpart += s0[j] + s1[j]; }
            u32x4 pw; pw[0] = cvt_pk_bf16(s0[0], s0[1]); pw[1] = cvt_pk_bf16(s0[2], s0[3]); pw[2] = cvt_pk_bf16(s1[0], s1[1]); pw[3] = cvt_pk_bf16(s1[2], s1[3]);
            bf16x8 pf; __builtin_memcpy(&pf, &pw, 16);
#pragma unroll
            for (int dt = 0; dt < 4; ++dt) {
                const bf16_t* vp = Vt + (dt * 16 + fr) * 136 + sb * 32 + fq * 4;
                u32x4 vw; const u32x2 va = *(const u32x2*)vp, vb = *(const u32x2*)(vp + 16); vw[0] = va[0]; vw[1] = va[1]; vw[2] = vb[0]; vw[3] = vb[1];
                bf16x8 vf; __builtin_memcpy(&vf, &vw, 16);
                oacc[dt] = __builtin_amdgcn_mfma_f32_16x16x32_bf16(vf, pf, oacc[dt], 0, 0, 0);
            }
        }
    }
    lpart += __shfl_xor(lpart, 16); lpart += __shfl_xor(lpart, 32);
    lsum += lpart;
    const float inv = 1.0f / lsum;
    const size_t t = (size_t)(qbase + wid * 16 + fr);
#pragma unroll
    for (int dt = 0; dt < 4; ++dt) {
        const int col = 512 + head * 64 + dt * 16 + fq * 4;
        const bf16x4 z = *(const bf16x4*)(Z + t * DM + col);
        u32x2 w; w[0] = cvt_pk_bf16(oacc[dt][0] * inv * bf2f((bf16_t)z[0]), oacc[dt][1] * inv * bf2f((bf16_t)z[1]));
        w[1] = cvt_pk_bf16(oacc[dt][2] * inv * bf2f((bf16_t)z[2]), oacc[dt][3] * inv * bf2f((bf16_t)z[3]));
        *(u32x2*)(YS + t * DM + col) = w;
    }
}

__device__ void chunk_item(const Params& p, int l, int ci, unsigned char* ldsb) {
    const int tid = TID(), lane = tid & 63, wid = tid >> 6, fr = lane & 15, fq = lane >> 4;
    const int chunk = ci >> 2, g = ci & 3, base = chunk * 128;
    bf16_t* wsb = (bf16_t*)ldsb;
    bf16_t* vt = wsb + 128 * 136;
    const float* P = (const float*)(PWS + WS_P);
    const bf16_t* Z = (const bf16_t*)(PWS + WS_Z);
    bf16_t* YS = (bf16_t*)(PWS + WS_YS);
    const float* wsrc = PIN(11) + (size_t)(l * 4 + g) * 128 * 128;
    __syncthreads();
#pragma unroll
    for (int i = 0; i < 8; ++i) { const int idx = tid + i * 512, r = idx >> 5, c4 = (idx & 31) * 4; const f32x4 v = *(const f32x4*)(wsrc + r * 128 + c4);
        u32x2 w; w[0] = cvt_pk_bf16(v[0], v[1]); w[1] = cvt_pk_bf16(v[2], v[3]); *(u32x2*)(wsb + r * 136 + c4) = w; }
    stage_vt(P + (size_t)base * PW + C_AV + g * 64, PW, vt, 128);
    __syncthreads();
    f32x4 acc[4];
#pragma unroll
    for (int n = 0; n < 4; ++n) acc[n] = (f32x4){0.f, 0.f, 0.f, 0.f};
#pragma unroll
    for (int k = 0; k < 4; ++k) {
        const bf16x8 af = *(const bf16x8*)(wsb + (wid * 16 + fr) * 136 + k * 32 + fq * 8);
#pragma unroll
        for (int n = 0; n < 4; ++n) { const bf16x8 bfv = *(const bf16x8*)(vt + (n * 16 + fr) * 136 + k * 32 + fq * 8);
            acc[n] = __builtin_amdgcn_mfma_f32_16x16x32_bf16(bfv, af, acc[n], 0, 0, 0); }
    }
    const int i = wid * 16 + fr; const size_t t = base + i;
    const float bsi = PIN(12)[(l * 4 + g) * 128 + i];
#pragma unroll
    for (int n = 0; n < 4; ++n) { const int col = g * 64 + n * 16 + fq * 4;
        const f32x4 u = *(const f32x4*)(P + t * PW + C_AU + col);
        const bf16x4 z = *(const bf16x4*)(Z + t * DM + col);
        u32x2 w; w[0] = cvt_pk_bf16(u[0] * (acc[n][0] + bsi) * bf2f((bf16_t)z[0]), u[1] * (acc[n][1] + bsi) * bf2f((bf16_t)z[1]));
        w[1] = cvt_pk_bf16(u[2] * (acc[n][2] + bsi) * bf2f((bf16_t)z[2]), u[3] * (acc[n][3] + bsi) * bf2f((bf16_t)z[3]));
        *(u32x2*)(YS + t * DM + col) = w; }
}

__device__ void pool_item(const Params& p, int l, int pi, unsigned char* ldsb) {
    const int tid = TID(), lane = tid & 63, wid = tid >> 6, fr = lane & 15, fq = lane >> 4, half = tid >> 8, ch = tid & 255, g = ch >> 6;
    const int tb = pi * 32; int seqbase, L, pos0; seq_of(tb, seqbase, L, pos0);
    float* pt = (float*)ldsb;
    bf16_t* dl = (bf16_t*)(pt + 48 * 256);
    bf16_t* wt = dl + 32 * 264;
    const float* P = (const float*)(PWS + WS_P);
    const bf16_t* Z = (const bf16_t*)(PWS + WS_Z);
    bf16_t* YS = (bf16_t*)(PWS + WS_YS);
    __syncthreads();
#pragma unroll
    for (int i = 0; i < 6; ++i) { const int idx = tid + i * 512, rr = idx >> 6, c4 = (idx & 63) * 4; const int pos = pos0 - 8 + rr;
        f32x4 v = (f32x4){0.f, 0.f, 0.f, 0.f};
        if (pos >= 0 && pos < L) v = *(const f32x4*)(P + (size_t)(seqbase + pos) * PW + C_DP + c4);
        *(f32x4*)(pt + rr * 256 + c4) = v; }
    { const float* pwsrc = PIN(23) + (size_t)l * 4 * 64 * 64;
#pragma unroll
      for (int gg = 0; gg < 4; ++gg) stage_vt(pwsrc + gg * 4096, 64, wt + gg * 64 * 72, 64, 72); }
    __syncthreads();
    const int w = 2 << g;
    for (int i = 0; i < 16; ++i) { const int tk = half * 16 + i, pos = pos0 + tk;
        int lo = pos - (w >> 1), hi = lo + w; lo = lo < 0 ? 0 : lo; hi = hi > L ? L : hi;
        float sm = 0.f;
        for (int q = lo; q < hi; ++q) sm += pt[(q - pos0 + 8) * 256 + ch];
        dl[tk * 264 + ch] = f2bf(sm / (float)(hi - lo) - pt[(tk + 8) * 256 + ch]); }
    __syncthreads();
    const int gw = wid >> 1, th = wid & 1;
    f32x4 acc[4];
#pragma unroll
    for (int n = 0; n < 4; ++n) acc[n] = (f32x4){0.f, 0.f, 0.f, 0.f};
#pragma unroll
    for (int k = 0; k < 2; ++k) {
        const bf16x8 af = *(const bf16x8*)(dl + (th * 16 + fr) * 264 + gw * 64 + k * 32 + fq * 8);
#pragma unroll
        for (int n = 0; n < 4; ++n) { const bf16x8 bfv = *(const bf16x8*)(wt + (gw * 64 + n * 16 + fr) * 72 + k * 32 + fq * 8);
            acc[n] = __builtin_amdgcn_mfma_f32_16x16x32_bf16(bfv, af, acc[n], 0, 0, 0); }
    }
    const size_t t = tb + th * 16 + fr;
#pragma unroll
    for (int n = 0; n < 4; ++n) { const int oc = gw * 64 + n * 16 + fq * 4;
        const f32x4 sc = *(const f32x4*)(PIN(24) + l * 256 + oc);
        const bf16x4 z = *(const bf16x4*)(Z + t * DM + 768 + oc);
        u32x2 wv; wv[0] = cvt_pk_bf16(acc[n][0] * sc[0] * bf2f((bf16_t)z[0]), acc[n][1] * sc[1] * bf2f((bf16_t)z[1]));
        wv[1] = cvt_pk_bf16(acc[n][2] * sc[2] * bf2f((bf16_t)z[2]), acc[n][3] * sc[3] * bf2f((bf16_t)z[3]));
        *(u32x2*)(YS + t * DM + 768 + oc) = wv; }
}

__device__ void phaseB1(const Params& p, int l, unsigned char* lds, int slot = 0, int part = 127) {
    const int tid = TID(), wid = tid >> 6;
    float* wl = (float*)lds + wid * 3072;
    if (!(part & 1)) {} else
    { const int nbh = (int)gridDim.x >> 1;
      if ((int)blockIdx.x < nbh) { if (wid < 4 && (part & 4)) for (int it = blockIdx.x * 4 + wid; it < 512; it += nbh * 4) { const int q = it >> 4, b = q >> 3;
            scan_run<1>(p, l, true, b, (q >> 1) & 3, q & 1, it & 15, 1024, NTP + b * 1024, wl); } }
      else { const int nb2 = (int)gridDim.x - nbh; if (part & 8) for (int it = ((int)blockIdx.x - nbh) * 8 + wid; it < 1024; it += nb2 * 8) { const int q = it >> 3, b = q >> 3;
            scan_run<2>(p, l, false, b, (q >> 1) & 3, q & 1, it & 7, 256, b * 256, wl); } } }
    __syncthreads();
    __shared__ int s_item;
    unsigned* ctr = (unsigned*)(PWS + WS_CTR) + l + 2 * slot;
    if (part & 2)
    for (;;) {
        if (tid == 0) s_item = (int)atomicAdd(ctr, 1u);
        __syncthreads();
        const int item = s_item;
        __syncthreads();
        if (item >= 768) break;
        if (item < 256) { if (part & 16) attn_item(p, l, item, lds); }
        else if (item < 512) { if (part & 32) chunk_item(p, l, item - 256, lds); }
        else { if (part & 64) pool_item(p, l, item - 512, lds); }
    }
}

__device__ void phaseB2(const Params& p, int l) {
    const int lane = TID() & 63, gw = blockIdx.x * 8 + (TID() >> 6), W = gridDim.x * 8;
    const float* O = (const float*)(PWS + WS_O);
    const float* recS = (const float*)(PWS + WS_RECS);
    const float* BC = (const float*)(PWS + WS_BC);
    const bf16_t* Z = (const bf16_t*)(PWS + WS_Z);
    bf16_t* YS = (bf16_t*)(PWS + WS_YS);
    const float* lng = PIN(20) + l * 256; const float* lnb = PIN(21) + l * 256;
    float g4[4], b4[4];
#pragma unroll
    for (int h = 0; h < 4; ++h) { g4[h] = lng[h * 64 + lane]; b4[h] = lnb[h * 64 + lane]; }
    for (int tok = gw; tok < NT; tok += W) {
        int seqbase, L, pos; seq_of(tok, seqbase, L, pos);
        float o[4], vv[4], z[4], mu[4], var[4];
        const f32x4 bc = *(const f32x4*)(BC + tok * 4);
#pragma unroll
        for (int h = 0; h < 4; ++h) { const int c = h * 64 + lane;
            o[h] = O[(size_t)tok * 256 + c] + O[(size_t)NT * 256 + (size_t)tok * 256 + c];
            vv[h] = recS[((size_t)seqbase * 4 + (size_t)h * L + pos) * 192 + 128 + lane];
            z[h] = bf2f(Z[(size_t)tok * DM + 256 + c]); }
#pragma unroll
        for (int h = 0; h < 4; ++h) mu[h] = wave_sum(o[h]) * (1.0f / 64.0f);
#pragma unroll
        for (int h = 0; h < 4; ++h) { o[h] -= mu[h]; var[h] = wave_sum(o[h] * o[h]) * (1.0f / 64.0f); }
#pragma unroll
        for (int h = 0; h < 4; ++h) { const float on = o[h] * rsqrtf(var[h] + 64e-5f);
            const float y = on * g4[h] + b4[h] + bc[h] * vv[h];
            YS[(size_t)tok * DM + 256 + h * 64 + lane] = f2bf(y * z[h]); }
    }
}

__device__ void phaseC1(const Params& p, int l, unsigned char* lds) {
    pg8::Gemm g; g.A = (const bf16_t*)(PWS + WS_H); g.Bt = (const bf16_t*)(PWS + WS_WTIN) + (size_t)l * INW * 1024 + (size_t)NA_COLS * 1024; g.M = NT; g.N = 4096; g.K = 1024;
    pg8::StaticOrder S; S.init(g.M, g.N, (int)gridDim.x, (int)blockIdx.x);
    EpiG E; E.G = (bf16_t*)(PWS + WS_G);
    pg8::gemm_phase<EpiG, pg8::StaticOrder, false>((PG8_LAS unsigned char*)lds, g, S, E, nullptr);
    __syncthreads();
}
__device__ void phaseC2(const Params& p, int l, unsigned char* lds) {
    constexpr int MT = 4, LDT = 72, A_BYTES = 256 * LDT * 2, B_BYTES = 128 * LDT * 2, BUF = A_BYTES + B_BYTES;
    const int tid = TID(), lane = tid & 63, wid = tid >> 6, wr = wid >> 1, wc = wid & 1, fr = lane & 15, fq = lane >> 4;
    const bf16_t* YS = (const bf16_t*)(PWS + WS_YS);
    const bf16_t* G = (const bf16_t*)(PWS + WS_G);
    const bf16_t* Wu = (const bf16_t*)(PWS + WS_WTUP) + (size_t)l * 4 * 1024 * 256;
    bf16_t* MG = (bf16_t*)(PWS + WS_MERGED);
    const int srow = tid >> 3, skc = tid & 7, soff = (srow * LDT + skc * 8) * 2;
    const int aoff = ((wr * MT * 16 + fr) * LDT + fq * 8) * 2, boff = A_BYTES + ((wc * 64 + fr) * LDT + fq * 8) * 2;
    const int NU = 32 * 8;
    for (int u = blockIdx.x; u < NU; u += gridDim.x) {
        const int pn = u / 32, pm = u % 32;
        const bf16_t* Ag = YS + ((size_t)pm * 256 + srow) * 1024 + skc * 8;
        const bf16_t* Bg = Wu + ((size_t)pn * 128 + srow) * 256 + skc * 8;
        f32x4 mg[4][4], acc[4][4]; zero_acc<4>(mg); zero_acc<4>(acc);
        u32x4 ra[MT], rb[2];
        auto gload = [&](int kt) {
#pragma unroll
            for (int i = 0; i < MT; ++i) ra[i] = *(const u32x4*)(Ag + (size_t)i * 64 * 1024 + kt * 64);
            const bf16_t* bb = Bg + (size_t)(kt >> 2) * 1024 * 256 + (kt & 3) * 64;
#pragma unroll
            for (int i = 0; i < 2; ++i) rb[i] = *(const u32x4*)(bb + (size_t)i * 64 * 256);
        };
        auto sstore = [&](int buf) { unsigned char* nb = lds + buf * BUF;
#pragma unroll
            for (int i = 0; i < MT; ++i) *(u32x4*)(nb + soff + i * 64 * LDT * 2) = ra[i];
#pragma unroll
            for (int i = 0; i < 2; ++i) *(u32x4*)(nb + A_BYTES + soff + i * 64 * LDT * 2) = rb[i];
        };
        __syncthreads();
        gload(0); sstore(0);
        __syncthreads();
        for (int t = 0; t < 16; ++t) {
            if (t + 1 < 16) gload(t + 1);
            const unsigned char* base = lds + (t & 1) * BUF;
#pragma unroll
            for (int kk = 0; kk < 2; ++kk) {
                bf16x8 af[MT], bfr[4];
#pragma unroll
                for (int m = 0; m < MT; ++m) af[m] = *(const bf16x8*)(base + aoff + m * 16 * LDT * 2 + kk * 64);
#pragma unroll
                for (int n = 0; n < 4; ++n) bfr[n] = *(const bf16x8*)(base + boff + n * 16 * LDT * 2 + kk * 64);
#pragma unroll
                for (int m = 0; m < MT; ++m)
#pragma unroll
                    for (int n = 0; n < 4; ++n) acc[m][n] = __builtin_amdgcn_mfma_f32_16x16x32_bf16(bfr[n], af[m], acc[m][n], 0, 0, 0);
            }
            if (t + 1 < 16) sstore((t + 1) & 1);
            if ((t & 3) == 3) {
                const int n = t >> 2;
#pragma unroll
                for (int m = 0; m < 4; ++m) { const int row = pm * 256 + wr * 64 + m * 16 + fr;
                    const bf16_t* gp = G + g_off(row, n * 1024 + pn * 128 + wc * 64 + fq * 4);
                    const bf16x8 ga = *(const bf16x8*)gp, gb = *(const bf16x8*)(gp + 8);
#pragma unroll
                    for (int q = 0; q < 4; ++q) {
#pragma unroll
                        for (int j = 0; j < 4; ++j) { const bf16_t gv = (bf16_t)(q < 2 ? ga[q * 4 + j] : gb[(q - 2) * 4 + j]); mg[m][q][j] += bf2f(gv) * acc[m][q][j]; }
                        acc[m][q] = (f32x4){0.f, 0.f, 0.f, 0.f}; } }
            }
            __syncthreads();
        }
#pragma unroll
        for (int m = 0; m < 4; ++m) { const size_t row = (size_t)pm * 256 + wr * 64 + m * 16 + fr;
#pragma unroll
            for (int q = 0; q < 4; ++q) { const int col = pn * 128 + wc * 64 + q * 16 + fq * 4;
                u32x2 w; w[0] = cvt_pk_bf16(mg[m][q][0], mg[m][q][1]); w[1] = cvt_pk_bf16(mg[m][q][2], mg[m][q][3]);
                *(u32x2*)(MG + row * DM + col) = w; } }
    }
}

__device__ void phaseD(const Params& p, int l, unsigned char* lds) {
    const int tid = TID(), lane = tid & 63, wid = tid >> 6, wr = wid >> 1, wc = wid & 1, fr = lane & 15, fq = lane >> 4;
    const bf16_t* MG = (const bf16_t*)(PWS + WS_MERGED);
    const bf16_t* Wo = (const bf16_t*)(PWS + WS_WTO) + (size_t)l * 1024 * 1024;
    const int NU = 32 * 8;
    for (int u = blockIdx.x; u < NU; u += gridDim.x) {
        const int pn = u / 32, pm = u % 32;
        f32x4 acc[4][4]; zero_acc<4>(acc);
        gemm_acc<4>(MG + (size_t)pm * 256 * 1024, 1024, Wo + (size_t)pn * 128 * 1024, 1024, 1024, acc, lds);
        float ssq[4];
#pragma unroll
        for (int m = 0; m < 4; ++m) { const int row = pm * 256 + wr * 64 + m * 16 + fr;
            const float* xr = xrow_ptr(p, l, row);
            const float* gate = (const float*)(PWS + WS_MOD) + (size_t)(l * 5 + modrow_of(row)) * 3072 + 2048;
            float sm = 0.f;
#pragma unroll
            for (int q = 0; q < 4; ++q) { const int col = pn * 128 + wc * 64 + q * 16 + fq * 4;
                const f32x4 xo = *(const f32x4*)(xr + col), gt = *(const f32x4*)(gate + col);
                acc[m][q] = xo + gt * acc[m][q];
                sm += (acc[m][q][0] * acc[m][q][0] + acc[m][q][1] * acc[m][q][1]) + (acc[m][q][2] * acc[m][q][2] + acc[m][q][3] * acc[m][q][3]); }
            sm += __shfl_xor(sm, 16); sm += __shfl_xor(sm, 32);
            ssq[m] = sm; }
        float* Pt = (float*)lds;
        float* St = Pt + 512;
        if (fq == 0) {
#pragma unroll
            for (int m = 0; m < 4; ++m) Pt[(wr * 64 + m * 16 + fr) * 2 + wc] = ssq[m]; }
        __syncthreads();
        float* XP = (float*)(PWS + WS_XP) + ((size_t)(l * 32 + pm) * 256) * 8;
        unsigned* cnt = (unsigned*)(PWS + WS_XCNT) + (size_t)(l * 32 + pm) * 64;
        if (tid < 256) __hip_atomic_store(XP + tid * 8 + pn, Pt[tid * 2] + Pt[tid * 2 + 1], __ATOMIC_RELAXED, __HIP_MEMORY_SCOPE_AGENT);
        asm volatile("s_waitcnt vmcnt(0)" ::: "memory");
        __syncthreads();
        if (tid == 0) {
            __hip_atomic_fetch_add(cnt, 1u, __ATOMIC_RELAXED, __HIP_MEMORY_SCOPE_AGENT);
            unsigned spins = 0;
            while (__hip_atomic_load(cnt, __ATOMIC_RELAXED, __HIP_MEMORY_SCOPE_AGENT) < 8u) { __builtin_amdgcn_s_sleep(2); if (++spins > (1u << 22)) break; }
            __builtin_amdgcn_fence(__ATOMIC_ACQUIRE, "agent");
            asm volatile("s_waitcnt vmcnt(0)" ::: "memory");
        }
        __syncthreads();
        if (tid < 256) { float t = 0.f;
#pragma unroll
            for (int k = 0; k < 8; ++k) t += __hip_atomic_load(XP + tid * 8 + k, __ATOMIC_RELAXED, __HIP_MEMORY_SCOPE_AGENT);
            St[tid] = rsqrtf(t * (1.0f / 1024.0f) + 1e-6f); }
        __syncthreads();
        const float* gn = (l == 0) ? PIN(9) + DM : PIN(27);
        bf16_t* H = (bf16_t*)(PWS + WS_H);
#pragma unroll
        for (int m = 0; m < 4; ++m) { const int rl_ = wr * 64 + m * 16 + fr, row = pm * 256 + rl_;
            const float rs = St[rl_];
            const float* md = (const float*)(PWS + WS_MOD) + (size_t)(5 + modrow_of(row)) * 3072;
#pragma unroll
            for (int q = 0; q < 4; ++q) { const int col = pn * 128 + wc * 64 + q * 16 + fq * 4;
                const f32x4 gg = *(const f32x4*)(gn + col);
                if (l == 0) { *(f32x4*)(POUT + (size_t)row * DM + col) = acc[m][q];
                    const f32x4 sh = *(const f32x4*)(md + col), scl = *(const f32x4*)(md + 1024 + col);
                    const f32x4 h = acc[m][q] * rs * gg * (1.0f + scl) + sh;
                    u32x2 w; w[0] = cvt_pk_bf16(h[0], h[1]); w[1] = cvt_pk_bf16(h[2], h[3]); *(u32x2*)(H + (size_t)row * DM + col) = w; }
                else *(f32x4*)(POUT + (size_t)row * DM + col) = acc[m][q] * rs * gg; } }
    }
}

__device__ void phaseF(const Params& p) {
    const int lane = TID() & 63, gw = blockIdx.x * 8 + (TID() >> 6), W = gridDim.x * 8;
    const float* g = PIN(27);
    for (int row = gw; row < NT; row += W) {
        float* x = POUT + (size_t)row * DM;
        f32x4 v[4]; float ss = 0.f;
#pragma unroll
        for (int i = 0; i < 4; ++i) { v[i] = *(const f32x4*)(x + i * 256 + lane * 4); ss += v[i][0] * v[i][0] + v[i][1] * v[i][1] + v[i][2] * v[i][2] + v[i][3] * v[i][3]; }
        ss = wave_sum(ss);
        const float rs = rsqrtf(ss * (1.0f / 1024.0f) + 1e-6f);
#pragma unroll
        for (int i = 0; i < 4; ++i) { const int c = i * 256 + lane * 4; *(f32x4*)(x + c) = v[i] * rs * *(const f32x4*)(g + c); }
    }
}

__global__ void __launch_bounds__(NTHREADS) fwd_megakernel(Params p) {
    extern __shared__ __attribute__((aligned(16))) unsigned char lds[];
    volatile LAS unsigned* st = (volatile LAS unsigned*)(lds + LDS_MAIN);
    if (threadIdx.x < 2) st[threadIdx.x] = 0u;
    if (threadIdx.x == 0) {
#pragma unroll
        for (int i = 0; i < 28; ++i) s_ptab[i] = (unsigned long long)p.in[i];
    }
    __syncthreads();
    const XcdBarrier xb = xcd_barrier_post((unsigned*)(PWS + WS_BAR), st);
#define GSYNC() xcd_barrier(xb)
    phase0(p, lds);
    GSYNC();
#pragma unroll 1
    for (int l = 0; l < 2; ++l) {
#pragma unroll 1
        for (int ap = 0; ap < 2; ++ap) { phaseA(p, l, lds, ap); if (ap == 0) GSYNC(); }
        phaseB0(p, l, lds);
        GSYNC();
        phaseB1(p, l, lds);
        GSYNC();
        phaseB2(p, l);
        phaseC1(p, l, lds);
        GSYNC();
        phaseC2(p, l, lds);
        GSYNC();
        phaseD(p, l, lds);
        if (l == 0) GSYNC();
    }
}

extern "C" void kernel_launch(void* const* d_in, const int* in_sizes, int n_in, void* d_out, int out_size, void* d_ws, size_t ws_size, hipStream_t stream) {
    static int grid_blocks = 0;
    if (!grid_blocks) {
        int dev = 0, cus = 0, per_cu = 0;
        hipGetDevice(&dev);
        hipDeviceGetAttribute(&cus, hipDeviceAttributeMultiprocessorCount, dev);
        hipFuncSetAttribute((const void*)fwd_megakernel, hipFuncAttributeMaxDynamicSharedMemorySize, LDS_BYTES);
        hipOccupancyMaxActiveBlocksPerMultiprocessor(&per_cu, (const void*)fwd_megakernel, NTHREADS, LDS_BYTES);
        if (per_cu < 1) { fprintf(stderr, "occupancy query returned %d\n", per_cu); per_cu = 1; }
        if (per_cu > 1) per_cu = 1;
        grid_blocks = cus * per_cu;
        if (ws_size < WS_END) fprintf(stderr, "workspace too small: %zu < %zu\n", ws_size, (size_t)WS_END);
    }
    Params p{};
    for (int i = 0; i < 28; ++i) p.in[i] = (const float*)d_in[i];
    p.out = (float*)d_out; p.ws = (unsigned char*)d_ws;
    hipMemsetAsync((char*)d_ws + WS_CTR, 0, 256 + 3456 * 4, stream);
    void* args[] = {&p};
    hipError_t e = hipLaunchCooperativeKernel((const void*)fwd_megakernel, dim3(grid_blocks), dim3(NTHREADS), args, LDS_BYTES, stream);
    if (e != hipSuccess) fprintf(stderr, "cooperative launch failed: %s (grid %d)\n", hipGetErrorString(e), grid_blocks);
}
```

```cpp
#include <hip/hip_runtime.h>
#include <hip/hip_cooperative_groups.h>
#include <cstdio>
namespace cg = cooperative_groups;

typedef unsigned short bf16_t;
typedef short bf16x8 __attribute__((ext_vector_type(8)));
typedef short bf16x4 __attribute__((ext_vector_type(4)));
typedef float f32x4 __attribute__((ext_vector_type(4)));
typedef float f32x2 __attribute__((ext_vector_type(2)));
typedef unsigned u32x4 __attribute__((ext_vector_type(4)));
typedef unsigned u32x2 __attribute__((ext_vector_type(2)));

constexpr int NT = 8192, NTP = 4096, DM = 1024, INW = 7296, NA_COLS = 3200, PW = 2176;
constexpr int NTHREADS = 512;
constexpr int C_AU = 0, C_AV = 256, C_BR = 512, C_BK = 768, C_BV = 1024, C_WD = 1280, C_AD = 1344, C_CQ = 1408, C_CK = 1664, C_CV = 1792, C_DP = 1920;
constexpr size_t O_YP = 0, O_YS = 4194304, O_NK = 8388608, O_NV = 9437184, O_NS = 10485760;
constexpr size_t WS_WTIN = 0;
constexpr size_t WS_WTUP = WS_WTIN + (size_t)2 * INW * DM * 2;
constexpr size_t WS_WTO  = WS_WTUP + (size_t)2 * 4 * 1024 * 256 * 2;
constexpr size_t WS_MOD  = WS_WTO + (size_t)2 * 1024 * 1024 * 2;
constexpr size_t WS_ROPE = WS_MOD + (size_t)2 * 5 * 3072 * 4;
constexpr size_t WS_CTR  = WS_ROPE + 64 * 16 * 8;
constexpr size_t WS_BAR  = WS_CTR + 256;
constexpr size_t WS_H    = WS_BAR + 3456 * 4;
constexpr size_t WS_P    = WS_H + (size_t)NT * DM * 2;
constexpr size_t WS_Z    = WS_P + (size_t)NT * PW * 4;
constexpr size_t WS_RECS = WS_Z + (size_t)NT * DM * 2;
constexpr size_t WS_RECD = WS_RECS + (size_t)NT * 4 * 192 * 4;
constexpr size_t WS_O    = WS_RECD + (size_t)2 * NT * 4 * 192 * 4;
constexpr size_t WS_BC   = WS_O + (size_t)2 * NT * 256 * 4;
constexpr size_t WS_YS   = WS_BC + (size_t)NT * 4 * 4;
constexpr size_t WS_LORAT = WS_YS + (size_t)NT * DM * 2;
constexpr size_t WS_XP   = WS_LORAT + (size_t)2 * 4 * 256 * 64 * 2;
constexpr size_t WS_XCNT = WS_XP + (size_t)2 * 32 * 256 * 8 * 4;
constexpr size_t WS_END  = WS_XCNT + (size_t)4 * 32 * 256;
constexpr size_t WS_G = WS_P;
constexpr size_t WS_MERGED = WS_RECS;
constexpr size_t RECD_STRIDE = (size_t)NT * 4 * 192;

constexpr int LDS_MAIN = 131072;
constexpr int LDS_BYTES = LDS_MAIN + 16;

struct Params {
    const float* in[28];
    float* out;
    unsigned char* ws;
};
__shared__ unsigned long long s_ptab[28];
__device__ __forceinline__ const float* ld_inptr(int k) {
    const unsigned long long v = s_ptab[k];
    const unsigned lo = __builtin_amdgcn_readfirstlane((unsigned)v), hi = __builtin_amdgcn_readfirstlane((unsigned)(v >> 32));
    return (const float*)(((unsigned long long)hi << 32) | lo);
}
#define PIN(k) (ld_inptr(k))
#define POUT (p.out)
#define PWS (p.ws)

__device__ __forceinline__ int TID() { int t = threadIdx.x; asm volatile("" : "+v"(t)); return t; }
__device__ __forceinline__ unsigned cvt_pk_bf16(float lo, float hi) { unsigned r; asm volatile("v_cvt_pk_bf16_f32 %0, %1, %2" : "=v"(r) : "v"(lo), "v"(hi)); return r; }
__device__ __forceinline__ bf16_t f2bf(float f) { return (bf16_t)(cvt_pk_bf16(f, 0.f) & 0xffffu); }
__device__ __forceinline__ float bf2f(bf16_t b) { return __uint_as_float(((unsigned)b) << 16); }
__device__ __forceinline__ float sigmoidf_(float x) { return 1.0f / (1.0f + __expf(-x)); }
__device__ __forceinline__ float siluf_(float x) { return x / (1.0f + __expf(-x)); }
template <int CTRL> __device__ __forceinline__ float dpp_f(float x) { return __int_as_float(__builtin_amdgcn_update_dpp(0, __float_as_int(x), CTRL, 0xF, 0xF, false)); }
__device__ __forceinline__ float row16_sum(float x) {
    x += dpp_f<0x128>(x); x += dpp_f<0x124>(x); x += dpp_f<0x122>(x); x += dpp_f<0x121>(x); return x;
}
__device__ __forceinline__ float wave_sum(float v) { v = row16_sum(v); v += __shfl_xor(v, 16); v += __shfl_xor(v, 32); return v; }
__device__ __forceinline__ void seq_of(int tok, int& seqbase, int& L, int& pos) {
    if (tok < NTP) { seqbase = tok & ~255; L = 256; pos = tok & 255; }
    else { int t2 = tok - NTP; seqbase = NTP + (t2 & ~1023); L = 1024; pos = t2 & 1023; }
}
__device__ __forceinline__ int modrow_of(int tok) { return tok < NTP ? 0 : 1 + ((tok - NTP) >> 10); }


#define XB_TMO      128
#define XB_XCNT(j)  (256  + 64 * (j))
#define XB_XSUB(j)  (1280 + 64 * (j))
#define XB_XGEN(j)  (2304 + 64 * (j))
#define XB_TOP      3328
#define XB_TOPGEN   3392
#define XCD_BAR_WORDS 3456
#define XB_SPIN_CAP (1u << 18)
#define LAS __attribute__((address_space(3)))
__device__ __forceinline__ unsigned xb_ld(unsigned* p)              { return __hip_atomic_load(p, __ATOMIC_RELAXED, __HIP_MEMORY_SCOPE_AGENT); }
__device__ __forceinline__ unsigned xb_add(unsigned* p, unsigned v) { return __hip_atomic_fetch_add(p, v, __ATOMIC_RELAXED, __HIP_MEMORY_SCOPE_AGENT); }
__device__ __forceinline__ unsigned xb_xcc_id() { return (unsigned)__builtin_amdgcn_s_getreg((3 << 11) | 20) & 0xFu; }
#define XB_SPIN(cond, bar) do { unsigned _sp = 0; while (cond) { __builtin_amdgcn_s_sleep(1); \
    if ((++_sp & 255u) == 0u) { if (xb_ld(&(bar)[XB_TMO])) break; if (_sp > XB_SPIN_CAP) { atomicAdd(&(bar)[XB_TMO], 1u); break; } } } } while (0)
struct XcdBarrier { unsigned* bar; unsigned x; volatile LAS unsigned* st; };
__device__ __forceinline__ XcdBarrier xcd_barrier_post(unsigned* bar, volatile LAS unsigned* st) {
    XcdBarrier b; b.bar = bar; b.x = xb_xcc_id(); b.st = st;
    if (threadIdx.x == 0) (void)xb_add(&bar[XB_XCNT(b.x)], 1u);
    return b;
}
__device__ __forceinline__ void xcd_barrier_complete(unsigned* bar, unsigned x, unsigned& nloc, unsigned& nx) {
    const unsigned G = gridDim.x * gridDim.y * gridDim.z;
    unsigned sum, cnt, mine, sp = 0u;
    for (;;) {
        sum = 0u; cnt = 0u; mine = 0u;
#pragma unroll
        for (unsigned j = 0; j < 16; ++j) { const unsigned c = xb_ld(&bar[XB_XCNT(j)]); sum += c; cnt += (c > 0u) ? 1u : 0u; mine = (j == x) ? c : mine; }
        if (sum == G) break;
        __builtin_amdgcn_s_sleep(1);
        if ((++sp & 255u) == 0u) { if (xb_ld(&bar[XB_TMO])) break; if (sp > XB_SPIN_CAP) { atomicAdd(&bar[XB_TMO], 1u); break; } }
    }
    nloc = mine > 0u ? mine : 1u; nx = cnt > 0u ? cnt : 1u;
}
__device__ __forceinline__ void xcd_barrier(const XcdBarrier& b0) {
    asm volatile("s_waitcnt vmcnt(0)" ::: "memory");
    __syncthreads();
    if (threadIdx.x == 0) {
        XcdBarrier b = b0;
        { unsigned xx = xb_xcc_id(); asm volatile("" : "+s"(xx)); b.x = xx; }
        unsigned* bar = b.bar;
        __builtin_amdgcn_s_waitcnt(0);
        unsigned nloc = b.st[0], nx = b.st[1];
        if (nloc == 0u) { xcd_barrier_complete(bar, b.x, nloc, nx); b.st[0] = nloc; b.st[1] = nx; }
        const unsigned old = xb_add(&bar[XB_XSUB(b.x)], 1u);
        const unsigned gen = old / nloc;
        if (old + 1u == (gen + 1u) * nloc) {
            __builtin_amdgcn_fence(__ATOMIC_RELEASE, "agent");
            asm volatile("s_waitcnt vmcnt(0)" ::: "memory");
            const unsigned og = xb_add(&bar[XB_TOP], 1u);
            const unsigned tg = og / nx;
            if (og + 1u == (tg + 1u) * nx) xb_add(&bar[XB_TOPGEN], 1u);
            else XB_SPIN(xb_ld(&bar[XB_TOPGEN]) == tg, bar);
            __builtin_amdgcn_fence(__ATOMIC_ACQUIRE, "agent");
            xb_add(&bar[XB_XGEN(b.x)], 1u);
            asm volatile("s_waitcnt vmcnt(0)" ::: "memory");
        } else {
            XB_SPIN(xb_ld(&bar[XB_XGEN(b.x)]) == gen, bar);
            __builtin_amdgcn_fence(__ATOMIC_ACQUIRE, "agent");
            asm volatile("s_waitcnt vmcnt(0)" ::: "memory");
        }
    }
    __syncthreads();
}

__device__ void conv_tile(const float* __restrict__ src, int N, bf16_t* __restrict__ dst, int K, int kt, int nt, float* tile) {
    const int tid = TID();
    { const int r = tid >> 4, c4 = (tid & 15) * 4;
#pragma unroll
      for (int i = 0; i < 2; ++i) { const int k = r + 32 * i; const f32x4 v = *(const f32x4*)(src + (size_t)(kt * 64 + k) * N + nt * 64 + c4);
          tile[k * 65 + c4 + 0] = v[0]; tile[k * 65 + c4 + 1] = v[1]; tile[k * 65 + c4 + 2] = v[2]; tile[k * 65 + c4 + 3] = v[3]; } }
    __syncthreads();
    { const int n = tid >> 3, kc = (tid & 7) * 8; u32x4 w;
      w[0] = cvt_pk_bf16(tile[(kc + 0) * 65 + n], tile[(kc + 1) * 65 + n]); w[1] = cvt_pk_bf16(tile[(kc + 2) * 65 + n], tile[(kc + 3) * 65 + n]);
      w[2] = cvt_pk_bf16(tile[(kc + 4) * 65 + n], tile[(kc + 5) * 65 + n]); w[3] = cvt_pk_bf16(tile[(kc + 6) * 65 + n], tile[(kc + 7) * 65 + n]);
      *(u32x4*)(dst + (size_t)(nt * 64 + n) * K + kt * 64 + kc) = w; }
    __syncthreads();
}

__device__ void mod_item(const Params& p, int l, int cc, float* lds) {
    const int tid = TID();
    float* sc = lds;
    float* red = lds + 5120;
    for (int i = tid; i < 5120; i += NTHREADS) { const int r = i >> 10, k = i & 1023; const float v = (r == 0) ? PIN(6)[k] : PIN(5)[(r - 1) * 1024 + k]; sc[i] = siluf_(v); }
    __syncthreads();
    const int kg = tid >> 5, c = tid & 31, col = cc * 32 + c;
    float a[5] = {0.f, 0.f, 0.f, 0.f, 0.f};
    const float* w = PIN(7) + (size_t)l * 1024 * 3072 + col;
    for (int k = kg * 64; k < kg * 64 + 64; ++k) { const float wv = w[(size_t)k * 3072];
#pragma unroll
        for (int r = 0; r < 5; ++r) a[r] += sc[r * 1024 + k] * wv; }
#pragma unroll
    for (int r = 0; r < 5; ++r) red[(kg * 5 + r) * 32 + c] = a[r];
    __syncthreads();
    if (tid < 160) { const int r = tid >> 5, c2 = tid & 31; float s = PIN(8)[l * 3072 + cc * 32 + c2];
        for (int g = 0; g < 16; ++g) s += red[(g * 5 + r) * 32 + c2];
        __hip_atomic_store((float*)(PWS + WS_MOD) + (l * 5 + r) * 3072 + cc * 32 + c2, s, __ATOMIC_RELAXED, __HIP_MEMORY_SCOPE_AGENT); }
    asm volatile("s_waitcnt vmcnt(0)" ::: "memory");
    __syncthreads();
    if (tid == 0 && l == 0) __hip_atomic_fetch_add((unsigned*)(PWS + WS_CTR) + 16, 1u, __ATOMIC_RELAXED, __HIP_MEMORY_SCOPE_AGENT);
}

__device__ void phaseA0(const Params& p, int l);
__device__ void phase0(const Params& p, unsigned char* lds) {
    const int NCONV_IN = 2 * 16 * 114, NCONV_UP = 8 * 64, NCONV_O = 2 * 256, NCONV_L = 32, NMOD = 192;
    const int total = NCONV_IN + NCONV_UP + NCONV_O + NCONV_L + NMOD + 1;
    for (int it = blockIdx.x; it < total; it += gridDim.x) {
        int i = it;
        if (i < NMOD) { mod_item(p, i / 96, i % 96, (float*)lds); continue; }
        i -= NMOD;
        if (i < NCONV_IN) { const int l = i / 1824, r = i % 1824, nt = r / 16, kt = r % 16;
            conv_tile(PIN(10) + (size_t)l * 1024 * INW, INW, (bf16_t*)(PWS + WS_WTIN) + (size_t)l * INW * 1024, 1024, kt, nt, (float*)lds); continue; }
        i -= NCONV_IN;
        if (i < NCONV_UP) { const int mtx = i / 64, r = i % 64, nt = r / 4, kt = r % 4;
            conv_tile(PIN(25) + (size_t)mtx * 256 * 1024, 1024, (bf16_t*)(PWS + WS_WTUP) + (size_t)mtx * 1024 * 256, 256, kt, nt, (float*)lds); continue; }
        i -= NCONV_UP;
        if (i < NCONV_O) { const int l = i / 256, r = i % 256, nt = r / 16, kt = r % 16;
            conv_tile(PIN(26) + (size_t)l * 1024 * 1024, 1024, (bf16_t*)(PWS + WS_WTO) + (size_t)l * 1024 * 1024, 1024, kt, nt, (float*)lds); continue; }
        i -= NCONV_O;
        if (i < NCONV_L) { const int l = i >> 4, m = (i >> 2) & 3, nt = i & 3;
            conv_tile((m < 2 ? PIN(14) : PIN(16)) + (size_t)(l * 2 + (m & 1)) * 64 * 256, 256, (bf16_t*)(PWS + WS_LORAT) + (size_t)(l * 4 + m) * 256 * 64, 64, 0, nt, (float*)lds); continue; }
        for (int e = TID(); e < 1024; e += NTHREADS) { const int pos = e >> 4, f = e & 15;
            const float inv = exp2f(-(float)f * (13.287712379549449f / 16.0f)); const float ang = (float)pos * inv;
            float sn, cs; sn = sinf(ang); cs = cosf(ang);
            ((f32x2*)(PWS + WS_ROPE))[e] = (f32x2){cs, sn}; }
        for (int e = TID(); e < 4 * 32 * 64; e += NTHREADS) ((unsigned*)(PWS + WS_XCNT))[e] = 0u;
    }
    if (TID() == 0) { unsigned* mc = (unsigned*)(PWS + WS_CTR) + 16; unsigned spins = 0;
        while (__hip_atomic_load(mc, __ATOMIC_RELAXED, __HIP_MEMORY_SCOPE_AGENT) < 96u) { __builtin_amdgcn_s_sleep(2); if (++spins > (1u << 22)) break; }
        __builtin_amdgcn_fence(__ATOMIC_ACQUIRE, "agent");
        asm volatile("s_waitcnt vmcnt(0)" ::: "memory"); }
    __syncthreads();
    phaseA0(p, 0);
}

__device__ __forceinline__ const float* xrow_ptr(const Params& p, int l, int row) {
    if (l == 0) return row < NTP ? PIN(0) + (size_t)row * DM : PIN(1) + (size_t)(row - NTP) * DM;
    return POUT + (size_t)row * DM;
}
__device__ void phaseA0(const Params& p, int l) {
    const int lane = TID() & 63, gw = blockIdx.x * 8 + (TID() >> 6), W = gridDim.x * 8;
    const float* g = PIN(9) + l * DM;
    bf16_t* H = (bf16_t*)(PWS + WS_H);
    for (int row = gw; row < NT; row += W) {
        const float* x = xrow_ptr(p, l, row);
        f32x4 v[4]; float ss = 0.f;
#pragma unroll
        for (int i = 0; i < 4; ++i) { v[i] = *(const f32x4*)(x + i * 256 + lane * 4); ss += v[i][0] * v[i][0] + v[i][1] * v[i][1] + v[i][2] * v[i][2] + v[i][3] * v[i][3]; }
        ss = wave_sum(ss);
        const float rs = rsqrtf(ss * (1.0f / 1024.0f) + 1e-6f);
        const float* mod = (const float*)(PWS + WS_MOD) + (size_t)(l * 5 + modrow_of(row)) * 3072;
#pragma unroll
        for (int i = 0; i < 4; ++i) { const int c = i * 256 + lane * 4;
            const f32x4 gg = *(const f32x4*)(g + c), sh = *(const f32x4*)(mod + c), scl = *(const f32x4*)(mod + 1024 + c);
            f32x4 h = v[i] * rs * gg * (1.0f + scl) + sh;
            u32x2 w; w[0] = cvt_pk_bf16(h[0], h[1]); w[1] = cvt_pk_bf16(h[2], h[3]);
            *(u32x2*)(H + (size_t)row * DM + c) = w; }
    }
}

template <int MT>
__device__ __forceinline__ void gemm_acc(const bf16_t* __restrict__ A, int lda, const bf16_t* __restrict__ B, int ldb, int K, f32x4 (&acc)[MT][4], unsigned char* lds) {
    constexpr int BM = MT * 64, LDT = 72, A_BYTES = BM * LDT * 2, B_BYTES = 128 * LDT * 2, BUF = A_BYTES + B_BYTES;
    const int tid = TID(), lane = tid & 63, wid = tid >> 6, wr = wid >> 1, wc = wid & 1, fr = lane & 15, fq = lane >> 4;
    u32x4 ra[MT], rb[2];
    const int srow = tid >> 3, skc = tid & 7;
    const bf16_t* Ag = A + (size_t)srow * lda + skc * 8;
    const bf16_t* Bg = B + (size_t)srow * ldb + skc * 8;
    const int soff = (srow * LDT + skc * 8) * 2;
    const int nt = K >> 6;
    __syncthreads();
#pragma unroll
    for (int i = 0; i < MT; ++i) ra[i] = *(const u32x4*)(Ag + (size_t)i * 64 * lda);
#pragma unroll
    for (int i = 0; i < 2; ++i) rb[i] = *(const u32x4*)(Bg + (size_t)i * 64 * ldb);
#pragma unroll
    for (int i = 0; i < MT; ++i) *(u32x4*)(lds + soff + i * 64 * LDT * 2) = ra[i];
#pragma unroll
    for (int i = 0; i < 2; ++i) *(u32x4*)(lds + A_BYTES + soff + i * 64 * LDT * 2) = rb[i];
    __syncthreads();
    const int aoff = ((wr * MT * 16 + fr) * LDT + fq * 8) * 2, boff = A_BYTES + ((wc * 64 + fr) * LDT + fq * 8) * 2;
    for (int t = 0; t < nt; ++t) {
        if (t + 1 < nt) {
#pragma unroll
            for (int i = 0; i < MT; ++i) ra[i] = *(const u32x4*)(Ag + (size_t)i * 64 * lda + (t + 1) * 64);
#pragma unroll
            for (int i = 0; i < 2; ++i) rb[i] = *(const u32x4*)(Bg + (size_t)i * 64 * ldb + (t + 1) * 64);
        }
        const unsigned char* base = lds + (t & 1) * BUF;
#pragma unroll
        for (int kk = 0; kk < 2; ++kk) {
            bf16x8 af[MT], bfr[4];
#pragma unroll
            for (int m = 0; m < MT; ++m) af[m] = *(const bf16x8*)(base + aoff + m * 16 * LDT * 2 + kk * 64);
#pragma unroll
            for (int n = 0; n < 4; ++n) bfr[n] = *(const bf16x8*)(base + boff + n * 16 * LDT * 2 + kk * 64);
#pragma unroll
            for (int m = 0; m < MT; ++m)
#pragma unroll
                for (int n = 0; n < 4; ++n) acc[m][n] = __builtin_amdgcn_mfma_f32_16x16x32_bf16(bfr[n], af[m], acc[m][n], 0, 0, 0);
        }
        if (t + 1 < nt) {
            unsigned char* nb = lds + ((t + 1) & 1) * BUF;
#pragma unroll
            for (int i = 0; i < MT; ++i) *(u32x4*)(nb + soff + i * 64 * LDT * 2) = ra[i];
#pragma unroll
            for (int i = 0; i < 2; ++i) *(u32x4*)(nb + A_BYTES + soff + i * 64 * LDT * 2) = rb[i];
        }
        __syncthreads();
    }
}
template <int MT> __device__ __forceinline__ void zero_acc(f32x4 (&acc)[MT][4]) {
#pragma unroll
    for (int m = 0; m < MT; ++m)
#pragma unroll
        for (int n = 0; n < 4; ++n) acc[m][n] = (f32x4){0.f, 0.f, 0.f, 0.f};
}

namespace pg8 {
#define PG8_LAS __attribute__((address_space(3)))
typedef unsigned short bf16_t;
typedef short bf16x8 __attribute__((ext_vector_type(8)));
typedef float f32x4 __attribute__((ext_vector_type(4)));
typedef unsigned u32x4 __attribute__((ext_vector_type(4)));
constexpr int BM = 256, BK = 64, HALF = 128, HTB = HALF * BK * 2  , STAGE_BYTES = 8 * HTB, NXCD = 8, WGM = 8;

__host__ __device__ __forceinline__ int lds_byte(int r, int c) { const int st = (r >> 4) * 2 + (c >> 5), rr = r & 15, cc = c & 31, ob = rr * 64 + cc * 2; return st * 1024 + (ob ^ (((ob >> 9) & 1) << 5)); }
__host__ __device__ __forceinline__ void stage_rc(int b, int& R, int& C) { const int st = b / 1024, sb = b % 1024, swz = sb ^ (((sb >> 9) & 1) << 5); R = (st >> 1) * 16 + swz / 64; C = (st & 1) * 32 + (swz % 64) / 2; }
__host__ __device__ __forceinline__ int perm32(int rho) { const int n = rho >> 4, i = rho & 15; return 8 * (i >> 2) + 4 * n + (i & 3); }

struct Unit { int pm, pn; };
struct Gemm { const bf16_t* A; const bf16_t* Bt; int M, N, K; };

struct StaticOrder {
    int nM, nN, nwg, G, c;
    __host__ __device__ void init(int M, int N, int G_, int c_) { nM = M / BM; nN = N / BM; nwg = nM * nN; G = G_; c = c_; }
    __host__ __device__ bool next(int i, Unit& u) const {
        const long L = (long)i * G + c; if (L >= nwg) return false;
        int wgid = (int)L; { const int q = nwg / NXCD, r = nwg % NXCD, xcd = wgid % NXCD, off = wgid / NXCD; wgid = (xcd < r ? xcd * (q + 1) : r * (q + 1) + (xcd - r) * q) + off; }
        const int nig = WGM * nN, gid = wgid / nig, fm = gid * WGM, gsz = (nM - fm) < WGM ? (nM - fm) : WGM;
        u.pm = fm + ((wgid % nig) % gsz); u.pn = (wgid % nig) / gsz; return true;
    }
    __device__ __forceinline__ void a_ready(const Unit&) const {}
    __device__ __forceinline__ void done(const Unit&) const {}
};
template <class Epi, class Sched, bool STAMP = false>
__device__ __forceinline__ void gemm_phase(PG8_LAS unsigned char* lds, const Gemm g, const Sched& S, const Epi& E, unsigned long long* stamps) {
    const int tid = ::TID(), wid = __builtin_amdgcn_readfirstlane(tid >> 6), lane = tid & 63, wr = wid >> 2, wc = wid & 3, fr = lane & 15, fq = lane >> 4;
    const int K = g.K, nt = K / BK;
    int ts_lo = 0, ts_hi = 0, nts = 0; const unsigned long long rt_entry = STAMP ? (unsigned long long)wall_clock64() : 0ull;
#define PG8_STAMP() do { if (STAMP && wid == 0 && nts < 64) { const unsigned long long _c = (unsigned long long)clock64(); \
        ts_lo = (lane == nts) ? (int)(unsigned)_c : ts_lo; ts_hi = (lane == nts) ? (int)(unsigned)(_c >> 32) : ts_hi; ++nts; } } while (0)
    PG8_STAMP();
    unsigned voffA[2], voffB[2];
#pragma unroll
    for (int i = 0; i < 2; ++i) { int R, C; stage_rc(tid * 16 + i * 8192, R, C); const int Rb = Epi::PERM ? ((R & ~31) + perm32(R & 31)) : R;
        voffA[i] = (unsigned)(R * K + C) * 2u; voffB[i] = (unsigned)(Rb * K + C) * 2u; }
    const size_t kstep = (size_t)(BK * 2);
    const size_t hstep = (size_t)HALF * K * 2;
    const size_t tstep = 2 * hstep;
    const unsigned ldsw = (unsigned)wid * 1024u;
    const int aoff = lds_byte(wr * 64 + fr, fq * 8), boff = lds_byte(wc * 32 + fr, fq * 8);
#define PG8_SA(b, h) (((b) * 2 + (h)) * HTB)
#define PG8_SB(b, h) ((4 + (b) * 2 + (h)) * HTB)
#define PG8_STAGE(bufoff, gbase, voff) do { _Pragma("unroll") for (int _i = 0; _i < 2; ++_i) \
        __builtin_amdgcn_global_load_lds((const unsigned*)((const char*)(gbase) + (voff)[_i]), (PG8_LAS unsigned*)(lds + (bufoff) + ldsw + _i * 8192), 16, 0, 0); } while (0)
#define PG8_LDA(dst, b, h) do { _Pragma("unroll") for (int m = 0; m < 4; ++m) _Pragma("unroll") for (int k = 0; k < 2; ++k) dst[m][k] = *(const PG8_LAS bf16x8*)(lds + PG8_SA(b, h) + aoff + m * 2048 + k * 1024); } while (0)
#define PG8_LDB(dst, b, h) do { _Pragma("unroll") for (int n = 0; n < 2; ++n) _Pragma("unroll") for (int k = 0; k < 2; ++k) dst[n][k] = *(const PG8_LAS bf16x8*)(lds + PG8_SB(b, h) + boff + n * 2048 + k * 1024); } while (0)
#define PG8_MMA(ai, bj, At, Bt) do { __builtin_amdgcn_s_setprio(1); _Pragma("unroll") for (int m = 0; m < 4; ++m) _Pragma("unroll") for (int n = 0; n < 2; ++n) _Pragma("unroll") for (int k = 0; k < 2; ++k) \
        acc[ai][bj][m][n] = __builtin_amdgcn_mfma_f32_16x16x32_bf16(Bt[n][k], At[m][k], acc[ai][bj][m][n], 0, 0, 0); __builtin_amdgcn_s_setprio(0); } while (0)
#define PG8_WAIT_V(n) asm volatile("s_waitcnt vmcnt(" #n ")" ::: "memory")
#define PG8_WAIT_L(n) asm volatile("s_waitcnt lgkmcnt(" #n ")" ::: "memory")
#define PG8_BAR __builtin_amdgcn_s_barrier()
#define PG8_SCHED __builtin_amdgcn_sched_barrier(0)
    Unit cur, nxt; int ui = 0;
    if (!S.next(0, cur)) return;
    f32x4 acc[2][2][4][2];
#pragma unroll
    for (int a = 0; a < 2; ++a)
#pragma unroll
        for (int b = 0; b < 2; ++b)
#pragma unroll
            for (int m = 0; m < 4; ++m)
#pragma unroll
                for (int n = 0; n < 2; ++n) acc[a][b][m][n] = (f32x4){0.f, 0.f, 0.f, 0.f};
    bf16x8 At[4][2], B0[2][2], B1[2][2];
    const char* cA = (const char*)g.A + (size_t)cur.pm * tstep; const char* cB = (const char*)g.Bt + (size_t)cur.pn * tstep;
    S.a_ready(cur);
    PG8_STAGE(PG8_SB(0, 0), cB, voffB); PG8_STAGE(PG8_SA(0, 0), cA, voffA); PG8_STAGE(PG8_SB(0, 1), cB + hstep, voffB); PG8_STAGE(PG8_SA(0, 1), cA + hstep, voffA);
    if (wr == 1) PG8_BAR;
    PG8_WAIT_V(4); PG8_BAR;
    PG8_STAGE(PG8_SB(1, 0), cB + kstep, voffB); PG8_STAGE(PG8_SA(1, 0), cA + kstep, voffA); PG8_STAGE(PG8_SB(1, 1), cB + hstep + kstep, voffB);
    PG8_WAIT_V(6); PG8_BAR;
    PG8_STAMP();
    for (;;) {
        const bool has_next = S.next(ui + 1, nxt);
        const char* nA = has_next ? (const char*)g.A + (size_t)nxt.pm * tstep : cA; const char* nB = has_next ? (const char*)g.Bt + (size_t)nxt.pn * tstep : cB;
        for (int t = 0; t < nt; t += 2) {
            const bool last = (t == nt - 2);
            const char* a1 = cA + (size_t)(t + 1) * kstep;
            const char* a2 = last ? nA : cA + (size_t)(t + 2) * kstep; const char* b2 = last ? nB : cB + (size_t)(t + 2) * kstep;
            const char* a3 = a2 + kstep; const char* b3 = b2 + kstep;
            if (last && has_next) S.a_ready(nxt);
            PG8_LDB(B0, 0, 0); PG8_SCHED; PG8_LDA(At, 0, 0); PG8_STAGE(PG8_SA(1, 1), a1 + hstep, voffA);
            PG8_WAIT_L(8); PG8_BAR; PG8_WAIT_L(0); PG8_MMA(0, 0, At, B0); PG8_BAR; PG8_SCHED;
            PG8_LDB(B1, 0, 1); PG8_STAGE(PG8_SB(0, 0), b2, voffB);
            PG8_BAR; PG8_WAIT_L(0); PG8_MMA(0, 1, At, B1); PG8_BAR;
            PG8_LDA(At, 0, 1); PG8_STAGE(PG8_SA(0, 0), a2, voffA);
            PG8_BAR; PG8_WAIT_L(0); PG8_MMA(1, 0, At, B0); PG8_BAR; PG8_SCHED;
            PG8_STAGE(PG8_SB(0, 1), b2 + hstep, voffB);
            PG8_WAIT_V(6); PG8_BAR; PG8_MMA(1, 1, At, B1); PG8_BAR;
            PG8_LDB(B0, 1, 0); PG8_SCHED; PG8_LDA(At, 1, 0); PG8_STAGE(PG8_SA(0, 1), a2 + hstep, voffA);
            PG8_WAIT_L(8); PG8_BAR; PG8_WAIT_L(0); PG8_MMA(0, 0, At, B0); PG8_BAR; PG8_SCHED;
            PG8_LDB(B1, 1, 1); PG8_STAGE(PG8_SB(1, 0), b3, voffB);
            PG8_BAR; PG8_WAIT_L(0); PG8_MMA(0, 1, At, B1); PG8_BAR;
            PG8_LDA(At, 1, 1); PG8_STAGE(PG8_SA(1, 0), a3, voffA);
            PG8_BAR; PG8_WAIT_L(0); PG8_MMA(1, 0, At, B0); PG8_BAR; PG8_SCHED;
            PG8_STAGE(PG8_SB(1, 1), b3 + hstep, voffB);
            PG8_WAIT_V(6); PG8_BAR; PG8_MMA(1, 1, At, B1); PG8_BAR;
        }
        PG8_STAMP();
        if constexpr (!Epi::AFTER_DRAIN) { E(acc, cur, wr, wc, fr, fq); S.done(cur); }
        PG8_STAMP();
        if (!has_next) break;
#pragma unroll
        for (int a = 0; a < 2; ++a)
#pragma unroll
            for (int b = 0; b < 2; ++b)
#pragma unroll
                for (int m = 0; m < 4; ++m)
#pragma unroll
                    for (int n = 0; n < 2; ++n) acc[a][b][m][n] = (f32x4){0.f, 0.f, 0.f, 0.f};
        cur = nxt; cA = nA; cB = nB; ++ui;
    }
    PG8_WAIT_V(0);
    if (wr == 0) PG8_BAR;
    PG8_BAR;
    if constexpr (Epi::AFTER_DRAIN) { E.fused(acc, cur, wr, wc, fr, fq, lds, wid, lane); S.done(cur); }
    PG8_STAMP();
    if (STAMP && wid == 0) { stamps[lane] = lane < nts ? (((unsigned long long)(unsigned)ts_hi << 32) | (unsigned)ts_lo) : 0ull;
        if (lane == 62) stamps[62] = rt_entry; if (lane == 63) stamps[63] = (unsigned long long)wall_clock64(); }
#undef PG8_STAMP
#undef PG8_SA
#undef PG8_SB
#undef PG8_STAGE
#undef PG8_LDA
#undef PG8_LDB
#undef PG8_MMA
#undef PG8_WAIT_V
#undef PG8_WAIT_L
#undef PG8_BAR
#undef PG8_SCHED
}
}

struct EpiA {
    static constexpr bool PERM = false, AFTER_DRAIN = false;
    float* P; bf16_t* Z; float* out; int l, cbase;
    __device__ __forceinline__ void operator()(const pg8::f32x4 (&acc)[2][2][4][2], const pg8::Unit& u, int wr, int wc, int fr, int fq) const {
#pragma unroll
        for (int ai = 0; ai < 2; ++ai)
#pragma unroll
            for (int m = 0; m < 4; ++m) { const int row = u.pm * 256 + ai * 128 + wr * 64 + m * 16 + fr;
#pragma unroll
                for (int bj = 0; bj < 2; ++bj)
#pragma unroll
                    for (int n = 0; n < 2; ++n) { const int col = cbase + u.pn * 256 + bj * 128 + wc * 32 + n * 16 + fq * 4; const f32x4 v = acc[ai][bj][m][n];
                        if (col < PW) { *(f32x4*)(P + (size_t)row * PW + col) = v;
                            if (col >= C_CK && col < C_DP && row < NTP) { const int b = row >> 8, s_ = row & 255; const bool isk = col < C_CV;
                                *(f32x4*)(out + (isk ? O_NK : O_NV) + ((size_t)((b * 2 + l) * 256 + s_)) * 128 + (col - (isk ? C_CK : C_CV))) = v; } }
                        else if (col < NA_COLS) { u32x2 w; w[0] = cvt_pk_bf16(siluf_(v[0]), siluf_(v[1])); w[1] = cvt_pk_bf16(siluf_(v[2]), siluf_(v[3])); *(u32x2*)(Z + (size_t)row * DM + (col - PW)) = w; } } }
    }
};
__device__ __forceinline__ size_t g_off(int row, int cg) {
    const int n = cg >> 10, c = cg & 1023;
    const int pm = row >> 8, wr2 = (row >> 6) & 3, m = (row >> 4) & 3, fr = row & 15;
    const int pn = c >> 7, wc2 = (c >> 6) & 1, q = (c >> 4) & 3, fq2 = (c >> 2) & 3;
    size_t o = (size_t)(n * 32 + pm); o = o * 8 + pn; o = o * 4 + wr2; o = o * 2 + wc2; o = o * 4 + m; o = o * 16 + fr; o = o * 4 + fq2; o = o * 16 + q * 4;
    return o;
}
struct EpiG {
    static constexpr bool PERM = true, AFTER_DRAIN = false;
    bf16_t* G;
    __device__ __forceinline__ void operator()(const pg8::f32x4 (&acc)[2][2][4][2], const pg8::Unit& u, int wr, int wc, int fr, int fq) const {
#pragma unroll
        for (int ai = 0; ai < 2; ++ai)
#pragma unroll
            for (int m = 0; m < 4; ++m) { const int row = u.pm * 256 + ai * 128 + wr * 64 + m * 16 + fr;
#pragma unroll
                for (int bj = 0; bj < 2; ++bj) { const int col = u.pn * 256 + bj * 128 + wc * 32 + 8 * fq; const f32x4 v0 = acc[ai][bj][m][0], v1 = acc[ai][bj][m][1];
                    u32x4 w; w[0] = cvt_pk_bf16(sigmoidf_(v0[0]), sigmoidf_(v0[1])); w[1] = cvt_pk_bf16(sigmoidf_(v0[2]), sigmoidf_(v0[3]));
                    w[2] = cvt_pk_bf16(sigmoidf_(v1[0]), sigmoidf_(v1[1])); w[3] = cvt_pk_bf16(sigmoidf_(v1[2]), sigmoidf_(v1[3]));
                    u32x2 wa, wb; wa[0] = w[0]; wa[1] = w[1]; wb[0] = w[2]; wb[1] = w[3];
                    *(u32x2*)(G + g_off(row, col)) = wa; *(u32x2*)(G + g_off(row, col + 4)) = wb; } }
    }
};

__device__ void phaseA(const Params& p, int l, unsigned char* lds, int part) {
    const int G = part ? ((int)gridDim.x < 160 ? (int)gridDim.x : 160) : (int)gridDim.x;
    if ((int)blockIdx.x < G) {
        pg8::Gemm g; g.A = (const bf16_t*)(PWS + WS_H); g.Bt = (const bf16_t*)(PWS + WS_WTIN) + (size_t)l * INW * 1024 + (size_t)(part ? 2048 : 0) * 1024; g.M = NT; g.N = part ? 5 * 256 : 8 * 256; g.K = 1024;
        pg8::StaticOrder S; S.init(g.M, g.N, G, (int)blockIdx.x);
        EpiA E; E.P = (float*)(PWS + WS_P); E.Z = (bf16_t*)(PWS + WS_Z); E.out = POUT; E.l = l; E.cbase = part ? 2048 : 0;
        pg8::gemm_phase<EpiA, pg8::StaticOrder, false>((PG8_LAS unsigned char*)lds, g, S, E, nullptr);
    }
    __syncthreads();
}

__device__ void phaseB0(const Params& p, int l, unsigned char* ldsb) {
    const int tid = TID(), lane = tid & 63, wid = tid >> 6, fr = lane & 15, fq = lane >> 4;
    const int h = wid >> 1, mt = wid & 1;
    bf16_t* Awd = (bf16_t*)ldsb;
    bf16_t* Aad = Awd + 32 * 72;
    const float* P = (const float*)(PWS + WS_P);
    float* recS = (float*)(PWS + WS_RECS);
    float* recD = (float*)(PWS + WS_RECD);
    float* BC = (float*)(PWS + WS_BC);
    const bf16_t* LT = (const bf16_t*)(PWS + WS_LORAT) + (size_t)l * 4 * 256 * 64;
    const float* pkk = PIN(17) + l * 256; const float* pka = PIN(18) + l * 256; const float* prk = PIN(19) + l * 256;
    const float* pw0 = PIN(13) + l * 512; const float* pa0 = PIN(15) + l * 512;
    __shared__ int s_b0;
    unsigned* ctr0 = (unsigned*)(PWS + WS_CTR) + 4 + l;
    for (;;) {
        if (tid == 0) s_b0 = (int)atomicAdd(ctr0, 1u);
        __syncthreads();
        const int it = s_b0;
        __syncthreads();
        if (it >= NT / 32) break;
        const int tb = it * 32;
        __syncthreads();
#pragma unroll
        for (int i = 0; i < 8; ++i) { const int idx = tid + i * 512, tk = idx >> 7, j = idx & 127; const float v = P[(size_t)(tb + tk) * PW + C_WD + j];
            if (j < 64) Awd[tk * 72 + j] = f2bf(1.0f - 2.0f / (1.0f + __expf(2.0f * v))); else Aad[tk * 72 + j - 64] = f2bf(v); }
        __syncthreads();
        f32x4 acc[4][4];
#pragma unroll
        for (int m = 0; m < 4; ++m)
#pragma unroll
            for (int n = 0; n < 4; ++n) acc[m][n] = (f32x4){0.f, 0.f, 0.f, 0.f};
#pragma unroll
        for (int ks = 0; ks < 2; ++ks) {
            const bf16x8 awf = *(const bf16x8*)(Awd + (mt * 16 + fr) * 72 + ks * 32 + fq * 8), aaf = *(const bf16x8*)(Aad + (mt * 16 + fr) * 72 + ks * 32 + fq * 8);
#pragma unroll
            for (int n = 0; n < 4; ++n) { const int cb = h * 64 + n * 16 + fr;
#pragma unroll
                for (int m = 0; m < 4; ++m) { const bf16x8 bfr = *(const bf16x8*)(LT + ((size_t)m * 256 + cb) * 64 + ks * 32 + fq * 8);
                    acc[m][n] = __builtin_amdgcn_mfma_f32_16x16x32_bf16(bfr, m < 2 ? awf : aaf, acc[m][n], 0, 0, 0); } }
        }
        const int tok = tb + mt * 16 + fr; int seqbase, L, pos; seq_of(tok, seqbase, L, pos);
        const float* pr = P + (size_t)tok * PW;
        const size_t ridx = ((size_t)seqbase * 4 + (size_t)h * L + pos) * 192;
        f32x4 k4[4], kk4[4]; float ss = 0.f;
#pragma unroll
        for (int n = 0; n < 4; ++n) { const int c4 = h * 64 + n * 16 + fq * 4;
            k4[n] = *(const f32x4*)(pr + C_BK + c4); kk4[n] = k4[n] * *(const f32x4*)(pkk + c4);
            ss += (kk4[n][0] * kk4[n][0] + kk4[n][1] * kk4[n][1]) + (kk4[n][2] * kk4[n][2] + kk4[n][3] * kk4[n][3]); }
        ss += __shfl_xor(ss, 16); ss += __shfl_xor(ss, 32);
        const float rn = rsqrtf(ss + 1e-12f);
        float bsum = 0.f;
#pragma unroll
        for (int n = 0; n < 4; ++n) { const int c4 = h * 64 + n * 16 + fq * 4, j4 = n * 16 + fq * 4;
            const f32x4 r4 = *(const f32x4*)(pr + C_BR + c4), v4 = *(const f32x4*)(pr + C_BV + c4);
            const f32x4 kk = kk4[n] * rn, ka4 = *(const f32x4*)(pka + c4), rk4 = *(const f32x4*)(prk + c4);
            *(f32x4*)(recS + ridx + j4) = r4; *(f32x4*)(recS + ridx + 64 + j4) = kk; *(f32x4*)(recS + ridx + 128 + j4) = v4;
#pragma unroll
            for (int d = 0; d < 2; ++d) {
                const f32x4 w0 = *(const f32x4*)(pw0 + d * 256 + c4), a0 = *(const f32x4*)(pa0 + d * 256 + c4);
                f32x4 dec, nka, kd;
#pragma unroll
                for (int j = 0; j < 4; ++j) {
                    const float wl = w0[j] + acc[d][n][j];
                    dec[j] = __expf(-0.6065306597126334f / (1.0f + __expf(-wl)));
                    const float a = 1.0f / (1.0f + __expf(-(a0[j] + acc[2 + d][n][j])));
                    kd[j] = k4[n][j] * (1.0f + (a - 1.0f) * ka4[j]); nka[j] = -(kk[j] * a);
                    bsum += r4[j] * kd[j] * rk4[j]; }
                float* rd = recD + (size_t)d * RECD_STRIDE + ridx + j4;
                *(f32x4*)(rd) = dec; *(f32x4*)(rd + 64) = nka; *(f32x4*)(rd + 128) = kd;
            }
        }
        bsum += __shfl_xor(bsum, 16); bsum += __shfl_xor(bsum, 32);
        if (fq == 0) BC[tok * 4 + h] = bsum;
    }
}

template <int NS>
__device__ __forceinline__ void scan_run(const Params& p, int l, bool sample, int b, int h, int dir, int rg, int L, int seqbase, float* wl) {
    const int lane = TID() & 63, rl = lane >> 4, kl = lane & 15;
    int row[NS]; f32x4 S[NS]; size_t sidx[NS];
#pragma unroll
    for (int q = 0; q < NS; ++q) { row[q] = (rg * NS + q) * 4 + rl;
        sidx[q] = ((size_t)(((b * 2 + l) * 2 + dir) * 4 + h)) * 4096 + row[q] * 64 + kl * 4;
        if (sample) S[q] = *(const f32x4*)(PIN(4) + sidx[q]); else S[q] = (f32x4){0.f, 0.f, 0.f, 0.f}; }
    const float* gS = (const float*)(PWS + WS_RECS) + ((size_t)seqbase * 4 + (size_t)h * L) * 192 + lane * 4;
    const float* gD = (const float*)(PWS + WS_RECD) + (size_t)dir * RECD_STRIDE + ((size_t)seqbase * 4 + (size_t)h * L) * 192 + lane * 4;
    float* O = (float*)(PWS + WS_O) + (size_t)dir * NT * 256 + (size_t)seqbase * 256 + h * 64;
    const int nch = L >> 2;
    f32x4 rA[6], rB[6];
    auto gl = [&](f32x4 (&r)[6], int c) {
        c = c < nch ? c : nch - 1;
        const int pos0 = dir ? (L - 4 * (c + 1)) : 4 * c;
        const float* s_ = gS + (size_t)pos0 * 192; const float* d_ = gD + (size_t)pos0 * 192;
#pragma unroll
        for (int i = 0; i < 3; ++i) { r[i] = *(const f32x4*)(s_ + i * 256); r[3 + i] = *(const f32x4*)(d_ + i * 256); }
    };
    auto st = [&](const f32x4 (&r)[6], float* buf) {
#pragma unroll
        for (int i = 0; i < 3; ++i) { *(f32x4*)(buf + i * 256 + lane * 4) = r[i]; *(f32x4*)(buf + 768 + i * 256 + lane * 4) = r[3 + i]; }
    };
    struct Ops { f32x4 r, kk, w, ka, kd; float v[NS]; };
    auto ldsread = [&](const float* buf, int s) -> Ops {
        const int tc = dir ? 3 - s : s;
        const float* bs = buf + tc * 192; const float* bd = buf + 768 + tc * 192;
        Ops o; o.r = *(const f32x4*)(bs + kl * 4); o.kk = *(const f32x4*)(bs + 64 + kl * 4);
        o.w = *(const f32x4*)(bd + kl * 4); o.ka = *(const f32x4*)(bd + 64 + kl * 4); o.kd = *(const f32x4*)(bd + 128 + kl * 4);
#pragma unroll
        for (int q = 0; q < NS; ++q) o.v[q] = bs[128 + row[q]];
        return o;
    };
    float opart[NS];
#pragma unroll
    for (int q = 0; q < NS; ++q) opart[q] = 0.f;
    auto chunk = [&](const float* cur, const float* nxtbuf, Ops& ops, int c) {
        float oval[NS];
#pragma unroll
        for (int q = 0; q < NS; ++q) oval[q] = 0.f;
#pragma unroll
        for (int s = 0; s < 4; ++s) {
            const Ops nx = (s < 3) ? ldsread(cur, s + 1) : ldsread(nxtbuf, 0);
            __builtin_amdgcn_sched_barrier(0);
            float sa[NS], opr[NS]; f32x2 ta[NS], tb[NS];
            const f32x2 kka = __builtin_shufflevector(ops.kk, ops.kk, 0, 1), kkb = __builtin_shufflevector(ops.kk, ops.kk, 2, 3);
            const f32x2 wa = __builtin_shufflevector(ops.w, ops.w, 0, 1), wb = __builtin_shufflevector(ops.w, ops.w, 2, 3);
            const f32x2 na = __builtin_shufflevector(ops.ka, ops.ka, 0, 1), nb = __builtin_shufflevector(ops.ka, ops.ka, 2, 3);
            const f32x2 da = __builtin_shufflevector(ops.kd, ops.kd, 0, 1), db = __builtin_shufflevector(ops.kd, ops.kd, 2, 3);
            const f32x2 ra = __builtin_shufflevector(ops.r, ops.r, 0, 1), rb = __builtin_shufflevector(ops.r, ops.r, 2, 3);
#pragma unroll
            for (int q = 0; q < NS; ++q) { const f32x2 Sa = __builtin_shufflevector(S[q], S[q], 0, 1), Sb = __builtin_shufflevector(S[q], S[q], 2, 3);
                f32x2 pp = Sa * kka; pp = Sb * kkb + pp; sa[q] = pp[0] + pp[1];
                const f32x2 v2 = (f32x2){ops.v[q], ops.v[q]};
                ta[q] = Sa * wa + v2 * da; tb[q] = Sb * wb + v2 * db; }
#pragma unroll
            for (int q = 0; q < NS; ++q) { sa[q] = row16_sum(sa[q]); opr[q] = row16_sum(opart[q]); oval[q] = (kl == s) ? opr[q] : oval[q]; }
#pragma unroll
            for (int q = 0; q < NS; ++q) { const f32x2 s2 = (f32x2){sa[q], sa[q]};
                const f32x2 Sa = s2 * na + ta[q], Sb = s2 * nb + tb[q];
                f32x2 qq = Sa * ra; qq = Sb * rb + qq; opart[q] = qq[0] + qq[1];
                S[q] = (f32x4){Sa[0], Sa[1], Sb[0], Sb[1]}; }
            ops = nx;
        }
        const int stp = 4 * c - 1 + (kl & 3);
        const int pos = dir ? (L - 1 - stp) : stp;
#pragma unroll
        for (int q = 0; q < NS; ++q) { if (kl < 4 && stp >= 0) O[(size_t)pos * 256 + row[q]] = oval[q]; }
    };
    float* buf0 = wl; float* buf1 = wl + 1536;
    gl(rA, 0); gl(rB, 1);
    st(rA, buf0); gl(rA, 2);
    __builtin_amdgcn_wave_barrier();
    Ops ops = ldsread(buf0, 0);
    for (int c = 0; c < nch; c += 2) {
        st(rB, buf1); gl(rB, c + 3);
        __builtin_amdgcn_wave_barrier();
        chunk(buf0, buf1, ops, c);
        st(rA, buf0); gl(rA, c + 4);
        __builtin_amdgcn_wave_barrier();
        chunk(buf1, buf0, ops, c + 1);
    }
#pragma unroll
    for (int q = 0; q < NS; ++q) { const float ol = row16_sum(opart[q]); if (kl == 0) O[(size_t)(dir ? 0 : L - 1) * 256 + row[q]] = ol; }
    if (!sample) {
#pragma unroll
        for (int q = 0; q < NS; ++q) *(f32x4*)(POUT + O_NS + sidx[q]) = S[q];
    }
}

__device__ __forceinline__ void stage_qk(const float* __restrict__ src, int stride, bf16_t* dst, bool rope, int pos0, float scale, const f32x2* __restrict__ rt) {
    const int tid = TID();
#pragma unroll
    for (int i = 0; i < 2; ++i) {
        const int task = tid + i * 512, row = task >> 3, half = (task >> 2) & 1, quad = task & 3;
        const float* s = src + (size_t)row * stride + half * 32 + quad * 4;
        f32x4 x1 = *(const f32x4*)s, x2 = *(const f32x4*)(s + 16);
        if (rope) { const int pos = pos0 + row; const int pi = half ? (pos & 63) : (pos >> 6);
#pragma unroll
            for (int j = 0; j < 4; ++j) { const f32x2 cs = rt[pi * 16 + quad * 4 + j]; const float a = x1[j], b = x2[j]; x1[j] = a * cs[0] - b * cs[1]; x2[j] = b * cs[0] + a * cs[1]; } }
        x1 *= scale; x2 *= scale;
        u32x2 w1, w2; w1[0] = cvt_pk_bf16(x1[0], x1[1]); w1[1] = cvt_pk_bf16(x1[2], x1[3]); w2[0] = cvt_pk_bf16(x2[0], x2[1]); w2[1] = cvt_pk_bf16(x2[2], x2[3]);
        *(u32x2*)(dst + row * 72 + half * 32 + quad * 4) = w1; *(u32x2*)(dst + row * 72 + half * 32 + 16 + quad * 4) = w2;
    }
}
__device__ __forceinline__ void stage_vt(const float* __restrict__ src, int stride, bf16_t* vt, int nkeys = 128, int pitch = 136) {
    const int tid = TID();
    for (int task = tid; task < nkeys * 16; task += 512) { const int key = task >> 4, dq = task & 15;
        const f32x4 v = *(const f32x4*)(src + (size_t)key * stride + dq * 4);
#pragma unroll
        for (int j = 0; j < 4; ++j) vt[(dq * 4 + j) * pitch + key] = f2bf(v[j]); }
}
__device__ void attn_item(const Params& p, int l, int ai, unsigned char* lds) {
    const int tid = TID(), lane = tid & 63, wid = tid >> 6, fr = lane & 15, fq = lane >> 4;
    bf16_t* Qs = (bf16_t*)lds; bf16_t* Ks = Qs + 128 * 72; bf16_t* Vt = Ks + 128 * 72;
    const float* P = (const float*)(PWS + WS_P);
    const bf16_t* Z = (const bf16_t*)(PWS + WS_Z);
    bf16_t* YS = (bf16_t*)(PWS + WS_YS);
    const f32x2* rt = (const f32x2*)(PWS + WS_ROPE);
    bool sample; int b, head, qt, seqbase;
    if (ai < 128) { sample = true; b = ai >> 5; head = (ai >> 3) & 3; qt = ai & 7; seqbase = NTP + b * 1024; }
    else { const int j = ai - 128; sample = false; b = j >> 3; head = (j >> 1) & 3; qt = j & 1; seqbase = b * 256; }
    const int kh = head >> 1, qbase = seqbase + qt * 128;
    __syncthreads();
    stage_qk(P + (size_t)qbase * PW + C_CQ + head * 64, PW, Qs, sample, qt * 128, 0.125f, rt);
    __syncthreads();
    bf16x8 qf[2];
    qf[0] = *(const bf16x8*)(Qs + (wid * 16 + fr) * 72 + fq * 8); qf[1] = *(const bf16x8*)(Qs + (wid * 16 + fr) * 72 + 32 + fq * 8);
    float m = PIN(22)[l * 4 + head], lsum = 1.0f, lpart = 0.f;
    f32x4 oacc[4];
#pragma unroll
    for (int i = 0; i < 4; ++i) oacc[i] = (f32x4){0.f, 0.f, 0.f, 0.f};
    const int nkb = sample ? 7 : 2;
    const int qpos = qt * 128 + wid * 16 + fr;
    const float* ck = PIN(2); const float* cv = PIN(3);
    auto kinfo = [&](int kb, const float*& ks, const float*& vs, int& stride, bool& rope, bool& mask, int& kpos0) -> bool {
        if (!sample) { ks = P + (size_t)(seqbase + kb * 128) * PW + C_CK + kh * 64; vs = ks + (C_CV - C_CK); stride = PW; rope = false; mask = false; kpos0 = 0; return true; }
        if (kb < 3) { const int nbk = qt - 1 + kb; if (nbk < 0 || nbk >= 8) return false; kpos0 = nbk * 128;
            ks = P + (size_t)(seqbase + kpos0) * PW + C_CK + kh * 64; vs = ks + (C_CV - C_CK); stride = PW; rope = true; mask = (kb != 1); return true; }
        const size_t o = ((size_t)((b * 2 + l) * 512 + (kb - 3) * 128) * 2 + kh) * 64; ks = ck + o; vs = cv + o; stride = 128; rope = false; mask = false; kpos0 = 0; return true;
    };
    f32x4 kx1[2], kx2[2], vx[2][2];
    auto kload = [&](const float* ks, const float* vs, int stride) {
#pragma unroll
        for (int i = 0; i < 2; ++i) { const int task = tid + i * 512, row = task >> 3, half = (task >> 2) & 1, quad = task & 3;
            const float* s_ = ks + (size_t)row * stride + half * 32 + quad * 4; kx1[i] = *(const f32x4*)s_; kx2[i] = *(const f32x4*)(s_ + 16); }
#pragma unroll
        for (int i = 0; i < 2; ++i) { const int task = tid + i * 512, kp = task >> 4, dq = task & 15;
            vx[i][0] = *(const f32x4*)(vs + (size_t)(2 * kp) * stride + dq * 4); vx[i][1] = *(const f32x4*)(vs + (size_t)(2 * kp + 1) * stride + dq * 4); }
    };
    auto kstore = [&](bool rope, int kpos0) {
#pragma unroll
        for (int i = 0; i < 2; ++i) { const int task = tid + i * 512, row = task >> 3, half = (task >> 2) & 1, quad = task & 3;
            f32x4 x1 = kx1[i], x2 = kx2[i];
            if (rope) { const int pos = kpos0 + row; const int pi = half ? (pos & 63) : (pos >> 6);
#pragma unroll
                for (int j = 0; j < 4; ++j) { const f32x2 cs = rt[pi * 16 + quad * 4 + j]; const float a_ = x1[j], b_ = x2[j]; x1[j] = a_ * cs[0] - b_ * cs[1]; x2[j] = b_ * cs[0] + a_ * cs[1]; } }
            u32x2 w1, w2; w1[0] = cvt_pk_bf16(x1[0], x1[1]); w1[1] = cvt_pk_bf16(x1[2], x1[3]); w2[0] = cvt_pk_bf16(x2[0], x2[1]); w2[1] = cvt_pk_bf16(x2[2], x2[3]);
            *(u32x2*)(Ks + row * 72 + half * 32 + quad * 4) = w1; *(u32x2*)(Ks + row * 72 + half * 32 + 16 + quad * 4) = w2; }
#pragma unroll
        for (int i = 0; i < 2; ++i) { const int task = tid + i * 512, kp = task >> 4, dq = task & 15;
#pragma unroll
            for (int j = 0; j < 4; ++j) *(unsigned*)(Vt + (dq * 4 + j) * 136 + 2 * kp) = cvt_pk_bf16(vx[i][0][j], vx[i][1][j]); }
    };
    const float* ksrc = nullptr; const float* vsrc = nullptr; int stride = 0, kpos0n = 0; bool ropen = false, maskn = false;
    int kb = 0;
    while (kb < nkb && !kinfo(kb, ksrc, vsrc, stride, ropen, maskn, kpos0n)) ++kb;
    if (kb < nkb) kload(ksrc, vsrc, stride);
    while (kb < nkb) {
        const bool mask = maskn; const int kpos0 = kpos0n; const bool rope = ropen;
        __syncthreads();
        kstore(rope, kpos0);
        __syncthreads();
        int nk = kb + 1;
        while (nk < nkb && !kinfo(nk, ksrc, vsrc, stride, ropen, maskn, kpos0n)) ++nk;
        if (nk < nkb) kload(ksrc, vsrc, stride);
        kb = nk;
        f32x4 sc[4][2];
#pragma unroll
        for (int sb = 0; sb < 4; ++sb) {
            f32x4 s0 = (f32x4){0.f, 0.f, 0.f, 0.f}, s1 = s0;
#pragma unroll
            for (int dh = 0; dh < 2; ++dh) {
                const bf16x8 k0 = *(const bf16x8*)(Ks + (sb * 32 + fr) * 72 + dh * 32 + fq * 8), k1 = *(const bf16x8*)(Ks + (sb * 32 + 16 + fr) * 72 + dh * 32 + fq * 8);
                s0 = __builtin_amdgcn_mfma_f32_16x16x32_bf16(k0, qf[dh], s0, 0, 0, 0);
                s1 = __builtin_amdgcn_mfma_f32_16x16x32_bf16(k1, qf[dh], s1, 0, 0, 0);
            }
            if (mask) {
#pragma unroll
                for (int j = 0; j < 4; ++j) { const int k0p = kpos0 + sb * 32 + fq * 4 + j, k1p = k0p + 16; int d0 = qpos - k0p, d1 = qpos - k1p; d0 = d0 < 0 ? -d0 : d0; d1 = d1 < 0 ? -d1 : d1;
                    if (d0 > 128) s0[j] = -1e30f; if (d1 > 128) s1[j] = -1e30f; }
            }
            sc[sb][0] = s0; sc[sb][1] = s1;
        }
        float mx = -1e30f;
#pragma unroll
        for (int sb = 0; sb < 4; ++sb)
#pragma unroll
            for (int j = 0; j < 4; ++j) mx = fmaxf(mx, fmaxf(sc[sb][0][j], sc[sb][1][j]));
        mx = fmaxf(mx, __shfl_xor(mx, 16)); mx = fmaxf(mx, __shfl_xor(mx, 32));
        const float mn = fmaxf(m, mx), alpha = __expf(m - mn);
        m = mn; lsum *= alpha; lpart *= alpha;
#pragma unroll
        for (int dt = 0; dt < 4; ++dt) oacc[dt] = oacc[dt] * alpha;
#pragma unroll
        for (int sb = 0; sb < 4; ++sb) {
            f32x4 s0 = sc[sb][0], s1 = sc[sb][1];
#pragma unroll
            for (int j = 0; j < 4; ++j) { s0[j] = __expf(s0[j] - mn); s1[j] = __expf(s1[j] - mn); lpart += s0[j] + s1[j]; }
            u32x4 pw; pw[0] = cvt_pk_bf16(s0[0], s0[1]); pw[1] = cvt_pk_bf16(s0[2], s0[3]); pw[2] = cvt_pk_bf16(s1[0], s1[1]); pw[3] = cvt_pk_bf16(s1[2], s1[3]);
            bf16x8 pf; __builtin_memcpy(&pf, &pw, 16);
#pragma unroll
            for (int dt = 0; dt < 4; ++dt) {
                const bf16_t* vp = Vt + (dt * 16 + fr) * 136 + sb * 32 + fq * 4;
                u32x4 vw; const u32x2 va = *(const u32x2*)vp, vb = *(const u32x2*)(vp + 16); vw[0] = va[0]; vw[1] = va[1]; vw[2] = vb[0]; vw[3] = vb[1];
                bf16x8 vf; __builtin_memcpy(&vf, &vw, 16);
                oacc[dt] = __builtin_amdgcn_mfma_f32_16x16x32_bf16(vf, pf, oacc[dt], 0, 0, 0);
            }
        }
    }
    lpart += __shfl_xor(lpart, 16); lpart += __shfl_xor(lpart, 32);
    lsum += lpart;
    const float inv = 1.0f / lsum;
    const size_t t = (size_t)(qbase + wid * 16 + fr);
#pragma unroll
    for (int dt = 0; dt < 4; ++dt) {
        const int col = 512 + head * 64 + dt * 16 + fq * 4;
        const bf16x4 z = *(const bf16x4*)(Z + t * DM + col);
        u32x2 w; w[0] = cvt_pk_bf16(oacc[dt][0] * inv * bf2f((bf16_t)z[0]), oacc[dt][1] * inv * bf2f((bf16_t)z[1]));
        w[1] = cvt_pk_bf16(oacc[dt][2] * inv * bf2f((bf16_t)z[2]), oacc[dt][3] * inv * bf2f((bf16_t)z[3]));
        *(u32x2*)(YS + t * DM + col) = w;
    }
}

__device__ void chunk_item(const Params& p, int l, int ci, unsigned char* ldsb) {
    const int tid = TID(), lane = tid & 63, wid = tid >> 6, fr = lane & 15, fq = lane >> 4;
    const int chunk = ci >> 2, g = ci & 3, base = chunk * 128;
    bf16_t* wsb = (bf16_t*)ldsb;
    bf16_t* vt = wsb + 128 * 136;
    const float* P = (const float*)(PWS + WS_P);
    const bf16_t* Z = (const bf16_t*)(PWS + WS_Z);
    bf16_t* YS = (bf16_t*)(PWS + WS_YS);
    const float* wsrc = PIN(11) + (size_t)(l * 4 + g) * 128 * 128;
    __syncthreads();
#pragma unroll
    for (int i = 0; i < 8; ++i) { const int idx = tid + i * 512, r = idx >> 5, c4 = (idx & 31) * 4; const f32x4 v = *(const f32x4*)(wsrc + r * 128 + c4);
        u32x2 w; w[0] = cvt_pk_bf16(v[0], v[1]); w[1] = cvt_pk_bf16(v[2], v[3]); *(u32x2*)(wsb + r * 136 + c4) = w; }
    stage_vt(P + (size_t)base * PW + C_AV + g * 64, PW, vt, 128);
    __syncthreads();
    f32x4 acc[4];
#pragma unroll
    for (int n = 0; n < 4; ++n) acc[n] = (f32x4){0.f, 0.f, 0.f, 0.f};
#pragma unroll
    for (int k = 0; k < 4; ++k) {
        const bf16x8 af = *(const bf16x8*)(wsb + (wid * 16 + fr) * 136 + k * 32 + fq * 8);
#pragma unroll
        for (int n = 0; n < 4; ++n) { const bf16x8 bfv = *(const bf16x8*)(vt + (n * 16 + fr) * 136 + k * 32 + fq * 8);
            acc[n] = __builtin_amdgcn_mfma_f32_16x16x32_bf16(bfv, af, acc[n], 0, 0, 0); }
    }
    const int i = wid * 16 + fr; const size_t t = base + i;
    const float bsi = PIN(12)[(l * 4 + g) * 128 + i];
#pragma unroll
    for (int n = 0; n < 4; ++n) { const int col = g * 64 + n * 16 + fq * 4;
        const f32x4 u = *(const f32x4*)(P + t * PW + C_AU + col);
        const bf16x4 z = *(const bf16x4*)(Z + t * DM + col);
        u32x2 w; w[0] = cvt_pk_bf16(u[0] * (acc[n][0] + bsi) * bf2f((bf16_t)z[0]), u[1] * (acc[n][1] + bsi) * bf2f((bf16_t)z[1]));
        w[1] = cvt_pk_bf16(u[2] * (acc[n][2] + bsi) * bf2f((bf16_t)z[2]), u[3] * (acc[n][3] + bsi) * bf2f((bf16_t)z[3]));
        *(u32x2*)(YS + t * DM + col) = w; }
}

__device__ void pool_item(const Params& p, int l, int pi, unsigned char* ldsb) {
    const int tid = TID(), lane = tid & 63, wid = tid >> 6, fr = lane & 15, fq = lane >> 4, half = tid >> 8, ch = tid & 255, g = ch >> 6;
    const int tb = pi * 32; int seqbase, L, pos0; seq_of(tb, seqbase, L, pos0);
    float* pt = (float*)ldsb;
    bf16_t* dl = (bf16_t*)(pt + 48 * 256);
    bf16_t* wt = dl + 32 * 264;
    const float* P = (const float*)(PWS + WS_P);
    const bf16_t* Z = (const bf16_t*)(PWS + WS_Z);
    bf16_t* YS = (bf16_t*)(PWS + WS_YS);
    __syncthreads();
#pragma unroll
    for (int i = 0; i < 6; ++i) { const int idx = tid + i * 512, rr = idx >> 6, c4 = (idx & 63) * 4; const int pos = pos0 - 8 + rr;
        f32x4 v = (f32x4){0.f, 0.f, 0.f, 0.f};
        if (pos >= 0 && pos < L) v = *(const f32x4*)(P + (size_t)(seqbase + pos) * PW + C_DP + c4);
        *(f32x4*)(pt + rr * 256 + c4) = v; }
    { const float* pwsrc = PIN(23) + (size_t)l * 4 * 64 * 64;
#pragma unroll
      for (int gg = 0; gg < 4; ++gg) stage_vt(pwsrc + gg * 4096, 64, wt + gg * 64 * 72, 64, 72); }
    __syncthreads();
    const int w = 2 << g;
    for (int i = 0; i < 16; ++i) { const int tk = half * 16 + i, pos = pos0 + tk;
        int lo = pos - (w >> 1), hi = lo + w; lo = lo < 0 ? 0 : lo; hi = hi > L ? L : hi;
        float sm = 0.f;
        for (int q = lo; q < hi; ++q) sm += pt[(q - pos0 + 8) * 256 + ch];
        dl[tk * 264 + ch] = f2bf(sm / (float)(hi - lo) - pt[(tk + 8) * 256 + ch]); }
    __syncthreads();
    const int gw = wid >> 1, th = wid & 1;
    f32x4 acc[4];
#pragma unroll
    for (int n = 0; n < 4; ++n) acc[n] = (f32x4){0.f, 0.f, 0.f, 0.f};
#pragma unroll
    for (int k = 0; k < 2; ++k) {
        const bf16x8 af = *(const bf16x8*)(dl + (th * 16 + fr) * 264 + gw * 64 + k * 32 + fq * 8);
#pragma unroll
        for (int n = 0; n < 4; ++n) { const bf16x8 bfv = *(const bf16x8*)(wt + (gw * 64 + n * 16 + fr) * 72 + k * 32 + fq * 8);
            acc[n] = __builtin_amdgcn_mfma_f32_16x16x32_bf16(bfv, af, acc[n], 0, 0, 0); }
    }
    const size_t t = tb + th * 16 + fr;
#pragma unroll
    for (int n = 0; n < 4; ++n) { const int oc = gw * 64 + n * 16 + fq * 4;
        const f32x4 sc = *(const f32x4*)(PIN(24) + l * 256 + oc);
        const bf16x4 z = *(const bf16x4*)(Z + t * DM + 768 + oc);
        u32x2 wv; wv[0] = cvt_pk_bf16(acc[n][0] * sc[0] * bf2f((bf16_t)z[0]), acc[n][1] * sc[1] * bf2f((bf16_t)z[1]));
        wv[1] = cvt_pk_bf16(acc[n][2] * sc[2] * bf2f((bf16_t)z[2]), acc[n][3] * sc[3] * bf2f((bf16_t)z[3]));
        *(u32x2*)(YS + t * DM + 768 + oc) = wv; }
}

__device__ void phaseB1(const Params& p, int l, unsigned char* lds, int slot = 0, int part = 127) {
    const int tid = TID(), wid = tid >> 6;
    float* wl = (float*)lds + wid * 3072;
    if (!(part & 1)) {} else
    { const int nbh = (int)gridDim.x >> 1;
      if ((int)blockIdx.x < nbh) { if (wid < 4 && (part & 4)) for (int it = blockIdx.x * 4 + wid; it < 512; it += nbh * 4) { const int q = it >> 4, b = q >> 3;
            scan_run<1>(p, l, true, b, (q >> 1) & 3, q & 1, it & 15, 1024, NTP + b * 1024, wl); } }
      else { const int nb2 = (int)gridDim.x - nbh; if (part & 8) for (int it = ((int)blockIdx.x - nbh) * 8 + wid; it < 1024; it += nb2 * 8) { const int q = it >> 3, b = q >> 3;
            scan_run<2>(p, l, false, b, (q >> 1) & 3, q & 1, it & 7, 256, b * 256, wl); } } }
    __syncthreads();
    __shared__ int s_item;
    unsigned* ctr = (unsigned*)(PWS + WS_CTR) + l + 2 * slot;
    if (part & 2)
    for (;;) {
        if (tid == 0) s_item = (int)atomicAdd(ctr, 1u);
        __syncthreads();
        const int item = s_item;
        __syncthreads();
        if (item >= 768) break;
        if (item < 256) { if (part & 16) attn_item(p, l, item, lds); }
        else if (item < 512) { if (part & 32) chunk_item(p, l, item - 256, lds); }
        else { if (part & 64) pool_item(p, l, item - 512, lds); }
    }
}

__device__ void phaseB2(const Params& p, int l) {
    const int lane = TID() & 63, gw = blockIdx.x * 8 + (TID() >> 6), W = gridDim.x * 8;
    const float* O = (const float*)(PWS + WS_O);
    const float* recS = (const float*)(PWS + WS_RECS);
    const float* BC = (const float*)(PWS + WS_BC);
    const bf16_t* Z = (const bf16_t*)(PWS + WS_Z);
    bf16_t* YS = (bf16_t*)(PWS + WS_YS);
    const float* lng = PIN(20) + l * 256; const float* lnb = PIN(21) + l * 256;
    float g4[4], b4[4];
#pragma unroll
    for (int h = 0; h < 4; ++h) { g4[h] = lng[h * 64 + lane]; b4[h] = lnb[h * 64 + lane]; }
    for (int tok = gw; tok < NT; tok += W) {
        int seqbase, L, pos; seq_of(tok, seqbase, L, pos);
        float o[4], vv[4], z[4], mu[4], var[4];
        const f32x4 bc = *(const f32x4*)(BC + tok * 4);
#pragma unroll
        for (int h = 0; h < 4; ++h) { const int c = h * 64 + lane;
            o[h] = O[(size_t)tok * 256 + c] + O[(size_t)NT * 256 + (size_t)tok * 256 + c];
            vv[h] = recS[((size_t)seqbase * 4 + (size_t)h * L + pos) * 192 + 128 + lane];
            z[h] = bf2f(Z[(size_t)tok * DM + 256 + c]); }
#pragma unroll
        for (int h = 0; h < 4; ++h) mu[h] = wave_sum(o[h]) * (1.0f / 64.0f);
#pragma unroll
        for (int h = 0; h < 4; ++h) { o[h] -= mu[h]; var[h] = wave_sum(o[h] * o[h]) * (1.0f / 64.0f); }
#pragma unroll
        for (int h = 0; h < 4; ++h) { const float on = o[h] * rsqrtf(var[h] + 64e-5f);
            const float y = on * g4[h] + b4[h] + bc[h] * vv[h];
            YS[(size_t)tok * DM + 256 + h * 64 + lane] = f2bf(y * z[h]); }
    }
}

__device__ void phaseC1(const Params& p, int l, unsigned char* lds) {
    pg8::Gemm g; g.A = (const bf16_t*)(PWS + WS_H); g.Bt = (const bf16_t*)(PWS + WS_WTIN) + (size_t)l * INW * 1024 + (size_t)NA_COLS * 1024; g.M = NT; g.N = 4096; g.K = 1024;
    pg8::StaticOrder S; S.init(g.M, g.N, (int)gridDim.x, (int)blockIdx.x);
    EpiG E; E.G = (bf16_t*)(PWS + WS_G);
    pg8::gemm_phase<EpiG, pg8::StaticOrder, false>((PG8_LAS unsigned char*)lds, g, S, E, nullptr);
    __syncthreads();
}
__device__ void phaseC2(const Params& p, int l, unsigned char* lds) {
    constexpr int MT = 4, LDT = 72, A_BYTES = 256 * LDT * 2, B_BYTES = 128 * LDT * 2, BUF = A_BYTES + B_BYTES;
    const int tid = TID(), lane = tid & 63, wid = tid >> 6, wr = wid >> 1, wc = wid & 1, fr = lane & 15, fq = lane >> 4;
    const bf16_t* YS = (const bf16_t*)(PWS + WS_YS);
    const bf16_t* G = (const bf16_t*)(PWS + WS_G);
    const bf16_t* Wu = (const bf16_t*)(PWS + WS_WTUP) + (size_t)l * 4 * 1024 * 256;
    bf16_t* MG = (bf16_t*)(PWS + WS_MERGED);
    const int srow = tid >> 3, skc = tid & 7, soff = (srow * LDT + skc * 8) * 2;
    const int aoff = ((wr * MT * 16 + fr) * LDT + fq * 8) * 2, boff = A_BYTES + ((wc * 64 + fr) * LDT + fq * 8) * 2;
    const int NU = 32 * 8;
    for (int u = blockIdx.x; u < NU; u += gridDim.x) {
        const int pn = u / 32, pm = u % 32;
        const bf16_t* Ag = YS + ((size_t)pm * 256 + srow) * 1024 + skc * 8;
        const bf16_t* Bg = Wu + ((size_t)pn * 128 + srow) * 256 + skc * 8;
        f32x4 mg[4][4], acc[4][4]; zero_acc<4>(mg); zero_acc<4>(acc);
        u32x4 ra[MT], rb[2];
        auto gload = [&](int kt) {
#pragma unroll
            for (int i = 0; i < MT; ++i) ra[i] = *(const u32x4*)(Ag + (size_t)i * 64 * 1024 + kt * 64);
            const bf16_t* bb = Bg + (size_t)(kt >> 2) * 1024 * 256 + (kt & 3) * 64;
#pragma unroll
            for (int i = 0; i < 2; ++i) rb[i] = *(const u32x4*)(bb + (size_t)i * 64 * 256);
        };
        auto sstore = [&](int buf) { unsigned char* nb = lds + buf * BUF;
#pragma unroll
            for (int i = 0; i < MT; ++i) *(u32x4*)(nb + soff + i * 64 * LDT * 2) = ra[i];
#pragma unroll
            for (int i = 0; i < 2; ++i) *(u32x4*)(nb + A_BYTES + soff + i * 64 * LDT * 2) = rb[i];
        };
        __syncthreads();
        gload(0); sstore(0);
        __syncthreads();
        for (int t = 0; t < 16; ++t) {
            if (t + 1 < 16) gload(t + 1);
            const unsigned char* base = lds + (t & 1) * BUF;
#pragma unroll
            for (int kk = 0; kk < 2; ++kk) {
                bf16x8 af[MT], bfr[4];
#pragma unroll
                for (int m = 0; m < MT; ++m) af[m] = *(const bf16x8*)(base + aoff + m * 16 * LDT * 2 + kk * 64);
#pragma unroll
                for (int n = 0; n < 4; ++n) bfr[n] = *(const bf16x8*)(base + boff + n * 16 * LDT * 2 + kk * 64);
#pragma unroll
                for (int m = 0; m < MT; ++m)
#pragma unroll
                    for (int n = 0; n < 4; ++n) acc[m][n] = __builtin_amdgcn_mfma_f32_16x16x32_bf16(bfr[n], af[m], acc[m][n], 0, 0, 0);
            }
            if (t + 1 < 16) sstore((t + 1) & 1);
            if ((t & 3) == 3) {
                const int n = t >> 2;
#pragma unroll
                for (int m = 0; m < 4; ++m) { const int row = pm * 256 + wr * 64 + m * 16 + fr;
                    const bf16_t* gp = G + g_off(row, n * 1024 + pn * 128 + wc * 64 + fq * 4);
                    const bf16x8 ga = *(const bf16x8*)gp, gb = *(const bf16x8*)(gp + 8);
#pragma unroll
                    for (int q = 0; q < 4; ++q) {
#pragma unroll
                        for (int j = 0; j < 4; ++j) { const bf16_t gv = (bf16_t)(q < 2 ? ga[q * 4 + j] : gb[(q - 2) * 4 + j]); mg[m][q][j] += bf2f(gv) * acc[m][q][j]; }
                        acc[m][q] = (f32x4){0.f, 0.f, 0.f, 0.f}; } }
            }
            __syncthreads();
        }
#pragma unroll
        for (int m = 0; m < 4; ++m) { const size_t row = (size_t)pm * 256 + wr * 64 + m * 16 + fr;
#pragma unroll
            for (int q = 0; q < 4; ++q) { const int col = pn * 128 + wc * 64 + q * 16 + fq * 4;
                u32x2 w; w[0] = cvt_pk_bf16(mg[m][q][0], mg[m][q][1]); w[1] = cvt_pk_bf16(mg[m][q][2], mg[m][q][3]);
                __hip_atomic_store((unsigned long long*)(MG + row * DM + col), ((unsigned long long)w[1] << 32) | w[0], __ATOMIC_RELAXED, __HIP_MEMORY_SCOPE_AGENT); } }
        asm volatile("s_waitcnt vmcnt(0)" ::: "memory");
        __syncthreads();
        if (tid == 0) __hip_atomic_fetch_add((unsigned*)(PWS + WS_XCNT) + (size_t)((2 + l) * 32 + pm) * 64, 1u, __ATOMIC_RELAXED, __HIP_MEMORY_SCOPE_AGENT);
    }
}

__device__ void phaseD(const Params& p, int l, unsigned char* lds) {
    const int tid = TID(), lane = tid & 63, wid = tid >> 6, wr = wid >> 1, wc = wid & 1, fr = lane & 15, fq = lane >> 4;
    const bf16_t* MG = (const bf16_t*)(PWS + WS_MERGED);
    const bf16_t* Wo = (const bf16_t*)(PWS + WS_WTO) + (size_t)l * 1024 * 1024;
    const int NU = 32 * 8;
    for (int u = blockIdx.x; u < NU; u += gridDim.x) {
        const int pn = u / 32, pm = u % 32;
        if (tid == 0) { unsigned* c2 = (unsigned*)(PWS + WS_XCNT) + (size_t)((2 + l) * 32 + pm) * 64; unsigned spins = 0;
            while (__hip_atomic_load(c2, __ATOMIC_RELAXED, __HIP_MEMORY_SCOPE_AGENT) < 8u) { __builtin_amdgcn_s_sleep(2); if (++spins > (1u << 22)) break; }
            __builtin_amdgcn_fence(__ATOMIC_ACQUIRE, "agent");
            asm volatile("s_waitcnt vmcnt(0)" ::: "memory"); }
        __syncthreads();
        f32x4 acc[4][4]; zero_acc<4>(acc);
        gemm_acc<4>(MG + (size_t)pm * 256 * 1024, 1024, Wo + (size_t)pn * 128 * 1024, 1024, 1024, acc, lds);
        float ssq[4];
#pragma unroll
        for (int m = 0; m < 4; ++m) { const int row = pm * 256 + wr * 64 + m * 16 + fr;
            const float* xr = xrow_ptr(p, l, row);
            const float* gate = (const float*)(PWS + WS_MOD) + (size_t)(l * 5 + modrow_of(row)) * 3072 + 2048;
            float sm = 0.f;
#pragma unroll
            for (int q = 0; q < 4; ++q) { const int col = pn * 128 + wc * 64 + q * 16 + fq * 4;
                const f32x4 xo = *(const f32x4*)(xr + col), gt = *(const f32x4*)(gate + col);
                acc[m][q] = xo + gt * acc[m][q];
                sm += (acc[m][q][0] * acc[m][q][0] + acc[m][q][1] * acc[m][q][1]) + (acc[m][q][2] * acc[m][q][2] + acc[m][q][3] * acc[m][q][3]); }
            sm += __shfl_xor(sm, 16); sm += __shfl_xor(sm, 32);
            ssq[m] = sm; }
        float* Pt = (float*)lds;
        float* St = Pt + 512;
        if (fq == 0) {
#pragma unroll
            for (int m = 0; m < 4; ++m) Pt[(wr * 64 + m * 16 + fr) * 2 + wc] = ssq[m]; }
        __syncthreads();
        float* XP = (float*)(PWS + WS_XP) + ((size_t)(l * 32 + pm) * 256) * 8;
        unsigned* cnt = (unsigned*)(PWS + WS_XCNT) + (size_t)(l * 32 + pm) * 64;
        if (tid < 256) __hip_atomic_store(XP + tid * 8 + pn, Pt[tid * 2] + Pt[tid * 2 + 1], __ATOMIC_RELAXED, __HIP_MEMORY_SCOPE_AGENT);
        asm volatile("s_waitcnt vmcnt(0)" ::: "memory");
        __syncthreads();
        if (tid == 0) {
            __hip_atomic_fetch_add(cnt, 1u, __ATOMIC_RELAXED, __HIP_MEMORY_SCOPE_AGENT);
            unsigned spins = 0;
            while (__hip_atomic_load(cnt, __ATOMIC_RELAXED, __HIP_MEMORY_SCOPE_AGENT) < 8u) { __builtin_amdgcn_s_sleep(2); if (++spins > (1u << 22)) break; }
            __builtin_amdgcn_fence(__ATOMIC_ACQUIRE, "agent");
            asm volatile("s_waitcnt vmcnt(0)" ::: "memory");
        }
        __syncthreads();
        if (tid < 256) { float t = 0.f;
#pragma unroll
            for (int k = 0; k < 8; ++k) t += __hip_atomic_load(XP + tid * 8 + k, __ATOMIC_RELAXED, __HIP_MEMORY_SCOPE_AGENT);
            St[tid] = rsqrtf(t * (1.0f / 1024.0f) + 1e-6f); }
        __syncthreads();
        const float* gn = (l == 0) ? PIN(9) + DM : PIN(27);
        bf16_t* H = (bf16_t*)(PWS + WS_H);
#pragma unroll
        for (int m = 0; m < 4; ++m) { const int rl_ = wr * 64 + m * 16 + fr, row = pm * 256 + rl_;
            const float rs = St[rl_];
            const float* md = (const float*)(PWS + WS_MOD) + (size_t)(5 + modrow_of(row)) * 3072;
#pragma unroll
            for (int q = 0; q < 4; ++q) { const int col = pn * 128 + wc * 64 + q * 16 + fq * 4;
                const f32x4 gg = *(const f32x4*)(gn + col);
                if (l == 0) { *(f32x4*)(POUT + (size_t)row * DM + col) = acc[m][q];
                    const f32x4 sh = *(const f32x4*)(md + col), scl = *(const f32x4*)(md + 1024 + col);
                    const f32x4 h = acc[m][q] * rs * gg * (1.0f + scl) + sh;
                    u32x2 w; w[0] = cvt_pk_bf16(h[0], h[1]); w[1] = cvt_pk_bf16(h[2], h[3]); *(u32x2*)(H + (size_t)row * DM + col) = w; }
                else *(f32x4*)(POUT + (size_t)row * DM + col) = acc[m][q] * rs * gg; } }
    }
}

__device__ void phaseF(const Params& p) {
    const int lane = TID() & 63, gw = blockIdx.x * 8 + (TID() >> 6), W = gridDim.x * 8;
    const float* g = PIN(27);
    for (int row = gw; row < NT; row += W) {
        float* x = POUT + (size_t)row * DM;
        f32x4 v[4]; float ss = 0.f;
#pragma unroll
        for (int i = 0; i < 4; ++i) { v[i] = *(const f32x4*)(x + i * 256 + lane * 4); ss += v[i][0] * v[i][0] + v[i][1] * v[i][1] + v[i][2] * v[i][2] + v[i][3] * v[i][3]; }
        ss = wave_sum(ss);
        const float rs = rsqrtf(ss * (1.0f / 1024.0f) + 1e-6f);
#pragma unroll
        for (int i = 0; i < 4; ++i) { const int c = i * 256 + lane * 4; *(f32x4*)(x + c) = v[i] * rs * *(const f32x4*)(g + c); }
    }
}

__global__ void __launch_bounds__(NTHREADS) fwd_megakernel(Params p) {
    extern __shared__ __attribute__((aligned(16))) unsigned char lds[];
    volatile LAS unsigned* st = (volatile LAS unsigned*)(lds + LDS_MAIN);
    if (threadIdx.x < 2) st[threadIdx.x] = 0u;
    if (threadIdx.x == 0) {
#pragma unroll
        for (int i = 0; i < 28; ++i) s_ptab[i] = (unsigned long long)p.in[i];
    }
    __syncthreads();
    const XcdBarrier xb = xcd_barrier_post((unsigned*)(PWS + WS_BAR), st);
#define GSYNC() xcd_barrier(xb)
    phase0(p, lds);
    GSYNC();
#pragma unroll 1
    for (int l = 0; l < 2; ++l) {
#pragma unroll 1
        for (int ap = 0; ap < 2; ++ap) { phaseA(p, l, lds, ap); if (ap == 0) GSYNC(); }
        phaseB0(p, l, lds);
        GSYNC();
        phaseB1(p, l, lds);
        GSYNC();
        phaseB2(p, l);
        phaseC1(p, l, lds);
        GSYNC();
        phaseC2(p, l, lds);
        phaseD(p, l, lds);
        if (l == 0) GSYNC();
    }
}

extern "C" void kernel_launch(void* const* d_in, const int* in_sizes, int n_in, void* d_out, int out_size, void* d_ws, size_t ws_size, hipStream_t stream) {
    static int grid_blocks = 0;
    if (!grid_blocks) {
        int dev = 0, cus = 0, per_cu = 0;
        hipGetDevice(&dev);
        hipDeviceGetAttribute(&cus, hipDeviceAttributeMultiprocessorCount, dev);
        hipFuncSetAttribute((const void*)fwd_megakernel, hipFuncAttributeMaxDynamicSharedMemorySize, LDS_BYTES);
        hipOccupancyMaxActiveBlocksPerMultiprocessor(&per_cu, (const void*)fwd_megakernel, NTHREADS, LDS_BYTES);
        if (per_cu < 1) { fprintf(stderr, "occupancy query returned %d\n", per_cu); per_cu = 1; }
        if (per_cu > 1) per_cu = 1;
        grid_blocks = cus * per_cu;
        if (ws_size < WS_END) fprintf(stderr, "workspace too small: %zu < %zu\n", ws_size, (size_t)WS_END);
    }
    Params p{};
    for (int i = 0; i < 28; ++i) p.in[i] = (const float*)d_in[i];
    p.out = (float*)d_out; p.ws = (unsigned char*)d_ws;
    hipMemsetAsync((char*)d_ws + WS_CTR, 0, 256 + 3456 * 4, stream);
    void* args[] = {&p};
    hipError_t e = hipLaunchCooperativeKernel((const void*)fwd_megakernel, dim3(grid_blocks), dim3(NTHREADS), args, LDS_BYTES, stream);
    if (e != hipSuccess) fprintf(stderr, "cooperative launch failed: %s (grid %d)\n", hipGetErrorString(e), grid_blocks);
}
```

```cpp
#include <hip/hip_runtime.h>
#include <hip/hip_cooperative_groups.h>
#include <cstdio>
namespace cg = cooperative_groups;

typedef unsigned short bf16_t;
typedef short bf16x8 __attribute__((ext_vector_type(8)));
typedef short bf16x4 __attribute__((ext_vector_type(4)));
typedef float f32x4 __attribute__((ext_vector_type(4)));
typedef float f32x2 __attribute__((ext_vector_type(2)));
typedef unsigned u32x4 __attribute__((ext_vector_type(4)));
typedef unsigned u32x2 __attribute__((ext_vector_type(2)));

constexpr int NT = 8192, NTP = 4096, DM = 1024, INW = 7296, NA_COLS = 3200, PW = 2176;
constexpr int NTHREADS = 512;
constexpr int C_AU = 0, C_AV = 256, C_BR = 512, C_BK = 768, C_BV = 1024, C_WD = 1280, C_AD = 1344, C_CQ = 1408, C_CK = 1664, C_CV = 1792, C_DP = 1920;
constexpr size_t O_YP = 0, O_YS = 4194304, O_NK = 8388608, O_NV = 9437184, O_NS = 10485760;
constexpr size_t WS_WTIN = 0;
constexpr size_t WS_WTUP = WS_WTIN + (size_t)2 * INW * DM * 2;
constexpr size_t WS_WTO  = WS_WTUP + (size_t)2 * 4 * 1024 * 256 * 2;
constexpr size_t WS_MOD  = WS_WTO + (size_t)2 * 1024 * 1024 * 2;
constexpr size_t WS_ROPE = WS_MOD + (size_t)2 * 5 * 3072 * 4;
constexpr size_t WS_CTR  = WS_ROPE + 64 * 16 * 8;
constexpr size_t WS_BAR  = WS_CTR + 256;
constexpr size_t WS_H    = WS_BAR + 3456 * 4;
constexpr size_t WS_P    = WS_H + (size_t)NT * DM * 2;
constexpr size_t WS_Z    = WS_P + (size_t)NT * PW * 4;
constexpr size_t WS_RECS = WS_Z + (size_t)NT * DM * 2;
constexpr size_t WS_RECD = WS_RECS + (size_t)NT * 4 * 192 * 4;
constexpr size_t WS_O    = WS_RECD + (size_t)2 * NT * 4 * 192 * 4;
constexpr size_t WS_BC   = WS_O + (size_t)2 * NT * 256 * 4;
constexpr size_t WS_YS   = WS_BC + (size_t)NT * 4 * 4;
constexpr size_t WS_LORAT = WS_YS + (size_t)NT * DM * 2;
constexpr size_t WS_XP   = WS_LORAT + (size_t)2 * 4 * 256 * 64 * 2;
constexpr size_t WS_XCNT = WS_XP + (size_t)2 * 32 * 256 * 8 * 4;
constexpr size_t WS_END  = WS_XCNT + (size_t)4 * 32 * 256;
constexpr size_t WS_G = WS_P;
constexpr size_t WS_MERGED = WS_RECS;
constexpr size_t RECD_STRIDE = (size_t)NT * 4 * 192;

constexpr int LDS_MAIN = 131072;
constexpr int LDS_BYTES = LDS_MAIN + 16;

struct Params {
    const float* in[28];
    float* out;
    unsigned char* ws;
};
__shared__ unsigned long long s_ptab[28];
__device__ __forceinline__ const float* ld_inptr(int k) {
    const unsigned long long v = s_ptab[k];
    const unsigned lo = __builtin_amdgcn_readfirstlane((unsigned)v), hi = __builtin_amdgcn_readfirstlane((unsigned)(v >> 32));
    return (const float*)(((unsigned long long)hi << 32) | lo);
}
#define PIN(k) (ld_inptr(k))
#define POUT (p.out)
#define PWS (p.ws)

__device__ __forceinline__ int TID() { int t = threadIdx.x; asm volatile("" : "+v"(t)); return t; }
__device__ __forceinline__ unsigned cvt_pk_bf16(float lo, float hi) { unsigned r; asm volatile("v_cvt_pk_bf16_f32 %0, %1, %2" : "=v"(r) : "v"(lo), "v"(hi)); return r; }
__device__ __forceinline__ bf16_t f2bf(float f) { return (bf16_t)(cvt_pk_bf16(f, 0.f) & 0xffffu); }
__device__ __forceinline__ float bf2f(bf16_t b) { return __uint_as_float(((unsigned)b) << 16); }
__device__ __forceinline__ float sigmoidf_(float x) { return 1.0f / (1.0f + __expf(-x)); }
__device__ __forceinline__ float siluf_(float x) { return x / (1.0f + __expf(-x)); }
template <int CTRL> __device__ __forceinline__ float dpp_f(float x) { return __int_as_float(__builtin_amdgcn_update_dpp(0, __float_as_int(x), CTRL, 0xF, 0xF, false)); }
__device__ __forceinline__ float row16_sum(float x) {
    x += dpp_f<0x128>(x); x += dpp_f<0x124>(x); x += dpp_f<0x122>(x); x += dpp_f<0x121>(x); return x;
}
__device__ __forceinline__ float wave_sum(float v) { v = row16_sum(v); v += __shfl_xor(v, 16); v += __shfl_xor(v, 32); return v; }
__device__ __forceinline__ void seq_of(int tok, int& seqbase, int& L, int& pos) {
    if (tok < NTP) { seqbase = tok & ~255; L = 256; pos = tok & 255; }
    else { int t2 = tok - NTP; seqbase = NTP + (t2 & ~1023); L = 1024; pos = t2 & 1023; }
}
__device__ __forceinline__ int modrow_of(int tok) { return tok < NTP ? 0 : 1 + ((tok - NTP) >> 10); }


#define XB_TMO      128
#define XB_XCNT(j)  (256  + 64 * (j))
#define XB_XSUB(j)  (1280 + 64 * (j))
#define XB_XGEN(j)  (2304 + 64 * (j))
#define XB_TOP      3328
#define XB_TOPGEN   3392
#define XCD_BAR_WORDS 3456
#define XB_SPIN_CAP (1u << 18)
#define LAS __attribute__((address_space(3)))
__device__ __forceinline__ unsigned xb_ld(unsigned* p)              { return __hip_atomic_load(p, __ATOMIC_RELAXED, __HIP_MEMORY_SCOPE_AGENT); }
__device__ __forceinline__ unsigned xb_add(unsigned* p, unsigned v) { return __hip_atomic_fetch_add(p, v, __ATOMIC_RELAXED, __HIP_MEMORY_SCOPE_AGENT); }
__device__ __forceinline__ unsigned xb_xcc_id() { return (unsigned)__builtin_amdgcn_s_getreg((3 << 11) | 20) & 0xFu; }
#define XB_SPIN(cond, bar) do { unsigned _sp = 0; while (cond) { __builtin_amdgcn_s_sleep(1); \
    if ((++_sp & 255u) == 0u) { if (xb_ld(&(bar)[XB_TMO])) break; if (_sp > XB_SPIN_CAP) { atomicAdd(&(bar)[XB_TMO], 1u); break; } } } } while (0)
struct XcdBarrier { unsigned* bar; unsigned x; volatile LAS unsigned* st; };
__device__ __forceinline__ XcdBarrier xcd_barrier_post(unsigned* bar, volatile LAS unsigned* st) {
    XcdBarrier b; b.bar = bar; b.x = xb_xcc_id(); b.st = st;
    if (threadIdx.x == 0) (void)xb_add(&bar[XB_XCNT(b.x)], 1u);
    return b;
}
__device__ __forceinline__ void xcd_barrier_complete(unsigned* bar, unsigned x, unsigned& nloc, unsigned& nx) {
    const unsigned G = gridDim.x * gridDim.y * gridDim.z;
    unsigned sum, cnt, mine, sp = 0u;
    for (;;) {
        sum = 0u; cnt = 0u; mine = 0u;
#pragma unroll
        for (unsigned j = 0; j < 16; ++j) { const unsigned c = xb_ld(&bar[XB_XCNT(j)]); sum += c; cnt += (c > 0u) ? 1u : 0u; mine = (j == x) ? c : mine; }
        if (sum == G) break;
        __builtin_amdgcn_s_sleep(1);
        if ((++sp & 255u) == 0u) { if (xb_ld(&bar[XB_TMO])) break; if (sp > XB_SPIN_CAP) { atomicAdd(&bar[XB_TMO], 1u); break; } }
    }
    nloc = mine > 0u ? mine : 1u; nx = cnt > 0u ? cnt : 1u;
}
__device__ __forceinline__ void xcd_barrier(const XcdBarrier& b0) {
    asm volatile("s_waitcnt vmcnt(0)" ::: "memory");
    __syncthreads();
    if (threadIdx.x == 0) {
        XcdBarrier b = b0;
        { unsigned xx = xb_xcc_id(); asm volatile("" : "+s"(xx)); b.x = xx; }
        unsigned* bar = b.bar;
        __builtin_amdgcn_s_waitcnt(0);
        unsigned nloc = b.st[0], nx = b.st[1];
        if (nloc == 0u) { xcd_barrier_complete(bar, b.x, nloc, nx); b.st[0] = nloc; b.st[1] = nx; }
        const unsigned old = xb_add(&bar[XB_XSUB(b.x)], 1u);
        const unsigned gen = old / nloc;
        if (old + 1u == (gen + 1u) * nloc) {
            __builtin_amdgcn_fence(__ATOMIC_RELEASE, "agent");
            asm volatile("s_waitcnt vmcnt(0)" ::: "memory");
            const unsigned og = xb_add(&bar[XB_TOP], 1u);
            const unsigned tg = og / nx;
            if (og + 1u == (tg + 1u) * nx) xb_add(&bar[XB_TOPGEN], 1u);
            else XB_SPIN(xb_ld(&bar[XB_TOPGEN]) == tg, bar);
            __builtin_amdgcn_fence(__ATOMIC_ACQUIRE, "agent");
            xb_add(&bar[XB_XGEN(b.x)], 1u);
            asm volatile("s_waitcnt vmcnt(0)" ::: "memory");
        } else {
            XB_SPIN(xb_ld(&bar[XB_XGEN(b.x)]) == gen, bar);
            __builtin_amdgcn_fence(__ATOMIC_ACQUIRE, "agent");
            asm volatile("s_waitcnt vmcnt(0)" ::: "memory");
        }
    }
    __syncthreads();
}

__device__ void conv_tile(const float* __restrict__ src, int N, bf16_t* __restrict__ dst, int K, int kt, int nt, float* tile) {
    const int tid = TID();
    { const int r = tid >> 4, c4 = (tid & 15) * 4;
#pragma unroll
      for (int i = 0; i < 2; ++i) { const int k = r + 32 * i; const f32x4 v = *(const f32x4*)(src + (size_t)(kt * 64 + k) * N + nt * 64 + c4);
          tile[k * 65 + c4 + 0] = v[0]; tile[k * 65 + c4 + 1] = v[1]; tile[k * 65 + c4 + 2] = v[2]; tile[k * 65 + c4 + 3] = v[3]; } }
    __syncthreads();
    { const int n = tid >> 3, kc = (tid & 7) * 8; u32x4 w;
      w[0] = cvt_pk_bf16(tile[(kc + 0) * 65 + n], tile[(kc + 1) * 65 + n]); w[1] = cvt_pk_bf16(tile[(kc + 2) * 65 + n], tile[(kc + 3) * 65 + n]);
      w[2] = cvt_pk_bf16(tile[(kc + 4) * 65 + n], tile[(kc + 5) * 65 + n]); w[3] = cvt_pk_bf16(tile[(kc + 6) * 65 + n], tile[(kc + 7) * 65 + n]);
      *(u32x4*)(dst + (size_t)(nt * 64 + n) * K + kt * 64 + kc) = w; }
    __syncthreads();
}

__device__ void mod_item(const Params& p, int l, int cc, float* lds) {
    const int tid = TID();
    float* sc = lds;
    float* red = lds + 5120;
    for (int i = tid; i < 5120; i += NTHREADS) { const int r = i >> 10, k = i & 1023; const float v = (r == 0) ? PIN(6)[k] : PIN(5)[(r - 1) * 1024 + k]; sc[i] = siluf_(v); }
    __syncthreads();
    const int kg = tid >> 5, c = tid & 31, col = cc * 32 + c;
    float a[5] = {0.f, 0.f, 0.f, 0.f, 0.f};
    const float* w = PIN(7) + (size_t)l * 1024 * 3072 + col;
    for (int k = kg * 64; k < kg * 64 + 64; ++k) { const float wv = w[(size_t)k * 3072];
#pragma unroll
        for (int r = 0; r < 5; ++r) a[r] += sc[r * 1024 + k] * wv; }
#pragma unroll
    for (int r = 0; r < 5; ++r) red[(kg * 5 + r) * 32 + c] = a[r];
    __syncthreads();
    if (tid < 160) { const int r = tid >> 5, c2 = tid & 31; float s = PIN(8)[l * 3072 + cc * 32 + c2];
        for (int g = 0; g < 16; ++g) s += red[(g * 5 + r) * 32 + c2];
        __hip_atomic_store((float*)(PWS + WS_MOD) + (l * 5 + r) * 3072 + cc * 32 + c2, s, __ATOMIC_RELAXED, __HIP_MEMORY_SCOPE_AGENT); }
    asm volatile("s_waitcnt vmcnt(0)" ::: "memory");
    __syncthreads();
    if (tid == 0 && l == 0) __hip_atomic_fetch_add((unsigned*)(PWS + WS_CTR) + 16, 1u, __ATOMIC_RELAXED, __HIP_MEMORY_SCOPE_AGENT);
}

__device__ void phaseA0(const Params& p, int l);
__device__ void phase0(const Params& p, unsigned char* lds) {
    const int NCONV_IN = 2 * 16 * 114, NCONV_UP = 8 * 64, NCONV_O = 2 * 256, NCONV_L = 32, NMOD = 192;
    const int total = NCONV_IN + NCONV_UP + NCONV_O + NCONV_L + NMOD + 1;
    for (int it = blockIdx.x; it < total; it += gridDim.x) {
        int i = it;
        if (i < NMOD) { mod_item(p, i / 96, i % 96, (float*)lds); continue; }
        i -= NMOD;
        if (i < NCONV_IN) { const int l = i / 1824, r = i % 1824, nt = r / 16, kt = r % 16;
            conv_tile(PIN(10) + (size_t)l * 1024 * INW, INW, (bf16_t*)(PWS + WS_WTIN) + (size_t)l * INW * 1024, 1024, kt, nt, (float*)lds); continue; }
        i -= NCONV_IN;
        if (i < NCONV_UP) { const int mtx = i / 64, r = i % 64, nt = r / 4, kt = r % 4;
            conv_tile(PIN(25) + (size_t)mtx * 256 * 1024, 1024, (bf16_t*)(PWS + WS_WTUP) + (size_t)mtx * 1024 * 256, 256, kt, nt, (float*)lds); continue; }
        i -= NCONV_UP;
        if (i < NCONV_O) { const int l = i / 256, r = i % 256, nt = r / 16, kt = r % 16;
            conv_tile(PIN(26) + (size_t)l * 1024 * 1024, 1024, (bf16_t*)(PWS + WS_WTO) + (size_t)l * 1024 * 1024, 1024, kt, nt, (float*)lds); continue; }
        i -= NCONV_O;
        if (i < NCONV_L) { const int l = i >> 4, m = (i >> 2) & 3, nt = i & 3;
            conv_tile((m < 2 ? PIN(14) : PIN(16)) + (size_t)(l * 2 + (m & 1)) * 64 * 256, 256, (bf16_t*)(PWS + WS_LORAT) + (size_t)(l * 4 + m) * 256 * 64, 64, 0, nt, (float*)lds); continue; }
        for (int e = TID(); e < 1024; e += NTHREADS) { const int pos = e >> 4, f = e & 15;
            const float inv = exp2f(-(float)f * (13.287712379549449f / 16.0f)); const float ang = (float)pos * inv;
            float sn, cs; sn = sinf(ang); cs = cosf(ang);
            ((f32x2*)(PWS + WS_ROPE))[e] = (f32x2){cs, sn}; }
        for (int e = TID(); e < 4 * 32 * 64; e += NTHREADS) ((unsigned*)(PWS + WS_XCNT))[e] = 0u;
    }
    if (TID() == 0) { unsigned* mc = (unsigned*)(PWS + WS_CTR) + 16; unsigned spins = 0;
        while (__hip_atomic_load(mc, __ATOMIC_RELAXED, __HIP_MEMORY_SCOPE_AGENT) < 96u) { __builtin_amdgcn_s_sleep(2); if (++spins > (1u << 22)) break; }
        __builtin_amdgcn_fence(__ATOMIC_ACQUIRE, "agent");
        asm volatile("s_waitcnt vmcnt(0)" ::: "memory"); }
    __syncthreads();
    phaseA0(p, 0);
}

__device__ __forceinline__ const float* xrow_ptr(const Params& p, int l, int row) {
    if (l == 0) return row < NTP ? PIN(0) + (size_t)row * DM : PIN(1) + (size_t)(row - NTP) * DM;
    return POUT + (size_t)row * DM;
}
__device__ void phaseA0(const Params& p, int l) {
    const int lane = TID() & 63, gw = blockIdx.x * 8 + (TID() >> 6), W = gridDim.x * 8;
    const float* g = PIN(9) + l * DM;
    bf16_t* H = (bf16_t*)(PWS + WS_H);
    for (int row = gw; row < NT; row += W) {
        const float* x = xrow_ptr(p, l, row);
        f32x4 v[4]; float ss = 0.f;
#pragma unroll
        for (int i = 0; i < 4; ++i) { v[i] = *(const f32x4*)(x + i * 256 + lane * 4); ss += v[i][0] * v[i][0] + v[i][1] * v[i][1] + v[i][2] * v[i][2] + v[i][3] * v[i][3]; }
        ss = wave_sum(ss);
        const float rs = rsqrtf(ss * (1.0f / 1024.0f) + 1e-6f);
        const float* mod = (const float*)(PWS + WS_MOD) + (size_t)(l * 5 + modrow_of(row)) * 3072;
#pragma unroll
        for (int i = 0; i < 4; ++i) { const int c = i * 256 + lane * 4;
            const f32x4 gg = *(const f32x4*)(g + c), sh = *(const f32x4*)(mod + c), scl = *(const f32x4*)(mod + 1024 + c);
            f32x4 h = v[i] * rs * gg * (1.0f + scl) + sh;
            u32x2 w; w[0] = cvt_pk_bf16(h[0], h[1]); w[1] = cvt_pk_bf16(h[2], h[3]);
            *(u32x2*)(H + (size_t)row * DM + c) = w; }
    }
}

template <int MT>
__device__ __forceinline__ void gemm_acc(const bf16_t* __restrict__ A, int lda, const bf16_t* __restrict__ B, int ldb, int K, f32x4 (&acc)[MT][4], unsigned char* lds) {
    constexpr int BM = MT * 64, LDT = 72, A_BYTES = BM * LDT * 2, B_BYTES = 128 * LDT * 2, BUF = A_BYTES + B_BYTES;
    const int tid = TID(), lane = tid & 63, wid = tid >> 6, wr = wid >> 1, wc = wid & 1, fr = lane & 15, fq = lane >> 4;
    u32x4 ra[MT], rb[2];
    const int srow = tid >> 3, skc = tid & 7;
    const bf16_t* Ag = A + (size_t)srow * lda + skc * 8;
    const bf16_t* Bg = B + (size_t)srow * ldb + skc * 8;
    const int soff = (srow * LDT + skc * 8) * 2;
    const int nt = K >> 6;
    __syncthreads();
#pragma unroll
    for (int i = 0; i < MT; ++i) ra[i] = *(const u32x4*)(Ag + (size_t)i * 64 * lda);
#pragma unroll
    for (int i = 0; i < 2; ++i) rb[i] = *(const u32x4*)(Bg + (size_t)i * 64 * ldb);
#pragma unroll
    for (int i = 0; i < MT; ++i) *(u32x4*)(lds + soff + i * 64 * LDT * 2) = ra[i];
#pragma unroll
    for (int i = 0; i < 2; ++i) *(u32x4*)(lds + A_BYTES + soff + i * 64 * LDT * 2) = rb[i];
    __syncthreads();
    const int aoff = ((wr * MT * 16 + fr) * LDT + fq * 8) * 2, boff = A_BYTES + ((wc * 64 + fr) * LDT + fq * 8) * 2;
    for (int t = 0; t < nt; ++t) {
        if (t + 1 < nt) {
#pragma unroll
            for (int i = 0; i < MT; ++i) ra[i] = *(const u32x4*)(Ag + (size_t)i * 64 * lda + (t + 1) * 64);
#pragma unroll
            for (int i = 0; i < 2; ++i) rb[i] = *(const u32x4*)(Bg + (size_t)i * 64 * ldb + (t + 1) * 64);
        }
        const unsigned char* base = lds + (t & 1) * BUF;
#pragma unroll
        for (int kk = 0; kk < 2; ++kk) {
            bf16x8 af[MT], bfr[4];
#pragma unroll
            for (int m = 0; m < MT; ++m) af[m] = *(const bf16x8*)(base + aoff + m * 16 * LDT * 2 + kk * 64);
#pragma unroll
            for (int n = 0; n < 4; ++n) bfr[n] = *(const bf16x8*)(base + boff + n * 16 * LDT * 2 + kk * 64);
#pragma unroll
            for (int m = 0; m < MT; ++m)
#pragma unroll
                for (int n = 0; n < 4; ++n) acc[m][n] = __builtin_amdgcn_mfma_f32_16x16x32_bf16(bfr[n], af[m], acc[m][n], 0, 0, 0);
        }
        if (t + 1 < nt) {
            unsigned char* nb = lds + ((t + 1) & 1) * BUF;
#pragma unroll
            for (int i = 0; i < MT; ++i) *(u32x4*)(nb + soff + i * 64 * LDT * 2) = ra[i];
#pragma unroll
            for (int i = 0; i < 2; ++i) *(u32x4*)(nb + A_BYTES + soff + i * 64 * LDT * 2) = rb[i];
        }
        __syncthreads();
    }
}
template <int MT> __device__ __forceinline__ void zero_acc(f32x4 (&acc)[MT][4]) {
#pragma unroll
    for (int m = 0; m < MT; ++m)
#pragma unroll
        for (int n = 0; n < 4; ++n) acc[m][n] = (f32x4){0.f, 0.f, 0.f, 0.f};
}

namespace pg8 {
#define PG8_LAS __attribute__((address_space(3)))
typedef unsigned short bf16_t;
typedef short bf16x8 __attribute__((ext_vector_type(8)));
typedef float f32x4 __attribute__((ext_vector_type(4)));
typedef unsigned u32x4 __attribute__((ext_vector_type(4)));
constexpr int BM = 256, BK = 64, HALF = 128, HTB = HALF * BK * 2  , STAGE_BYTES = 8 * HTB, NXCD = 8, WGM = 8;

__host__ __device__ __forceinline__ int lds_byte(int r, int c) { const int st = (r >> 4) * 2 + (c >> 5), rr = r & 15, cc = c & 31, ob = rr * 64 + cc * 2; return st * 1024 + (ob ^ (((ob >> 9) & 1) << 5)); }
__host__ __device__ __forceinline__ void stage_rc(int b, int& R, int& C) { const int st = b / 1024, sb = b % 1024, swz = sb ^ (((sb >> 9) & 1) << 5); R = (st >> 1) * 16 + swz / 64; C = (st & 1) * 32 + (swz % 64) / 2; }
__host__ __device__ __forceinline__ int perm32(int rho) { const int n = rho >> 4, i = rho & 15; return 8 * (i >> 2) + 4 * n + (i & 3); }

struct Unit { int pm, pn; };
struct Gemm { const bf16_t* A; const bf16_t* Bt; int M, N, K; };

struct StaticOrder {
    int nM, nN, nwg, G, c;
    __host__ __device__ void init(int M, int N, int G_, int c_) { nM = M / BM; nN = N / BM; nwg = nM * nN; G = G_; c = c_; }
    __host__ __device__ bool next(int i, Unit& u) const {
        const long L = (long)i * G + c; if (L >= nwg) return false;
        int wgid = (int)L; { const int q = nwg / NXCD, r = nwg % NXCD, xcd = wgid % NXCD, off = wgid / NXCD; wgid = (xcd < r ? xcd * (q + 1) : r * (q + 1) + (xcd - r) * q) + off; }
        const int nig = WGM * nN, gid = wgid / nig, fm = gid * WGM, gsz = (nM - fm) < WGM ? (nM - fm) : WGM;
        u.pm = fm + ((wgid % nig) % gsz); u.pn = (wgid % nig) / gsz; return true;
    }
    __device__ __forceinline__ void a_ready(const Unit&) const {}
    __device__ __forceinline__ void done(const Unit&) const {}
};
template <class Epi, class Sched, bool STAMP = false>
__device__ __forceinline__ void gemm_phase(PG8_LAS unsigned char* lds, const Gemm g, const Sched& S, const Epi& E, unsigned long long* stamps) {
    const int tid = ::TID(), wid = __builtin_amdgcn_readfirstlane(tid >> 6), lane = tid & 63, wr = wid >> 2, wc = wid & 3, fr = lane & 15, fq = lane >> 4;
    const int K = g.K, nt = K / BK;
    int ts_lo = 0, ts_hi = 0, nts = 0; const unsigned long long rt_entry = STAMP ? (unsigned long long)wall_clock64() : 0ull;
#define PG8_STAMP() do { if (STAMP && wid == 0 && nts < 64) { const unsigned long long _c = (unsigned long long)clock64(); \
        ts_lo = (lane == nts) ? (int)(unsigned)_c : ts_lo; ts_hi = (lane == nts) ? (int)(unsigned)(_c >> 32) : ts_hi; ++nts; } } while (0)
    PG8_STAMP();
    unsigned voffA[2], voffB[2];
#pragma unroll
    for (int i = 0; i < 2; ++i) { int R, C; stage_rc(tid * 16 + i * 8192, R, C); const int Rb = Epi::PERM ? ((R & ~31) + perm32(R & 31)) : R;
        voffA[i] = (unsigned)(R * K + C) * 2u; voffB[i] = (unsigned)(Rb * K + C) * 2u; }
    const size_t kstep = (size_t)(BK * 2);
    const size_t hstep = (size_t)HALF * K * 2;
    const size_t tstep = 2 * hstep;
    const unsigned ldsw = (unsigned)wid * 1024u;
    const int aoff = lds_byte(wr * 64 + fr, fq * 8), boff = lds_byte(wc * 32 + fr, fq * 8);
#define PG8_SA(b, h) (((b) * 2 + (h)) * HTB)
#define PG8_SB(b, h) ((4 + (b) * 2 + (h)) * HTB)
#define PG8_STAGE(bufoff, gbase, voff) do { _Pragma("unroll") for (int _i = 0; _i < 2; ++_i) \
        __builtin_amdgcn_global_load_lds((const unsigned*)((const char*)(gbase) + (voff)[_i]), (PG8_LAS unsigned*)(lds + (bufoff) + ldsw + _i * 8192), 16, 0, 0); } while (0)
#define PG8_LDA(dst, b, h) do { _Pragma("unroll") for (int m = 0; m < 4; ++m) _Pragma("unroll") for (int k = 0; k < 2; ++k) dst[m][k] = *(const PG8_LAS bf16x8*)(lds + PG8_SA(b, h) + aoff + m * 2048 + k * 1024); } while (0)
#define PG8_LDB(dst, b, h) do { _Pragma("unroll") for (int n = 0; n < 2; ++n) _Pragma("unroll") for (int k = 0; k < 2; ++k) dst[n][k] = *(const PG8_LAS bf16x8*)(lds + PG8_SB(b, h) + boff + n * 2048 + k * 1024); } while (0)
#define PG8_MMA(ai, bj, At, Bt) do { __builtin_amdgcn_s_setprio(1); _Pragma("unroll") for (int m = 0; m < 4; ++m) _Pragma("unroll") for (int n = 0; n < 2; ++n) _Pragma("unroll") for (int k = 0; k < 2; ++k) \
        acc[ai][bj][m][n] = __builtin_amdgcn_mfma_f32_16x16x32_bf16(Bt[n][k], At[m][k], acc[ai][bj][m][n], 0, 0, 0); __builtin_amdgcn_s_setprio(0); } while (0)
#define PG8_WAIT_V(n) asm volatile("s_waitcnt vmcnt(" #n ")" ::: "memory")
#define PG8_WAIT_L(n) asm volatile("s_waitcnt lgkmcnt(" #n ")" ::: "memory")
#define PG8_BAR __builtin_amdgcn_s_barrier()
#define PG8_SCHED __builtin_amdgcn_sched_barrier(0)
    Unit cur, nxt; int ui = 0;
    if (!S.next(0, cur)) return;
    f32x4 acc[2][2][4][2];
#pragma unroll
    for (int a = 0; a < 2; ++a)
#pragma unroll
        for (int b = 0; b < 2; ++b)
#pragma unroll
            for (int m = 0; m < 4; ++m)
#pragma unroll
                for (int n = 0; n < 2; ++n) acc[a][b][m][n] = (f32x4){0.f, 0.f, 0.f, 0.f};
    bf16x8 At[4][2], B0[2][2], B1[2][2];
    const char* cA = (const char*)g.A + (size_t)cur.pm * tstep; const char* cB = (const char*)g.Bt + (size_t)cur.pn * tstep;
    S.a_ready(cur);
    PG8_STAGE(PG8_SB(0, 0), cB, voffB); PG8_STAGE(PG8_SA(0, 0), cA, voffA); PG8_STAGE(PG8_SB(0, 1), cB + hstep, voffB); PG8_STAGE(PG8_SA(0, 1), cA + hstep, voffA);
    if (wr == 1) PG8_BAR;
    PG8_WAIT_V(4); PG8_BAR;
    PG8_STAGE(PG8_SB(1, 0), cB + kstep, voffB); PG8_STAGE(PG8_SA(1, 0), cA + kstep, voffA); PG8_STAGE(PG8_SB(1, 1), cB + hstep + kstep, voffB);
    PG8_WAIT_V(6); PG8_BAR;
    PG8_STAMP();
    for (;;) {
        const bool has_next = S.next(ui + 1, nxt);
        const char* nA = has_next ? (const char*)g.A + (size_t)nxt.pm * tstep : cA; const char* nB = has_next ? (const char*)g.Bt + (size_t)nxt.pn * tstep : cB;
        for (int t = 0; t < nt; t += 2) {
            const bool last = (t == nt - 2);
            const char* a1 = cA + (size_t)(t + 1) * kstep;
            const char* a2 = last ? nA : cA + (size_t)(t + 2) * kstep; const char* b2 = last ? nB : cB + (size_t)(t + 2) * kstep;
            const char* a3 = a2 + kstep; const char* b3 = b2 + kstep;
            if (last && has_next) S.a_ready(nxt);
            PG8_LDB(B0, 0, 0); PG8_SCHED; PG8_LDA(At, 0, 0); PG8_STAGE(PG8_SA(1, 1), a1 + hstep, voffA);
            PG8_WAIT_L(8); PG8_BAR; PG8_WAIT_L(0); PG8_MMA(0, 0, At, B0); PG8_BAR; PG8_SCHED;
            PG8_LDB(B1, 0, 1); PG8_STAGE(PG8_SB(0, 0), b2, voffB);
            PG8_BAR; PG8_WAIT_L(0); PG8_MMA(0, 1, At, B1); PG8_BAR;
            PG8_LDA(At, 0, 1); PG8_STAGE(PG8_SA(0, 0), a2, voffA);
            PG8_BAR; PG8_WAIT_L(0); PG8_MMA(1, 0, At, B0); PG8_BAR; PG8_SCHED;
            PG8_STAGE(PG8_SB(0, 1), b2 + hstep, voffB);
            PG8_WAIT_V(6); PG8_BAR; PG8_MMA(1, 1, At, B1); PG8_BAR;
            PG8_LDB(B0, 1, 0); PG8_SCHED; PG8_LDA(At, 1, 0); PG8_STAGE(PG8_SA(0, 1), a2 + hstep, voffA);
            PG8_WAIT_L(8); PG8_BAR; PG8_WAIT_L(0); PG8_MMA(0, 0, At, B0); PG8_BAR; PG8_SCHED;
            PG8_LDB(B1, 1, 1); PG8_STAGE(PG8_SB(1, 0), b3, voffB);
            PG8_BAR; PG8_WAIT_L(0); PG8_MMA(0, 1, At, B1); PG8_BAR;
            PG8_LDA(At, 1, 1); PG8_STAGE(PG8_SA(1, 0), a3, voffA);
            PG8_BAR; PG8_WAIT_L(0); PG8_MMA(1, 0, At, B0); PG8_BAR; PG8_SCHED;
            PG8_STAGE(PG8_SB(1, 1), b3 + hstep, voffB);
            PG8_WAIT_V(6); PG8_BAR; PG8_MMA(1, 1, At, B1); PG8_BAR;
        }
        PG8_STAMP();
        if constexpr (!Epi::AFTER_DRAIN) { E(acc, cur, wr, wc, fr, fq); S.done(cur); }
        PG8_STAMP();
        if (!has_next) break;
#pragma unroll
        for (int a = 0; a < 2; ++a)
#pragma unroll
            for (int b = 0; b < 2; ++b)
#pragma unroll
                for (int m = 0; m < 4; ++m)
#pragma unroll
                    for (int n = 0; n < 2; ++n) acc[a][b][m][n] = (f32x4){0.f, 0.f, 0.f, 0.f};
        cur = nxt; cA = nA; cB = nB; ++ui;
    }
    PG8_WAIT_V(0);
    if (wr == 0) PG8_BAR;
    PG8_BAR;
    if constexpr (Epi::AFTER_DRAIN) { E.fused(acc, cur, wr, wc, fr, fq, lds, wid, lane); S.done(cur); }
    PG8_STAMP();
    if (STAMP && wid == 0) { stamps[lane] = lane < nts ? (((unsigned long long)(unsigned)ts_hi << 32) | (unsigned)ts_lo) : 0ull;
        if (lane == 62) stamps[62] = rt_entry; if (lane == 63) stamps[63] = (unsigned long long)wall_clock64(); }
#undef PG8_STAMP
#undef PG8_SA
#undef PG8_SB
#undef PG8_STAGE
#undef PG8_LDA
#undef PG8_LDB
#undef PG8_MMA
#undef PG8_WAIT_V
#undef PG8_WAIT_L
#undef PG8_BAR
#undef PG8_SCHED
}
}

struct EpiA {
    static constexpr bool PERM = false, AFTER_DRAIN = false;
    float* P; bf16_t* Z; float* out; int l, cbase;
    __device__ __forceinline__ void operator()(const pg8::f32x4 (&acc)[2][2][4][2], const pg8::Unit& u, int wr, int wc, int fr, int fq) const {
#pragma unroll
        for (int ai = 0; ai < 2; ++ai)
#pragma unroll
            for (int m = 0; m < 4; ++m) { const int row = u.pm * 256 + ai * 128 + wr * 64 + m * 16 + fr;
#pragma unroll
                for (int bj = 0; bj < 2; ++bj)
#pragma unroll
                    for (int n = 0; n < 2; ++n) { const int col = cbase + u.pn * 256 + bj * 128 + wc * 32 + n * 16 + fq * 4; const f32x4 v = acc[ai][bj][m][n];
                        if (col < PW) { *(f32x4*)(P + (size_t)row * PW + col) = v;
                            if (col >= C_CK && col < C_DP && row < NTP) { const int b = row >> 8, s_ = row & 255; const bool isk = col < C_CV;
                                *(f32x4*)(out + (isk ? O_NK : O_NV) + ((size_t)((b * 2 + l) * 256 + s_)) * 128 + (col - (isk ? C_CK : C_CV))) = v; } }
                        else if (col < NA_COLS) { u32x2 w; w[0] = cvt_pk_bf16(siluf_(v[0]), siluf_(v[1])); w[1] = cvt_pk_bf16(siluf_(v[2]), siluf_(v[3])); *(u32x2*)(Z + (size_t)row * DM + (col - PW)) = w; } } }
    }
};
__device__ __forceinline__ size_t g_off(int row, int cg) {
    const int n = cg >> 10, c = cg & 1023;
    const int pm = row >> 8, wr2 = (row >> 6) & 3, m = (row >> 4) & 3, fr = row & 15;
    const int pn = c >> 7, wc2 = (c >> 6) & 1, q = (c >> 4) & 3, fq2 = (c >> 2) & 3;
    size_t o = (size_t)(n * 32 + pm); o = o * 8 + pn; o = o * 4 + wr2; o = o * 2 + wc2; o = o * 4 + m; o = o * 16 + fr; o = o * 4 + fq2; o = o * 16 + q * 4;
    return o;
}
struct EpiG {
    static constexpr bool PERM = true, AFTER_DRAIN = false;
    bf16_t* G;
    __device__ __forceinline__ void operator()(const pg8::f32x4 (&acc)[2][2][4][2], const pg8::Unit& u, int wr, int wc, int fr, int fq) const {
#pragma unroll
        for (int ai = 0; ai < 2; ++ai)
#pragma unroll
            for (int m = 0; m < 4; ++m) { const int row = u.pm * 256 + ai * 128 + wr * 64 + m * 16 + fr;
#pragma unroll
                for (int bj = 0; bj < 2; ++bj) { const int col = u.pn * 256 + bj * 128 + wc * 32 + 8 * fq; const f32x4 v0 = acc[ai][bj][m][0], v1 = acc[ai][bj][m][1];
                    u32x4 w; w[0] = cvt_pk_bf16(sigmoidf_(v0[0]), sigmoidf_(v0[1])); w[1] = cvt_pk_bf16(sigmoidf_(v0[2]), sigmoidf_(v0[3]));
                    w[2] = cvt_pk_bf16(sigmoidf_(v1[0]), sigmoidf_(v1[1])); w[3] = cvt_pk_bf16(sigmoidf_(v1[2]), sigmoidf_(v1[3]));
                    u32x2 wa, wb; wa[0] = w[0]; wa[1] = w[1]; wb[0] = w[2]; wb[1] = w[3];
                    *(u32x2*)(G + g_off(row, col)) = wa; *(u32x2*)(G + g_off(row, col + 4)) = wb; } }
    }
};

__device__ void phaseA(const Params& p, int l, unsigned char* lds, int part) {
    const int G = part ? ((int)gridDim.x < 160 ? (int)gridDim.x : 160) : (int)gridDim.x;
    if ((int)blockIdx.x < G) {
        pg8::Gemm g; g.A = (const bf16_t*)(PWS + WS_H); g.Bt = (const bf16_t*)(PWS + WS_WTIN) + (size_t)l * INW * 1024 + (size_t)(part ? 2048 : 0) * 1024; g.M = NT; g.N = part ? 5 * 256 : 8 * 256; g.K = 1024;
        pg8::StaticOrder S; S.init(g.M, g.N, G, (int)blockIdx.x);
        EpiA E; E.P = (float*)(PWS + WS_P); E.Z = (bf16_t*)(PWS + WS_Z); E.out = POUT; E.l = l; E.cbase = part ? 2048 : 0;
        pg8::gemm_phase<EpiA, pg8::StaticOrder, false>((PG8_LAS unsigned char*)lds, g, S, E, nullptr);
    }
    __syncthreads();
}

__device__ void phaseB0(const Params& p, int l, unsigned char* ldsb) {
    const int tid = TID(), lane = tid & 63, wid = tid >> 6, fr = lane & 15, fq = lane >> 4;
    const int h = wid >> 1, mt = wid & 1;
    bf16_t* Awd = (bf16_t*)ldsb;
    bf16_t* Aad = Awd + 32 * 72;
    const float* P = (const float*)(PWS + WS_P);
    float* recS = (float*)(PWS + WS_RECS);
    float* recD = (float*)(PWS + WS_RECD);
    float* BC = (float*)(PWS + WS_BC);
    const bf16_t* LT = (const bf16_t*)(PWS + WS_LORAT) + (size_t)l * 4 * 256 * 64;
    const float* pkk = PIN(17) + l * 256; const float* pka = PIN(18) + l * 256; const float* prk = PIN(19) + l * 256;
    const float* pw0 = PIN(13) + l * 512; const float* pa0 = PIN(15) + l * 512;
    __shared__ int s_b0;
    unsigned* ctr0 = (unsigned*)(PWS + WS_CTR) + 4 + l;
    const int nA2 = (int)gridDim.x < 160 ? (int)gridDim.x : 160, nstat = (int)gridDim.x - nA2;
    for (int iter = 0;; ++iter) {
        int it;
        if (iter == 0 && (int)blockIdx.x >= nA2) it = (int)blockIdx.x - nA2;
        else { if (tid == 0) s_b0 = nstat + (int)atomicAdd(ctr0, 1u);
            __syncthreads();
            it = s_b0;
            __syncthreads(); }
        if (it >= NT / 32) break;
        const int tb = it * 32;
        __syncthreads();
#pragma unroll
        for (int i = 0; i < 8; ++i) { const int idx = tid + i * 512, tk = idx >> 7, j = idx & 127; const float v = P[(size_t)(tb + tk) * PW + C_WD + j];
            if (j < 64) Awd[tk * 72 + j] = f2bf(1.0f - 2.0f / (1.0f + __expf(2.0f * v))); else Aad[tk * 72 + j - 64] = f2bf(v); }
        __syncthreads();
        f32x4 acc[4][4];
#pragma unroll
        for (int m = 0; m < 4; ++m)
#pragma unroll
            for (int n = 0; n < 4; ++n) acc[m][n] = (f32x4){0.f, 0.f, 0.f, 0.f};
#pragma unroll
        for (int ks = 0; ks < 2; ++ks) {
            const bf16x8 awf = *(const bf16x8*)(Awd + (mt * 16 + fr) * 72 + ks * 32 + fq * 8), aaf = *(const bf16x8*)(Aad + (mt * 16 + fr) * 72 + ks * 32 + fq * 8);
#pragma unroll
            for (int n = 0; n < 4; ++n) { const int cb = h * 64 + n * 16 + fr;
#pragma unroll
                for (int m = 0; m < 4; ++m) { const bf16x8 bfr = *(const bf16x8*)(LT + ((size_t)m * 256 + cb) * 64 + ks * 32 + fq * 8);
                    acc[m][n] = __builtin_amdgcn_mfma_f32_16x16x32_bf16(bfr, m < 2 ? awf : aaf, acc[m][n], 0, 0, 0); } }
        }
        const int tok = tb + mt * 16 + fr; int seqbase, L, pos; seq_of(tok, seqbase, L, pos);
        const float* pr = P + (size_t)tok * PW;
        const size_t ridx = ((size_t)seqbase * 4 + (size_t)h * L + pos) * 192;
        f32x4 k4[4], kk4[4]; float ss = 0.f;
#pragma unroll
        for (int n = 0; n < 4; ++n) { const int c4 = h * 64 + n * 16 + fq * 4;
            k4[n] = *(const f32x4*)(pr + C_BK + c4); kk4[n] = k4[n] * *(const f32x4*)(pkk + c4);
            ss += (kk4[n][0] * kk4[n][0] + kk4[n][1] * kk4[n][1]) + (kk4[n][2] * kk4[n][2] + kk4[n][3] * kk4[n][3]); }
        ss += __shfl_xor(ss, 16); ss += __shfl_xor(ss, 32);
        const float rn = rsqrtf(ss + 1e-12f);
        float bsum = 0.f;
#pragma unroll
        for (int n = 0; n < 4; ++n) { const int c4 = h * 64 + n * 16 + fq * 4, j4 = n * 16 + fq * 4;
            const f32x4 r4 = *(const f32x4*)(pr + C_BR + c4), v4 = *(const f32x4*)(pr + C_BV + c4);
            const f32x4 kk = kk4[n] * rn, ka4 = *(const f32x4*)(pka + c4), rk4 = *(const f32x4*)(prk + c4);
            *(f32x4*)(recS + ridx + j4) = r4; *(f32x4*)(recS + ridx + 64 + j4) = kk; *(f32x4*)(recS + ridx + 128 + j4) = v4;
#pragma unroll
            for (int d = 0; d < 2; ++d) {
                const f32x4 w0 = *(const f32x4*)(pw0 + d * 256 + c4), a0 = *(const f32x4*)(pa0 + d * 256 + c4);
                f32x4 dec, nka, kd;
#pragma unroll
                for (int j = 0; j < 4; ++j) {
                    const float wl = w0[j] + acc[d][n][j];
                    dec[j] = __expf(-0.6065306597126334f / (1.0f + __expf(-wl)));
                    const float a = 1.0f / (1.0f + __expf(-(a0[j] + acc[2 + d][n][j])));
                    kd[j] = k4[n][j] * (1.0f + (a - 1.0f) * ka4[j]); nka[j] = -(kk[j] * a);
                    bsum += r4[j] * kd[j] * rk4[j]; }
                float* rd = recD + (size_t)d * RECD_STRIDE + ridx + j4;
                *(f32x4*)(rd) = dec; *(f32x4*)(rd + 64) = nka; *(f32x4*)(rd + 128) = kd;
            }
        }
        bsum += __shfl_xor(bsum, 16); bsum += __shfl_xor(bsum, 32);
        if (fq == 0) BC[tok * 4 + h] = bsum;
    }
}

template <int NS>
__device__ __forceinline__ void scan_run(const Params& p, int l, bool sample, int b, int h, int dir, int rg, int L, int seqbase, float* wl) {
    const int lane = TID() & 63, rl = lane >> 4, kl = lane & 15;
    int row[NS]; f32x4 S[NS]; size_t sidx[NS];
#pragma unroll
    for (int q = 0; q < NS; ++q) { row[q] = (rg * NS + q) * 4 + rl;
        sidx[q] = ((size_t)(((b * 2 + l) * 2 + dir) * 4 + h)) * 4096 + row[q] * 64 + kl * 4;
        if (sample) S[q] = *(const f32x4*)(PIN(4) + sidx[q]); else S[q] = (f32x4){0.f, 0.f, 0.f, 0.f}; }
    const float* gS = (const float*)(PWS + WS_RECS) + ((size_t)seqbase * 4 + (size_t)h * L) * 192 + lane * 4;
    const float* gD = (const float*)(PWS + WS_RECD) + (size_t)dir * RECD_STRIDE + ((size_t)seqbase * 4 + (size_t)h * L) * 192 + lane * 4;
    float* O = (float*)(PWS + WS_O) + (size_t)dir * NT * 256 + (size_t)seqbase * 256 + h * 64;
    const int nch = L >> 2;
    f32x4 rA[6], rB[6];
    auto gl = [&](f32x4 (&r)[6], int c) {
        c = c < nch ? c : nch - 1;
        const int pos0 = dir ? (L - 4 * (c + 1)) : 4 * c;
        const float* s_ = gS + (size_t)pos0 * 192; const float* d_ = gD + (size_t)pos0 * 192;
#pragma unroll
        for (int i = 0; i < 3; ++i) { r[i] = *(const f32x4*)(s_ + i * 256); r[3 + i] = *(const f32x4*)(d_ + i * 256); }
    };
    auto st = [&](const f32x4 (&r)[6], float* buf) {
#pragma unroll
        for (int i = 0; i < 3; ++i) { *(f32x4*)(buf + i * 256 + lane * 4) = r[i]; *(f32x4*)(buf + 768 + i * 256 + lane * 4) = r[3 + i]; }
    };
    struct Ops { f32x4 r, kk, w, ka, kd; float v[NS]; };
    auto ldsread = [&](const float* buf, int s) -> Ops {
        const int tc = dir ? 3 - s : s;
        const float* bs = buf + tc * 192; const float* bd = buf + 768 + tc * 192;
        Ops o; o.r = *(const f32x4*)(bs + kl * 4); o.kk = *(const f32x4*)(bs + 64 + kl * 4);
        o.w = *(const f32x4*)(bd + kl * 4); o.ka = *(const f32x4*)(bd + 64 + kl * 4); o.kd = *(const f32x4*)(bd + 128 + kl * 4);
#pragma unroll
        for (int q = 0; q < NS; ++q) o.v[q] = bs[128 + row[q]];
        return o;
    };
    float opart[NS];
#pragma unroll
    for (int q = 0; q < NS; ++q) opart[q] = 0.f;
    auto chunk = [&](const float* cur, const float* nxtbuf, Ops& ops, int c) {
        float oval[NS];
#pragma unroll
        for (int q = 0; q < NS; ++q) oval[q] = 0.f;
#pragma unroll
        for (int s = 0; s < 4; ++s) {
            const Ops nx = (s < 3) ? ldsread(cur, s + 1) : ldsread(nxtbuf, 0);
            __builtin_amdgcn_sched_barrier(0);
            float sa[NS], opr[NS]; f32x2 ta[NS], tb[NS];
            const f32x2 kka = __builtin_shufflevector(ops.kk, ops.kk, 0, 1), kkb = __builtin_shufflevector(ops.kk, ops.kk, 2, 3);
            const f32x2 wa = __builtin_shufflevector(ops.w, ops.w, 0, 1), wb = __builtin_shufflevector(ops.w, ops.w, 2, 3);
            const f32x2 na = __builtin_shufflevector(ops.ka, ops.ka, 0, 1), nb = __builtin_shufflevector(ops.ka, ops.ka, 2, 3);
            const f32x2 da = __builtin_shufflevector(ops.kd, ops.kd, 0, 1), db = __builtin_shufflevector(ops.kd, ops.kd, 2, 3);
            const f32x2 ra = __builtin_shufflevector(ops.r, ops.r, 0, 1), rb = __builtin_shufflevector(ops.r, ops.r, 2, 3);
#pragma unroll
            for (int q = 0; q < NS; ++q) { const f32x2 Sa = __builtin_shufflevector(S[q], S[q], 0, 1), Sb = __builtin_shufflevector(S[q], S[q], 2, 3);
                f32x2 pp = Sa * kka; pp = Sb * kkb + pp; sa[q] = pp[0] + pp[1];
                const f32x2 v2 = (f32x2){ops.v[q], ops.v[q]};
                ta[q] = Sa * wa + v2 * da; tb[q] = Sb * wb + v2 * db; }
#pragma unroll
            for (int q = 0; q < NS; ++q) { sa[q] = row16_sum(sa[q]); opr[q] = row16_sum(opart[q]); oval[q] = (kl == s) ? opr[q] : oval[q]; }
#pragma unroll
            for (int q = 0; q < NS; ++q) { const f32x2 s2 = (f32x2){sa[q], sa[q]};
                const f32x2 Sa = s2 * na + ta[q], Sb = s2 * nb + tb[q];
                f32x2 qq = Sa * ra; qq = Sb * rb + qq; opart[q] = qq[0] + qq[1];
                S[q] = (f32x4){Sa[0], Sa[1], Sb[0], Sb[1]}; }
            ops = nx;
        }
        const int stp = 4 * c - 1 + (kl & 3);
        const int pos = dir ? (L - 1 - stp) : stp;
#pragma unroll
        for (int q = 0; q < NS; ++q) { if (kl < 4 && stp >= 0) O[(size_t)pos * 256 + row[q]] = oval[q]; }
    };
    float* buf0 = wl; float* buf1 = wl + 1536;
    gl(rA, 0); gl(rB, 1);
    st(rA, buf0); gl(rA, 2);
    __builtin_amdgcn_wave_barrier();
    Ops ops = ldsread(buf0, 0);
    for (int c = 0; c < nch; c += 2) {
        st(rB, buf1); gl(rB, c + 3);
        __builtin_amdgcn_wave_barrier();
        chunk(buf0, buf1, ops, c);
        st(rA, buf0); gl(rA, c + 4);
        __builtin_amdgcn_wave_barrier();
        chunk(buf1, buf0, ops, c + 1);
    }
#pragma unroll
    for (int q = 0; q < NS; ++q) { const float ol = row16_sum(opart[q]); if (kl == 0) O[(size_t)(dir ? 0 : L - 1) * 256 + row[q]] = ol; }
    if (!sample) {
#pragma unroll
        for (int q = 0; q < NS; ++q) *(f32x4*)(POUT + O_NS + sidx[q]) = S[q];
    }
}

__device__ __forceinline__ void stage_qk(const float* __restrict__ src, int stride, bf16_t* dst, bool rope, int pos0, float scale, const f32x2* __restrict__ rt) {
    const int tid = TID();
#pragma unroll
    for (int i = 0; i < 2; ++i) {
        const int task = tid + i * 512, row = task >> 3, half = (task >> 2) & 1, quad = task & 3;
        const float* s = src + (size_t)row * stride + half * 32 + quad * 4;
        f32x4 x1 = *(const f32x4*)s, x2 = *(const f32x4*)(s + 16);
        if (rope) { const int pos = pos0 + row; const int pi = half ? (pos & 63) : (pos >> 6);
#pragma unroll
            for (int j = 0; j < 4; ++j) { const f32x2 cs = rt[pi * 16 + quad * 4 + j]; const float a = x1[j], b = x2[j]; x1[j] = a * cs[0] - b * cs[1]; x2[j] = b * cs[0] + a * cs[1]; } }
        x1 *= scale; x2 *= scale;
        u32x2 w1, w2; w1[0] = cvt_pk_bf16(x1[0], x1[1]); w1[1] = cvt_pk_bf16(x1[2], x1[3]); w2[0] = cvt_pk_bf16(x2[0], x2[1]); w2[1] = cvt_pk_bf16(x2[2], x2[3]);
        *(u32x2*)(dst + row * 72 + half * 32 + quad * 4) = w1; *(u32x2*)(dst + row * 72 + half * 32 + 16 + quad * 4) = w2;
    }
}
__device__ __forceinline__ void stage_vt(const float* __restrict__ src, int stride, bf16_t* vt, int nkeys = 128, int pitch = 136) {
    const int tid = TID();
    for (int task = tid; task < nkeys * 16; task += 512) { const int key = task >> 4, dq = task & 15;
        const f32x4 v = *(const f32x4*)(src + (size_t)key * stride + dq * 4);
#pragma unroll
        for (int j = 0; j < 4; ++j) vt[(dq * 4 + j) * pitch + key] = f2bf(v[j]); }
}
__device__ void attn_item(const Params& p, int l, int ai, unsigned char* lds) {
    const int tid = TID(), lane = tid & 63, wid = tid >> 6, fr = lane & 15, fq = lane >> 4;
    bf16_t* Qs = (bf16_t*)lds; bf16_t* Ks = Qs + 128 * 72; bf16_t* Vt = Ks + 128 * 72;
    const float* P = (const float*)(PWS + WS_P);
    const bf16_t* Z = (const bf16_t*)(PWS + WS_Z);
    bf16_t* YS = (bf16_t*)(PWS + WS_YS);
    const f32x2* rt = (const f32x2*)(PWS + WS_ROPE);
    bool sample; int b, head, qt, seqbase;
    if (ai < 128) { sample = true; b = ai >> 5; head = (ai >> 3) & 3; qt = ai & 7; seqbase = NTP + b * 1024; }
    else { const int j = ai - 128; sample = false; b = j >> 3; head = (j >> 1) & 3; qt = j & 1; seqbase = b * 256; }
    const int kh = head >> 1, qbase = seqbase + qt * 128;
    __syncthreads();
    stage_qk(P + (size_t)qbase * PW + C_CQ + head * 64, PW, Qs, sample, qt * 128, 0.125f, rt);
    __syncthreads();
    bf16x8 qf[2];
    qf[0] = *(const bf16x8*)(Qs + (wid * 16 + fr) * 72 + fq * 8); qf[1] = *(const bf16x8*)(Qs + (wid * 16 + fr) * 72 + 32 + fq * 8);
    float m = PIN(22)[l * 4 + head], lsum = 1.0f, lpart = 0.f;
    f32x4 oacc[4];
#pragma unroll
    for (int i = 0; i < 4; ++i) oacc[i] = (f32x4){0.f, 0.f, 0.f, 0.f};
    const int nkb = sample ? 7 : 2;
    const int qpos = qt * 128 + wid * 16 + fr;
    const float* ck = PIN(2); const float* cv = PIN(3);
    auto kinfo = [&](int kb, const float*& ks, const float*& vs, int& stride, bool& rope, bool& mask, int& kpos0) -> bool {
        if (!sample) { ks = P + (size_t)(seqbase + kb * 128) * PW + C_CK + kh * 64; vs = ks + (C_CV - C_CK); stride = PW; rope = false; mask = false; kpos0 = 0; return true; }
        if (kb < 3) { const int nbk = qt - 1 + kb; if (nbk < 0 || nbk >= 8) return false; kpos0 = nbk * 128;
            ks = P + (size_t)(seqbase + kpos0) * PW + C_CK + kh * 64; vs = ks + (C_CV - C_CK); stride = PW; rope = true; mask = (kb != 1); return true; }
        const size_t o = ((size_t)((b * 2 + l) * 512 + (kb - 3) * 128) * 2 + kh) * 64; ks = ck + o; vs = cv + o; stride = 128; rope = false; mask = false; kpos0 = 0; return true;
    };
    f32x4 kx1[2], kx2[2], vx[2][2];
    auto kload = [&](const float* ks, const float* vs, int stride) {
#pragma unroll
        for (int i = 0; i < 2; ++i) { const int task = tid + i * 512, row = task >> 3, half = (task >> 2) & 1, quad = task & 3;
            const float* s_ = ks + (size_t)row * stride + half * 32 + quad * 4; kx1[i] = *(const f32x4*)s_; kx2[i] = *(const f32x4*)(s_ + 16); }
#pragma unroll
        for (int i = 0; i < 2; ++i) { const int task = tid + i * 512, kp = task >> 4, dq = task & 15;
            vx[i][0] = *(const f32x4*)(vs + (size_t)(2 * kp) * stride + dq * 4); vx[i][1] = *(const f32x4*)(vs + (size_t)(2 * kp + 1) * stride + dq * 4); }
    };
    auto kstore = [&](bool rope, int kpos0) {
#pragma unroll
        for (int i = 0; i < 2; ++i) { const int task = tid + i * 512, row = task >> 3, half = (task >> 2) & 1, quad = task & 3;
            f32x4 x1 = kx1[i], x2 = kx2[i];
            if (rope) { const int pos = kpos0 + row; const int pi = half ? (pos & 63) : (pos >> 6);
#pragma unroll
                for (int j = 0; j < 4; ++j) { const f32x2 cs = rt[pi * 16 + quad * 4 + j]; const float a_ = x1[j], b_ = x2[j]; x1[j] = a_ * cs[0] - b_ * cs[1]; x2[j] = b_ * cs[0] + a_ * cs[1]; } }
            u32x2 w1, w2; w1[0] = cvt_pk_bf16(x1[0], x1[1]); w1[1] = cvt_pk_bf16(x1[2], x1[3]); w2[0] = cvt_pk_bf16(x2[0], x2[1]); w2[1] = cvt_pk_bf16(x2[2], x2[3]);
            *(u32x2*)(Ks + row * 72 + half * 32 + quad * 4) = w1; *(u32x2*)(Ks + row * 72 + half * 32 + 16 + quad * 4) = w2; }
#pragma unroll
        for (int i = 0; i < 2; ++i) { const int task = tid + i * 512, kp = task >> 4, dq = task & 15;
#pragma unroll
            for (int j = 0; j < 4; ++j) *(unsigned*)(Vt + (dq * 4 + j) * 136 + 2 * kp) = cvt_pk_bf16(vx[i][0][j], vx[i][1][j]); }
    };
    const float* ksrc = nullptr; const float* vsrc = nullptr; int stride = 0, kpos0n = 0; bool ropen = false, maskn = false;
    int kb = 0;
    while (kb < nkb && !kinfo(kb, ksrc, vsrc, stride, ropen, maskn, kpos0n)) ++kb;
    if (kb < nkb) kload(ksrc, vsrc, stride);
    while (kb < nkb) {
        const bool mask = maskn; const int kpos0 = kpos0n; const bool rope = ropen;
        __syncthreads();
        kstore(rope, kpos0);
        __syncthreads();
        int nk = kb + 1;
        while (nk < nkb && !kinfo(nk, ksrc, vsrc, stride, ropen, maskn, kpos0n)) ++nk;
        if (nk < nkb) kload(ksrc, vsrc, stride);
        kb = nk;
        f32x4 sc[4][2];
#pragma unroll
        for (int sb = 0; sb < 4; ++sb) {
            f32x4 s0 = (f32x4){0.f, 0.f, 0.f, 0.f}, s1 = s0;
#pragma unroll
            for (int dh = 0; dh < 2; ++dh) {
                const bf16x8 k0 = *(const bf16x8*)(Ks + (sb * 32 + fr) * 72 + dh * 32 + fq * 8), k1 = *(const bf16x8*)(Ks + (sb * 32 + 16 + fr) * 72 + dh * 32 + fq * 8);
                s0 = __builtin_amdgcn_mfma_f32_16x16x32_bf16(k0, qf[dh], s0, 0, 0, 0);
                s1 = __builtin_amdgcn_mfma_f32_16x16x32_bf16(k1, qf[dh], s1, 0, 0, 0);
            }
            if (mask) {
#pragma unroll
                for (int j = 0; j < 4; ++j) { const int k0p = kpos0 + sb * 32 + fq * 4 + j, k1p = k0p + 16; int d0 = qpos - k0p, d1 = qpos - k1p; d0 = d0 < 0 ? -d0 : d0; d1 = d1 < 0 ? -d1 : d1;
                    if (d0 > 128) s0[j] = -1e30f; if (d1 > 128) s1[j] = -1e30f; }
            }
            sc[sb][0] = s0; sc[sb][1] = s1;
        }
        float mx = -1e30f;
#pragma unroll
        for (int sb = 0; sb < 4; ++sb)
#pragma unroll
            for (int j = 0; j < 4; ++j) mx = fmaxf(mx, fmaxf(sc[sb][0][j], sc[sb][1][j]));
        mx = fmaxf(mx, __shfl_xor(mx, 16)); mx = fmaxf(mx, __shfl_xor(mx, 32));
        const float mn = fmaxf(m, mx), alpha = __expf(m - mn);
        m = mn; lsum *= alpha; lpart *= alpha;
#pragma unroll
        for (int dt = 0; dt < 4; ++dt) oacc[dt] = oacc[dt] * alpha;
#pragma unroll
        for (int sb = 0; sb < 4; ++sb) {
            f32x4 s0 = sc[sb][0], s1 = sc[sb][1];
#pragma unroll
            for (int j = 0; j < 4; ++j) { s0[j] = __expf(s0[j] - mn); s1[j] = __expf(s1[j] - mn); lpart += s0[j] + s1[j]; }
            u32x4 pw; pw[0] = cvt_pk_bf16(s0[0], s0[1]); pw[1] = cvt_pk_bf16(s0[2], s0[3]); pw[2] = cvt_pk_bf16(s1[0], s1[1]); pw[3] = cvt_pk_bf16(s1[2], s1[3]);
            bf16x8 pf; __builtin_memcpy(&pf, &pw, 16);
#pragma unroll
            for (int dt = 0; dt < 4; ++dt) {
                const bf16_t* vp = Vt + (dt * 16 + fr) * 136 + sb * 32 + fq * 4;
                u32x4 vw; const u32x2 va = *(const u32x2*)vp, vb = *(const u32x2*)(vp + 16); vw[0] = va[0]; vw[1] = va[1]; vw[2] = vb[0]; vw[3] = vb[1];
                bf16x8 vf; __builtin_memcpy(&vf, &vw, 16);
                oacc[dt] = __builtin_amdgcn_mfma_f32_16x16x32_bf16(vf, pf, oacc[dt], 0, 0, 0);
            }
        }
    }
    lpart += __shfl_xor(lpart, 16); lpart += __shfl_xor(lpart, 32);
    lsum += lpart;
    const float inv = 1.0f / lsum;
    const size_t t = (size_t)(qbase + wid * 16 + fr);
#pragma unroll
    for (int dt = 0; dt < 4; ++dt) {
        const int col = 512 + head * 64 + dt * 16 + fq * 4;
        const bf16x4 z = *(const bf16x4*)(Z + t * DM + col);
        u32x2 w; w[0] = cvt_pk_bf16(oacc[dt][0] * inv * bf2f((bf16_t)z[0]), oacc[dt][1] * inv * bf2f((bf16_t)z[1]));
        w[1] = cvt_pk_bf16(oacc[dt][2] * inv * bf2f((bf16_t)z[2]), oacc[dt][3] * inv * bf2f((bf16_t)z[3]));
        *(u32x2*)(YS + t * DM + col) = w;
    }
}

__device__ void chunk_item(const Params& p, int l, int ci, unsigned char* ldsb) {
    const int tid = TID(), lane = tid & 63, wid = tid >> 6, fr = lane & 15, fq = lane >> 4;
    const int chunk = ci >> 2, g = ci & 3, base = chunk * 128;
    bf16_t* wsb = (bf16_t*)ldsb;
    bf16_t* vt = wsb + 128 * 136;
    const float* P = (const float*)(PWS + WS_P);
    const bf16_t* Z = (const bf16_t*)(PWS + WS_Z);
    bf16_t* YS = (bf16_t*)(PWS + WS_YS);
    const float* wsrc = PIN(11) + (size_t)(l * 4 + g) * 128 * 128;
    __syncthreads();
#pragma unroll
    for (int i = 0; i < 8; ++i) { const int idx = tid + i * 512, r = idx >> 5, c4 = (idx & 31) * 4; const f32x4 v = *(const f32x4*)(wsrc + r * 128 + c4);
        u32x2 w; w[0] = cvt_pk_bf16(v[0], v[1]); w[1] = cvt_pk_bf16(v[2], v[3]); *(u32x2*)(wsb + r * 136 + c4) = w; }
    stage_vt(P + (size_t)base * PW + C_AV + g * 64, PW, vt, 128);
    __syncthreads();
    f32x4 acc[4];
#pragma unroll
    for (int n = 0; n < 4; ++n) acc[n] = (f32x4){0.f, 0.f, 0.f, 0.f};
#pragma unroll
    for (int k = 0; k < 4; ++k) {
        const bf16x8 af = *(const bf16x8*)(wsb + (wid * 16 + fr) * 136 + k * 32 + fq * 8);
#pragma unroll
        for (int n = 0; n < 4; ++n) { const bf16x8 bfv = *(const bf16x8*)(vt + (n * 16 + fr) * 136 + k * 32 + fq * 8);
            acc[n] = __builtin_amdgcn_mfma_f32_16x16x32_bf16(bfv, af, acc[n], 0, 0, 0); }
    }
    const int i = wid * 16 + fr; const size_t t = base + i;
    const float bsi = PIN(12)[(l * 4 + g) * 128 + i];
#pragma unroll
    for (int n = 0; n < 4; ++n) { const int col = g * 64 + n * 16 + fq * 4;
        const f32x4 u = *(const f32x4*)(P + t * PW + C_AU + col);
        const bf16x4 z = *(const bf16x4*)(Z + t * DM + col);
        u32x2 w; w[0] = cvt_pk_bf16(u[0] * (acc[n][0] + bsi) * bf2f((bf16_t)z[0]), u[1] * (acc[n][1] + bsi) * bf2f((bf16_t)z[1]));
        w[1] = cvt_pk_bf16(u[2] * (acc[n][2] + bsi) * bf2f((bf16_t)z[2]), u[3] * (acc[n][3] + bsi) * bf2f((bf16_t)z[3]));
        *(u32x2*)(YS + t * DM + col) = w; }
}

__device__ void pool_item(const Params& p, int l, int pi, unsigned char* ldsb) {
    const int tid = TID(), lane = tid & 63, wid = tid >> 6, fr = lane & 15, fq = lane >> 4, half = tid >> 8, ch = tid & 255, g = ch >> 6;
    const int tb = pi * 32; int seqbase, L, pos0; seq_of(tb, seqbase, L, pos0);
    float* pt = (float*)ldsb;
    bf16_t* dl = (bf16_t*)(pt + 48 * 256);
    bf16_t* wt = dl + 32 * 264;
    const float* P = (const float*)(PWS + WS_P);
    const bf16_t* Z = (const bf16_t*)(PWS + WS_Z);
    bf16_t* YS = (bf16_t*)(PWS + WS_YS);
    __syncthreads();
#pragma unroll
    for (int i = 0; i < 6; ++i) { const int idx = tid + i * 512, rr = idx >> 6, c4 = (idx & 63) * 4; const int pos = pos0 - 8 + rr;
        f32x4 v = (f32x4){0.f, 0.f, 0.f, 0.f};
        if (pos >= 0 && pos < L) v = *(const f32x4*)(P + (size_t)(seqbase + pos) * PW + C_DP + c4);
        *(f32x4*)(pt + rr * 256 + c4) = v; }
    { const float* pwsrc = PIN(23) + (size_t)l * 4 * 64 * 64;
#pragma unroll
      for (int gg = 0; gg < 4; ++gg) stage_vt(pwsrc + gg * 4096, 64, wt + gg * 64 * 72, 64, 72); }
    __syncthreads();
    const int w = 2 << g;
    for (int i = 0; i < 16; ++i) { const int tk = half * 16 + i, pos = pos0 + tk;
        int lo = pos - (w >> 1), hi = lo + w; lo = lo < 0 ? 0 : lo; hi = hi > L ? L : hi;
        float sm = 0.f;
        for (int q = lo; q < hi; ++q) sm += pt[(q - pos0 + 8) * 256 + ch];
        dl[tk * 264 + ch] = f2bf(sm / (float)(hi - lo) - pt[(tk + 8) * 256 + ch]); }
    __syncthreads();
    const int gw = wid >> 1, th = wid & 1;
    f32x4 acc[4];
#pragma unroll
    for (int n = 0; n < 4; ++n) acc[n] = (f32x4){0.f, 0.f, 0.f, 0.f};
#pragma unroll
    for (int k = 0; k < 2; ++k) {
        const bf16x8 af = *(const bf16x8*)(dl + (th * 16 + fr) * 264 + gw * 64 + k * 32 + fq * 8);
#pragma unroll
        for (int n = 0; n < 4; ++n) { const bf16x8 bfv = *(const bf16x8*)(wt + (gw * 64 + n * 16 + fr) * 72 + k * 32 + fq * 8);
            acc[n] = __builtin_amdgcn_mfma_f32_16x16x32_bf16(bfv, af, acc[n], 0, 0, 0); }
    }
    const size_t t = tb + th * 16 + fr;
#pragma unroll
    for (int n = 0; n < 4; ++n) { const int oc = gw * 64 + n * 16 + fq * 4;
        const f32x4 sc = *(const f32x4*)(PIN(24) + l * 256 + oc);
        const bf16x4 z = *(const bf16x4*)(Z + t * DM + 768 + oc);
        u32x2 wv; wv[0] = cvt_pk_bf16(acc[n][0] * sc[0] * bf2f((bf16_t)z[0]), acc[n][1] * sc[1] * bf2f((bf16_t)z[1]));
        wv[1] = cvt_pk_bf16(acc[n][2] * sc[2] * bf2f((bf16_t)z[2]), acc[n][3] * sc[3] * bf2f((bf16_t)z[3]));
        *(u32x2*)(YS + t * DM + 768 + oc) = wv; }
}

__device__ void phaseB1(const Params& p, int l, unsigned char* lds, int slot = 0, int part = 127) {
    const int tid = TID(), wid = tid >> 6;
    float* wl = (float*)lds + wid * 3072;
    if (!(part & 1)) {} else
    { const int nbh = (int)gridDim.x >> 1;
      if ((int)blockIdx.x < nbh) { if (wid < 4 && (part & 4)) for (int it = blockIdx.x * 4 + wid; it < 512; it += nbh * 4) { const int q = it >> 4, b = q >> 3;
            scan_run<1>(p, l, true, b, (q >> 1) & 3, q & 1, it & 15, 1024, NTP + b * 1024, wl); } }
      else { const int nb2 = (int)gridDim.x - nbh; if (part & 8) for (int it = ((int)blockIdx.x - nbh) * 8 + wid; it < 1024; it += nb2 * 8) { const int q = it >> 3, b = q >> 3;
            scan_run<2>(p, l, false, b, (q >> 1) & 3, q & 1, it & 7, 256, b * 256, wl); } } }
    __syncthreads();
    __shared__ int s_item;
    unsigned* ctr = (unsigned*)(PWS + WS_CTR) + l + 2 * slot;
    if (part & 2)
    for (;;) {
        if (tid == 0) s_item = (int)atomicAdd(ctr, 1u);
        __syncthreads();
        const int item = s_item;
        __syncthreads();
        if (item >= 768) break;
        if (item < 256) { if (part & 16) attn_item(p, l, item, lds); }
        else if (item < 512) { if (part & 32) chunk_item(p, l, item - 256, lds); }
        else { if (part & 64) pool_item(p, l, item - 512, lds); }
    }
}

__device__ void phaseB2(const Params& p, int l) {
    const int lane = TID() & 63, gw = blockIdx.x * 8 + (TID() >> 6), W = gridDim.x * 8;
    const float* O = (const float*)(PWS + WS_O);
    const float* recS = (const float*)(PWS + WS_RECS);
    const float* BC = (const float*)(PWS + WS_BC);
    const bf16_t* Z = (const bf16_t*)(PWS + WS_Z);
    bf16_t* YS = (bf16_t*)(PWS + WS_YS);
    const float* lng = PIN(20) + l * 256; const float* lnb = PIN(21) + l * 256;
    float g4[4], b4[4];
#pragma unroll
    for (int h = 0; h < 4; ++h) { g4[h] = lng[h * 64 + lane]; b4[h] = lnb[h * 64 + lane]; }
    for (int tok = gw; tok < NT; tok += W) {
        int seqbase, L, pos; seq_of(tok, seqbase, L, pos);
        float o[4], vv[4], z[4], mu[4], var[4];
        const f32x4 bc = *(const f32x4*)(BC + tok * 4);
#pragma unroll
        for (int h = 0; h < 4; ++h) { const int c = h * 64 + lane;
            o[h] = O[(size_t)tok * 256 + c] + O[(size_t)NT * 256 + (size_t)tok * 256 + c];
            vv[h] = recS[((size_t)seqbase * 4 + (size_t)h * L + pos) * 192 + 128 + lane];
            z[h] = bf2f(Z[(size_t)tok * DM + 256 + c]); }
#pragma unroll
        for (int h = 0; h < 4; ++h) mu[h] = wave_sum(o[h]) * (1.0f / 64.0f);
#pragma unroll
        for (int h = 0; h < 4; ++h) { o[h] -= mu[h]; var[h] = wave_sum(o[h] * o[h]) * (1.0f / 64.0f); }
#pragma unroll
        for (int h = 0; h < 4; ++h) { const float on = o[h] * rsqrtf(var[h] + 64e-5f);
            const float y = on * g4[h] + b4[h] + bc[h] * vv[h];
            YS[(size_t)tok * DM + 256 + h * 64 + lane] = f2bf(y * z[h]); }
    }
}

__device__ void phaseC1(const Params& p, int l, unsigned char* lds) {
    pg8::Gemm g; g.A = (const bf16_t*)(PWS + WS_H); g.Bt = (const bf16_t*)(PWS + WS_WTIN) + (size_t)l * INW * 1024 + (size_t)NA_COLS * 1024; g.M = NT; g.N = 4096; g.K = 1024;
    pg8::StaticOrder S; S.init(g.M, g.N, (int)gridDim.x, (int)blockIdx.x);
    EpiG E; E.G = (bf16_t*)(PWS + WS_G);
    pg8::gemm_phase<EpiG, pg8::StaticOrder, false>((PG8_LAS unsigned char*)lds, g, S, E, nullptr);
    __syncthreads();
}
__device__ void phaseC2(const Params& p, int l, unsigned char* lds) {
    constexpr int MT = 4, LDT = 72, A_BYTES = 256 * LDT * 2, B_BYTES = 128 * LDT * 2, BUF = A_BYTES + B_BYTES;
    const int tid = TID(), lane = tid & 63, wid = tid >> 6, wr = wid >> 1, wc = wid & 1, fr = lane & 15, fq = lane >> 4;
    const bf16_t* YS = (const bf16_t*)(PWS + WS_YS);
    const bf16_t* G = (const bf16_t*)(PWS + WS_G);
    const bf16_t* Wu = (const bf16_t*)(PWS + WS_WTUP) + (size_t)l * 4 * 1024 * 256;
    bf16_t* MG = (bf16_t*)(PWS + WS_MERGED);
    const int srow = tid >> 3, skc = tid & 7, soff = (srow * LDT + skc * 8) * 2;
    const int aoff = ((wr * MT * 16 + fr) * LDT + fq * 8) * 2, boff = A_BYTES + ((wc * 64 + fr) * LDT + fq * 8) * 2;
    const int NU = 32 * 8;
    for (int u = blockIdx.x; u < NU; u += gridDim.x) {
        const int pn = u / 32, pm = u % 32;
        const bf16_t* Ag = YS + ((size_t)pm * 256 + srow) * 1024 + skc * 8;
        const bf16_t* Bg = Wu + ((size_t)pn * 128 + srow) * 256 + skc * 8;
        f32x4 mg[4][4], acc[4][4]; zero_acc<4>(mg); zero_acc<4>(acc);
        u32x4 ra[MT], rb[2];
        auto gload = [&](int kt) {
#pragma unroll
            for (int i = 0; i < MT; ++i) ra[i] = *(const u32x4*)(Ag + (size_t)i * 64 * 1024 + kt * 64);
            const bf16_t* bb = Bg + (size_t)(kt >> 2) * 1024 * 256 + (kt & 3) * 64;
#pragma unroll
            for (int i = 0; i < 2; ++i) rb[i] = *(const u32x4*)(bb + (size_t)i * 64 * 256);
        };
        auto sstore = [&](int buf) { unsigned char* nb = lds + buf * BUF;
#pragma unroll
            for (int i = 0; i < MT; ++i) *(u32x4*)(nb + soff + i * 64 * LDT * 2) = ra[i];
#pragma unroll
            for (int i = 0; i < 2; ++i) *(u32x4*)(nb + A_BYTES + soff + i * 64 * LDT * 2) = rb[i];
        };
        __syncthreads();
        gload(0); sstore(0);
        __syncthreads();
        for (int t = 0; t < 16; ++t) {
            if (t + 1 < 16) gload(t + 1);
            const unsigned char* base = lds + (t & 1) * BUF;
#pragma unroll
            for (int kk = 0; kk < 2; ++kk) {
                bf16x8 af[MT], bfr[4];
#pragma unroll
                for (int m = 0; m < MT; ++m) af[m] = *(const bf16x8*)(base + aoff + m * 16 * LDT * 2 + kk * 64);
#pragma unroll
                for (int n = 0; n < 4; ++n) bfr[n] = *(const bf16x8*)(base + boff + n * 16 * LDT * 2 + kk * 64);
#pragma unroll
                for (int m = 0; m < MT; ++m)
#pragma unroll
                    for (int n = 0; n < 4; ++n) acc[m][n] = __builtin_amdgcn_mfma_f32_16x16x32_bf16(bfr[n], af[m], acc[m][n], 0, 0, 0);
            }
            if (t + 1 < 16) sstore((t + 1) & 1);
            if ((t & 3) == 3) {
                const int n = t >> 2;
#pragma unroll
                for (int m = 0; m < 4; ++m) { const int row = pm * 256 + wr * 64 + m * 16 + fr;
                    const bf16_t* gp = G + g_off(row, n * 1024 + pn * 128 + wc * 64 + fq * 4);
                    const bf16x8 ga = *(const bf16x8*)gp, gb = *(const bf16x8*)(gp + 8);
#pragma unroll
                    for (int q = 0; q < 4; ++q) {
#pragma unroll
                        for (int j = 0; j < 4; ++j) { const bf16_t gv = (bf16_t)(q < 2 ? ga[q * 4 + j] : gb[(q - 2) * 4 + j]); mg[m][q][j] += bf2f(gv) * acc[m][q][j]; }
                        acc[m][q] = (f32x4){0.f, 0.f, 0.f, 0.f}; } }
            }
            __syncthreads();
        }
#pragma unroll
        for (int m = 0; m < 4; ++m) { const size_t row = (size_t)pm * 256 + wr * 64 + m * 16 + fr;
#pragma unroll
            for (int q = 0; q < 4; ++q) { const int col = pn * 128 + wc * 64 + q * 16 + fq * 4;
                u32x2 w; w[0] = cvt_pk_bf16(mg[m][q][0], mg[m][q][1]); w[1] = cvt_pk_bf16(mg[m][q][2], mg[m][q][3]);
                __hip_atomic_store((unsigned long long*)(MG + row * DM + col), ((unsigned long long)w[1] << 32) | w[0], __ATOMIC_RELAXED, __HIP_MEMORY_SCOPE_AGENT); } }
        asm volatile("s_waitcnt vmcnt(0)" ::: "memory");
        __syncthreads();
        if (tid == 0) __hip_atomic_fetch_add((unsigned*)(PWS + WS_XCNT) + (size_t)((2 + l) * 32 + pm) * 64, 1u, __ATOMIC_RELAXED, __HIP_MEMORY_SCOPE_AGENT);
    }
}

__device__ void phaseD(const Params& p, int l, unsigned char* lds) {
    const int tid = TID(), lane = tid & 63, wid = tid >> 6, wr = wid >> 1, wc = wid & 1, fr = lane & 15, fq = lane >> 4;
    const bf16_t* MG = (const bf16_t*)(PWS + WS_MERGED);
    const bf16_t* Wo = (const bf16_t*)(PWS + WS_WTO) + (size_t)l * 1024 * 1024;
    const int NU = 32 * 8;
    for (int u = blockIdx.x; u < NU; u += gridDim.x) {
        const int pn = u / 32, pm = u % 32;
        if (tid == 0) { unsigned* c2 = (unsigned*)(PWS + WS_XCNT) + (size_t)((2 + l) * 32 + pm) * 64; unsigned spins = 0;
            while (__hip_atomic_load(c2, __ATOMIC_RELAXED, __HIP_MEMORY_SCOPE_AGENT) < 8u) { __builtin_amdgcn_s_sleep(2); if (++spins > (1u << 22)) break; }
            __builtin_amdgcn_fence(__ATOMIC_ACQUIRE, "agent");
            asm volatile("s_waitcnt vmcnt(0)" ::: "memory"); }
        __syncthreads();
        f32x4 acc[4][4]; zero_acc<4>(acc);
        gemm_acc<4>(MG + (size_t)pm * 256 * 1024, 1024, Wo + (size_t)pn * 128 * 1024, 1024, 1024, acc, lds);
        float ssq[4];
#pragma unroll
        for (int m = 0; m < 4; ++m) { const int row = pm * 256 + wr * 64 + m * 16 + fr;
            const float* xr = xrow_ptr(p, l, row);
            const float* gate = (const float*)(PWS + WS_MOD) + (size_t)(l * 5 + modrow_of(row)) * 3072 + 2048;
            float sm = 0.f;
#pragma unroll
            for (int q = 0; q < 4; ++q) { const int col = pn * 128 + wc * 64 + q * 16 + fq * 4;
                const f32x4 xo = *(const f32x4*)(xr + col), gt = *(const f32x4*)(gate + col);
                acc[m][q] = xo + gt * acc[m][q];
                sm += (acc[m][q][0] * acc[m][q][0] + acc[m][q][1] * acc[m][q][1]) + (acc[m][q][2] * acc[m][q][2] + acc[m][q][3] * acc[m][q][3]); }
            sm += __shfl_xor(sm, 16); sm += __shfl_xor(sm, 32);
            ssq[m] = sm; }
        float* Pt = (float*)lds;
        float* St = Pt + 512;
        if (fq == 0) {
#pragma unroll
            for (int m = 0; m < 4; ++m) Pt[(wr * 64 + m * 16 + fr) * 2 + wc] = ssq[m]; }
        __syncthreads();
        float* XP = (float*)(PWS + WS_XP) + ((size_t)(l * 32 + pm) * 256) * 8;
        unsigned* cnt = (unsigned*)(PWS + WS_XCNT) + (size_t)(l * 32 + pm) * 64;
        if (tid < 256) __hip_atomic_store(XP + tid * 8 + pn, Pt[tid * 2] + Pt[tid * 2 + 1], __ATOMIC_RELAXED, __HIP_MEMORY_SCOPE_AGENT);
        asm volatile("s_waitcnt vmcnt(0)" ::: "memory");
        __syncthreads();
        if (tid == 0) {
            __hip_atomic_fetch_add(cnt, 1u, __ATOMIC_RELAXED, __HIP_MEMORY_SCOPE_AGENT);
            unsigned spins = 0;
            while (__hip_atomic_load(cnt, __ATOMIC_RELAXED, __HIP_MEMORY_SCOPE_AGENT) < 8u) { __builtin_amdgcn_s_sleep(2); if (++spins > (1u << 22)) break; }
            __builtin_amdgcn_fence(__ATOMIC_ACQUIRE, "agent");
            asm volatile("s_waitcnt vmcnt(0)" ::: "memory");
        }
        __syncthreads();
        if (tid < 256) { float t = 0.f;
#pragma unroll
            for (int k = 0; k < 8; ++k) t += __hip_atomic_load(XP + tid * 8 + k, __ATOMIC_RELAXED, __HIP_MEMORY_SCOPE_AGENT);
            St[tid] = rsqrtf(t * (1.0f / 1024.0f) + 1e-6f); }
        __syncthreads();
        const float* gn = (l == 0) ? PIN(9) + DM : PIN(27);
        bf16_t* H = (bf16_t*)(PWS + WS_H);
#pragma unroll
        for (int m = 0; m < 4; ++m) { const int rl_ = wr * 64 + m * 16 + fr, row = pm * 256 + rl_;
            const float rs = St[rl_];
            const float* md = (const float*)(PWS + WS_MOD) + (size_t)(5 + modrow_of(row)) * 3072;
#pragma unroll
            for (int q = 0; q < 4; ++q) { const int col = pn * 128 + wc * 64 + q * 16 + fq * 4;
                const f32x4 gg = *(const f32x4*)(gn + col);
                if (l == 0) { *(f32x4*)(POUT + (size_t)row * DM + col) = acc[m][q];
                    const f32x4 sh = *(const f32x4*)(md + col), scl = *(const f32x4*)(md + 1024 + col);
                    const f32x4 h = acc[m][q] * rs * gg * (1.0f + scl) + sh;
                    u32x2 w; w[0] = cvt_pk_bf16(h[0], h[1]); w[1] = cvt_pk_bf16(h[2], h[3]); *(u32x2*)(H + (size_t)row * DM + col) = w; }
                else *(f32x4*)(POUT + (size_t)row * DM + col) = acc[m][q] * rs * gg; } }
    }
}

__device__ void phaseF(const Params& p) {
    const int lane = TID() & 63, gw = blockIdx.x * 8 + (TID() >> 6), W = gridDim.x * 8;
    const float* g = PIN(27);
    for (int row = gw; row < NT; row += W) {
        float* x = POUT + (size_t)row * DM;
        f32x4 v[4]; float ss = 0.f;
#pragma unroll
        for (int i = 0; i < 4; ++i) { v[i] = *(const f32x4*)(x + i * 256 + lane * 4); ss += v[i][0] * v[i][0] + v[i][1] * v[i][1] + v[i][2] * v[i][2] + v[i][3] * v[i][3]; }
        ss = wave_sum(ss);
        const float rs = rsqrtf(ss * (1.0f / 1024.0f) + 1e-6f);
#pragma unroll
        for (int i = 0; i < 4; ++i) { const int c = i * 256 + lane * 4; *(f32x4*)(x + c) = v[i] * rs * *(const f32x4*)(g + c); }
    }
}

__global__ void __launch_bounds__(NTHREADS) fwd_megakernel(Params p) {
    extern __shared__ __attribute__((aligned(16))) unsigned char lds[];
    volatile LAS unsigned* st = (volatile LAS unsigned*)(lds + LDS_MAIN);
    if (threadIdx.x < 2) st[threadIdx.x] = 0u;
    if (threadIdx.x == 0) {
#pragma unroll
        for (int i = 0; i < 28; ++i) s_ptab[i] = (unsigned long long)p.in[i];
    }
    __syncthreads();
    const XcdBarrier xb = xcd_barrier_post((unsigned*)(PWS + WS_BAR), st);
#define GSYNC() xcd_barrier(xb)
    phase0(p, lds);
    GSYNC();
#pragma unroll 1
    for (int l = 0; l < 2; ++l) {
#pragma unroll 1
        for (int ap = 0; ap < 2; ++ap) { phaseA(p, l, lds, ap); if (ap == 0) GSYNC(); }
        phaseB0(p, l, lds);
        GSYNC();
        phaseB1(p, l, lds);
        GSYNC();
        phaseB2(p, l);
        phaseC1(p, l, lds);
        GSYNC();
        phaseC2(p, l, lds);
        phaseD(p, l, lds);
        if (l == 0) GSYNC();
    }
}

extern "C" void kernel_launch(void* const* d_in, const int* in_sizes, int n_in, void* d_out, int out_size, void* d_ws, size_t ws_size, hipStream_t stream) {
    static int grid_blocks = 0;
    if (!grid_blocks) {
        int dev = 0, cus = 0, per_cu = 0;
        hipGetDevice(&dev);
        hipDeviceGetAttribute(&cus, hipDeviceAttributeMultiprocessorCount, dev);
        hipFuncSetAttribute((const void*)fwd_megakernel, hipFuncAttributeMaxDynamicSharedMemorySize, LDS_BYTES);
        hipOccupancyMaxActiveBlocksPerMultiprocessor(&per_cu, (const void*)fwd_megakernel, NTHREADS, LDS_BYTES);
        if (per_cu < 1) { fprintf(stderr, "occupancy query returned %d\n", per_cu); per_cu = 1; }
        if (per_cu > 1) per_cu = 1;
        grid_blocks = cus * per_cu;
        if (ws_size < WS_END) fprintf(stderr, "workspace too small: %zu < %zu\n", ws_size, (size_t)WS_END);
    }
    Params p{};
    for (int i = 0; i < 28; ++i) p.in[i] = (const float*)d_in[i];
    p.out = (float*)d_out; p.ws = (unsigned char*)d_ws;
    hipMemsetAsync((char*)d_ws + WS_CTR, 0, 256 + 3456 * 4, stream);
    void* args[] = {&p};
    hipError_t e = hipLaunchCooperativeKernel((const void*)fwd_megakernel, dim3(grid_blocks), dim3(NTHREADS), args, LDS_BYTES, stream);
    if (e != hipSuccess) fprintf(stderr, "cooperative launch failed: %s (grid %d)\n", hipGetErrorString(e), grid_blocks);
}
```

```cpp
#include <hip/hip_runtime.h>
#include <hip/hip_cooperative_groups.h>
#include <cstdio>
namespace cg = cooperative_groups;

typedef unsigned short bf16_t;
typedef short bf16x8 __attribute__((ext_vector_type(8)));
typedef short bf16x4 __attribute__((ext_vector_type(4)));
typedef float f32x4 __attribute__((ext_vector_type(4)));
typedef float f32x2 __attribute__((ext_vector_type(2)));
typedef unsigned u32x4 __attribute__((ext_vector_type(4)));
typedef unsigned u32x2 __attribute__((ext_vector_type(2)));

constexpr int NT = 8192, NTP = 4096, DM = 1024, INW = 7296, NA_COLS = 3200, PW = 2176;
constexpr int NTHREADS = 512;
constexpr int C_AU = 0, C_AV = 256, C_BR = 512, C_BK = 768, C_BV = 1024, C_WD = 1280, C_AD = 1344, C_CQ = 1408, C_CK = 1664, C_CV = 1792, C_DP = 1920;
constexpr size_t O_YP = 0, O_YS = 4194304, O_NK = 8388608, O_NV = 9437184, O_NS = 10485760;
constexpr size_t WS_WTIN = 0;
constexpr size_t WS_WTUP = WS_WTIN + (size_t)2 * INW * DM * 2;
constexpr size_t WS_WTO  = WS_WTUP + (size_t)2 * 4 * 1024 * 256 * 2;
constexpr size_t WS_MOD  = WS_WTO + (size_t)2 * 1024 * 1024 * 2;
constexpr size_t WS_ROPE = WS_MOD + (size_t)2 * 5 * 3072 * 4;
constexpr size_t WS_CTR  = WS_ROPE + 64 * 16 * 8;
constexpr size_t WS_BAR  = WS_CTR + 256;
constexpr size_t WS_H    = WS_BAR + 3456 * 4;
constexpr size_t WS_P    = WS_H + (size_t)NT * DM * 2;
constexpr size_t WS_Z    = WS_P + (size_t)NT * PW * 4;
constexpr size_t WS_RECS = WS_Z + (size_t)NT * DM * 2;
constexpr size_t WS_RECD = WS_RECS + (size_t)NT * 4 * 192 * 4;
constexpr size_t WS_O    = WS_RECD + (size_t)2 * NT * 4 * 192 * 4;
constexpr size_t WS_BC   = WS_O + (size_t)2 * NT * 256 * 4;
constexpr size_t WS_YS   = WS_BC + (size_t)NT * 4 * 4;
constexpr size_t WS_LORAT = WS_YS + (size_t)NT * DM * 2;
constexpr size_t WS_XP   = WS_LORAT + (size_t)2 * 4 * 256 * 64 * 2;
constexpr size_t WS_XCNT = WS_XP + (size_t)2 * 32 * 256 * 8 * 4;
constexpr size_t WS_END  = WS_XCNT + (size_t)4 * 32 * 256;
constexpr size_t WS_G = WS_P;
constexpr size_t WS_MERGED = WS_RECS;
constexpr size_t RECD_STRIDE = (size_t)NT * 4 * 192;

constexpr int LDS_MAIN = 131072;
constexpr int LDS_BYTES = LDS_MAIN + 16;

struct Params {
    const float* in[28];
    float* out;
    unsigned char* ws;
};
__shared__ unsigned long long s_ptab[28];
__device__ __forceinline__ const float* ld_inptr(int k) {
    const unsigned long long v = s_ptab[k];
    const unsigned lo = __builtin_amdgcn_readfirstlane((unsigned)v), hi = __builtin_amdgcn_readfirstlane((unsigned)(v >> 32));
    return (const float*)(((unsigned long long)hi << 32) | lo);
}
#define PIN(k) (ld_inptr(k))
#define POUT (p.out)
#define PWS (p.ws)

__device__ __forceinline__ int TID() { int t = threadIdx.x; asm volatile("" : "+v"(t)); return t; }
__device__ __forceinline__ unsigned cvt_pk_bf16(float lo, float hi) { unsigned r; asm volatile("v_cvt_pk_bf16_f32 %0, %1, %2" : "=v"(r) : "v"(lo), "v"(hi)); return r; }
__device__ __forceinline__ bf16_t f2bf(float f) { return (bf16_t)(cvt_pk_bf16(f, 0.f) & 0xffffu); }
__device__ __forceinline__ float bf2f(bf16_t b) { return __uint_as_float(((unsigned)b) << 16); }
__device__ __forceinline__ float sigmoidf_(float x) { return 1.0f / (1.0f + __expf(-x)); }
__device__ __forceinline__ float siluf_(float x) { return x / (1.0f + __expf(-x)); }
template <int CTRL> __device__ __forceinline__ float dpp_f(float x) { return __int_as_float(__builtin_amdgcn_update_dpp(0, __float_as_int(x), CTRL, 0xF, 0xF, false)); }
__device__ __forceinline__ float row16_sum(float x) {
    x += dpp_f<0x128>(x); x += dpp_f<0x124>(x); x += dpp_f<0x122>(x); x += dpp_f<0x121>(x); return x;
}
__device__ __forceinline__ float wave_sum(float v) { v = row16_sum(v); v += __shfl_xor(v, 16); v += __shfl_xor(v, 32); return v; }
__device__ __forceinline__ void seq_of(int tok, int& seqbase, int& L, int& pos) {
    if (tok < NTP) { seqbase = tok & ~255; L = 256; pos = tok & 255; }
    else { int t2 = tok - NTP; seqbase = NTP + (t2 & ~1023); L = 1024; pos = t2 & 1023; }
}
__device__ __forceinline__ int modrow_of(int tok) { return tok < NTP ? 0 : 1 + ((tok - NTP) >> 10); }


#define XB_TMO      128
#define XB_XCNT(j)  (256  + 64 * (j))
#define XB_XSUB(j)  (1280 + 64 * (j))
#define XB_XGEN(j)  (2304 + 64 * (j))
#define XB_TOP      3328
#define XB_TOPGEN   3392
#define XCD_BAR_WORDS 3456
#define XB_SPIN_CAP (1u << 18)
#define LAS __attribute__((address_space(3)))
__device__ __forceinline__ unsigned xb_ld(unsigned* p)              { return __hip_atomic_load(p, __ATOMIC_RELAXED, __HIP_MEMORY_SCOPE_AGENT); }
__device__ __forceinline__ unsigned xb_add(unsigned* p, unsigned v) { return __hip_atomic_fetch_add(p, v, __ATOMIC_RELAXED, __HIP_MEMORY_SCOPE_AGENT); }
__device__ __forceinline__ unsigned xb_xcc_id() { return (unsigned)__builtin_amdgcn_s_getreg((3 << 11) | 20) & 0xFu; }
#define XB_SPIN(cond, bar) do { unsigned _sp = 0; while (cond) { __builtin_amdgcn_s_sleep(1); \
    if ((++_sp & 255u) == 0u) { if (xb_ld(&(bar)[XB_TMO])) break; if (_sp > XB_SPIN_CAP) { atomicAdd(&(bar)[XB_TMO], 1u); break; } } } } while (0)
struct XcdBarrier { unsigned* bar; unsigned x; volatile LAS unsigned* st; };
__device__ __forceinline__ XcdBarrier xcd_barrier_post(unsigned* bar, volatile LAS unsigned* st) {
    XcdBarrier b; b.bar = bar; b.x = xb_xcc_id(); b.st = st;
    if (threadIdx.x == 0) (void)xb_add(&bar[XB_XCNT(b.x)], 1u);
    return b;
}
__device__ __forceinline__ void xcd_barrier_complete(unsigned* bar, unsigned x, unsigned& nloc, unsigned& nx) {
    const unsigned G = gridDim.x * gridDim.y * gridDim.z;
    unsigned sum, cnt, mine, sp = 0u;
    for (;;) {
        sum = 0u; cnt = 0u; mine = 0u;
#pragma unroll
        for (unsigned j = 0; j < 16; ++j) { const unsigned c = xb_ld(&bar[XB_XCNT(j)]); sum += c; cnt += (c > 0u) ? 1u : 0u; mine = (j == x) ? c : mine; }
        if (sum == G) break;
        __builtin_amdgcn_s_sleep(1);
        if ((++sp & 255u) == 0u) { if (xb_ld(&bar[XB_TMO])) break; if (sp > XB_SPIN_CAP) { atomicAdd(&bar[XB_TMO], 1u); break; } }
    }
    nloc = mine > 0u ? mine : 1u; nx = cnt > 0u ? cnt : 1u;
}
__device__ __forceinline__ void xcd_barrier(const XcdBarrier& b0) {
    asm volatile("s_waitcnt vmcnt(0)" ::: "memory");
    __syncthreads();
    if (threadIdx.x == 0) {
        XcdBarrier b = b0;
        { unsigned xx = xb_xcc_id(); asm volatile("" : "+s"(xx)); b.x = xx; }
        unsigned* bar = b.bar;
        __builtin_amdgcn_s_waitcnt(0);
        unsigned nloc = b.st[0], nx = b.st[1];
        if (nloc == 0u) { xcd_barrier_complete(bar, b.x, nloc, nx); b.st[0] = nloc; b.st[1] = nx; }
        const unsigned old = xb_add(&bar[XB_XSUB(b.x)], 1u);
        const unsigned gen = old / nloc;
        if (old + 1u == (gen + 1u) * nloc) {
            __builtin_amdgcn_fence(__ATOMIC_RELEASE, "agent");
            asm volatile("s_waitcnt vmcnt(0)" ::: "memory");
            const unsigned og = xb_add(&bar[XB_TOP], 1u);
            const unsigned tg = og / nx;
            if (og + 1u == (tg + 1u) * nx) xb_add(&bar[XB_TOPGEN], 1u);
            else XB_SPIN(xb_ld(&bar[XB_TOPGEN]) == tg, bar);
            __builtin_amdgcn_fence(__ATOMIC_ACQUIRE, "agent");
            xb_add(&bar[XB_XGEN(b.x)], 1u);
            asm volatile("s_waitcnt vmcnt(0)" ::: "memory");
        } else {
            XB_SPIN(xb_ld(&bar[XB_XGEN(b.x)]) == gen, bar);
            __builtin_amdgcn_fence(__ATOMIC_ACQUIRE, "agent");
            asm volatile("s_waitcnt vmcnt(0)" ::: "memory");
        }
    }
    __syncthreads();
}

__device__ void conv_tile(const float* __restrict__ src, int N, bf16_t* __restrict__ dst, int K, int kt, int nt, float* tile) {
    const int tid = TID();
    { const int r = tid >> 4, c4 = (tid & 15) * 4;
#pragma unroll
      for (int i = 0; i < 2; ++i) { const int k = r + 32 * i; const f32x4 v = __builtin_nontemporal_load((const f32x4*)(src + (size_t)(kt * 64 + k) * N + nt * 64 + c4));
          tile[k * 65 + c4 + 0] = v[0]; tile[k * 65 + c4 + 1] = v[1]; tile[k * 65 + c4 + 2] = v[2]; tile[k * 65 + c4 + 3] = v[3]; } }
    __syncthreads();
    { const int n = tid >> 3, kc = (tid & 7) * 8; u32x4 w;
      w[0] = cvt_pk_bf16(tile[(kc + 0) * 65 + n], tile[(kc + 1) * 65 + n]); w[1] = cvt_pk_bf16(tile[(kc + 2) * 65 + n], tile[(kc + 3) * 65 + n]);
      w[2] = cvt_pk_bf16(tile[(kc + 4) * 65 + n], tile[(kc + 5) * 65 + n]); w[3] = cvt_pk_bf16(tile[(kc + 6) * 65 + n], tile[(kc + 7) * 65 + n]);
      *(u32x4*)(dst + (size_t)(nt * 64 + n) * K + kt * 64 + kc) = w; }
    __syncthreads();
}

__device__ void mod_item(const Params& p, int l, int cc, float* lds) {
    const int tid = TID();
    float* sc = lds;
    float* red = lds + 5120;
    for (int i = tid; i < 5120; i += NTHREADS) { const int r = i >> 10, k = i & 1023; const float v = (r == 0) ? PIN(6)[k] : PIN(5)[(r - 1) * 1024 + k]; sc[i] = siluf_(v); }
    __syncthreads();
    const int kg = tid >> 5, c = tid & 31, col = cc * 32 + c;
    float a[5] = {0.f, 0.f, 0.f, 0.f, 0.f};
    const float* w = PIN(7) + (size_t)l * 1024 * 3072 + col;
    for (int k = kg * 64; k < kg * 64 + 64; ++k) { const float wv = w[(size_t)k * 3072];
#pragma unroll
        for (int r = 0; r < 5; ++r) a[r] += sc[r * 1024 + k] * wv; }
#pragma unroll
    for (int r = 0; r < 5; ++r) red[(kg * 5 + r) * 32 + c] = a[r];
    __syncthreads();
    if (tid < 160) { const int r = tid >> 5, c2 = tid & 31; float s = PIN(8)[l * 3072 + cc * 32 + c2];
        for (int g = 0; g < 16; ++g) s += red[(g * 5 + r) * 32 + c2];
        __hip_atomic_store((float*)(PWS + WS_MOD) + (l * 5 + r) * 3072 + cc * 32 + c2, s, __ATOMIC_RELAXED, __HIP_MEMORY_SCOPE_AGENT); }
    asm volatile("s_waitcnt vmcnt(0)" ::: "memory");
    __syncthreads();
    if (tid == 0 && l == 0) __hip_atomic_fetch_add((unsigned*)(PWS + WS_CTR) + 16, 1u, __ATOMIC_RELAXED, __HIP_MEMORY_SCOPE_AGENT);
}

__device__ void phaseA0(const Params& p, int l);
__device__ void phase0(const Params& p, unsigned char* lds) {
    const int NCONV_IN = 2 * 16 * 114, NCONV_UP = 8 * 64, NCONV_O = 2 * 256, NCONV_L = 32, NMOD = 192;
    const int total = NCONV_IN + NCONV_UP + NCONV_O + NCONV_L + NMOD + 1;
    for (int it = blockIdx.x; it < total; it += gridDim.x) {
        int i = it;
        if (i < NMOD) { mod_item(p, i / 96, i % 96, (float*)lds); continue; }
        i -= NMOD;
        if (i < NCONV_IN) { const int l = i / 1824, r = i % 1824, nt = r / 16, kt = r % 16;
            conv_tile(PIN(10) + (size_t)l * 1024 * INW, INW, (bf16_t*)(PWS + WS_WTIN) + (size_t)l * INW * 1024, 1024, kt, nt, (float*)lds); continue; }
        i -= NCONV_IN;
        if (i < NCONV_UP) { const int mtx = i / 64, r = i % 64, nt = r / 4, kt = r % 4;
            conv_tile(PIN(25) + (size_t)mtx * 256 * 1024, 1024, (bf16_t*)(PWS + WS_WTUP) + (size_t)mtx * 1024 * 256, 256, kt, nt, (float*)lds); continue; }
        i -= NCONV_UP;
        if (i < NCONV_O) { const int l = i / 256, r = i % 256, nt = r / 16, kt = r % 16;
            conv_tile(PIN(26) + (size_t)l * 1024 * 1024, 1024, (bf16_t*)(PWS + WS_WTO) + (size_t)l * 1024 * 1024, 1024, kt, nt, (float*)lds); continue; }
        i -= NCONV_O;
        if (i < NCONV_L) { const int l = i >> 4, m = (i >> 2) & 3, nt = i & 3;
            conv_tile((m < 2 ? PIN(14) : PIN(16)) + (size_t)(l * 2 + (m & 1)) * 64 * 256, 256, (bf16_t*)(PWS + WS_LORAT) + (size_t)(l * 4 + m) * 256 * 64, 64, 0, nt, (float*)lds); continue; }
        for (int e = TID(); e < 1024; e += NTHREADS) { const int pos = e >> 4, f = e & 15;
            const float inv = exp2f(-(float)f * (13.287712379549449f / 16.0f)); const float ang = (float)pos * inv;
            float sn, cs; sn = sinf(ang); cs = cosf(ang);
            ((f32x2*)(PWS + WS_ROPE))[e] = (f32x2){cs, sn}; }
        for (int e = TID(); e < 4 * 32 * 64; e += NTHREADS) ((unsigned*)(PWS + WS_XCNT))[e] = 0u;
    }
    if (TID() == 0) { unsigned* mc = (unsigned*)(PWS + WS_CTR) + 16; unsigned spins = 0;
        while (__hip_atomic_load(mc, __ATOMIC_RELAXED, __HIP_MEMORY_SCOPE_AGENT) < 96u) { __builtin_amdgcn_s_sleep(2); if (++spins > (1u << 22)) break; }
        __builtin_amdgcn_fence(__ATOMIC_ACQUIRE, "agent");
        asm volatile("s_waitcnt vmcnt(0)" ::: "memory"); }
    __syncthreads();
    phaseA0(p, 0);
}

__device__ __forceinline__ const float* xrow_ptr(const Params& p, int l, int row) {
    if (l == 0) return row < NTP ? PIN(0) + (size_t)row * DM : PIN(1) + (size_t)(row - NTP) * DM;
    return POUT + (size_t)row * DM;
}
__device__ void phaseA0(const Params& p, int l) {
    const int lane = TID() & 63, gw = blockIdx.x * 8 + (TID() >> 6), W = gridDim.x * 8;
    const float* g = PIN(9) + l * DM;
    bf16_t* H = (bf16_t*)(PWS + WS_H);
    for (int row = gw; row < NT; row += W) {
        const float* x = xrow_ptr(p, l, row);
        f32x4 v[4]; float ss = 0.f;
#pragma unroll
        for (int i = 0; i < 4; ++i) { v[i] = *(const f32x4*)(x + i * 256 + lane * 4); ss += v[i][0] * v[i][0] + v[i][1] * v[i][1] + v[i][2] * v[i][2] + v[i][3] * v[i][3]; }
        ss = wave_sum(ss);
        const float rs = rsqrtf(ss * (1.0f / 1024.0f) + 1e-6f);
        const float* mod = (const float*)(PWS + WS_MOD) + (size_t)(l * 5 + modrow_of(row)) * 3072;
#pragma unroll
        for (int i = 0; i < 4; ++i) { const int c = i * 256 + lane * 4;
            const f32x4 gg = *(const f32x4*)(g + c), sh = *(const f32x4*)(mod + c), scl = *(const f32x4*)(mod + 1024 + c);
            f32x4 h = v[i] * rs * gg * (1.0f + scl) + sh;
            u32x2 w; w[0] = cvt_pk_bf16(h[0], h[1]); w[1] = cvt_pk_bf16(h[2], h[3]);
            *(u32x2*)(H + (size_t)row * DM + c) = w; }
    }
}

template <int MT>
__device__ __forceinline__ void gemm_acc(const bf16_t* __restrict__ A, int lda, const bf16_t* __restrict__ B, int ldb, int K, f32x4 (&acc)[MT][4], unsigned char* lds) {
    constexpr int BM = MT * 64, LDT = 72, A_BYTES = BM * LDT * 2, B_BYTES = 128 * LDT * 2, BUF = A_BYTES + B_BYTES;
    const int tid = TID(), lane = tid & 63, wid = tid >> 6, wr = wid >> 1, wc = wid & 1, fr = lane & 15, fq = lane >> 4;
    u32x4 ra[MT], rb[2];
    const int srow = tid >> 3, skc = tid & 7;
    const bf16_t* Ag = A + (size_t)srow * lda + skc * 8;
    const bf16_t* Bg = B + (size_t)srow * ldb + skc * 8;
    const int soff = (srow * LDT + skc * 8) * 2;
    const int nt = K >> 6;
    __syncthreads();
#pragma unroll
    for (int i = 0; i < MT; ++i) ra[i] = *(const u32x4*)(Ag + (size_t)i * 64 * lda);
#pragma unroll
    for (int i = 0; i < 2; ++i) rb[i] = *(const u32x4*)(Bg + (size_t)i * 64 * ldb);
#pragma unroll
    for (int i = 0; i < MT; ++i) *(u32x4*)(lds + soff + i * 64 * LDT * 2) = ra[i];
#pragma unroll
    for (int i = 0; i < 2; ++i) *(u32x4*)(lds + A_BYTES + soff + i * 64 * LDT * 2) = rb[i];
    __syncthreads();
    const int aoff = ((wr * MT * 16 + fr) * LDT + fq * 8) * 2, boff = A_BYTES + ((wc * 64 + fr) * LDT + fq * 8) * 2;
    for (int t = 0; t < nt; ++t) {
        if (t + 1 < nt) {
#pragma unroll
            for (int i = 0; i < MT; ++i) ra[i] = *(const u32x4*)(Ag + (size_t)i * 64 * lda + (t + 1) * 64);
#pragma unroll
            for (int i = 0; i < 2; ++i) rb[i] = *(const u32x4*)(Bg + (size_t)i * 64 * ldb + (t + 1) * 64);
        }
        const unsigned char* base = lds + (t & 1) * BUF;
#pragma unroll
        for (int kk = 0; kk < 2; ++kk) {
            bf16x8 af[MT], bfr[4];
#pragma unroll
            for (int m = 0; m < MT; ++m) af[m] = *(const bf16x8*)(base + aoff + m * 16 * LDT * 2 + kk * 64);
#pragma unroll
            for (int n = 0; n < 4; ++n) bfr[n] = *(const bf16x8*)(base + boff + n * 16 * LDT * 2 + kk * 64);
#pragma unroll
            for (int m = 0; m < MT; ++m)
#pragma unroll
                for (int n = 0; n < 4; ++n) acc[m][n] = __builtin_amdgcn_mfma_f32_16x16x32_bf16(bfr[n], af[m], acc[m][n], 0, 0, 0);
        }
        if (t + 1 < nt) {
            unsigned char* nb = lds + ((t + 1) & 1) * BUF;
#pragma unroll
            for (int i = 0; i < MT; ++i) *(u32x4*)(nb + soff + i * 64 * LDT * 2) = ra[i];
#pragma unroll
            for (int i = 0; i < 2; ++i) *(u32x4*)(nb + A_BYTES + soff + i * 64 * LDT * 2) = rb[i];
        }
        __syncthreads();
    }
}
template <int MT> __device__ __forceinline__ void zero_acc(f32x4 (&acc)[MT][4]) {
#pragma unroll
    for (int m = 0; m < MT; ++m)
#pragma unroll
        for (int n = 0; n < 4; ++n) acc[m][n] = (f32x4){0.f, 0.f, 0.f, 0.f};
}

namespace pg8 {
#define PG8_LAS __attribute__((address_space(3)))
typedef unsigned short bf16_t;
typedef short bf16x8 __attribute__((ext_vector_type(8)));
typedef float f32x4 __attribute__((ext_vector_type(4)));
typedef unsigned u32x4 __attribute__((ext_vector_type(4)));
constexpr int BM = 256, BK = 64, HALF = 128, HTB = HALF * BK * 2  , STAGE_BYTES = 8 * HTB, NXCD = 8, WGM = 8;

__host__ __device__ __forceinline__ int lds_byte(int r, int c) { const int st = (r >> 4) * 2 + (c >> 5), rr = r & 15, cc = c & 31, ob = rr * 64 + cc * 2; return st * 1024 + (ob ^ (((ob >> 9) & 1) << 5)); }
__host__ __device__ __forceinline__ void stage_rc(int b, int& R, int& C) { const int st = b / 1024, sb = b % 1024, swz = sb ^ (((sb >> 9) & 1) << 5); R = (st >> 1) * 16 + swz / 64; C = (st & 1) * 32 + (swz % 64) / 2; }
__host__ __device__ __forceinline__ int perm32(int rho) { const int n = rho >> 4, i = rho & 15; return 8 * (i >> 2) + 4 * n + (i & 3); }

struct Unit { int pm, pn; };
struct Gemm { const bf16_t* A; const bf16_t* Bt; int M, N, K; };

struct StaticOrder {
    int nM, nN, nwg, G, c;
    __host__ __device__ void init(int M, int N, int G_, int c_) { nM = M / BM; nN = N / BM; nwg = nM * nN; G = G_; c = c_; }
    __host__ __device__ bool next(int i, Unit& u) const {
        const long L = (long)i * G + c; if (L >= nwg) return false;
        int wgid = (int)L; { const int q = nwg / NXCD, r = nwg % NXCD, xcd = wgid % NXCD, off = wgid / NXCD; wgid = (xcd < r ? xcd * (q + 1) : r * (q + 1) + (xcd - r) * q) + off; }
        const int nig = WGM * nN, gid = wgid / nig, fm = gid * WGM, gsz = (nM - fm) < WGM ? (nM - fm) : WGM;
        u.pm = fm + ((wgid % nig) % gsz); u.pn = (wgid % nig) / gsz; return true;
    }
    __device__ __forceinline__ void a_ready(const Unit&) const {}
    __device__ __forceinline__ void done(const Unit&) const {}
};
template <class Epi, class Sched, bool STAMP = false>
__device__ __forceinline__ void gemm_phase(PG8_LAS unsigned char* lds, const Gemm g, const Sched& S, const Epi& E, unsigned long long* stamps) {
    const int tid = ::TID(), wid = __builtin_amdgcn_readfirstlane(tid >> 6), lane = tid & 63, wr = wid >> 2, wc = wid & 3, fr = lane & 15, fq = lane >> 4;
    const int K = g.K, nt = K / BK;
    int ts_lo = 0, ts_hi = 0, nts = 0; const unsigned long long rt_entry = STAMP ? (unsigned long long)wall_clock64() : 0ull;
#define PG8_STAMP() do { if (STAMP && wid == 0 && nts < 64) { const unsigned long long _c = (unsigned long long)clock64(); \
        ts_lo = (lane == nts) ? (int)(unsigned)_c : ts_lo; ts_hi = (lane == nts) ? (int)(unsigned)(_c >> 32) : ts_hi; ++nts; } } while (0)
    PG8_STAMP();
    unsigned voffA[2], voffB[2];
#pragma unroll
    for (int i = 0; i < 2; ++i) { int R, C; stage_rc(tid * 16 + i * 8192, R, C); const int Rb = Epi::PERM ? ((R & ~31) + perm32(R & 31)) : R;
        voffA[i] = (unsigned)(R * K + C) * 2u; voffB[i] = (unsigned)(Rb * K + C) * 2u; }
    const size_t kstep = (size_t)(BK * 2);
    const size_t hstep = (size_t)HALF * K * 2;
    const size_t tstep = 2 * hstep;
    const unsigned ldsw = (unsigned)wid * 1024u;
    const int aoff = lds_byte(wr * 64 + fr, fq * 8), boff = lds_byte(wc * 32 + fr, fq * 8);
#define PG8_SA(b, h) (((b) * 2 + (h)) * HTB)
#define PG8_SB(b, h) ((4 + (b) * 2 + (h)) * HTB)
#define PG8_STAGE(bufoff, gbase, voff) do { _Pragma("unroll") for (int _i = 0; _i < 2; ++_i) \
        __builtin_amdgcn_global_load_lds((const unsigned*)((const char*)(gbase) + (voff)[_i]), (PG8_LAS unsigned*)(lds + (bufoff) + ldsw + _i * 8192), 16, 0, 0); } while (0)
#define PG8_LDA(dst, b, h) do { _Pragma("unroll") for (int m = 0; m < 4; ++m) _Pragma("unroll") for (int k = 0; k < 2; ++k) dst[m][k] = *(const PG8_LAS bf16x8*)(lds + PG8_SA(b, h) + aoff + m * 2048 + k * 1024); } while (0)
#define PG8_LDB(dst, b, h) do { _Pragma("unroll") for (int n = 0; n < 2; ++n) _Pragma("unroll") for (int k = 0; k < 2; ++k) dst[n][k] = *(const PG8_LAS bf16x8*)(lds + PG8_SB(b, h) + boff + n * 2048 + k * 1024); } while (0)
#define PG8_MMA(ai, bj, At, Bt) do { __builtin_amdgcn_s_setprio(1); _Pragma("unroll") for (int m = 0; m < 4; ++m) _Pragma("unroll") for (int n = 0; n < 2; ++n) _Pragma("unroll") for (int k = 0; k < 2; ++k) \
        acc[ai][bj][m][n] = __builtin_amdgcn_mfma_f32_16x16x32_bf16(Bt[n][k], At[m][k], acc[ai][bj][m][n], 0, 0, 0); __builtin_amdgcn_s_setprio(0); } while (0)
#define PG8_WAIT_V(n) asm volatile("s_waitcnt vmcnt(" #n ")" ::: "memory")
#define PG8_WAIT_L(n) asm volatile("s_waitcnt lgkmcnt(" #n ")" ::: "memory")
#define PG8_BAR __builtin_amdgcn_s_barrier()
#define PG8_SCHED __builtin_amdgcn_sched_barrier(0)
    Unit cur, nxt; int ui = 0;
    if (!S.next(0, cur)) return;
    f32x4 acc[2][2][4][2];
#pragma unroll
    for (int a = 0; a < 2; ++a)
#pragma unroll
        for (int b = 0; b < 2; ++b)
#pragma unroll
            for (int m = 0; m < 4; ++m)
#pragma unroll
                for (int n = 0; n < 2; ++n) acc[a][b][m][n] = (f32x4){0.f, 0.f, 0.f, 0.f};
    bf16x8 At[4][2], B0[2][2], B1[2][2];
    const char* cA = (const char*)g.A + (size_t)cur.pm * tstep; const char* cB = (const char*)g.Bt + (size_t)cur.pn * tstep;
    S.a_ready(cur);
    PG8_STAGE(PG8_SB(0, 0), cB, voffB); PG8_STAGE(PG8_SA(0, 0), cA, voffA); PG8_STAGE(PG8_SB(0, 1), cB + hstep, voffB); PG8_STAGE(PG8_SA(0, 1), cA + hstep, voffA);
    if (wr == 1) PG8_BAR;
    PG8_WAIT_V(4); PG8_BAR;
    PG8_STAGE(PG8_SB(1, 0), cB + kstep, voffB); PG8_STAGE(PG8_SA(1, 0), cA + kstep, voffA); PG8_STAGE(PG8_SB(1, 1), cB + hstep + kstep, voffB);
    PG8_WAIT_V(6); PG8_BAR;
    PG8_STAMP();
    for (;;) {
        const bool has_next = S.next(ui + 1, nxt);
        const char* nA = has_next ? (const char*)g.A + (size_t)nxt.pm * tstep : cA; const char* nB = has_next ? (const char*)g.Bt + (size_t)nxt.pn * tstep : cB;
        for (int t = 0; t < nt; t += 2) {
            const bool last = (t == nt - 2);
            const char* a1 = cA + (size_t)(t + 1) * kstep;
            const char* a2 = last ? nA : cA + (size_t)(t + 2) * kstep; const char* b2 = last ? nB : cB + (size_t)(t + 2) * kstep;
            const char* a3 = a2 + kstep; const char* b3 = b2 + kstep;
            if (last && has_next) S.a_ready(nxt);
            PG8_LDB(B0, 0, 0); PG8_SCHED; PG8_LDA(At, 0, 0); PG8_STAGE(PG8_SA(1, 1), a1 + hstep, voffA);
            PG8_WAIT_L(8); PG8_BAR; PG8_WAIT_L(0); PG8_MMA(0, 0, At, B0); PG8_BAR; PG8_SCHED;
            PG8_LDB(B1, 0, 1); PG8_STAGE(PG8_SB(0, 0), b2, voffB);
            PG8_BAR; PG8_WAIT_L(0); PG8_MMA(0, 1, At, B1); PG8_BAR;
            PG8_LDA(At, 0, 1); PG8_STAGE(PG8_SA(0, 0), a2, voffA);
            PG8_BAR; PG8_WAIT_L(0); PG8_MMA(1, 0, At, B0); PG8_BAR; PG8_SCHED;
            PG8_STAGE(PG8_SB(0, 1), b2 + hstep, voffB);
            PG8_WAIT_V(6); PG8_BAR; PG8_MMA(1, 1, At, B1); PG8_BAR;
            PG8_LDB(B0, 1, 0); PG8_SCHED; PG8_LDA(At, 1, 0); PG8_STAGE(PG8_SA(0, 1), a2 + hstep, voffA);
            PG8_WAIT_L(8); PG8_BAR; PG8_WAIT_L(0); PG8_MMA(0, 0, At, B0); PG8_BAR; PG8_SCHED;
            PG8_LDB(B1, 1, 1); PG8_STAGE(PG8_SB(1, 0), b3, voffB);
            PG8_BAR; PG8_WAIT_L(0); PG8_MMA(0, 1, At, B1); PG8_BAR;
            PG8_LDA(At, 1, 1); PG8_STAGE(PG8_SA(1, 0), a3, voffA);
            PG8_BAR; PG8_WAIT_L(0); PG8_MMA(1, 0, At, B0); PG8_BAR; PG8_SCHED;
            PG8_STAGE(PG8_SB(1, 1), b3 + hstep, voffB);
            PG8_WAIT_V(6); PG8_BAR; PG8_MMA(1, 1, At, B1); PG8_BAR;
        }
        PG8_STAMP();
        if constexpr (!Epi::AFTER_DRAIN) { E(acc, cur, wr, wc, fr, fq); S.done(cur); }
        PG8_STAMP();
        if (!has_next) break;
#pragma unroll
        for (int a = 0; a < 2; ++a)
#pragma unroll
            for (int b = 0; b < 2; ++b)
#pragma unroll
                for (int m = 0; m < 4; ++m)
#pragma unroll
                    for (int n = 0; n < 2; ++n) acc[a][b][m][n] = (f32x4){0.f, 0.f, 0.f, 0.f};
        cur = nxt; cA = nA; cB = nB; ++ui;
    }
    PG8_WAIT_V(0);
    if (wr == 0) PG8_BAR;
    PG8_BAR;
    if constexpr (Epi::AFTER_DRAIN) { E.fused(acc, cur, wr, wc, fr, fq, lds, wid, lane); S.done(cur); }
    PG8_STAMP();
    if (STAMP && wid == 0) { stamps[lane] = lane < nts ? (((unsigned long long)(unsigned)ts_hi << 32) | (unsigned)ts_lo) : 0ull;
        if (lane == 62) stamps[62] = rt_entry; if (lane == 63) stamps[63] = (unsigned long long)wall_clock64(); }
#undef PG8_STAMP
#undef PG8_SA
#undef PG8_SB
#undef PG8_STAGE
#undef PG8_LDA
#undef PG8_LDB
#undef PG8_MMA
#undef PG8_WAIT_V
#undef PG8_WAIT_L
#undef PG8_BAR
#undef PG8_SCHED
}
}

struct EpiA {
    static constexpr bool PERM = false, AFTER_DRAIN = false;
    float* P; bf16_t* Z; float* out; int l, cbase;
    __device__ __forceinline__ void operator()(const pg8::f32x4 (&acc)[2][2][4][2], const pg8::Unit& u, int wr, int wc, int fr, int fq) const {
#pragma unroll
        for (int ai = 0; ai < 2; ++ai)
#pragma unroll
            for (int m = 0; m < 4; ++m) { const int row = u.pm * 256 + ai * 128 + wr * 64 + m * 16 + fr;
#pragma unroll
                for (int bj = 0; bj < 2; ++bj)
#pragma unroll
                    for (int n = 0; n < 2; ++n) { const int col = cbase + u.pn * 256 + bj * 128 + wc * 32 + n * 16 + fq * 4; const f32x4 v = acc[ai][bj][m][n];
                        if (col < PW) { *(f32x4*)(P + (size_t)row * PW + col) = v;
                            if (col >= C_CK && col < C_DP && row < NTP) { const int b = row >> 8, s_ = row & 255; const bool isk = col < C_CV;
                                *(f32x4*)(out + (isk ? O_NK : O_NV) + ((size_t)((b * 2 + l) * 256 + s_)) * 128 + (col - (isk ? C_CK : C_CV))) = v; } }
                        else if (col < NA_COLS) { u32x2 w; w[0] = cvt_pk_bf16(siluf_(v[0]), siluf_(v[1])); w[1] = cvt_pk_bf16(siluf_(v[2]), siluf_(v[3])); *(u32x2*)(Z + (size_t)row * DM + (col - PW)) = w; } } }
    }
};
__device__ __forceinline__ size_t g_off(int row, int cg) {
    const int n = cg >> 10, c = cg & 1023;
    const int pm = row >> 8, wr2 = (row >> 6) & 3, m = (row >> 4) & 3, fr = row & 15;
    const int pn = c >> 7, wc2 = (c >> 6) & 1, q = (c >> 4) & 3, fq2 = (c >> 2) & 3;
    size_t o = (size_t)(n * 32 + pm); o = o * 8 + pn; o = o * 4 + wr2; o = o * 2 + wc2; o = o * 4 + m; o = o * 16 + fr; o = o * 4 + fq2; o = o * 16 + q * 4;
    return o;
}
struct EpiG {
    static constexpr bool PERM = true, AFTER_DRAIN = false;
    bf16_t* G;
    __device__ __forceinline__ void operator()(const pg8::f32x4 (&acc)[2][2][4][2], const pg8::Unit& u, int wr, int wc, int fr, int fq) const {
#pragma unroll
        for (int ai = 0; ai < 2; ++ai)
#pragma unroll
            for (int m = 0; m < 4; ++m) { const int row = u.pm * 256 + ai * 128 + wr * 64 + m * 16 + fr;
#pragma unroll
                for (int bj = 0; bj < 2; ++bj) { const int col = u.pn * 256 + bj * 128 + wc * 32 + 8 * fq; const f32x4 v0 = acc[ai][bj][m][0], v1 = acc[ai][bj][m][1];
                    u32x4 w; w[0] = cvt_pk_bf16(sigmoidf_(v0[0]), sigmoidf_(v0[1])); w[1] = cvt_pk_bf16(sigmoidf_(v0[2]), sigmoidf_(v0[3]));
                    w[2] = cvt_pk_bf16(sigmoidf_(v1[0]), sigmoidf_(v1[1])); w[3] = cvt_pk_bf16(sigmoidf_(v1[2]), sigmoidf_(v1[3]));
                    u32x2 wa, wb; wa[0] = w[0]; wa[1] = w[1]; wb[0] = w[2]; wb[1] = w[3];
                    *(u32x2*)(G + g_off(row, col)) = wa; *(u32x2*)(G + g_off(row, col + 4)) = wb; } }
    }
};

__device__ void phaseA(const Params& p, int l, unsigned char* lds, int part) {
    const int G = part ? ((int)gridDim.x < 160 ? (int)gridDim.x : 160) : (int)gridDim.x;
    if ((int)blockIdx.x < G) {
        pg8::Gemm g; g.A = (const bf16_t*)(PWS + WS_H); g.Bt = (const bf16_t*)(PWS + WS_WTIN) + (size_t)l * INW * 1024 + (size_t)(part ? 2048 : 0) * 1024; g.M = NT; g.N = part ? 5 * 256 : 8 * 256; g.K = 1024;
        pg8::StaticOrder S; S.init(g.M, g.N, G, (int)blockIdx.x);
        EpiA E; E.P = (float*)(PWS + WS_P); E.Z = (bf16_t*)(PWS + WS_Z); E.out = POUT; E.l = l; E.cbase = part ? 2048 : 0;
        pg8::gemm_phase<EpiA, pg8::StaticOrder, false>((PG8_LAS unsigned char*)lds, g, S, E, nullptr);
    }
    __syncthreads();
}

__device__ void phaseB0(const Params& p, int l, unsigned char* ldsb) {
    const int tid = TID(), lane = tid & 63, wid = tid >> 6, fr = lane & 15, fq = lane >> 4;
    const int h = wid >> 1, mt = wid & 1;
    bf16_t* Awd = (bf16_t*)ldsb;
    bf16_t* Aad = Awd + 32 * 72;
    const float* P = (const float*)(PWS + WS_P);
    float* recS = (float*)(PWS + WS_RECS);
    float* recD = (float*)(PWS + WS_RECD);
    float* BC = (float*)(PWS + WS_BC);
    const bf16_t* LT = (const bf16_t*)(PWS + WS_LORAT) + (size_t)l * 4 * 256 * 64;
    const float* pkk = PIN(17) + l * 256; const float* pka = PIN(18) + l * 256; const float* prk = PIN(19) + l * 256;
    const float* pw0 = PIN(13) + l * 512; const float* pa0 = PIN(15) + l * 512;
    __shared__ int s_b0;
    unsigned* ctr0 = (unsigned*)(PWS + WS_CTR) + 4 + l;
    const int nA2 = (int)gridDim.x < 160 ? (int)gridDim.x : 160, nstat = (int)gridDim.x - nA2;
    for (int iter = 0;; ++iter) {
        int it;
        if (iter == 0 && (int)blockIdx.x >= nA2) it = (int)blockIdx.x - nA2;
        else { if (tid == 0) s_b0 = nstat + (int)atomicAdd(ctr0, 1u);
            __syncthreads();
            it = s_b0;
            __syncthreads(); }
        if (it >= NT / 32) break;
        const int tb = it * 32;
        __syncthreads();
#pragma unroll
        for (int i = 0; i < 8; ++i) { const int idx = tid + i * 512, tk = idx >> 7, j = idx & 127; const float v = P[(size_t)(tb + tk) * PW + C_WD + j];
            if (j < 64) Awd[tk * 72 + j] = f2bf(1.0f - 2.0f / (1.0f + __expf(2.0f * v))); else Aad[tk * 72 + j - 64] = f2bf(v); }
        __syncthreads();
        f32x4 acc[4][4];
#pragma unroll
        for (int m = 0; m < 4; ++m)
#pragma unroll
            for (int n = 0; n < 4; ++n) acc[m][n] = (f32x4){0.f, 0.f, 0.f, 0.f};
#pragma unroll
        for (int ks = 0; ks < 2; ++ks) {
            const bf16x8 awf = *(const bf16x8*)(Awd + (mt * 16 + fr) * 72 + ks * 32 + fq * 8), aaf = *(const bf16x8*)(Aad + (mt * 16 + fr) * 72 + ks * 32 + fq * 8);
#pragma unroll
            for (int n = 0; n < 4; ++n) { const int cb = h * 64 + n * 16 + fr;
#pragma unroll
                for (int m = 0; m < 4; ++m) { const bf16x8 bfr = *(const bf16x8*)(LT + ((size_t)m * 256 + cb) * 64 + ks * 32 + fq * 8);
                    acc[m][n] = __builtin_amdgcn_mfma_f32_16x16x32_bf16(bfr, m < 2 ? awf : aaf, acc[m][n], 0, 0, 0); } }
        }
        const int tok = tb + mt * 16 + fr; int seqbase, L, pos; seq_of(tok, seqbase, L, pos);
        const float* pr = P + (size_t)tok * PW;
        const size_t ridx = ((size_t)seqbase * 4 + (size_t)h * L + pos) * 192;
        f32x4 k4[4], kk4[4]; float ss = 0.f;
#pragma unroll
        for (int n = 0; n < 4; ++n) { const int c4 = h * 64 + n * 16 + fq * 4;
            k4[n] = *(const f32x4*)(pr + C_BK + c4); kk4[n] = k4[n] * *(const f32x4*)(pkk + c4);
            ss += (kk4[n][0] * kk4[n][0] + kk4[n][1] * kk4[n][1]) + (kk4[n][2] * kk4[n][2] + kk4[n][3] * kk4[n][3]); }
        ss += __shfl_xor(ss, 16); ss += __shfl_xor(ss, 32);
        const float rn = rsqrtf(ss + 1e-12f);
        float bsum = 0.f;
#pragma unroll
        for (int n = 0; n < 4; ++n) { const int c4 = h * 64 + n * 16 + fq * 4, j4 = n * 16 + fq * 4;
            const f32x4 r4 = *(const f32x4*)(pr + C_BR + c4), v4 = *(const f32x4*)(pr + C_BV + c4);
            const f32x4 kk = kk4[n] * rn, ka4 = *(const f32x4*)(pka + c4), rk4 = *(const f32x4*)(prk + c4);
            *(f32x4*)(recS + ridx + j4) = r4; *(f32x4*)(recS + ridx + 64 + j4) = kk; *(f32x4*)(recS + ridx + 128 + j4) = v4;
#pragma unroll
            for (int d = 0; d < 2; ++d) {
                const f32x4 w0 = *(const f32x4*)(pw0 + d * 256 + c4), a0 = *(const f32x4*)(pa0 + d * 256 + c4);
                f32x4 dec, nka, kd;
#pragma unroll
                for (int j = 0; j < 4; ++j) {
                    const float wl = w0[j] + acc[d][n][j];
                    dec[j] = __expf(-0.6065306597126334f / (1.0f + __expf(-wl)));
                    const float a = 1.0f / (1.0f + __expf(-(a0[j] + acc[2 + d][n][j])));
                    kd[j] = k4[n][j] * (1.0f + (a - 1.0f) * ka4[j]); nka[j] = -(kk[j] * a);
                    bsum += r4[j] * kd[j] * rk4[j]; }
                float* rd = recD + (size_t)d * RECD_STRIDE + ridx + j4;
                *(f32x4*)(rd) = dec; *(f32x4*)(rd + 64) = nka; *(f32x4*)(rd + 128) = kd;
            }
        }
        bsum += __shfl_xor(bsum, 16); bsum += __shfl_xor(bsum, 32);
        if (fq == 0) BC[tok * 4 + h] = bsum;
    }
}

template <int NS>
__device__ __forceinline__ void scan_run(const Params& p, int l, bool sample, int b, int h, int dir, int rg, int L, int seqbase, float* wl) {
    const int lane = TID() & 63, rl = lane >> 4, kl = lane & 15;
    int row[NS]; f32x4 S[NS]; size_t sidx[NS];
#pragma unroll
    for (int q = 0; q < NS; ++q) { row[q] = (rg * NS + q) * 4 + rl;
        sidx[q] = ((size_t)(((b * 2 + l) * 2 + dir) * 4 + h)) * 4096 + row[q] * 64 + kl * 4;
        if (sample) S[q] = *(const f32x4*)(PIN(4) + sidx[q]); else S[q] = (f32x4){0.f, 0.f, 0.f, 0.f}; }
    const float* gS = (const float*)(PWS + WS_RECS) + ((size_t)seqbase * 4 + (size_t)h * L) * 192 + lane * 4;
    const float* gD = (const float*)(PWS + WS_RECD) + (size_t)dir * RECD_STRIDE + ((size_t)seqbase * 4 + (size_t)h * L) * 192 + lane * 4;
    float* O = (float*)(PWS + WS_O) + (size_t)dir * NT * 256 + (size_t)seqbase * 256 + h * 64;
    const int nch = L >> 2;
    f32x4 rA[6], rB[6];
    auto gl = [&](f32x4 (&r)[6], int c) {
        c = c < nch ? c : nch - 1;
        const int pos0 = dir ? (L - 4 * (c + 1)) : 4 * c;
        const float* s_ = gS + (size_t)pos0 * 192; const float* d_ = gD + (size_t)pos0 * 192;
#pragma unroll
        for (int i = 0; i < 3; ++i) { r[i] = *(const f32x4*)(s_ + i * 256); r[3 + i] = *(const f32x4*)(d_ + i * 256); }
    };
    auto st = [&](const f32x4 (&r)[6], float* buf) {
#pragma unroll
        for (int i = 0; i < 3; ++i) { *(f32x4*)(buf + i * 256 + lane * 4) = r[i]; *(f32x4*)(buf + 768 + i * 256 + lane * 4) = r[3 + i]; }
    };
    struct Ops { f32x4 r, kk, w, ka, kd; float v[NS]; };
    auto ldsread = [&](const float* buf, int s) -> Ops {
        const int tc = dir ? 3 - s : s;
        const float* bs = buf + tc * 192; const float* bd = buf + 768 + tc * 192;
        Ops o; o.r = *(const f32x4*)(bs + kl * 4); o.kk = *(const f32x4*)(bs + 64 + kl * 4);
        o.w = *(const f32x4*)(bd + kl * 4); o.ka = *(const f32x4*)(bd + 64 + kl * 4); o.kd = *(const f32x4*)(bd + 128 + kl * 4);
#pragma unroll
        for (int q = 0; q < NS; ++q) o.v[q] = bs[128 + row[q]];
        return o;
    };
    float opart[NS];
#pragma unroll
    for (int q = 0; q < NS; ++q) opart[q] = 0.f;
    auto chunk = [&](const float* cur, const float* nxtbuf, Ops& ops, int c) {
        float oval[NS];
#pragma unroll
        for (int q = 0; q < NS; ++q) oval[q] = 0.f;
#pragma unroll
        for (int s = 0; s < 4; ++s) {
            const Ops nx = (s < 3) ? ldsread(cur, s + 1) : ldsread(nxtbuf, 0);
            __builtin_amdgcn_sched_barrier(0);
            float sa[NS], opr[NS]; f32x2 ta[NS], tb[NS];
            const f32x2 kka = __builtin_shufflevector(ops.kk, ops.kk, 0, 1), kkb = __builtin_shufflevector(ops.kk, ops.kk, 2, 3);
            const f32x2 wa = __builtin_shufflevector(ops.w, ops.w, 0, 1), wb = __builtin_shufflevector(ops.w, ops.w, 2, 3);
            const f32x2 na = __builtin_shufflevector(ops.ka, ops.ka, 0, 1), nb = __builtin_shufflevector(ops.ka, ops.ka, 2, 3);
            const f32x2 da = __builtin_shufflevector(ops.kd, ops.kd, 0, 1), db = __builtin_shufflevector(ops.kd, ops.kd, 2, 3);
            const f32x2 ra = __builtin_shufflevector(ops.r, ops.r, 0, 1), rb = __builtin_shufflevector(ops.r, ops.r, 2, 3);
#pragma unroll
            for (int q = 0; q < NS; ++q) { const f32x2 Sa = __builtin_shufflevector(S[q], S[q], 0, 1), Sb = __builtin_shufflevector(S[q], S[q], 2, 3);
                f32x2 pp = Sa * kka; pp = Sb * kkb + pp; sa[q] = pp[0] + pp[1];
                const f32x2 v2 = (f32x2){ops.v[q], ops.v[q]};
                ta[q] = Sa * wa + v2 * da; tb[q] = Sb * wb + v2 * db; }
#pragma unroll
            for (int q = 0; q < NS; ++q) { sa[q] = row16_sum(sa[q]); opr[q] = row16_sum(opart[q]); oval[q] = (kl == s) ? opr[q] : oval[q]; }
#pragma unroll
            for (int q = 0; q < NS; ++q) { const f32x2 s2 = (f32x2){sa[q], sa[q]};
                const f32x2 Sa = s2 * na + ta[q], Sb = s2 * nb + tb[q];
                f32x2 qq = Sa * ra; qq = Sb * rb + qq; opart[q] = qq[0] + qq[1];
                S[q] = (f32x4){Sa[0], Sa[1], Sb[0], Sb[1]}; }
            ops = nx;
        }
        const int stp = 4 * c - 1 + (kl & 3);
        const int pos = dir ? (L - 1 - stp) : stp;
#pragma unroll
        for (int q = 0; q < NS; ++q) { if (kl < 4 && stp >= 0) O[(size_t)pos * 256 + row[q]] = oval[q]; }
    };
    float* buf0 = wl; float* buf1 = wl + 1536;
    gl(rA, 0); gl(rB, 1);
    st(rA, buf0); gl(rA, 2);
    __builtin_amdgcn_wave_barrier();
    Ops ops = ldsread(buf0, 0);
    for (int c = 0; c < nch; c += 2) {
        st(rB, buf1); gl(rB, c + 3);
        __builtin_amdgcn_wave_barrier();
        chunk(buf0, buf1, ops, c);
        st(rA, buf0); gl(rA, c + 4);
        __builtin_amdgcn_wave_barrier();
        chunk(buf1, buf0, ops, c + 1);
    }
#pragma unroll
    for (int q = 0; q < NS; ++q) { const float ol = row16_sum(opart[q]); if (kl == 0) O[(size_t)(dir ? 0 : L - 1) * 256 + row[q]] = ol; }
    if (!sample) {
#pragma unroll
        for (int q = 0; q < NS; ++q) *(f32x4*)(POUT + O_NS + sidx[q]) = S[q];
    }
}

__device__ __forceinline__ void stage_qk(const float* __restrict__ src, int stride, bf16_t* dst, bool rope, int pos0, float scale, const f32x2* __restrict__ rt) {
    const int tid = TID();
#pragma unroll
    for (int i = 0; i < 2; ++i) {
        const int task = tid + i * 512, row = task >> 3, half = (task >> 2) & 1, quad = task & 3;
        const float* s = src + (size_t)row * stride + half * 32 + quad * 4;
        f32x4 x1 = *(const f32x4*)s, x2 = *(const f32x4*)(s + 16);
        if (rope) { const int pos = pos0 + row; const int pi = half ? (pos & 63) : (pos >> 6);
#pragma unroll
            for (int j = 0; j < 4; ++j) { const f32x2 cs = rt[pi * 16 + quad * 4 + j]; const float a = x1[j], b = x2[j]; x1[j] = a * cs[0] - b * cs[1]; x2[j] = b * cs[0] + a * cs[1]; } }
        x1 *= scale; x2 *= scale;
        u32x2 w1, w2; w1[0] = cvt_pk_bf16(x1[0], x1[1]); w1[1] = cvt_pk_bf16(x1[2], x1[3]); w2[0] = cvt_pk_bf16(x2[0], x2[1]); w2[1] = cvt_pk_bf16(x2[2], x2[3]);
        *(u32x2*)(dst + row * 72 + half * 32 + quad * 4) = w1; *(u32x2*)(dst + row * 72 + half * 32 + 16 + quad * 4) = w2;
    }
}
__device__ __forceinline__ void stage_vt(const float* __restrict__ src, int stride, bf16_t* vt, int nkeys = 128, int pitch = 136) {
    const int tid = TID();
    for (int task = tid; task < nkeys * 16; task += 512) { const int key = task >> 4, dq = task & 15;
        const f32x4 v = *(const f32x4*)(src + (size_t)key * stride + dq * 4);
#pragma unroll
        for (int j = 0; j < 4; ++j) vt[(dq * 4 + j) * pitch + key] = f2bf(v[j]); }
}
__device__ void attn_item(const Params& p, int l, int ai, unsigned char* lds) {
    const int tid = TID(), lane = tid & 63, wid = tid >> 6, fr = lane & 15, fq = lane >> 4;
    bf16_t* Qs = (bf16_t*)lds; bf16_t* Ks = Qs + 128 * 72; bf16_t* Vt = Ks + 128 * 72;
    const float* P = (const float*)(PWS + WS_P);
    const bf16_t* Z = (const bf16_t*)(PWS + WS_Z);
    bf16_t* YS = (bf16_t*)(PWS + WS_YS);
    const f32x2* rt = (const f32x2*)(PWS + WS_ROPE);
    bool sample; int b, head, qt, seqbase;
    if (ai < 128) { sample = true; b = ai >> 5; head = (ai >> 3) & 3; qt = ai & 7; seqbase = NTP + b * 1024; }
    else { const int j = ai - 128; sample = false; b = j >> 3; head = (j >> 1) & 3; qt = j & 1; seqbase = b * 256; }
    const int kh = head >> 1, qbase = seqbase + qt * 128;
    __syncthreads();
    stage_qk(P + (size_t)qbase * PW + C_CQ + head * 64, PW, Qs, sample, qt * 128, 0.125f, rt);
    __syncthreads();
    bf16x8 qf[2];
    qf[0] = *(const bf16x8*)(Qs + (wid * 16 + fr) * 72 + fq * 8); qf[1] = *(const bf16x8*)(Qs + (wid * 16 + fr) * 72 + 32 + fq * 8);
    float m = PIN(22)[l * 4 + head], lsum = 1.0f, lpart = 0.f;
    f32x4 oacc[4];
#pragma unroll
    for (int i = 0; i < 4; ++i) oacc[i] = (f32x4){0.f, 0.f, 0.f, 0.f};
    const int nkb = sample ? 7 : 2;
    const int qpos = qt * 128 + wid * 16 + fr;
    const float* ck = PIN(2); const float* cv = PIN(3);
    auto kinfo = [&](int kb, const float*& ks, const float*& vs, int& stride, bool& rope, bool& mask, int& kpos0) -> bool {
        if (!sample) { ks = P + (size_t)(seqbase + kb * 128) * PW + C_CK + kh * 64; vs = ks + (C_CV - C_CK); stride = PW; rope = false; mask = false; kpos0 = 0; return true; }
        if (kb < 3) { const int nbk = qt - 1 + kb; if (nbk < 0 || nbk >= 8) return false; kpos0 = nbk * 128;
            ks = P + (size_t)(seqbase + kpos0) * PW + C_CK + kh * 64; vs = ks + (C_CV - C_CK); stride = PW; rope = true; mask = (kb != 1); return true; }
        const size_t o = ((size_t)((b * 2 + l) * 512 + (kb - 3) * 128) * 2 + kh) * 64; ks = ck + o; vs = cv + o; stride = 128; rope = false; mask = false; kpos0 = 0; return true;
    };
    f32x4 kx1[2], kx2[2], vx[2][2];
    auto kload = [&](const float* ks, const float* vs, int stride) {
#pragma unroll
        for (int i = 0; i < 2; ++i) { const int task = tid + i * 512, row = task >> 3, half = (task >> 2) & 1, quad = task & 3;
            const float* s_ = ks + (size_t)row * stride + half * 32 + quad * 4; kx1[i] = *(const f32x4*)s_; kx2[i] = *(const f32x4*)(s_ + 16); }
#pragma unroll
        for (int i = 0; i < 2; ++i) { const int task = tid + i * 512, kp = task >> 4, dq = task & 15;
            vx[i][0] = *(const f32x4*)(vs + (size_t)(2 * kp) * stride + dq * 4); vx[i][1] = *(const f32x4*)(vs + (size_t)(2 * kp + 1) * stride + dq * 4); }
    };
    auto kstore = [&](bool rope, int kpos0) {
#pragma unroll
        for (int i = 0; i < 2; ++i) { const int task = tid + i * 512, row = task >> 3, half = (task >> 2) & 1, quad = task & 3;
            f32x4 x1 = kx1[i], x2 = kx2[i];
            if (rope) { const int pos = kpos0 + row; const int pi = half ? (pos & 63) : (pos >> 6);
#pragma unroll
                for (int j = 0; j < 4; ++j) { const f32x2 cs = rt[pi * 16 + quad * 4 + j]; const float a_ = x1[j], b_ = x2[j]; x1[j] = a_ * cs[0] - b_ * cs[1]; x2[j] = b_ * cs[0] + a_ * cs[1]; } }
            u32x2 w1, w2; w1[0] = cvt_pk_bf16(x1[0], x1[1]); w1[1] = cvt_pk_bf16(x1[2], x1[3]); w2[0] = cvt_pk_bf16(x2[0], x2[1]); w2[1] = cvt_pk_bf16(x2[2], x2[3]);
            *(u32x2*)(Ks + row * 72 + half * 32 + quad * 4) = w1; *(u32x2*)(Ks + row * 72 + half * 32 + 16 + quad * 4) = w2; }
#pragma unroll
        for (int i = 0; i < 2; ++i) { const int task = tid + i * 512, kp = task >> 4, dq = task & 15;
#pragma unroll
            for (int j = 0; j < 4; ++j) *(unsigned*)(Vt + (dq * 4 + j) * 136 + 2 * kp) = cvt_pk_bf16(vx[i][0][j], vx[i][1][j]); }
    };
    const float* ksrc = nullptr; const float* vsrc = nullptr; int stride = 0, kpos0n = 0; bool ropen = false, maskn = false;
    int kb = 0;
    while (kb < nkb && !kinfo(kb, ksrc, vsrc, stride, ropen, maskn, kpos0n)) ++kb;
    if (kb < nkb) kload(ksrc, vsrc, stride);
    while (kb < nkb) {
        const bool mask = maskn; const int kpos0 = kpos0n; const bool rope = ropen;
        __syncthreads();
        kstore(rope, kpos0);
        __syncthreads();
        int nk = kb + 1;
        while (nk < nkb && !kinfo(nk, ksrc, vsrc, stride, ropen, maskn, kpos0n)) ++nk;
        if (nk < nkb) kload(ksrc, vsrc, stride);
        kb = nk;
        f32x4 sc[4][2];
#pragma unroll
        for (int sb = 0; sb < 4; ++sb) {
            f32x4 s0 = (f32x4){0.f, 0.f, 0.f, 0.f}, s1 = s0;
#pragma unroll
            for (int dh = 0; dh < 2; ++dh) {
                const bf16x8 k0 = *(const bf16x8*)(Ks + (sb * 32 + fr) * 72 + dh * 32 + fq * 8), k1 = *(const bf16x8*)(Ks + (sb * 32 + 16 + fr) * 72 + dh * 32 + fq * 8);
                s0 = __builtin_amdgcn_mfma_f32_16x16x32_bf16(k0, qf[dh], s0, 0, 0, 0);
                s1 = __builtin_amdgcn_mfma_f32_16x16x32_bf16(k1, qf[dh], s1, 0, 0, 0);
            }
            if (mask) {
#pragma unroll
                for (int j = 0; j < 4; ++j) { const int k0p = kpos0 + sb * 32 + fq * 4 + j, k1p = k0p + 16; int d0 = qpos - k0p, d1 = qpos - k1p; d0 = d0 < 0 ? -d0 : d0; d1 = d1 < 0 ? -d1 : d1;
                    if (d0 > 128) s0[j] = -1e30f; if (d1 > 128) s1[j] = -1e30f; }
            }
            sc[sb][0] = s0; sc[sb][1] = s1;
        }
        float mx = -1e30f;
#pragma unroll
        for (int sb = 0; sb < 4; ++sb)
#pragma unroll
            for (int j = 0; j < 4; ++j) mx = fmaxf(mx, fmaxf(sc[sb][0][j], sc[sb][1][j]));
        mx = fmaxf(mx, __shfl_xor(mx, 16)); mx = fmaxf(mx, __shfl_xor(mx, 32));
        const float mn = fmaxf(m, mx), alpha = __expf(m - mn);
        m = mn; lsum *= alpha; lpart *= alpha;
#pragma unroll
        for (int dt = 0; dt < 4; ++dt) oacc[dt] = oacc[dt] * alpha;
#pragma unroll
        for (int sb = 0; sb < 4; ++sb) {
            f32x4 s0 = sc[sb][0], s1 = sc[sb][1];
#pragma unroll
            for (int j = 0; j < 4; ++j) { s0[j] = __expf(s0[j] - mn); s1[j] = __expf(s1[j] - mn); lpart += s0[j] + s1[j]; }
            u32x4 pw; pw[0] = cvt_pk_bf16(s0[0], s0[1]); pw[1] = cvt_pk_bf16(s0[2], s0[3]); pw[2] = cvt_pk_bf16(s1[0], s1[1]); pw[3] = cvt_pk_bf16(s1[2], s1[3]);
            bf16x8 pf; __builtin_memcpy(&pf, &pw, 16);
#pragma unroll
            for (int dt = 0; dt < 4; ++dt) {
                const bf16_t* vp = Vt + (dt * 16 + fr) * 136 + sb * 32 + fq * 4;
                u32x4 vw; const u32x2 va = *(const u32x2*)vp, vb = *(const u32x2*)(vp + 16); vw[0] = va[0]; vw[1] = va[1]; vw[2] = vb[0]; vw[3] = vb[1];
                bf16x8 vf; __builtin_memcpy(&vf, &vw, 16);
                oacc[dt] = __builtin_amdgcn_mfma_f32_16x16x32_bf16(vf, pf, oacc[dt], 0, 0, 0);
            }
        }
    }
    lpart += __shfl_xor(lpart, 16); lpart += __shfl_xor(lpart, 32);
    lsum += lpart;
    const float inv = 1.0f / lsum;
    const size_t t = (size_t)(qbase + wid * 16 + fr);
#pragma unroll
    for (int dt = 0; dt < 4; ++dt) {
        const int col = 512 + head * 64 + dt * 16 + fq * 4;
        const bf16x4 z = *(const bf16x4*)(Z + t * DM + col);
        u32x2 w; w[0] = cvt_pk_bf16(oacc[dt][0] * inv * bf2f((bf16_t)z[0]), oacc[dt][1] * inv * bf2f((bf16_t)z[1]));
        w[1] = cvt_pk_bf16(oacc[dt][2] * inv * bf2f((bf16_t)z[2]), oacc[dt][3] * inv * bf2f((bf16_t)z[3]));
        *(u32x2*)(YS + t * DM + col) = w;
    }
}

__device__ void chunk_item(const Params& p, int l, int ci, unsigned char* ldsb) {
    const int tid = TID(), lane = tid & 63, wid = tid >> 6, fr = lane & 15, fq = lane >> 4;
    const int chunk = ci >> 2, g = ci & 3, base = chunk * 128;
    bf16_t* wsb = (bf16_t*)ldsb;
    bf16_t* vt = wsb + 128 * 136;
    const float* P = (const float*)(PWS + WS_P);
    const bf16_t* Z = (const bf16_t*)(PWS + WS_Z);
    bf16_t* YS = (bf16_t*)(PWS + WS_YS);
    const float* wsrc = PIN(11) + (size_t)(l * 4 + g) * 128 * 128;
    __syncthreads();
#pragma unroll
    for (int i = 0; i < 8; ++i) { const int idx = tid + i * 512, r = idx >> 5, c4 = (idx & 31) * 4; const f32x4 v = *(const f32x4*)(wsrc + r * 128 + c4);
        u32x2 w; w[0] = cvt_pk_bf16(v[0], v[1]); w[1] = cvt_pk_bf16(v[2], v[3]); *(u32x2*)(wsb + r * 136 + c4) = w; }
    stage_vt(P + (size_t)base * PW + C_AV + g * 64, PW, vt, 128);
    __syncthreads();
    f32x4 acc[4];
#pragma unroll
    for (int n = 0; n < 4; ++n) acc[n] = (f32x4){0.f, 0.f, 0.f, 0.f};
#pragma unroll
    for (int k = 0; k < 4; ++k) {
        const bf16x8 af = *(const bf16x8*)(wsb + (wid * 16 + fr) * 136 + k * 32 + fq * 8);
#pragma unroll
        for (int n = 0; n < 4; ++n) { const bf16x8 bfv = *(const bf16x8*)(vt + (n * 16 + fr) * 136 + k * 32 + fq * 8);
            acc[n] = __builtin_amdgcn_mfma_f32_16x16x32_bf16(bfv, af, acc[n], 0, 0, 0); }
    }
    const int i = wid * 16 + fr; const size_t t = base + i;
    const float bsi = PIN(12)[(l * 4 + g) * 128 + i];
#pragma unroll
    for (int n = 0; n < 4; ++n) { const int col = g * 64 + n * 16 + fq * 4;
        const f32x4 u = *(const f32x4*)(P + t * PW + C_AU + col);
        const bf16x4 z = *(const bf16x4*)(Z + t * DM + col);
        u32x2 w; w[0] = cvt_pk_bf16(u[0] * (acc[n][0] + bsi) * bf2f((bf16_t)z[0]), u[1] * (acc[n][1] + bsi) * bf2f((bf16_t)z[1]));
        w[1] = cvt_pk_bf16(u[2] * (acc[n][2] + bsi) * bf2f((bf16_t)z[2]), u[3] * (acc[n][3] + bsi) * bf2f((bf16_t)z[3]));
        *(u32x2*)(YS + t * DM + col) = w; }
}

__device__ void pool_item(const Params& p, int l, int pi, unsigned char* ldsb) {
    const int tid = TID(), lane = tid & 63, wid = tid >> 6, fr = lane & 15, fq = lane >> 4, half = tid >> 8, ch = tid & 255, g = ch >> 6;
    const int tb = pi * 32; int seqbase, L, pos0; seq_of(tb, seqbase, L, pos0);
    float* pt = (float*)ldsb;
    bf16_t* dl = (bf16_t*)(pt + 48 * 256);
    bf16_t* wt = dl + 32 * 264;
    const float* P = (const float*)(PWS + WS_P);
    const bf16_t* Z = (const bf16_t*)(PWS + WS_Z);
    bf16_t* YS = (bf16_t*)(PWS + WS_YS);
    __syncthreads();
#pragma unroll
    for (int i = 0; i < 6; ++i) { const int idx = tid + i * 512, rr = idx >> 6, c4 = (idx & 63) * 4; const int pos = pos0 - 8 + rr;
        f32x4 v = (f32x4){0.f, 0.f, 0.f, 0.f};
        if (pos >= 0 && pos < L) v = *(const f32x4*)(P + (size_t)(seqbase + pos) * PW + C_DP + c4);
        *(f32x4*)(pt + rr * 256 + c4) = v; }
    { const float* pwsrc = PIN(23) + (size_t)l * 4 * 64 * 64;
#pragma unroll
      for (int gg = 0; gg < 4; ++gg) stage_vt(pwsrc + gg * 4096, 64, wt + gg * 64 * 72, 64, 72); }
    __syncthreads();
    const int w = 2 << g;
    for (int i = 0; i < 16; ++i) { const int tk = half * 16 + i, pos = pos0 + tk;
        int lo = pos - (w >> 1), hi = lo + w; lo = lo < 0 ? 0 : lo; hi = hi > L ? L : hi;
        float sm = 0.f;
        for (int q = lo; q < hi; ++q) sm += pt[(q - pos0 + 8) * 256 + ch];
        dl[tk * 264 + ch] = f2bf(sm / (float)(hi - lo) - pt[(tk + 8) * 256 + ch]); }
    __syncthreads();
    const int gw = wid >> 1, th = wid & 1;
    f32x4 acc[4];
#pragma unroll
    for (int n = 0; n < 4; ++n) acc[n] = (f32x4){0.f, 0.f, 0.f, 0.f};
#pragma unroll
    for (int k = 0; k < 2; ++k) {
        const bf16x8 af = *(const bf16x8*)(dl + (th * 16 + fr) * 264 + gw * 64 + k * 32 + fq * 8);
#pragma unroll
        for (int n = 0; n < 4; ++n) { const bf16x8 bfv = *(const bf16x8*)(wt + (gw * 64 + n * 16 + fr) * 72 + k * 32 + fq * 8);
            acc[n] = __builtin_amdgcn_mfma_f32_16x16x32_bf16(bfv, af, acc[n], 0, 0, 0); }
    }
    const size_t t = tb + th * 16 + fr;
#pragma unroll
    for (int n = 0; n < 4; ++n) { const int oc = gw * 64 + n * 16 + fq * 4;
        const f32x4 sc = *(const f32x4*)(PIN(24) + l * 256 + oc);
        const bf16x4 z = *(const bf16x4*)(Z + t * DM + 768 + oc);
        u32x2 wv; wv[0] = cvt_pk_bf16(acc[n][0] * sc[0] * bf2f((bf16_t)z[0]), acc[n][1] * sc[1] * bf2f((bf16_t)z[1]));
        wv[1] = cvt_pk_bf16(acc[n][2] * sc[2] * bf2f((bf16_t)z[2]), acc[n][3] * sc[3] * bf2f((bf16_t)z[3]));
        *(u32x2*)(YS + t * DM + 768 + oc) = wv; }
}

__device__ void phaseB1(const Params& p, int l, unsigned char* lds, int slot = 0, int part = 127) {
    const int tid = TID(), wid = tid >> 6;
    float* wl = (float*)lds + wid * 3072;
    if (!(part & 1)) {} else
    { const int nbh = (int)gridDim.x >> 1;
      if ((int)blockIdx.x < nbh) { if (wid < 4 && (part & 4)) for (int it = blockIdx.x * 4 + wid; it < 512; it += nbh * 4) { const int q = it >> 4, b = q >> 3;
            scan_run<1>(p, l, true, b, (q >> 1) & 3, q & 1, it & 15, 1024, NTP + b * 1024, wl); } }
      else { const int nb2 = (int)gridDim.x - nbh; if (part & 8) for (int it = ((int)blockIdx.x - nbh) * 8 + wid; it < 1024; it += nb2 * 8) { const int q = it >> 3, b = q >> 3;
            scan_run<2>(p, l, false, b, (q >> 1) & 3, q & 1, it & 7, 256, b * 256, wl); } } }
    __syncthreads();
    __shared__ int s_item;
    unsigned* ctr = (unsigned*)(PWS + WS_CTR) + l + 2 * slot;
    if (part & 2)
    for (;;) {
        if (tid == 0) s_item = (int)atomicAdd(ctr, 1u);
        __syncthreads();
        const int item = s_item;
        __syncthreads();
        if (item >= 768) break;
        if (item < 256) { if (part & 16) attn_item(p, l, item, lds); }
        else if (item < 512) { if (part & 32) chunk_item(p, l, item - 256, lds); }
        else { if (part & 64) pool_item(p, l, item - 512, lds); }
    }
}

__device__ void phaseB2(const Params& p, int l) {
    const int lane = TID() & 63, gw = blockIdx.x * 8 + (TID() >> 6), W = gridDim.x * 8;
    const float* O = (const float*)(PWS + WS_O);
    const float* recS = (const float*)(PWS + WS_RECS);
    const float* BC = (const float*)(PWS + WS_BC);
    const bf16_t* Z = (const bf16_t*)(PWS + WS_Z);
    bf16_t* YS = (bf16_t*)(PWS + WS_YS);
    const float* lng = PIN(20) + l * 256; const float* lnb = PIN(21) + l * 256;
    float g4[4], b4[4];
#pragma unroll
    for (int h = 0; h < 4; ++h) { g4[h] = lng[h * 64 + lane]; b4[h] = lnb[h * 64 + lane]; }
    for (int tok = gw; tok < NT; tok += W) {
        int seqbase, L, pos; seq_of(tok, seqbase, L, pos);
        float o[4], vv[4], z[4], mu[4], var[4];
        const f32x4 bc = *(const f32x4*)(BC + tok * 4);
#pragma unroll
        for (int h = 0; h < 4; ++h) { const int c = h * 64 + lane;
            o[h] = O[(size_t)tok * 256 + c] + O[(size_t)NT * 256 + (size_t)tok * 256 + c];
            vv[h] = recS[((size_t)seqbase * 4 + (size_t)h * L + pos) * 192 + 128 + lane];
            z[h] = bf2f(Z[(size_t)tok * DM + 256 + c]); }
#pragma unroll
        for (int h = 0; h < 4; ++h) mu[h] = wave_sum(o[h]) * (1.0f / 64.0f);
#pragma unroll
        for (int h = 0; h < 4; ++h) { o[h] -= mu[h]; var[h] = wave_sum(o[h] * o[h]) * (1.0f / 64.0f); }
#pragma unroll
        for (int h = 0; h < 4; ++h) { const float on = o[h] * rsqrtf(var[h] + 64e-5f);
            const float y = on * g4[h] + b4[h] + bc[h] * vv[h];
            YS[(size_t)tok * DM + 256 + h * 64 + lane] = f2bf(y * z[h]); }
    }
}

__device__ void phaseC1(const Params& p, int l, unsigned char* lds) {
    pg8::Gemm g; g.A = (const bf16_t*)(PWS + WS_H); g.Bt = (const bf16_t*)(PWS + WS_WTIN) + (size_t)l * INW * 1024 + (size_t)NA_COLS * 1024; g.M = NT; g.N = 4096; g.K = 1024;
    pg8::StaticOrder S; S.init(g.M, g.N, (int)gridDim.x, (int)blockIdx.x);
    EpiG E; E.G = (bf16_t*)(PWS + WS_G);
    pg8::gemm_phase<EpiG, pg8::StaticOrder, false>((PG8_LAS unsigned char*)lds, g, S, E, nullptr);
    __syncthreads();
}
__device__ void phaseC2(const Params& p, int l, unsigned char* lds) {
    constexpr int MT = 4, LDT = 72, A_BYTES = 256 * LDT * 2, B_BYTES = 128 * LDT * 2, BUF = A_BYTES + B_BYTES;
    const int tid = TID(), lane = tid & 63, wid = tid >> 6, wr = wid >> 1, wc = wid & 1, fr = lane & 15, fq = lane >> 4;
    const bf16_t* YS = (const bf16_t*)(PWS + WS_YS);
    const bf16_t* G = (const bf16_t*)(PWS + WS_G);
    const bf16_t* Wu = (const bf16_t*)(PWS + WS_WTUP) + (size_t)l * 4 * 1024 * 256;
    bf16_t* MG = (bf16_t*)(PWS + WS_MERGED);
    const int srow = tid >> 3, skc = tid & 7, soff = (srow * LDT + skc * 8) * 2;
    const int aoff = ((wr * MT * 16 + fr) * LDT + fq * 8) * 2, boff = A_BYTES + ((wc * 64 + fr) * LDT + fq * 8) * 2;
    const int NU = 32 * 8;
    for (int u = blockIdx.x; u < NU; u += gridDim.x) {
        const int pn = u / 32, pm = u % 32;
        const bf16_t* Ag = YS + ((size_t)pm * 256 + srow) * 1024 + skc * 8;
        const bf16_t* Bg = Wu + ((size_t)pn * 128 + srow) * 256 + skc * 8;
        f32x4 mg[4][4], acc[4][4]; zero_acc<4>(mg); zero_acc<4>(acc);
        u32x4 ra[MT], rb[2];
        auto gload = [&](int kt) {
#pragma unroll
            for (int i = 0; i < MT; ++i) ra[i] = *(const u32x4*)(Ag + (size_t)i * 64 * 1024 + kt * 64);
            const bf16_t* bb = Bg + (size_t)(kt >> 2) * 1024 * 256 + (kt & 3) * 64;
#pragma unroll
            for (int i = 0; i < 2; ++i) rb[i] = *(const u32x4*)(bb + (size_t)i * 64 * 256);
        };
        auto sstore = [&](int buf) { unsigned char* nb = lds + buf * BUF;
#pragma unroll
            for (int i = 0; i < MT; ++i) *(u32x4*)(nb + soff + i * 64 * LDT * 2) = ra[i];
#pragma unroll
            for (int i = 0; i < 2; ++i) *(u32x4*)(nb + A_BYTES + soff + i * 64 * LDT * 2) = rb[i];
        };
        __syncthreads();
        gload(0); sstore(0);
        __syncthreads();
        for (int t = 0; t < 16; ++t) {
            if (t + 1 < 16) gload(t + 1);
            const unsigned char* base = lds + (t & 1) * BUF;
#pragma unroll
            for (int kk = 0; kk < 2; ++kk) {
                bf16x8 af[MT], bfr[4];
#pragma unroll
                for (int m = 0; m < MT; ++m) af[m] = *(const bf16x8*)(base + aoff + m * 16 * LDT * 2 + kk * 64);
#pragma unroll
                for (int n = 0; n < 4; ++n) bfr[n] = *(const bf16x8*)(base + boff + n * 16 * LDT * 2 + kk * 64);
#pragma unroll
                for (int m = 0; m < MT; ++m)
#pragma unroll
                    for (int n = 0; n < 4; ++n) acc[m][n] = __builtin_amdgcn_mfma_f32_16x16x32_bf16(bfr[n], af[m], acc[m][n], 0, 0, 0);
            }
            if (t + 1 < 16) sstore((t + 1) & 1);
            if ((t & 3) == 3) {
                const int n = t >> 2;
#pragma unroll
                for (int m = 0; m < 4; ++m) { const int row = pm * 256 + wr * 64 + m * 16 + fr;
                    const bf16_t* gp = G + g_off(row, n * 1024 + pn * 128 + wc * 64 + fq * 4);
                    const bf16x8 ga = *(const bf16x8*)gp, gb = *(const bf16x8*)(gp + 8);
#pragma unroll
                    for (int q = 0; q < 4; ++q) {
#pragma unroll
                        for (int j = 0; j < 4; ++j) { const bf16_t gv = (bf16_t)(q < 2 ? ga[q * 4 + j] : gb[(q - 2) * 4 + j]); mg[m][q][j] += bf2f(gv) * acc[m][q][j]; }
                        acc[m][q] = (f32x4){0.f, 0.f, 0.f, 0.f}; } }
            }
            __syncthreads();
        }
#pragma unroll
        for (int m = 0; m < 4; ++m) { const size_t row = (size_t)pm * 256 + wr * 64 + m * 16 + fr;
#pragma unroll
            for (int q = 0; q < 4; ++q) { const int col = pn * 128 + wc * 64 + q * 16 + fq * 4;
                u32x2 w; w[0] = cvt_pk_bf16(mg[m][q][0], mg[m][q][1]); w[1] = cvt_pk_bf16(mg[m][q][2], mg[m][q][3]);
                __hip_atomic_store((unsigned long long*)(MG + row * DM + col), ((unsigned long long)w[1] << 32) | w[0], __ATOMIC_RELAXED, __HIP_MEMORY_SCOPE_AGENT); } }
        asm volatile("s_waitcnt vmcnt(0)" ::: "memory");
        __syncthreads();
        if (tid == 0) __hip_atomic_fetch_add((unsigned*)(PWS + WS_XCNT) + (size_t)((2 + l) * 32 + pm) * 64, 1u, __ATOMIC_RELAXED, __HIP_MEMORY_SCOPE_AGENT);
    }
}

__device__ void phaseD(const Params& p, int l, unsigned char* lds) {
    const int tid = TID(), lane = tid & 63, wid = tid >> 6, wr = wid >> 1, wc = wid & 1, fr = lane & 15, fq = lane >> 4;
    const bf16_t* MG = (const bf16_t*)(PWS + WS_MERGED);
    const bf16_t* Wo = (const bf16_t*)(PWS + WS_WTO) + (size_t)l * 1024 * 1024;
    const int NU = 32 * 8;
    for (int u = blockIdx.x; u < NU; u += gridDim.x) {
        const int pn = u / 32, pm = u % 32;
        if (tid == 0) { unsigned* c2 = (unsigned*)(PWS + WS_XCNT) + (size_t)((2 + l) * 32 + pm) * 64; unsigned spins = 0;
            while (__hip_atomic_load(c2, __ATOMIC_RELAXED, __HIP_MEMORY_SCOPE_AGENT) < 8u) { __builtin_amdgcn_s_sleep(2); if (++spins > (1u << 22)) break; }
            __builtin_amdgcn_fence(__ATOMIC_ACQUIRE, "agent");
            asm volatile("s_waitcnt vmcnt(0)" ::: "memory"); }
        __syncthreads();
        f32x4 acc[4][4]; zero_acc<4>(acc);
        gemm_acc<4>(MG + (size_t)pm * 256 * 1024, 1024, Wo + (size_t)pn * 128 * 1024, 1024, 1024, acc, lds);
        float ssq[4];
#pragma unroll
        for (int m = 0; m < 4; ++m) { const int row = pm * 256 + wr * 64 + m * 16 + fr;
            const float* xr = xrow_ptr(p, l, row);
            const float* gate = (const float*)(PWS + WS_MOD) + (size_t)(l * 5 + modrow_of(row)) * 3072 + 2048;
            float sm = 0.f;
#pragma unroll
            for (int q = 0; q < 4; ++q) { const int col = pn * 128 + wc * 64 + q * 16 + fq * 4;
                const f32x4 xo = *(const f32x4*)(xr + col), gt = *(const f32x4*)(gate + col);
                acc[m][q] = xo + gt * acc[m][q];
                sm += (acc[m][q][0] * acc[m][q][0] + acc[m][q][1] * acc[m][q][1]) + (acc[m][q][2] * acc[m][q][2] + acc[m][q][3] * acc[m][q][3]); }
            sm += __shfl_xor(sm, 16); sm += __shfl_xor(sm, 32);
            ssq[m] = sm; }
        float* Pt = (float*)lds;
        float* St = Pt + 512;
        if (fq == 0) {
#pragma unroll
            for (int m = 0; m < 4; ++m) Pt[(wr * 64 + m * 16 + fr) * 2 + wc] = ssq[m]; }
        __syncthreads();
        float* XP = (float*)(PWS + WS_XP) + ((size_t)(l * 32 + pm) * 256) * 8;
        unsigned* cnt = (unsigned*)(PWS + WS_XCNT) + (size_t)(l * 32 + pm) * 64;
        if (tid < 256) __hip_atomic_store(XP + tid * 8 + pn, Pt[tid * 2] + Pt[tid * 2 + 1], __ATOMIC_RELAXED, __HIP_MEMORY_SCOPE_AGENT);
        asm volatile("s_waitcnt vmcnt(0)" ::: "memory");
        __syncthreads();
        if (tid == 0) {
            __hip_atomic_fetch_add(cnt, 1u, __ATOMIC_RELAXED, __HIP_MEMORY_SCOPE_AGENT);
            unsigned spins = 0;
            while (__hip_atomic_load(cnt, __ATOMIC_RELAXED, __HIP_MEMORY_SCOPE_AGENT) < 8u) { __builtin_amdgcn_s_sleep(2); if (++spins > (1u << 22)) break; }
            __builtin_amdgcn_fence(__ATOMIC_ACQUIRE, "agent");
            asm volatile("s_waitcnt vmcnt(0)" ::: "memory");
        }
        __syncthreads();
        if (tid < 256) { float t = 0.f;
#pragma unroll
            for (int k = 0; k < 8; ++k) t += __hip_atomic_load(XP + tid * 8 + k, __ATOMIC_RELAXED, __HIP_MEMORY_SCOPE_AGENT);
            St[tid] = rsqrtf(t * (1.0f / 1024.0f) + 1e-6f); }
        __syncthreads();
        const float* gn = (l == 0) ? PIN(9) + DM : PIN(27);
        bf16_t* H = (bf16_t*)(PWS + WS_H);
#pragma unroll
        for (int m = 0; m < 4; ++m) { const int rl_ = wr * 64 + m * 16 + fr, row = pm * 256 + rl_;
            const float rs = St[rl_];
            const float* md = (const float*)(PWS + WS_MOD) + (size_t)(5 + modrow_of(row)) * 3072;
#pragma unroll
            for (int q = 0; q < 4; ++q) { const int col = pn * 128 + wc * 64 + q * 16 + fq * 4;
                const f32x4 gg = *(const f32x4*)(gn + col);
                if (l == 0) { *(f32x4*)(POUT + (size_t)row * DM + col) = acc[m][q];
                    const f32x4 sh = *(const f32x4*)(md + col), scl = *(const f32x4*)(md + 1024 + col);
                    const f32x4 h = acc[m][q] * rs * gg * (1.0f + scl) + sh;
                    u32x2 w; w[0] = cvt_pk_bf16(h[0], h[1]); w[1] = cvt_pk_bf16(h[2], h[3]); *(u32x2*)(H + (size_t)row * DM + col) = w; }
                else *(f32x4*)(POUT + (size_t)row * DM + col) = acc[m][q] * rs * gg; } }
    }
}

__device__ void phaseF(const Params& p) {
    const int lane = TID() & 63, gw = blockIdx.x * 8 + (TID() >> 6), W = gridDim.x * 8;
    const float* g = PIN(27);
    for (int row = gw; row < NT; row += W) {
        float* x = POUT + (size_t)row * DM;
        f32x4 v[4]; float ss = 0.f;
#pragma unroll
        for (int i = 0; i < 4; ++i) { v[i] = *(const f32x4*)(x + i * 256 + lane * 4); ss += v[i][0] * v[i][0] + v[i][1] * v[i][1] + v[i][2] * v[i][2] + v[i][3] * v[i][3]; }
        ss = wave_sum(ss);
        const float rs = rsqrtf(ss * (1.0f / 1024.0f) + 1e-6f);
#pragma unroll
        for (int i = 0; i < 4; ++i) { const int c = i * 256 + lane * 4; *(f32x4*)(x + c) = v[i] * rs * *(const f32x4*)(g + c); }
    }
}

__global__ void __launch_bounds__(NTHREADS) fwd_megakernel(Params p) {
    extern __shared__ __attribute__((aligned(16))) unsigned char lds[];
    volatile LAS unsigned* st = (volatile LAS unsigned*)(lds + LDS_MAIN);
    if (threadIdx.x < 2) st[threadIdx.x] = 0u;
    if (threadIdx.x == 0) {
#pragma unroll
        for (int i = 0; i < 28; ++i) s_ptab[i] = (unsigned long long)p.in[i];
    }
    __syncthreads();
    const XcdBarrier xb = xcd_barrier_post((unsigned*)(PWS + WS_BAR), st);
#define GSYNC() xcd_barrier(xb)
    phase0(p, lds);
    GSYNC();
#pragma unroll 1
    for (int l = 0; l < 2; ++l) {
#pragma unroll 1
        for (int ap = 0; ap < 2; ++ap) { phaseA(p, l, lds, ap); if (ap == 0) GSYNC(); }
        phaseB0(p, l, lds);
        GSYNC();
        phaseB1(p, l, lds);
        GSYNC();
        phaseB2(p, l);
        phaseC1(p, l, lds);
        GSYNC();
        phaseC2(p, l, lds);
        phaseD(p, l, lds);
        if (l == 0) GSYNC();
    }
}

extern "C" void kernel_launch(void* const* d_in, const int* in_sizes, int n_in, void* d_out, int out_size, void* d_ws, size_t ws_size, hipStream_t stream) {
    static int grid_blocks = 0;
    if (!grid_blocks) {
        int dev = 0, cus = 0, per_cu = 0;
        hipGetDevice(&dev);
        hipDeviceGetAttribute(&cus, hipDeviceAttributeMultiprocessorCount, dev);
        hipFuncSetAttribute((const void*)fwd_megakernel, hipFuncAttributeMaxDynamicSharedMemorySize, LDS_BYTES);
        hipOccupancyMaxActiveBlocksPerMultiprocessor(&per_cu, (const void*)fwd_megakernel, NTHREADS, LDS_BYTES);
        if (per_cu < 1) { fprintf(stderr, "occupancy query returned %d\n", per_cu); per_cu = 1; }
        if (per_cu > 1) per_cu = 1;
        grid_blocks = cus * per_cu;
        if (ws_size < WS_END) fprintf(stderr, "workspace too small: %zu < %zu\n", ws_size, (size_t)WS_END);
    }
    Params p{};
    for (int i = 0; i < 28; ++i) p.in[i] = (const float*)d_in[i];
    p.out = (float*)d_out; p.ws = (unsigned char*)d_ws;
    hipMemsetAsync((char*)d_ws + WS_CTR, 0, 256 + 3456 * 4, stream);
    void* args[] = {&p};
    hipError_t e = hipLaunchCooperativeKernel((const void*)fwd_megakernel, dim3(grid_blocks), dim3(NTHREADS), args, LDS_BYTES, stream);
    if (e != hipSuccess) fprintf(stderr, "cooperative launch failed: %s (grid %d)\n", hipGetErrorString(e), grid_blocks);
}
```

```cpp
#include <hip/hip_runtime.h>
#include <hip/hip_cooperative_groups.h>
#include <cstdio>
namespace cg = cooperative_groups;

typedef unsigned short bf16_t;
typedef short bf16x8 __attribute__((ext_vector_type(8)));
typedef short bf16x4 __attribute__((ext_vector_type(4)));
typedef float f32x4 __attribute__((ext_vector_type(4)));
typedef float f32x2 __attribute__((ext_vector_type(2)));
typedef unsigned u32x4 __attribute__((ext_vector_type(4)));
typedef unsigned u32x2 __attribute__((ext_vector_type(2)));

constexpr int NT = 8192, NTP = 4096, DM = 1024, INW = 7296, NA_COLS = 3200, PW = 2176;
constexpr int NTHREADS = 512;
constexpr int C_AU = 0, C_AV = 256, C_BR = 512, C_BK = 768, C_BV = 1024, C_WD = 1280, C_AD = 1344, C_CQ = 1408, C_CK = 1664, C_CV = 1792, C_DP = 1920;
constexpr size_t O_YP = 0, O_YS = 4194304, O_NK = 8388608, O_NV = 9437184, O_NS = 10485760;
constexpr size_t WS_WTIN = 0;
constexpr size_t WS_WTUP = WS_WTIN + (size_t)2 * INW * DM * 2;
constexpr size_t WS_WTO  = WS_WTUP + (size_t)2 * 4 * 1024 * 256 * 2;
constexpr size_t WS_MOD  = WS_WTO + (size_t)2 * 1024 * 1024 * 2;
constexpr size_t WS_ROPE = WS_MOD + (size_t)2 * 5 * 3072 * 4;
constexpr size_t WS_CTR  = WS_ROPE + 64 * 16 * 8;
constexpr size_t WS_BAR  = WS_CTR + 256;
constexpr size_t WS_H    = WS_BAR + 3456 * 4;
constexpr size_t WS_P    = WS_H + (size_t)NT * DM * 2;
constexpr size_t WS_Z    = WS_P + (size_t)NT * PW * 4;
constexpr size_t WS_RECS = WS_Z + (size_t)NT * DM * 2;
constexpr size_t WS_RECD = WS_RECS + (size_t)NT * 4 * 192 * 4;
constexpr size_t WS_O    = WS_RECD + (size_t)2 * NT * 4 * 192 * 4;
constexpr size_t WS_BC   = WS_O + (size_t)2 * NT * 256 * 4;
constexpr size_t WS_YS   = WS_BC + (size_t)NT * 4 * 4;
constexpr size_t WS_LORAT = WS_YS + (size_t)NT * DM * 2;
constexpr size_t WS_XP   = WS_LORAT + (size_t)2 * 4 * 256 * 64 * 2;
constexpr size_t WS_XCNT = WS_XP + (size_t)2 * 32 * 256 * 8 * 4;
constexpr size_t WS_END  = WS_XCNT + (size_t)4 * 32 * 256;
constexpr size_t WS_G = WS_P;
constexpr size_t WS_MERGED = WS_RECS;
constexpr size_t RECD_STRIDE = (size_t)NT * 4 * 192;

constexpr int LDS_MAIN = 131072;
constexpr int LDS_BYTES = LDS_MAIN + 16;

struct Params {
    const float* in[28];
    float* out;
    unsigned char* ws;
};
__shared__ unsigned long long s_ptab[28];
__device__ __forceinline__ const float* ld_inptr(int k) {
    const unsigned long long v = s_ptab[k];
    const unsigned lo = __builtin_amdgcn_readfirstlane((unsigned)v), hi = __builtin_amdgcn_readfirstlane((unsigned)(v >> 32));
    return (const float*)(((unsigned long long)hi << 32) | lo);
}
#define PIN(k) (ld_inptr(k))
#define POUT (p.out)
#define PWS (p.ws)

__device__ __forceinline__ int TID() { int t = threadIdx.x; asm volatile("" : "+v"(t)); return t; }
__device__ __forceinline__ unsigned cvt_pk_bf16(float lo, float hi) { unsigned r; asm volatile("v_cvt_pk_bf16_f32 %0, %1, %2" : "=v"(r) : "v"(lo), "v"(hi)); return r; }
__device__ __forceinline__ bf16_t f2bf(float f) { return (bf16_t)(cvt_pk_bf16(f, 0.f) & 0xffffu); }
__device__ __forceinline__ float bf2f(bf16_t b) { return __uint_as_float(((unsigned)b) << 16); }
__device__ __forceinline__ float sigmoidf_(float x) { return 1.0f / (1.0f + __expf(-x)); }
__device__ __forceinline__ float siluf_(float x) { return x / (1.0f + __expf(-x)); }
template <int CTRL> __device__ __forceinline__ float dpp_f(float x) { return __int_as_float(__builtin_amdgcn_update_dpp(0, __float_as_int(x), CTRL, 0xF, 0xF, false)); }
__device__ __forceinline__ float row16_sum(float x) {
    x += dpp_f<0x128>(x); x += dpp_f<0x124>(x); x += dpp_f<0x122>(x); x += dpp_f<0x121>(x); return x;
}
__device__ __forceinline__ float wave_sum(float v) { v = row16_sum(v); v += __shfl_xor(v, 16); v += __shfl_xor(v, 32); return v; }
__device__ __forceinline__ void seq_of(int tok, int& seqbase, int& L, int& pos) {
    if (tok < NTP) { seqbase = tok & ~255; L = 256; pos = tok & 255; }
    else { int t2 = tok - NTP; seqbase = NTP + (t2 & ~1023); L = 1024; pos = t2 & 1023; }
}
__device__ __forceinline__ int modrow_of(int tok) { return tok < NTP ? 0 : 1 + ((tok - NTP) >> 10); }


#define XB_TMO      128
#define XB_XCNT(j)  (256  + 64 * (j))
#define XB_XSUB(j)  (1280 + 64 * (j))
#define XB_XGEN(j)  (2304 + 64 * (j))
#define XB_TOP      3328
#define XB_TOPGEN   3392
#define XCD_BAR_WORDS 3456
#define XB_SPIN_CAP (1u << 18)
#define LAS __attribute__((address_space(3)))
__device__ __forceinline__ unsigned xb_ld(unsigned* p)              { return __hip_atomic_load(p, __ATOMIC_RELAXED, __HIP_MEMORY_SCOPE_AGENT); }
__device__ __forceinline__ unsigned xb_add(unsigned* p, unsigned v) { return __hip_atomic_fetch_add(p, v, __ATOMIC_RELAXED, __HIP_MEMORY_SCOPE_AGENT); }
__device__ __forceinline__ unsigned xb_xcc_id() { return (unsigned)__builtin_amdgcn_s_getreg((3 << 11) | 20) & 0xFu; }
#define XB_SPIN(cond, bar) do { unsigned _sp = 0; while (cond) { __builtin_amdgcn_s_sleep(1); \
    if ((++_sp & 255u) == 0u) { if (xb_ld(&(bar)[XB_TMO])) break; if (_sp > XB_SPIN_CAP) { atomicAdd(&(bar)[XB_TMO], 1u); break; } } } } while (0)
struct XcdBarrier { unsigned* bar; unsigned x; volatile LAS unsigned* st; };
__device__ __forceinline__ XcdBarrier xcd_barrier_post(unsigned* bar, volatile LAS unsigned* st) {
    XcdBarrier b; b.bar = bar; b.x = xb_xcc_id(); b.st = st;
    if (threadIdx.x == 0) (void)xb_add(&bar[XB_XCNT(b.x)], 1u);
    return b;
}
__device__ __forceinline__ void xcd_barrier_complete(unsigned* bar, unsigned x, unsigned& nloc, unsigned& nx) {
    const unsigned G = gridDim.x * gridDim.y * gridDim.z;
    unsigned sum, cnt, mine, sp = 0u;
    for (;;) {
        sum = 0u; cnt = 0u; mine = 0u;
#pragma unroll
        for (unsigned j = 0; j < 16; ++j) { const unsigned c = xb_ld(&bar[XB_XCNT(j)]); sum += c; cnt += (c > 0u) ? 1u : 0u; mine = (j == x) ? c : mine; }
        if (sum == G) break;
        __builtin_amdgcn_s_sleep(1);
        if ((++sp & 255u) == 0u) { if (xb_ld(&bar[XB_TMO])) break; if (sp > XB_SPIN_CAP) { atomicAdd(&bar[XB_TMO], 1u); break; } }
    }
    nloc = mine > 0u ? mine : 1u; nx = cnt > 0u ? cnt : 1u;
}
__device__ __forceinline__ void xcd_barrier(const XcdBarrier& b0) {
    asm volatile("s_waitcnt vmcnt(0)" ::: "memory");
    __syncthreads();
    if (threadIdx.x == 0) {
        XcdBarrier b = b0;
        { unsigned xx = xb_xcc_id(); asm volatile("" : "+s"(xx)); b.x = xx; }
        unsigned* bar = b.bar;
        __builtin_amdgcn_s_waitcnt(0);
        unsigned nloc = b.st[0], nx = b.st[1];
        if (nloc == 0u) { xcd_barrier_complete(bar, b.x, nloc, nx); b.st[0] = nloc; b.st[1] = nx; }
        const unsigned old = xb_add(&bar[XB_XSUB(b.x)], 1u);
        const unsigned gen = old / nloc;
        if (old + 1u == (gen + 1u) * nloc) {
            __builtin_amdgcn_fence(__ATOMIC_RELEASE, "agent");
            asm volatile("s_waitcnt vmcnt(0)" ::: "memory");
            const unsigned og = xb_add(&bar[XB_TOP], 1u);
            const unsigned tg = og / nx;
            if (og + 1u == (tg + 1u) * nx) xb_add(&bar[XB_TOPGEN], 1u);
            else XB_SPIN(xb_ld(&bar[XB_TOPGEN]) == tg, bar);
            __builtin_amdgcn_fence(__ATOMIC_ACQUIRE, "agent");
            xb_add(&bar[XB_XGEN(b.x)], 1u);
            asm volatile("s_waitcnt vmcnt(0)" ::: "memory");
        } else {
            XB_SPIN(xb_ld(&bar[XB_XGEN(b.x)]) == gen, bar);
            __builtin_amdgcn_fence(__ATOMIC_ACQUIRE, "agent");
            asm volatile("s_waitcnt vmcnt(0)" ::: "memory");
        }
    }
    __syncthreads();
}

__device__ void conv_tile(const float* __restrict__ src, int N, bf16_t* __restrict__ dst, int K, int kt, int nt, float* tile) {
    const int tid = TID();
    { const int r = tid >> 4, c4 = (tid & 15) * 4;
#pragma unroll
      for (int i = 0; i < 2; ++i) { const int k = r + 32 * i; const f32x4 v = __builtin_nontemporal_load((const f32x4*)(src + (size_t)(kt * 64 + k) * N + nt * 64 + c4));
          tile[k * 65 + c4 + 0] = v[0]; tile[k * 65 + c4 + 1] = v[1]; tile[k * 65 + c4 + 2] = v[2]; tile[k * 65 + c4 + 3] = v[3]; } }
    __syncthreads();
    { const int n = tid >> 3, kc = (tid & 7) * 8; u32x4 w;
      w[0] = cvt_pk_bf16(tile[(kc + 0) * 65 + n], tile[(kc + 1) * 65 + n]); w[1] = cvt_pk_bf16(tile[(kc + 2) * 65 + n], tile[(kc + 3) * 65 + n]);
      w[2] = cvt_pk_bf16(tile[(kc + 4) * 65 + n], tile[(kc + 5) * 65 + n]); w[3] = cvt_pk_bf16(tile[(kc + 6) * 65 + n], tile[(kc + 7) * 65 + n]);
      *(u32x4*)(dst + (size_t)(nt * 64 + n) * K + kt * 64 + kc) = w; }
    __syncthreads();
}

__device__ void mod_item(const Params& p, int l, int cc, float* lds) {
    const int tid = TID();
    float* sc = lds;
    float* red = lds + 5120;
    for (int i = tid; i < 5120; i += NTHREADS) { const int r = i >> 10, k = i & 1023; const float v = (r == 0) ? PIN(6)[k] : PIN(5)[(r - 1) * 1024 + k]; sc[i] = siluf_(v); }
    __syncthreads();
    const int kg = tid >> 5, c = tid & 31, col = cc * 32 + c;
    float a[5] = {0.f, 0.f, 0.f, 0.f, 0.f};
    const float* w = PIN(7) + (size_t)l * 1024 * 3072 + col;
    for (int k = kg * 64; k < kg * 64 + 64; ++k) { const float wv = __builtin_nontemporal_load(w + (size_t)k * 3072);
#pragma unroll
        for (int r = 0; r < 5; ++r) a[r] += sc[r * 1024 + k] * wv; }
#pragma unroll
    for (int r = 0; r < 5; ++r) red[(kg * 5 + r) * 32 + c] = a[r];
    __syncthreads();
    if (tid < 160) { const int r = tid >> 5, c2 = tid & 31; float s = PIN(8)[l * 3072 + cc * 32 + c2];
        for (int g = 0; g < 16; ++g) s += red[(g * 5 + r) * 32 + c2];
        __hip_atomic_store((float*)(PWS + WS_MOD) + (l * 5 + r) * 3072 + cc * 32 + c2, s, __ATOMIC_RELAXED, __HIP_MEMORY_SCOPE_AGENT); }
    asm volatile("s_waitcnt vmcnt(0)" ::: "memory");
    __syncthreads();
    if (tid == 0 && l == 0) __hip_atomic_fetch_add((unsigned*)(PWS + WS_CTR) + 16, 1u, __ATOMIC_RELAXED, __HIP_MEMORY_SCOPE_AGENT);
}

__device__ void phaseA0(const Params& p, int l);
__device__ void phase0(const Params& p, unsigned char* lds) {
    const int NCONV_IN = 2 * 16 * 114, NCONV_UP = 8 * 64, NCONV_O = 2 * 256, NCONV_L = 32, NMOD = 192;
    const int total = NCONV_IN + NCONV_UP + NCONV_O + NCONV_L + NMOD + 1;
    for (int it = blockIdx.x; it < total; it += gridDim.x) {
        int i = it;
        if (i < NMOD) { mod_item(p, i / 96, i % 96, (float*)lds); continue; }
        i -= NMOD;
        if (i < NCONV_IN) { const int l = i / 1824, r = i % 1824, nt = r / 16, kt = r % 16;
            conv_tile(PIN(10) + (size_t)l * 1024 * INW, INW, (bf16_t*)(PWS + WS_WTIN) + (size_t)l * INW * 1024, 1024, kt, nt, (float*)lds); continue; }
        i -= NCONV_IN;
        if (i < NCONV_UP) { const int mtx = i / 64, r = i % 64, nt = r / 4, kt = r % 4;
            conv_tile(PIN(25) + (size_t)mtx * 256 * 1024, 1024, (bf16_t*)(PWS + WS_WTUP) + (size_t)mtx * 1024 * 256, 256, kt, nt, (float*)lds); continue; }
        i -= NCONV_UP;
        if (i < NCONV_O) { const int l = i / 256, r = i % 256, nt = r / 16, kt = r % 16;
            conv_tile(PIN(26) + (size_t)l * 1024 * 1024, 1024, (bf16_t*)(PWS + WS_WTO) + (size_t)l * 1024 * 1024, 1024, kt, nt, (float*)lds); continue; }
        i -= NCONV_O;
        if (i < NCONV_L) { const int l = i >> 4, m = (i >> 2) & 3, nt = i & 3;
            conv_tile((m < 2 ? PIN(14) : PIN(16)) + (size_t)(l * 2 + (m & 1)) * 64 * 256, 256, (bf16_t*)(PWS + WS_LORAT) + (size_t)(l * 4 + m) * 256 * 64, 64, 0, nt, (float*)lds); continue; }
        for (int e = TID(); e < 1024; e += NTHREADS) { const int pos = e >> 4, f = e & 15;
            const float inv = exp2f(-(float)f * (13.287712379549449f / 16.0f)); const float ang = (float)pos * inv;
            float sn, cs; sn = sinf(ang); cs = cosf(ang);
            ((f32x2*)(PWS + WS_ROPE))[e] = (f32x2){cs, sn}; }
        for (int e = TID(); e < 4 * 32 * 64; e += NTHREADS) ((unsigned*)(PWS + WS_XCNT))[e] = 0u;
    }
    if (TID() == 0) { unsigned* mc = (unsigned*)(PWS + WS_CTR) + 16; unsigned spins = 0;
        while (__hip_atomic_load(mc, __ATOMIC_RELAXED, __HIP_MEMORY_SCOPE_AGENT) < 96u) { __builtin_amdgcn_s_sleep(2); if (++spins > (1u << 22)) break; }
        __builtin_amdgcn_fence(__ATOMIC_ACQUIRE, "agent");
        asm volatile("s_waitcnt vmcnt(0)" ::: "memory"); }
    __syncthreads();
    phaseA0(p, 0);
}

__device__ __forceinline__ const float* xrow_ptr(const Params& p, int l, int row) {
    if (l == 0) return row < NTP ? PIN(0) + (size_t)row * DM : PIN(1) + (size_t)(row - NTP) * DM;
    return POUT + (size_t)row * DM;
}
__device__ void phaseA0(const Params& p, int l) {
    const int lane = TID() & 63, gw = blockIdx.x * 8 + (TID() >> 6), W = gridDim.x * 8;
    const float* g = PIN(9) + l * DM;
    bf16_t* H = (bf16_t*)(PWS + WS_H);
    for (int row = gw; row < NT; row += W) {
        const float* x = xrow_ptr(p, l, row);
        f32x4 v[4]; float ss = 0.f;
#pragma unroll
        for (int i = 0; i < 4; ++i) { v[i] = *(const f32x4*)(x + i * 256 + lane * 4); ss += v[i][0] * v[i][0] + v[i][1] * v[i][1] + v[i][2] * v[i][2] + v[i][3] * v[i][3]; }
        ss = wave_sum(ss);
        const float rs = rsqrtf(ss * (1.0f / 1024.0f) + 1e-6f);
        const float* mod = (const float*)(PWS + WS_MOD) + (size_t)(l * 5 + modrow_of(row)) * 3072;
#pragma unroll
        for (int i = 0; i < 4; ++i) { const int c = i * 256 + lane * 4;
            const f32x4 gg = *(const f32x4*)(g + c), sh = *(const f32x4*)(mod + c), scl = *(const f32x4*)(mod + 1024 + c);
            f32x4 h = v[i] * rs * gg * (1.0f + scl) + sh;
            u32x2 w; w[0] = cvt_pk_bf16(h[0], h[1]); w[1] = cvt_pk_bf16(h[2], h[3]);
            *(u32x2*)(H + (size_t)row * DM + c) = w; }
    }
}

template <int MT>
__device__ __forceinline__ void gemm_acc(const bf16_t* __restrict__ A, int lda, const bf16_t* __restrict__ B, int ldb, int K, f32x4 (&acc)[MT][4], unsigned char* lds) {
    constexpr int BM = MT * 64, LDT = 72, A_BYTES = BM * LDT * 2, B_BYTES = 128 * LDT * 2, BUF = A_BYTES + B_BYTES;
    const int tid = TID(), lane = tid & 63, wid = tid >> 6, wr = wid >> 1, wc = wid & 1, fr = lane & 15, fq = lane >> 4;
    u32x4 ra[MT], rb[2];
    const int srow = tid >> 3, skc = tid & 7;
    const bf16_t* Ag = A + (size_t)srow * lda + skc * 8;
    const bf16_t* Bg = B + (size_t)srow * ldb + skc * 8;
    const int soff = (srow * LDT + skc * 8) * 2;
    const int nt = K >> 6;
    __syncthreads();
#pragma unroll
    for (int i = 0; i < MT; ++i) ra[i] = *(const u32x4*)(Ag + (size_t)i * 64 * lda);
#pragma unroll
    for (int i = 0; i < 2; ++i) rb[i] = *(const u32x4*)(Bg + (size_t)i * 64 * ldb);
#pragma unroll
    for (int i = 0; i < MT; ++i) *(u32x4*)(lds + soff + i * 64 * LDT * 2) = ra[i];
#pragma unroll
    for (int i = 0; i < 2; ++i) *(u32x4*)(lds + A_BYTES + soff + i * 64 * LDT * 2) = rb[i];
    __syncthreads();
    const int aoff = ((wr * MT * 16 + fr) * LDT + fq * 8) * 2, boff = A_BYTES + ((wc * 64 + fr) * LDT + fq * 8) * 2;
    for (int t = 0; t < nt; ++t) {
        if (t + 1 < nt) {
#pragma unroll
            for (int i = 0; i < MT; ++i) ra[i] = *(const u32x4*)(Ag + (size_t)i * 64 * lda + (t + 1) * 64);
#pragma unroll
            for (int i = 0; i < 2; ++i) rb[i] = *(const u32x4*)(Bg + (size_t)i * 64 * ldb + (t + 1) * 64);
        }
        const unsigned char* base = lds + (t & 1) * BUF;
#pragma unroll
        for (int kk = 0; kk < 2; ++kk) {
            bf16x8 af[MT], bfr[4];
#pragma unroll
            for (int m = 0; m < MT; ++m) af[m] = *(const bf16x8*)(base + aoff + m * 16 * LDT * 2 + kk * 64);
#pragma unroll
            for (int n = 0; n < 4; ++n) bfr[n] = *(const bf16x8*)(base + boff + n * 16 * LDT * 2 + kk * 64);
#pragma unroll
            for (int m = 0; m < MT; ++m)
#pragma unroll
                for (int n = 0; n < 4; ++n) acc[m][n] = __builtin_amdgcn_mfma_f32_16x16x32_bf16(bfr[n], af[m], acc[m][n], 0, 0, 0);
        }
        if (t + 1 < nt) {
            unsigned char* nb = lds + ((t + 1) & 1) * BUF;
#pragma unroll
            for (int i = 0; i < MT; ++i) *(u32x4*)(nb + soff + i * 64 * LDT * 2) = ra[i];
#pragma unroll
            for (int i = 0; i < 2; ++i) *(u32x4*)(nb + A_BYTES + soff + i * 64 * LDT * 2) = rb[i];
        }
        __syncthreads();
    }
}
template <int MT> __device__ __forceinline__ void zero_acc(f32x4 (&acc)[MT][4]) {
#pragma unroll
    for (int m = 0; m < MT; ++m)
#pragma unroll
        for (int n = 0; n < 4; ++n) acc[m][n] = (f32x4){0.f, 0.f, 0.f, 0.f};
}

namespace pg8 {
#define PG8_LAS __attribute__((address_space(3)))
typedef unsigned short bf16_t;
typedef short bf16x8 __attribute__((ext_vector_type(8)));
typedef float f32x4 __attribute__((ext_vector_type(4)));
typedef unsigned u32x4 __attribute__((ext_vector_type(4)));
constexpr int BM = 256, BK = 64, HALF = 128, HTB = HALF * BK * 2  , STAGE_BYTES = 8 * HTB, NXCD = 8, WGM = 8;

__host__ __device__ __forceinline__ int lds_byte(int r, int c) { const int st = (r >> 4) * 2 + (c >> 5), rr = r & 15, cc = c & 31, ob = rr * 64 + cc * 2; return st * 1024 + (ob ^ (((ob >> 9) & 1) << 5)); }
__host__ __device__ __forceinline__ void stage_rc(int b, int& R, int& C) { const int st = b / 1024, sb = b % 1024, swz = sb ^ (((sb >> 9) & 1) << 5); R = (st >> 1) * 16 + swz / 64; C = (st & 1) * 32 + (swz % 64) / 2; }
__host__ __device__ __forceinline__ int perm32(int rho) { const int n = rho >> 4, i = rho & 15; return 8 * (i >> 2) + 4 * n + (i & 3); }

struct Unit { int pm, pn; };
struct Gemm { const bf16_t* A; const bf16_t* Bt; int M, N, K; };

struct StaticOrder {
    int nM, nN, nwg, G, c;
    __host__ __device__ void init(int M, int N, int G_, int c_) { nM = M / BM; nN = N / BM; nwg = nM * nN; G = G_; c = c_; }
    __host__ __device__ bool next(int i, Unit& u) const {
        const long L = (long)i * G + c; if (L >= nwg) return false;
        int wgid = (int)L; { const int q = nwg / NXCD, r = nwg % NXCD, xcd = wgid % NXCD, off = wgid / NXCD; wgid = (xcd < r ? xcd * (q + 1) : r * (q + 1) + (xcd - r) * q) + off; }
        const int nig = WGM * nN, gid = wgid / nig, fm = gid * WGM, gsz = (nM - fm) < WGM ? (nM - fm) : WGM;
        u.pm = fm + ((wgid % nig) % gsz); u.pn = (wgid % nig) / gsz; return true;
    }
    __device__ __forceinline__ void a_ready(const Unit&) const {}
    __device__ __forceinline__ void done(const Unit&) const {}
};
template <class Epi, class Sched, bool STAMP = false>
__device__ __forceinline__ void gemm_phase(PG8_LAS unsigned char* lds, const Gemm g, const Sched& S, const Epi& E, unsigned long long* stamps) {
    const int tid = ::TID(), wid = __builtin_amdgcn_readfirstlane(tid >> 6), lane = tid & 63, wr = wid >> 2, wc = wid & 3, fr = lane & 15, fq = lane >> 4;
    const int K = g.K, nt = K / BK;
    int ts_lo = 0, ts_hi = 0, nts = 0; const unsigned long long rt_entry = STAMP ? (unsigned long long)wall_clock64() : 0ull;
#define PG8_STAMP() do { if (STAMP && wid == 0 && nts < 64) { const unsigned long long _c = (unsigned long long)clock64(); \
        ts_lo = (lane == nts) ? (int)(unsigned)_c : ts_lo; ts_hi = (lane == nts) ? (int)(unsigned)(_c >> 32) : ts_hi; ++nts; } } while (0)
    PG8_STAMP();
    unsigned voffA[2], voffB[2];
#pragma unroll
    for (int i = 0; i < 2; ++i) { int R, C; stage_rc(tid * 16 + i * 8192, R, C); const int Rb = Epi::PERM ? ((R & ~31) + perm32(R & 31)) : R;
        voffA[i] = (unsigned)(R * K + C) * 2u; voffB[i] = (unsigned)(Rb * K + C) * 2u; }
    const size_t kstep = (size_t)(BK * 2);
    const size_t hstep = (size_t)HALF * K * 2;
    const size_t tstep = 2 * hstep;
    const unsigned ldsw = (unsigned)wid * 1024u;
    const int aoff = lds_byte(wr * 64 + fr, fq * 8), boff = lds_byte(wc * 32 + fr, fq * 8);
#define PG8_SA(b, h) (((b) * 2 + (h)) * HTB)
#define PG8_SB(b, h) ((4 + (b) * 2 + (h)) * HTB)
#define PG8_STAGE(bufoff, gbase, voff) do { _Pragma("unroll") for (int _i = 0; _i < 2; ++_i) \
        __builtin_amdgcn_global_load_lds((const unsigned*)((const char*)(gbase) + (voff)[_i]), (PG8_LAS unsigned*)(lds + (bufoff) + ldsw + _i * 8192), 16, 0, 0); } while (0)
#define PG8_LDA(dst, b, h) do { _Pragma("unroll") for (int m = 0; m < 4; ++m) _Pragma("unroll") for (int k = 0; k < 2; ++k) dst[m][k] = *(const PG8_LAS bf16x8*)(lds + PG8_SA(b, h) + aoff + m * 2048 + k * 1024); } while (0)
#define PG8_LDB(dst, b, h) do { _Pragma("unroll") for (int n = 0; n < 2; ++n) _Pragma("unroll") for (int k = 0; k < 2; ++k) dst[n][k] = *(const PG8_LAS bf16x8*)(lds + PG8_SB(b, h) + boff + n * 2048 + k * 1024); } while (0)
#define PG8_MMA(ai, bj, At, Bt) do { __builtin_amdgcn_s_setprio(1); _Pragma("unroll") for (int m = 0; m < 4; ++m) _Pragma("unroll") for (int n = 0; n < 2; ++n) _Pragma("unroll") for (int k = 0; k < 2; ++k) \
        acc[ai][bj][m][n] = __builtin_amdgcn_mfma_f32_16x16x32_bf16(Bt[n][k], At[m][k], acc[ai][bj][m][n], 0, 0, 0); __builtin_amdgcn_s_setprio(0); } while (0)
#define PG8_WAIT_V(n) asm volatile("s_waitcnt vmcnt(" #n ")" ::: "memory")
#define PG8_WAIT_L(n) asm volatile("s_waitcnt lgkmcnt(" #n ")" ::: "memory")
#define PG8_BAR __builtin_amdgcn_s_barrier()
#define PG8_SCHED __builtin_amdgcn_sched_barrier(0)
    Unit cur, nxt; int ui = 0;
    if (!S.next(0, cur)) return;
    f32x4 acc[2][2][4][2];
#pragma unroll
    for (int a = 0; a < 2; ++a)
#pragma unroll
        for (int b = 0; b < 2; ++b)
#pragma unroll
            for (int m = 0; m < 4; ++m)
#pragma unroll
                for (int n = 0; n < 2; ++n) acc[a][b][m][n] = (f32x4){0.f, 0.f, 0.f, 0.f};
    bf16x8 At[4][2], B0[2][2], B1[2][2];
    const char* cA = (const char*)g.A + (size_t)cur.pm * tstep; const char* cB = (const char*)g.Bt + (size_t)cur.pn * tstep;
    S.a_ready(cur);
    PG8_STAGE(PG8_SB(0, 0), cB, voffB); PG8_STAGE(PG8_SA(0, 0), cA, voffA); PG8_STAGE(PG8_SB(0, 1), cB + hstep, voffB); PG8_STAGE(PG8_SA(0, 1), cA + hstep, voffA);
    if (wr == 1) PG8_BAR;
    PG8_WAIT_V(4); PG8_BAR;
    PG8_STAGE(PG8_SB(1, 0), cB + kstep, voffB); PG8_STAGE(PG8_SA(1, 0), cA + kstep, voffA); PG8_STAGE(PG8_SB(1, 1), cB + hstep + kstep, voffB);
    PG8_WAIT_V(6); PG8_BAR;
    PG8_STAMP();
    for (;;) {
        const bool has_next = S.next(ui + 1, nxt);
        const char* nA = has_next ? (const char*)g.A + (size_t)nxt.pm * tstep : cA; const char* nB = has_next ? (const char*)g.Bt + (size_t)nxt.pn * tstep : cB;
        for (int t = 0; t < nt; t += 2) {
            const bool last = (t == nt - 2);
            const char* a1 = cA + (size_t)(t + 1) * kstep;
            const char* a2 = last ? nA : cA + (size_t)(t + 2) * kstep; const char* b2 = last ? nB : cB + (size_t)(t + 2) * kstep;
            const char* a3 = a2 + kstep; const char* b3 = b2 + kstep;
            if (last && has_next) S.a_ready(nxt);
            PG8_LDB(B0, 0, 0); PG8_SCHED; PG8_LDA(At, 0, 0); PG8_STAGE(PG8_SA(1, 1), a1 + hstep, voffA);
            PG8_WAIT_L(8); PG8_BAR; PG8_WAIT_L(0); PG8_MMA(0, 0, At, B0); PG8_BAR; PG8_SCHED;
            PG8_LDB(B1, 0, 1); PG8_STAGE(PG8_SB(0, 0), b2, voffB);
            PG8_BAR; PG8_WAIT_L(0); PG8_MMA(0, 1, At, B1); PG8_BAR;
            PG8_LDA(At, 0, 1); PG8_STAGE(PG8_SA(0, 0), a2, voffA);
            PG8_BAR; PG8_WAIT_L(0); PG8_MMA(1, 0, At, B0); PG8_BAR; PG8_SCHED;
            PG8_STAGE(PG8_SB(0, 1), b2 + hstep, voffB);
            PG8_WAIT_V(6); PG8_BAR; PG8_MMA(1, 1, At, B1); PG8_BAR;
            PG8_LDB(B0, 1, 0); PG8_SCHED; PG8_LDA(At, 1, 0); PG8_STAGE(PG8_SA(0, 1), a2 + hstep, voffA);
            PG8_WAIT_L(8); PG8_BAR; PG8_WAIT_L(0); PG8_MMA(0, 0, At, B0); PG8_BAR; PG8_SCHED;
            PG8_LDB(B1, 1, 1); PG8_STAGE(PG8_SB(1, 0), b3, voffB);
            PG8_BAR; PG8_WAIT_L(0); PG8_MMA(0, 1, At, B1); PG8_BAR;
            PG8_LDA(At, 1, 1); PG8_STAGE(PG8_SA(1, 0), a3, voffA);
            PG8_BAR; PG8_WAIT_L(0); PG8_MMA(1, 0, At, B0); PG8_BAR; PG8_SCHED;
            PG8_STAGE(PG8_SB(1, 1), b3 + hstep, voffB);
            PG8_WAIT_V(6); PG8_BAR; PG8_MMA(1, 1, At, B1); PG8_BAR;
        }
        PG8_STAMP();
        if constexpr (!Epi::AFTER_DRAIN) { E(acc, cur, wr, wc, fr, fq); S.done(cur); }
        PG8_STAMP();
        if (!has_next) break;
#pragma unroll
        for (int a = 0; a < 2; ++a)
#pragma unroll
            for (int b = 0; b < 2; ++b)
#pragma unroll
                for (int m = 0; m < 4; ++m)
#pragma unroll
                    for (int n = 0; n < 2; ++n) acc[a][b][m][n] = (f32x4){0.f, 0.f, 0.f, 0.f};
        cur = nxt; cA = nA; cB = nB; ++ui;
    }
    PG8_WAIT_V(0);
    if (wr == 0) PG8_BAR;
    PG8_BAR;
    if constexpr (Epi::AFTER_DRAIN) { E.fused(acc, cur, wr, wc, fr, fq, lds, wid, lane); S.done(cur); }
    PG8_STAMP();
    if (STAMP && wid == 0) { stamps[lane] = lane < nts ? (((unsigned long long)(unsigned)ts_hi << 32) | (unsigned)ts_lo) : 0ull;
        if (lane == 62) stamps[62] = rt_entry; if (lane == 63) stamps[63] = (unsigned long long)wall_clock64(); }
#undef PG8_STAMP
#undef PG8_SA
#undef PG8_SB
#undef PG8_STAGE
#undef PG8_LDA
#undef PG8_LDB
#undef PG8_MMA
#undef PG8_WAIT_V
#undef PG8_WAIT_L
#undef PG8_BAR
#undef PG8_SCHED
}
}

struct EpiA {
    static constexpr bool PERM = false, AFTER_DRAIN = false;
    float* P; bf16_t* Z; float* out; int l, cbase;
    __device__ __forceinline__ void operator()(const pg8::f32x4 (&acc)[2][2][4][2], const pg8::Unit& u, int wr, int wc, int fr, int fq) const {
#pragma unroll
        for (int ai = 0; ai < 2; ++ai)
#pragma unroll
            for (int m = 0; m < 4; ++m) { const int row = u.pm * 256 + ai * 128 + wr * 64 + m * 16 + fr;
#pragma unroll
                for (int bj = 0; bj < 2; ++bj)
#pragma unroll
                    for (int n = 0; n < 2; ++n) { const int col = cbase + u.pn * 256 + bj * 128 + wc * 32 + n * 16 + fq * 4; const f32x4 v = acc[ai][bj][m][n];
                        if (col < PW) { *(f32x4*)(P + (size_t)row * PW + col) = v;
                            if (col >= C_CK && col < C_DP && row < NTP) { const int b = row >> 8, s_ = row & 255; const bool isk = col < C_CV;
                                *(f32x4*)(out + (isk ? O_NK : O_NV) + ((size_t)((b * 2 + l) * 256 + s_)) * 128 + (col - (isk ? C_CK : C_CV))) = v; } }
                        else if (col < NA_COLS) { u32x2 w; w[0] = cvt_pk_bf16(siluf_(v[0]), siluf_(v[1])); w[1] = cvt_pk_bf16(siluf_(v[2]), siluf_(v[3])); *(u32x2*)(Z + (size_t)row * DM + (col - PW)) = w; } } }
    }
};
__device__ __forceinline__ size_t g_off(int row, int cg) {
    const int n = cg >> 10, c = cg & 1023;
    const int pm = row >> 8, wr2 = (row >> 6) & 3, m = (row >> 4) & 3, fr = row & 15;
    const int pn = c >> 7, wc2 = (c >> 6) & 1, q = (c >> 4) & 3, fq2 = (c >> 2) & 3;
    size_t o = (size_t)(n * 32 + pm); o = o * 8 + pn; o = o * 4 + wr2; o = o * 2 + wc2; o = o * 4 + m; o = o * 16 + fr; o = o * 4 + fq2; o = o * 16 + q * 4;
    return o;
}
struct EpiG {
    static constexpr bool PERM = true, AFTER_DRAIN = false;
    bf16_t* G;
    __device__ __forceinline__ void operator()(const pg8::f32x4 (&acc)[2][2][4][2], const pg8::Unit& u, int wr, int wc, int fr, int fq) const {
#pragma unroll
        for (int ai = 0; ai < 2; ++ai)
#pragma unroll
            for (int m = 0; m < 4; ++m) { const int row = u.pm * 256 + ai * 128 + wr * 64 + m * 16 + fr;
#pragma unroll
                for (int bj = 0; bj < 2; ++bj) { const int col = u.pn * 256 + bj * 128 + wc * 32 + 8 * fq; const f32x4 v0 = acc[ai][bj][m][0], v1 = acc[ai][bj][m][1];
                    u32x4 w; w[0] = cvt_pk_bf16(sigmoidf_(v0[0]), sigmoidf_(v0[1])); w[1] = cvt_pk_bf16(sigmoidf_(v0[2]), sigmoidf_(v0[3]));
                    w[2] = cvt_pk_bf16(sigmoidf_(v1[0]), sigmoidf_(v1[1])); w[3] = cvt_pk_bf16(sigmoidf_(v1[2]), sigmoidf_(v1[3]));
                    u32x2 wa, wb; wa[0] = w[0]; wa[1] = w[1]; wb[0] = w[2]; wb[1] = w[3];
                    *(u32x2*)(G + g_off(row, col)) = wa; *(u32x2*)(G + g_off(row, col + 4)) = wb; } }
    }
};

__device__ void phaseA(const Params& p, int l, unsigned char* lds, int part) {
    const int G = part ? ((int)gridDim.x < 160 ? (int)gridDim.x : 160) : (int)gridDim.x;
    if ((int)blockIdx.x < G) {
        pg8::Gemm g; g.A = (const bf16_t*)(PWS + WS_H); g.Bt = (const bf16_t*)(PWS + WS_WTIN) + (size_t)l * INW * 1024 + (size_t)(part ? 2048 : 0) * 1024; g.M = NT; g.N = part ? 5 * 256 : 8 * 256; g.K = 1024;
        pg8::StaticOrder S; S.init(g.M, g.N, G, (int)blockIdx.x);
        EpiA E; E.P = (float*)(PWS + WS_P); E.Z = (bf16_t*)(PWS + WS_Z); E.out = POUT; E.l = l; E.cbase = part ? 2048 : 0;
        pg8::gemm_phase<EpiA, pg8::StaticOrder, false>((PG8_LAS unsigned char*)lds, g, S, E, nullptr);
    }
    __syncthreads();
}

__device__ void phaseB0(const Params& p, int l, unsigned char* ldsb) {
    const int tid = TID(), lane = tid & 63, wid = tid >> 6, fr = lane & 15, fq = lane >> 4;
    const int h = wid >> 1, mt = wid & 1;
    bf16_t* Awd = (bf16_t*)ldsb;
    bf16_t* Aad = Awd + 32 * 72;
    const float* P = (const float*)(PWS + WS_P);
    float* recS = (float*)(PWS + WS_RECS);
    float* recD = (float*)(PWS + WS_RECD);
    float* BC = (float*)(PWS + WS_BC);
    const bf16_t* LT = (const bf16_t*)(PWS + WS_LORAT) + (size_t)l * 4 * 256 * 64;
    const float* pkk = PIN(17) + l * 256; const float* pka = PIN(18) + l * 256; const float* prk = PIN(19) + l * 256;
    const float* pw0 = PIN(13) + l * 512; const float* pa0 = PIN(15) + l * 512;
    __shared__ int s_b0;
    unsigned* ctr0 = (unsigned*)(PWS + WS_CTR) + 4 + l;
    const int nA2 = (int)gridDim.x < 160 ? (int)gridDim.x : 160, nstat = (int)gridDim.x - nA2;
    for (int iter = 0;; ++iter) {
        int it;
        if (iter == 0 && (int)blockIdx.x >= nA2) it = (int)blockIdx.x - nA2;
        else { if (tid == 0) s_b0 = nstat + (int)atomicAdd(ctr0, 1u);
            __syncthreads();
            it = s_b0;
            __syncthreads(); }
        if (it >= NT / 32) break;
        const int tb = it * 32;
        __syncthreads();
#pragma unroll
        for (int i = 0; i < 8; ++i) { const int idx = tid + i * 512, tk = idx >> 7, j = idx & 127; const float v = P[(size_t)(tb + tk) * PW + C_WD + j];
            if (j < 64) Awd[tk * 72 + j] = f2bf(1.0f - 2.0f / (1.0f + __expf(2.0f * v))); else Aad[tk * 72 + j - 64] = f2bf(v); }
        __syncthreads();
        f32x4 acc[4][4];
#pragma unroll
        for (int m = 0; m < 4; ++m)
#pragma unroll
            for (int n = 0; n < 4; ++n) acc[m][n] = (f32x4){0.f, 0.f, 0.f, 0.f};
#pragma unroll
        for (int ks = 0; ks < 2; ++ks) {
            const bf16x8 awf = *(const bf16x8*)(Awd + (mt * 16 + fr) * 72 + ks * 32 + fq * 8), aaf = *(const bf16x8*)(Aad + (mt * 16 + fr) * 72 + ks * 32 + fq * 8);
#pragma unroll
            for (int n = 0; n < 4; ++n) { const int cb = h * 64 + n * 16 + fr;
#pragma unroll
                for (int m = 0; m < 4; ++m) { const bf16x8 bfr = *(const bf16x8*)(LT + ((size_t)m * 256 + cb) * 64 + ks * 32 + fq * 8);
                    acc[m][n] = __builtin_amdgcn_mfma_f32_16x16x32_bf16(bfr, m < 2 ? awf : aaf, acc[m][n], 0, 0, 0); } }
        }
        const int tok = tb + mt * 16 + fr; int seqbase, L, pos; seq_of(tok, seqbase, L, pos);
        const float* pr = P + (size_t)tok * PW;
        const size_t ridx = ((size_t)seqbase * 4 + (size_t)h * L + pos) * 192;
        f32x4 k4[4], kk4[4]; float ss = 0.f;
#pragma unroll
        for (int n = 0; n < 4; ++n) { const int c4 = h * 64 + n * 16 + fq * 4;
            k4[n] = *(const f32x4*)(pr + C_BK + c4); kk4[n] = k4[n] * *(const f32x4*)(pkk + c4);
            ss += (kk4[n][0] * kk4[n][0] + kk4[n][1] * kk4[n][1]) + (kk4[n][2] * kk4[n][2] + kk4[n][3] * kk4[n][3]); }
        ss += __shfl_xor(ss, 16); ss += __shfl_xor(ss, 32);
        const float rn = rsqrtf(ss + 1e-12f);
        float bsum = 0.f;
#pragma unroll
        for (int n = 0; n < 4; ++n) { const int c4 = h * 64 + n * 16 + fq * 4, j4 = n * 16 + fq * 4;
            const f32x4 r4 = *(const f32x4*)(pr + C_BR + c4), v4 = *(const f32x4*)(pr + C_BV + c4);
            const f32x4 kk = kk4[n] * rn, ka4 = *(const f32x4*)(pka + c4), rk4 = *(const f32x4*)(prk + c4);
            *(f32x4*)(recS + ridx + j4) = r4; *(f32x4*)(recS + ridx + 64 + j4) = kk; *(f32x4*)(recS + ridx + 128 + j4) = v4;
#pragma unroll
            for (int d = 0; d < 2; ++d) {
                const f32x4 w0 = *(const f32x4*)(pw0 + d * 256 + c4), a0 = *(const f32x4*)(pa0 + d * 256 + c4);
                f32x4 dec, nka, kd;
#pragma unroll
                for (int j = 0; j < 4; ++j) {
                    const float wl = w0[j] + acc[d][n][j];
                    dec[j] = __expf(-0.6065306597126334f / (1.0f + __expf(-wl)));
                    const float a = 1.0f / (1.0f + __expf(-(a0[j] + acc[2 + d][n][j])));
                    kd[j] = k4[n][j] * (1.0f + (a - 1.0f) * ka4[j]); nka[j] = -(kk[j] * a);
                    bsum += r4[j] * kd[j] * rk4[j]; }
                float* rd = recD + (size_t)d * RECD_STRIDE + ridx + j4;
                *(f32x4*)(rd) = dec; *(f32x4*)(rd + 64) = nka; *(f32x4*)(rd + 128) = kd;
            }
        }
        bsum += __shfl_xor(bsum, 16); bsum += __shfl_xor(bsum, 32);
        if (fq == 0) BC[tok * 4 + h] = bsum;
    }
}

template <int NS>
__device__ __forceinline__ void scan_run(const Params& p, int l, bool sample, int b, int h, int dir, int rg, int L, int seqbase, float* wl) {
    const int lane = TID() & 63, rl = lane >> 4, kl = lane & 15;
    int row[NS]; f32x4 S[NS]; size_t sidx[NS];
#pragma unroll
    for (int q = 0; q < NS; ++q) { row[q] = (rg * NS + q) * 4 + rl;
        sidx[q] = ((size_t)(((b * 2 + l) * 2 + dir) * 4 + h)) * 4096 + row[q] * 64 + kl * 4;
        if (sample) S[q] = *(const f32x4*)(PIN(4) + sidx[q]); else S[q] = (f32x4){0.f, 0.f, 0.f, 0.f}; }
    const float* gS = (const float*)(PWS + WS_RECS) + ((size_t)seqbase * 4 + (size_t)h * L) * 192 + lane * 4;
    const float* gD = (const float*)(PWS + WS_RECD) + (size_t)dir * RECD_STRIDE + ((size_t)seqbase * 4 + (size_t)h * L) * 192 + lane * 4;
    float* O = (float*)(PWS + WS_O) + (size_t)dir * NT * 256 + (size_t)seqbase * 256 + h * 64;
    const int nch = L >> 2;
    f32x4 rA[6], rB[6];
    auto gl = [&](f32x4 (&r)[6], int c) {
        c = c < nch ? c : nch - 1;
        const int pos0 = dir ? (L - 4 * (c + 1)) : 4 * c;
        const float* s_ = gS + (size_t)pos0 * 192; const float* d_ = gD + (size_t)pos0 * 192;
#pragma unroll
        for (int i = 0; i < 3; ++i) { r[i] = *(const f32x4*)(s_ + i * 256); r[3 + i] = *(const f32x4*)(d_ + i * 256); }
    };
    auto st = [&](const f32x4 (&r)[6], float* buf) {
#pragma unroll
        for (int i = 0; i < 3; ++i) { *(f32x4*)(buf + i * 256 + lane * 4) = r[i]; *(f32x4*)(buf + 768 + i * 256 + lane * 4) = r[3 + i]; }
    };
    struct Ops { f32x4 r, kk, w, ka, kd; float v[NS]; };
    auto ldsread = [&](const float* buf, int s) -> Ops {
        const int tc = dir ? 3 - s : s;
        const float* bs = buf + tc * 192; const float* bd = buf + 768 + tc * 192;
        Ops o; o.r = *(const f32x4*)(bs + kl * 4); o.kk = *(const f32x4*)(bs + 64 + kl * 4);
        o.w = *(const f32x4*)(bd + kl * 4); o.ka = *(const f32x4*)(bd + 64 + kl * 4); o.kd = *(const f32x4*)(bd + 128 + kl * 4);
#pragma unroll
        for (int q = 0; q < NS; ++q) o.v[q] = bs[128 + row[q]];
        return o;
    };
    float opart[NS];
#pragma unroll
    for (int q = 0; q < NS; ++q) opart[q] = 0.f;
    auto chunk = [&](const float* cur, const float* nxtbuf, Ops& ops, int c) {
        float oval[NS];
#pragma unroll
        for (int q = 0; q < NS; ++q) oval[q] = 0.f;
#pragma unroll
        for (int s = 0; s < 4; ++s) {
            const Ops nx = (s < 3) ? ldsread(cur, s + 1) : ldsread(nxtbuf, 0);
            __builtin_amdgcn_sched_barrier(0);
            float sa[NS], opr[NS]; f32x2 ta[NS], tb[NS];
            const f32x2 kka = __builtin_shufflevector(ops.kk, ops.kk, 0, 1), kkb = __builtin_shufflevector(ops.kk, ops.kk, 2, 3);
            const f32x2 wa = __builtin_shufflevector(ops.w, ops.w, 0, 1), wb = __builtin_shufflevector(ops.w, ops.w, 2, 3);
            const f32x2 na = __builtin_shufflevector(ops.ka, ops.ka, 0, 1), nb = __builtin_shufflevector(ops.ka, ops.ka, 2, 3);
            const f32x2 da = __builtin_shufflevector(ops.kd, ops.kd, 0, 1), db = __builtin_shufflevector(ops.kd, ops.kd, 2, 3);
            const f32x2 ra = __builtin_shufflevector(ops.r, ops.r, 0, 1), rb = __builtin_shufflevector(ops.r, ops.r, 2, 3);
#pragma unroll
            for (int q = 0; q < NS; ++q) { const f32x2 Sa = __builtin_shufflevector(S[q], S[q], 0, 1), Sb = __builtin_shufflevector(S[q], S[q], 2, 3);
                f32x2 pp = Sa * kka; pp = Sb * kkb + pp; sa[q] = pp[0] + pp[1];
                const f32x2 v2 = (f32x2){ops.v[q], ops.v[q]};
                ta[q] = Sa * wa + v2 * da; tb[q] = Sb * wb + v2 * db; }
#pragma unroll
            for (int q = 0; q < NS; ++q) { sa[q] = row16_sum(sa[q]); opr[q] = row16_sum(opart[q]); oval[q] = (kl == s) ? opr[q] : oval[q]; }
#pragma unroll
            for (int q = 0; q < NS; ++q) { const f32x2 s2 = (f32x2){sa[q], sa[q]};
                const f32x2 Sa = s2 * na + ta[q], Sb = s2 * nb + tb[q];
                f32x2 qq = Sa * ra; qq = Sb * rb + qq; opart[q] = qq[0] + qq[1];
                S[q] = (f32x4){Sa[0], Sa[1], Sb[0], Sb[1]}; }
            ops = nx;
        }
        const int stp = 4 * c - 1 + (kl & 3);
        const int pos = dir ? (L - 1 - stp) : stp;
#pragma unroll
        for (int q = 0; q < NS; ++q) { if (kl < 4 && stp >= 0) O[(size_t)pos * 256 + row[q]] = oval[q]; }
    };
    float* buf0 = wl; float* buf1 = wl + 1536;
    gl(rA, 0); gl(rB, 1);
    st(rA, buf0); gl(rA, 2);
    __builtin_amdgcn_wave_barrier();
    Ops ops = ldsread(buf0, 0);
    for (int c = 0; c < nch; c += 2) {
        st(rB, buf1); gl(rB, c + 3);
        __builtin_amdgcn_wave_barrier();
        chunk(buf0, buf1, ops, c);
        st(rA, buf0); gl(rA, c + 4);
        __builtin_amdgcn_wave_barrier();
        chunk(buf1, buf0, ops, c + 1);
    }
#pragma unroll
    for (int q = 0; q < NS; ++q) { const float ol = row16_sum(opart[q]); if (kl == 0) O[(size_t)(dir ? 0 : L - 1) * 256 + row[q]] = ol; }
    if (!sample) {
#pragma unroll
        for (int q = 0; q < NS; ++q) *(f32x4*)(POUT + O_NS + sidx[q]) = S[q];
    }
}

__device__ __forceinline__ void stage_qk(const float* __restrict__ src, int stride, bf16_t* dst, bool rope, int pos0, float scale, const f32x2* __restrict__ rt) {
    const int tid = TID();
#pragma unroll
    for (int i = 0; i < 2; ++i) {
        const int task = tid + i * 512, row = task >> 3, half = (task >> 2) & 1, quad = task & 3;
        const float* s = src + (size_t)row * stride + half * 32 + quad * 4;
        f32x4 x1 = *(const f32x4*)s, x2 = *(const f32x4*)(s + 16);
        if (rope) { const int pos = pos0 + row; const int pi = half ? (pos & 63) : (pos >> 6);
#pragma unroll
            for (int j = 0; j < 4; ++j) { const f32x2 cs = rt[pi * 16 + quad * 4 + j]; const float a = x1[j], b = x2[j]; x1[j] = a * cs[0] - b * cs[1]; x2[j] = b * cs[0] + a * cs[1]; } }
        x1 *= scale; x2 *= scale;
        u32x2 w1, w2; w1[0] = cvt_pk_bf16(x1[0], x1[1]); w1[1] = cvt_pk_bf16(x1[2], x1[3]); w2[0] = cvt_pk_bf16(x2[0], x2[1]); w2[1] = cvt_pk_bf16(x2[2], x2[3]);
        *(u32x2*)(dst + row * 72 + half * 32 + quad * 4) = w1; *(u32x2*)(dst + row * 72 + half * 32 + 16 + quad * 4) = w2;
    }
}
__device__ __forceinline__ void stage_vt(const float* __restrict__ src, int stride, bf16_t* vt, int nkeys = 128, int pitch = 136) {
    const int tid = TID();
    for (int task = tid; task < nkeys * 16; task += 512) { const int key = task >> 4, dq = task & 15;
        const f32x4 v = *(const f32x4*)(src + (size_t)key * stride + dq * 4);
#pragma unroll
        for (int j = 0; j < 4; ++j) vt[(dq * 4 + j) * pitch + key] = f2bf(v[j]); }
}
__device__ void attn_item(const Params& p, int l, int ai, unsigned char* lds) {
    const int tid = TID(), lane = tid & 63, wid = tid >> 6, fr = lane & 15, fq = lane >> 4;
    bf16_t* Qs = (bf16_t*)lds; bf16_t* Ks = Qs + 128 * 72; bf16_t* Vt = Ks + 128 * 72;
    const float* P = (const float*)(PWS + WS_P);
    const bf16_t* Z = (const bf16_t*)(PWS + WS_Z);
    bf16_t* YS = (bf16_t*)(PWS + WS_YS);
    const f32x2* rt = (const f32x2*)(PWS + WS_ROPE);
    bool sample; int b, head, qt, seqbase;
    if (ai < 128) { sample = true; b = ai >> 5; head = (ai >> 3) & 3; qt = ai & 7; seqbase = NTP + b * 1024; }
    else { const int j = ai - 128; sample = false; b = j >> 3; head = (j >> 1) & 3; qt = j & 1; seqbase = b * 256; }
    const int kh = head >> 1, qbase = seqbase + qt * 128;
    __syncthreads();
    stage_qk(P + (size_t)qbase * PW + C_CQ + head * 64, PW, Qs, sample, qt * 128, 0.125f, rt);
    __syncthreads();
    bf16x8 qf[2];
    qf[0] = *(const bf16x8*)(Qs + (wid * 16 + fr) * 72 + fq * 8); qf[1] = *(const bf16x8*)(Qs + (wid * 16 + fr) * 72 + 32 + fq * 8);
    float m = PIN(22)[l * 4 + head], lsum = 1.0f, lpart = 0.f;
    f32x4 oacc[4];
#pragma unroll
    for (int i = 0; i < 4; ++i) oacc[i] = (f32x4){0.f, 0.f, 0.f, 0.f};
    const int nkb = sample ? 7 : 2;
    const int qpos = qt * 128 + wid * 16 + fr;
    const float* ck = PIN(2); const float* cv = PIN(3);
    auto kinfo = [&](int kb, const float*& ks, const float*& vs, int& stride, bool& rope, bool& mask, int& kpos0) -> bool {
        if (!sample) { ks = P + (size_t)(seqbase + kb * 128) * PW + C_CK + kh * 64; vs = ks + (C_CV - C_CK); stride = PW; rope = false; mask = false; kpos0 = 0; return true; }
        if (kb < 3) { const int nbk = qt - 1 + kb; if (nbk < 0 || nbk >= 8) return false; kpos0 = nbk * 128;
            ks = P + (size_t)(seqbase + kpos0) * PW + C_CK + kh * 64; vs = ks + (C_CV - C_CK); stride = PW; rope = true; mask = (kb != 1); return true; }
        const size_t o = ((size_t)((b * 2 + l) * 512 + (kb - 3) * 128) * 2 + kh) * 64; ks = ck + o; vs = cv + o; stride = 128; rope = false; mask = false; kpos0 = 0; return true;
    };
    f32x4 kx1[2], kx2[2], vx[2][2];
    auto kload = [&](const float* ks, const float* vs, int stride) {
#pragma unroll
        for (int i = 0; i < 2; ++i) { const int task = tid + i * 512, row = task >> 3, half = (task >> 2) & 1, quad = task & 3;
            const float* s_ = ks + (size_t)row * stride + half * 32 + quad * 4; kx1[i] = *(const f32x4*)s_; kx2[i] = *(const f32x4*)(s_ + 16); }
#pragma unroll
        for (int i = 0; i < 2; ++i) { const int task = tid + i * 512, kp = task >> 4, dq = task & 15;
            vx[i][0] = *(const f32x4*)(vs + (size_t)(2 * kp) * stride + dq * 4); vx[i][1] = *(const f32x4*)(vs + (size_t)(2 * kp + 1) * stride + dq * 4); }
    };
    auto kstore = [&](bool rope, int kpos0) {
#pragma unroll
        for (int i = 0; i < 2; ++i) { const int task = tid + i * 512, row = task >> 3, half = (task >> 2) & 1, quad = task & 3;
            f32x4 x1 = kx1[i], x2 = kx2[i];
            if (rope) { const int pos = kpos0 + row; const int pi = half ? (pos & 63) : (pos >> 6);
#pragma unroll
                for (int j = 0; j < 4; ++j) { const f32x2 cs = rt[pi * 16 + quad * 4 + j]; const float a_ = x1[j], b_ = x2[j]; x1[j] = a_ * cs[0] - b_ * cs[1]; x2[j] = b_ * cs[0] + a_ * cs[1]; } }
            u32x2 w1, w2; w1[0] = cvt_pk_bf16(x1[0], x1[1]); w1[1] = cvt_pk_bf16(x1[2], x1[3]); w2[0] = cvt_pk_bf16(x2[0], x2[1]); w2[1] = cvt_pk_bf16(x2[2], x2[3]);
            *(u32x2*)(Ks + row * 72 + half * 32 + quad * 4) = w1; *(u32x2*)(Ks + row * 72 + half * 32 + 16 + quad * 4) = w2; }
#pragma unroll
        for (int i = 0; i < 2; ++i) { const int task = tid + i * 512, kp = task >> 4, dq = task & 15;
#pragma unroll
            for (int j = 0; j < 4; ++j) *(unsigned*)(Vt + (dq * 4 + j) * 136 + 2 * kp) = cvt_pk_bf16(vx[i][0][j], vx[i][1][j]); }
    };
    const float* ksrc = nullptr; const float* vsrc = nullptr; int stride = 0, kpos0n = 0; bool ropen = false, maskn = false;
    int kb = 0;
    while (kb < nkb && !kinfo(kb, ksrc, vsrc, stride, ropen, maskn, kpos0n)) ++kb;
    if (kb < nkb) kload(ksrc, vsrc, stride);
    while (kb < nkb) {
        const bool mask = maskn; const int kpos0 = kpos0n; const bool rope = ropen;
        __syncthreads();
        kstore(rope, kpos0);
        __syncthreads();
        int nk = kb + 1;
        while (nk < nkb && !kinfo(nk, ksrc, vsrc, stride, ropen, maskn, kpos0n)) ++nk;
        if (nk < nkb) kload(ksrc, vsrc, stride);
        kb = nk;
        f32x4 sc[4][2];
#pragma unroll
        for (int sb = 0; sb < 4; ++sb) {
            f32x4 s0 = (f32x4){0.f, 0.f, 0.f, 0.f}, s1 = s0;
#pragma unroll
            for (int dh = 0; dh < 2; ++dh) {
                const bf16x8 k0 = *(const bf16x8*)(Ks + (sb * 32 + fr) * 72 + dh * 32 + fq * 8), k1 = *(const bf16x8*)(Ks + (sb * 32 + 16 + fr) * 72 + dh * 32 + fq * 8);
                s0 = __builtin_amdgcn_mfma_f32_16x16x32_bf16(k0, qf[dh], s0, 0, 0, 0);
                s1 = __builtin_amdgcn_mfma_f32_16x16x32_bf16(k1, qf[dh], s1, 0, 0, 0);
            }
            if (mask) {
#pragma unroll
                for (int j = 0; j < 4; ++j) { const int k0p = kpos0 + sb * 32 + fq * 4 + j, k1p = k0p + 16; int d0 = qpos - k0p, d1 = qpos - k1p; d0 = d0 < 0 ? -d0 : d0; d1 = d1 < 0 ? -d1 : d1;
                    if (d0 > 128) s0[j] = -1e30f; if (d1 > 128) s1[j] = -1e30f; }
            }
            sc[sb][0] = s0; sc[sb][1] = s1;
        }
        float mx = -1e30f;
#pragma unroll
        for (int sb = 0; sb < 4; ++sb)
#pragma unroll
            for (int j = 0; j < 4; ++j) mx = fmaxf(mx, fmaxf(sc[sb][0][j], sc[sb][1][j]));
        mx = fmaxf(mx, __shfl_xor(mx, 16)); mx = fmaxf(mx, __shfl_xor(mx, 32));
        const float mn = fmaxf(m, mx), alpha = __expf(m - mn);
        m = mn; lsum *= alpha; lpart *= alpha;
#pragma unroll
        for (int dt = 0; dt < 4; ++dt) oacc[dt] = oacc[dt] * alpha;
#pragma unroll
        for (int sb = 0; sb < 4; ++sb) {
            f32x4 s0 = sc[sb][0], s1 = sc[sb][1];
#pragma unroll
            for (int j = 0; j < 4; ++j) { s0[j] = __expf(s0[j] - mn); s1[j] = __expf(s1[j] - mn); lpart += s0[j] + s1[j]; }
            u32x4 pw; pw[0] = cvt_pk_bf16(s0[0], s0[1]); pw[1] = cvt_pk_bf16(s0[2], s0[3]); pw[2] = cvt_pk_bf16(s1[0], s1[1]); pw[3] = cvt_pk_bf16(s1[2], s1[3]);
            bf16x8 pf; __builtin_memcpy(&pf, &pw, 16);
#pragma unroll
            for (int dt = 0; dt < 4; ++dt) {
                const bf16_t* vp = Vt + (dt * 16 + fr) * 136 + sb * 32 + fq * 4;
                u32x4 vw; const u32x2 va = *(const u32x2*)vp, vb = *(const u32x2*)(vp + 16); vw[0] = va[0]; vw[1] = va[1]; vw[2] = vb[0]; vw[3] = vb[1];
                bf16x8 vf; __builtin_memcpy(&vf, &vw, 16);
                oacc[dt] = __builtin_amdgcn_mfma_f32_16x16x32_bf16(vf, pf, oacc[dt], 0, 0, 0);
            }
        }
    }
    lpart += __shfl_xor(lpart, 16); lpart += __shfl_xor(lpart, 32);
    lsum += lpart;
    const float inv = 1.0f / lsum;
    const size_t t = (size_t)(qbase + wid * 16 + fr);
#pragma unroll
    for (int dt = 0; dt < 4; ++dt) {
        const int col = 512 + head * 64 + dt * 16 + fq * 4;
        const bf16x4 z = *(const bf16x4*)(Z + t * DM + col);
        u32x2 w; w[0] = cvt_pk_bf16(oacc[dt][0] * inv * bf2f((bf16_t)z[0]), oacc[dt][1] * inv * bf2f((bf16_t)z[1]));
        w[1] = cvt_pk_bf16(oacc[dt][2] * inv * bf2f((bf16_t)z[2]), oacc[dt][3] * inv * bf2f((bf16_t)z[3]));
        *(u32x2*)(YS + t * DM + col) = w;
    }
}

__device__ void chunk_item(const Params& p, int l, int ci, unsigned char* ldsb) {
    const int tid = TID(), lane = tid & 63, wid = tid >> 6, fr = lane & 15, fq = lane >> 4;
    const int chunk = ci >> 2, g = ci & 3, base = chunk * 128;
    bf16_t* wsb = (bf16_t*)ldsb;
    bf16_t* vt = wsb + 128 * 136;
    const float* P = (const float*)(PWS + WS_P);
    const bf16_t* Z = (const bf16_t*)(PWS + WS_Z);
    bf16_t* YS = (bf16_t*)(PWS + WS_YS);
    const float* wsrc = PIN(11) + (size_t)(l * 4 + g) * 128 * 128;
    __syncthreads();
#pragma unroll
    for (int i = 0; i < 8; ++i) { const int idx = tid + i * 512, r = idx >> 5, c4 = (idx & 31) * 4; const f32x4 v = *(const f32x4*)(wsrc + r * 128 + c4);
        u32x2 w; w[0] = cvt_pk_bf16(v[0], v[1]); w[1] = cvt_pk_bf16(v[2], v[3]); *(u32x2*)(wsb + r * 136 + c4) = w; }
    stage_vt(P + (size_t)base * PW + C_AV + g * 64, PW, vt, 128);
    __syncthreads();
    f32x4 acc[4];
#pragma unroll
    for (int n = 0; n < 4; ++n) acc[n] = (f32x4){0.f, 0.f, 0.f, 0.f};
#pragma unroll
    for (int k = 0; k < 4; ++k) {
        const bf16x8 af = *(const bf16x8*)(wsb + (wid * 16 + fr) * 136 + k * 32 + fq * 8);
#pragma unroll
        for (int n = 0; n < 4; ++n) { const bf16x8 bfv = *(const bf16x8*)(vt + (n * 16 + fr) * 136 + k * 32 + fq * 8);
            acc[n] = __builtin_amdgcn_mfma_f32_16x16x32_bf16(bfv, af, acc[n], 0, 0, 0); }
    }
    const int i = wid * 16 + fr; const size_t t = base + i;
    const float bsi = PIN(12)[(l * 4 + g) * 128 + i];
#pragma unroll
    for (int n = 0; n < 4; ++n) { const int col = g * 64 + n * 16 + fq * 4;
        const f32x4 u = *(const f32x4*)(P + t * PW + C_AU + col);
        const bf16x4 z = *(const bf16x4*)(Z + t * DM + col);
        u32x2 w; w[0] = cvt_pk_bf16(u[0] * (acc[n][0] + bsi) * bf2f((bf16_t)z[0]), u[1] * (acc[n][1] + bsi) * bf2f((bf16_t)z[1]));
        w[1] = cvt_pk_bf16(u[2] * (acc[n][2] + bsi) * bf2f((bf16_t)z[2]), u[3] * (acc[n][3] + bsi) * bf2f((bf16_t)z[3]));
        *(u32x2*)(YS + t * DM + col) = w; }
}

__device__ void pool_item(const Params& p, int l, int pi, unsigned char* ldsb) {
    const int tid = TID(), lane = tid & 63, wid = tid >> 6, fr = lane & 15, fq = lane >> 4, half = tid >> 8, ch = tid & 255, g = ch >> 6;
    const int tb = pi * 32; int seqbase, L, pos0; seq_of(tb, seqbase, L, pos0);
    float* pt = (float*)ldsb;
    bf16_t* dl = (bf16_t*)(pt + 48 * 256);
    bf16_t* wt = dl + 32 * 264;
    const float* P = (const float*)(PWS + WS_P);
    const bf16_t* Z = (const bf16_t*)(PWS + WS_Z);
    bf16_t* YS = (bf16_t*)(PWS + WS_YS);
    __syncthreads();
#pragma unroll
    for (int i = 0; i < 6; ++i) { const int idx = tid + i * 512, rr = idx >> 6, c4 = (idx & 63) * 4; const int pos = pos0 - 8 + rr;
        f32x4 v = (f32x4){0.f, 0.f, 0.f, 0.f};
        if (pos >= 0 && pos < L) v = *(const f32x4*)(P + (size_t)(seqbase + pos) * PW + C_DP + c4);
        *(f32x4*)(pt + rr * 256 + c4) = v; }
    { const float* pwsrc = PIN(23) + (size_t)l * 4 * 64 * 64;
#pragma unroll
      for (int gg = 0; gg < 4; ++gg) stage_vt(pwsrc + gg * 4096, 64, wt + gg * 64 * 72, 64, 72); }
    __syncthreads();
    const int w = 2 << g;
    for (int i = 0; i < 16; ++i) { const int tk = half * 16 + i, pos = pos0 + tk;
        int lo = pos - (w >> 1), hi = lo + w; lo = lo < 0 ? 0 : lo; hi = hi > L ? L : hi;
        float sm = 0.f;
        for (int q = lo; q < hi; ++q) sm += pt[(q - pos0 + 8) * 256 + ch];
        dl[tk * 264 + ch] = f2bf(sm / (float)(hi - lo) - pt[(tk + 8) * 256 + ch]); }
    __syncthreads();
    const int gw = wid >> 1, th = wid & 1;
    f32x4 acc[4];
#pragma unroll
    for (int n = 0; n < 4; ++n) acc[n] = (f32x4){0.f, 0.f, 0.f, 0.f};
#pragma unroll
    for (int k = 0; k < 2; ++k) {
        const bf16x8 af = *(const bf16x8*)(dl + (th * 16 + fr) * 264 + gw * 64 + k * 32 + fq * 8);
#pragma unroll
        for (int n = 0; n < 4; ++n) { const bf16x8 bfv = *(const bf16x8*)(wt + (gw * 64 + n * 16 + fr) * 72 + k * 32 + fq * 8);
            acc[n] = __builtin_amdgcn_mfma_f32_16x16x32_bf16(bfv, af, acc[n], 0, 0, 0); }
    }
    const size_t t = tb + th * 16 + fr;
#pragma unroll
    for (int n = 0; n < 4; ++n) { const int oc = gw * 64 + n * 16 + fq * 4;
        const f32x4 sc = *(const f32x4*)(PIN(24) + l * 256 + oc);
        const bf16x4 z = *(const bf16x4*)(Z + t * DM + 768 + oc);
        u32x2 wv; wv[0] = cvt_pk_bf16(acc[n][0] * sc[0] * bf2f((bf16_t)z[0]), acc[n][1] * sc[1] * bf2f((bf16_t)z[1]));
        wv[1] = cvt_pk_bf16(acc[n][2] * sc[2] * bf2f((bf16_t)z[2]), acc[n][3] * sc[3] * bf2f((bf16_t)z[3]));
        *(u32x2*)(YS + t * DM + 768 + oc) = wv; }
}

__device__ void phaseB1(const Params& p, int l, unsigned char* lds, int slot = 0, int part = 127) {
    const int tid = TID(), wid = tid >> 6;
    float* wl = (float*)lds + wid * 3072;
    if (!(part & 1)) {} else
    { const int nbh = (int)gridDim.x >> 1;
      if ((int)blockIdx.x < nbh) { if (wid < 4 && (part & 4)) for (int it = blockIdx.x * 4 + wid; it < 512; it += nbh * 4) { const int q = it >> 4, b = q >> 3;
            scan_run<1>(p, l, true, b, (q >> 1) & 3, q & 1, it & 15, 1024, NTP + b * 1024, wl); } }
      else { const int nb2 = (int)gridDim.x - nbh; if (part & 8) for (int it = ((int)blockIdx.x - nbh) * 8 + wid; it < 1024; it += nb2 * 8) { const int q = it >> 3, b = q >> 3;
            scan_run<2>(p, l, false, b, (q >> 1) & 3, q & 1, it & 7, 256, b * 256, wl); } } }
    __syncthreads();
    __shared__ int s_item;
    unsigned* ctr = (unsigned*)(PWS + WS_CTR) + l + 2 * slot;
    if (part & 2)
    for (;;) {
        if (tid == 0) s_item = (int)atomicAdd(ctr, 1u);
        __syncthreads();
        const int item = s_item;
        __syncthreads();
        if (item >= 768) break;
        if (item < 256) { if (part & 16) attn_item(p, l, item, lds); }
        else if (item < 512) { if (part & 32) chunk_item(p, l, item - 256, lds); }
        else { if (part & 64) pool_item(p, l, item - 512, lds); }
    }
}

__device__ void phaseB2(const Params& p, int l) {
    const int lane = TID() & 63, gw = blockIdx.x * 8 + (TID() >> 6), W = gridDim.x * 8;
    const float* O = (const float*)(PWS + WS_O);
    const float* recS = (const float*)(PWS + WS_RECS);
    const float* BC = (const float*)(PWS + WS_BC);
    const bf16_t* Z = (const bf16_t*)(PWS + WS_Z);
    bf16_t* YS = (bf16_t*)(PWS + WS_YS);
    const float* lng = PIN(20) + l * 256; const float* lnb = PIN(21) + l * 256;
    float g4[4], b4[4];
#pragma unroll
    for (int h = 0; h < 4; ++h) { g4[h] = lng[h * 64 + lane]; b4[h] = lnb[h * 64 + lane]; }
    for (int tok = gw; tok < NT; tok += W) {
        int seqbase, L, pos; seq_of(tok, seqbase, L, pos);
        float o[4], vv[4], z[4], mu[4], var[4];
        const f32x4 bc = *(const f32x4*)(BC + tok * 4);
#pragma unroll
        for (int h = 0; h < 4; ++h) { const int c = h * 64 + lane;
            o[h] = __builtin_nontemporal_load(O + (size_t)tok * 256 + c) + __builtin_nontemporal_load(O + (size_t)NT * 256 + (size_t)tok * 256 + c);
            vv[h] = recS[((size_t)seqbase * 4 + (size_t)h * L + pos) * 192 + 128 + lane];
            z[h] = bf2f(Z[(size_t)tok * DM + 256 + c]); }
#pragma unroll
        for (int h = 0; h < 4; ++h) mu[h] = wave_sum(o[h]) * (1.0f / 64.0f);
#pragma unroll
        for (int h = 0; h < 4; ++h) { o[h] -= mu[h]; var[h] = wave_sum(o[h] * o[h]) * (1.0f / 64.0f); }
#pragma unroll
        for (int h = 0; h < 4; ++h) { const float on = o[h] * rsqrtf(var[h] + 64e-5f);
            const float y = on * g4[h] + b4[h] + bc[h] * vv[h];
            YS[(size_t)tok * DM + 256 + h * 64 + lane] = f2bf(y * z[h]); }
    }
}

__device__ void phaseC1(const Params& p, int l, unsigned char* lds) {
    pg8::Gemm g; g.A = (const bf16_t*)(PWS + WS_H); g.Bt = (const bf16_t*)(PWS + WS_WTIN) + (size_t)l * INW * 1024 + (size_t)NA_COLS * 1024; g.M = NT; g.N = 4096; g.K = 1024;
    pg8::StaticOrder S; S.init(g.M, g.N, (int)gridDim.x, (int)blockIdx.x);
    EpiG E; E.G = (bf16_t*)(PWS + WS_G);
    pg8::gemm_phase<EpiG, pg8::StaticOrder, false>((PG8_LAS unsigned char*)lds, g, S, E, nullptr);
    __syncthreads();
}
__device__ void phaseC2(const Params& p, int l, unsigned char* lds) {
    constexpr int MT = 4, LDT = 72, A_BYTES = 256 * LDT * 2, B_BYTES = 128 * LDT * 2, BUF = A_BYTES + B_BYTES;
    const int tid = TID(), lane = tid & 63, wid = tid >> 6, wr = wid >> 1, wc = wid & 1, fr = lane & 15, fq = lane >> 4;
    const bf16_t* YS = (const bf16_t*)(PWS + WS_YS);
    const bf16_t* G = (const bf16_t*)(PWS + WS_G);
    const bf16_t* Wu = (const bf16_t*)(PWS + WS_WTUP) + (size_t)l * 4 * 1024 * 256;
    bf16_t* MG = (bf16_t*)(PWS + WS_MERGED);
    const int srow = tid >> 3, skc = tid & 7, soff = (srow * LDT + skc * 8) * 2;
    const int aoff = ((wr * MT * 16 + fr) * LDT + fq * 8) * 2, boff = A_BYTES + ((wc * 64 + fr) * LDT + fq * 8) * 2;
    const int NU = 32 * 8;
    for (int u = blockIdx.x; u < NU; u += gridDim.x) {
        const int pn = u / 32, pm = u % 32;
        const bf16_t* Ag = YS + ((size_t)pm * 256 + srow) * 1024 + skc * 8;
        const bf16_t* Bg = Wu + ((size_t)pn * 128 + srow) * 256 + skc * 8;
        f32x4 mg[4][4], acc[4][4]; zero_acc<4>(mg); zero_acc<4>(acc);
        u32x4 ra[MT], rb[2];
        auto gload = [&](int kt) {
#pragma unroll
            for (int i = 0; i < MT; ++i) ra[i] = *(const u32x4*)(Ag + (size_t)i * 64 * 1024 + kt * 64);
            const bf16_t* bb = Bg + (size_t)(kt >> 2) * 1024 * 256 + (kt & 3) * 64;
#pragma unroll
            for (int i = 0; i < 2; ++i) rb[i] = *(const u32x4*)(bb + (size_t)i * 64 * 256);
        };
        auto sstore = [&](int buf) { unsigned char* nb = lds + buf * BUF;
#pragma unroll
            for (int i = 0; i < MT; ++i) *(u32x4*)(nb + soff + i * 64 * LDT * 2) = ra[i];
#pragma unroll
            for (int i = 0; i < 2; ++i) *(u32x4*)(nb + A_BYTES + soff + i * 64 * LDT * 2) = rb[i];
        };
        __syncthreads();
        gload(0); sstore(0);
        __syncthreads();
        for (int t = 0; t < 16; ++t) {
            if (t + 1 < 16) gload(t + 1);
            const unsigned char* base = lds + (t & 1) * BUF;
#pragma unroll
            for (int kk = 0; kk < 2; ++kk) {
                bf16x8 af[MT], bfr[4];
#pragma unroll
                for (int m = 0; m < MT; ++m) af[m] = *(const bf16x8*)(base + aoff + m * 16 * LDT * 2 + kk * 64);
#pragma unroll
                for (int n = 0; n < 4; ++n) bfr[n] = *(const bf16x8*)(base + boff + n * 16 * LDT * 2 + kk * 64);
#pragma unroll
                for (int m = 0; m < MT; ++m)
#pragma unroll
                    for (int n = 0; n < 4; ++n) acc[m][n] = __builtin_amdgcn_mfma_f32_16x16x32_bf16(bfr[n], af[m], acc[m][n], 0, 0, 0);
            }
            if (t + 1 < 16) sstore((t + 1) & 1);
            if ((t & 3) == 3) {
                const int n = t >> 2;
#pragma unroll
                for (int m = 0; m < 4; ++m) { const int row = pm * 256 + wr * 64 + m * 16 + fr;
                    const bf16_t* gp = G + g_off(row, n * 1024 + pn * 128 + wc * 64 + fq * 4);
                    const bf16x8 ga = __builtin_nontemporal_load((const bf16x8*)gp), gb = __builtin_nontemporal_load((const bf16x8*)(gp + 8));
#pragma unroll
                    for (int q = 0; q < 4; ++q) {
#pragma unroll
                        for (int j = 0; j < 4; ++j) { const bf16_t gv = (bf16_t)(q < 2 ? ga[q * 4 + j] : gb[(q - 2) * 4 + j]); mg[m][q][j] += bf2f(gv) * acc[m][q][j]; }
                        acc[m][q] = (f32x4){0.f, 0.f, 0.f, 0.f}; } }
            }
            __syncthreads();
        }
#pragma unroll
        for (int m = 0; m < 4; ++m) { const size_t row = (size_t)pm * 256 + wr * 64 + m * 16 + fr;
#pragma unroll
            for (int q = 0; q < 4; ++q) { const int col = pn * 128 + wc * 64 + q * 16 + fq * 4;
                u32x2 w; w[0] = cvt_pk_bf16(mg[m][q][0], mg[m][q][1]); w[1] = cvt_pk_bf16(mg[m][q][2], mg[m][q][3]);
                __hip_atomic_store((unsigned long long*)(MG + row * DM + col), ((unsigned long long)w[1] << 32) | w[0], __ATOMIC_RELAXED, __HIP_MEMORY_SCOPE_AGENT); } }
        asm volatile("s_waitcnt vmcnt(0)" ::: "memory");
        __syncthreads();
        if (tid == 0) __hip_atomic_fetch_add((unsigned*)(PWS + WS_XCNT) + (size_t)((2 + l) * 32 + pm) * 64, 1u, __ATOMIC_RELAXED, __HIP_MEMORY_SCOPE_AGENT);
    }
}

__device__ void phaseD(const Params& p, int l, unsigned char* lds) {
    const int tid = TID(), lane = tid & 63, wid = tid >> 6, wr = wid >> 1, wc = wid & 1, fr = lane & 15, fq = lane >> 4;
    const bf16_t* MG = (const bf16_t*)(PWS + WS_MERGED);
    const bf16_t* Wo = (const bf16_t*)(PWS + WS_WTO) + (size_t)l * 1024 * 1024;
    const int NU = 32 * 8;
    for (int u = blockIdx.x; u < NU; u += gridDim.x) {
        const int pn = u / 32, pm = u % 32;
        if (tid == 0) { unsigned* c2 = (unsigned*)(PWS + WS_XCNT) + (size_t)((2 + l) * 32 + pm) * 64; unsigned spins = 0;
            while (__hip_atomic_load(c2, __ATOMIC_RELAXED, __HIP_MEMORY_SCOPE_AGENT) < 8u) { __builtin_amdgcn_s_sleep(2); if (++spins > (1u << 22)) break; }
            __builtin_amdgcn_fence(__ATOMIC_ACQUIRE, "agent");
            asm volatile("s_waitcnt vmcnt(0)" ::: "memory"); }
        __syncthreads();
        f32x4 acc[4][4]; zero_acc<4>(acc);
        gemm_acc<4>(MG + (size_t)pm * 256 * 1024, 1024, Wo + (size_t)pn * 128 * 1024, 1024, 1024, acc, lds);
        float ssq[4];
#pragma unroll
        for (int m = 0; m < 4; ++m) { const int row = pm * 256 + wr * 64 + m * 16 + fr;
            const float* xr = xrow_ptr(p, l, row);
            const float* gate = (const float*)(PWS + WS_MOD) + (size_t)(l * 5 + modrow_of(row)) * 3072 + 2048;
            float sm = 0.f;
#pragma unroll
            for (int q = 0; q < 4; ++q) { const int col = pn * 128 + wc * 64 + q * 16 + fq * 4;
                const f32x4 xo = __builtin_nontemporal_load((const f32x4*)(xr + col)), gt = *(const f32x4*)(gate + col);
                acc[m][q] = xo + gt * acc[m][q];
                sm += (acc[m][q][0] * acc[m][q][0] + acc[m][q][1] * acc[m][q][1]) + (acc[m][q][2] * acc[m][q][2] + acc[m][q][3] * acc[m][q][3]); }
            sm += __shfl_xor(sm, 16); sm += __shfl_xor(sm, 32);
            ssq[m] = sm; }
        float* Pt = (float*)lds;
        float* St = Pt + 512;
        if (fq == 0) {
#pragma unroll
            for (int m = 0; m < 4; ++m) Pt[(wr * 64 + m * 16 + fr) * 2 + wc] = ssq[m]; }
        __syncthreads();
        float* XP = (float*)(PWS + WS_XP) + ((size_t)(l * 32 + pm) * 256) * 8;
        unsigned* cnt = (unsigned*)(PWS + WS_XCNT) + (size_t)(l * 32 + pm) * 64;
        if (tid < 256) __hip_atomic_store(XP + tid * 8 + pn, Pt[tid * 2] + Pt[tid * 2 + 1], __ATOMIC_RELAXED, __HIP_MEMORY_SCOPE_AGENT);
        asm volatile("s_waitcnt vmcnt(0)" ::: "memory");
        __syncthreads();
        if (tid == 0) {
            __hip_atomic_fetch_add(cnt, 1u, __ATOMIC_RELAXED, __HIP_MEMORY_SCOPE_AGENT);
            unsigned spins = 0;
            while (__hip_atomic_load(cnt, __ATOMIC_RELAXED, __HIP_MEMORY_SCOPE_AGENT) < 8u) { __builtin_amdgcn_s_sleep(2); if (++spins > (1u << 22)) break; }
            __builtin_amdgcn_fence(__ATOMIC_ACQUIRE, "agent");
            asm volatile("s_waitcnt vmcnt(0)" ::: "memory");
        }
        __syncthreads();
        if (tid < 256) { float t = 0.f;
#pragma unroll
            for (int k = 0; k < 8; ++k) t += __hip_atomic_load(XP + tid * 8 + k, __ATOMIC_RELAXED, __HIP_MEMORY_SCOPE_AGENT);
            St[tid] = rsqrtf(t * (1.0f / 1024.0f) + 1e-6f); }
        __syncthreads();
        const float* gn = (l == 0) ? PIN(9) + DM : PIN(27);
        bf16_t* H = (bf16_t*)(PWS + WS_H);
#pragma unroll
        for (int m = 0; m < 4; ++m) { const int rl_ = wr * 64 + m * 16 + fr, row = pm * 256 + rl_;
            const float rs = St[rl_];
            const float* md = (const float*)(PWS + WS_MOD) + (size_t)(5 + modrow_of(row)) * 3072;
#pragma unroll
            for (int q = 0; q < 4; ++q) { const int col = pn * 128 + wc * 64 + q * 16 + fq * 4;
                const f32x4 gg = *(const f32x4*)(gn + col);
                if (l == 0) { *(f32x4*)(POUT + (size_t)row * DM + col) = acc[m][q];
                    const f32x4 sh = *(const f32x4*)(md + col), scl = *(const f32x4*)(md + 1024 + col);
                    const f32x4 h = acc[m][q] * rs * gg * (1.0f + scl) + sh;
                    u32x2 w; w[0] = cvt_pk_bf16(h[0], h[1]); w[1] = cvt_pk_bf16(h[2], h[3]); *(u32x2*)(H + (size_t)row * DM + col) = w; }
                else *(f32x4*)(POUT + (size_t)row * DM + col) = acc[m][q] * rs * gg; } }
    }
}

__device__ void phaseF(const Params& p) {
    const int lane = TID() & 63, gw = blockIdx.x * 8 + (TID() >> 6), W = gridDim.x * 8;
    const float* g = PIN(27);
    for (int row = gw; row < NT; row += W) {
        float* x = POUT + (size_t)row * DM;
        f32x4 v[4]; float ss = 0.f;
#pragma unroll
        for (int i = 0; i < 4; ++i) { v[i] = *(const f32x4*)(x + i * 256 + lane * 4); ss += v[i][0] * v[i][0] + v[i][1] * v[i][1] + v[i][2] * v[i][2] + v[i][3] * v[i][3]; }
        ss = wave_sum(ss);
        const float rs = rsqrtf(ss * (1.0f / 1024.0f) + 1e-6f);
#pragma unroll
        for (int i = 0; i < 4; ++i) { const int c = i * 256 + lane * 4; *(f32x4*)(x + c) = v[i] * rs * *(const f32x4*)(g + c); }
    }
}

__global__ void __launch_bounds__(NTHREADS) fwd_megakernel(Params p) {
    extern __shared__ __attribute__((aligned(16))) unsigned char lds[];
    volatile LAS unsigned* st = (volatile LAS unsigned*)(lds + LDS_MAIN);
    if (threadIdx.x < 2) st[threadIdx.x] = 0u;
    if (threadIdx.x == 0) {
#pragma unroll
        for (int i = 0; i < 28; ++i) s_ptab[i] = (unsigned long long)p.in[i];
    }
    __syncthreads();
    const XcdBarrier xb = xcd_barrier_post((unsigned*)(PWS + WS_BAR), st);
#define GSYNC() xcd_barrier(xb)
    phase0(p, lds);
    GSYNC();
#pragma unroll 1
    for (int l = 0; l < 2; ++l) {
#pragma unroll 1
        for (int ap = 0; ap < 2; ++ap) { phaseA(p, l, lds, ap); if (ap == 0) GSYNC(); }
        phaseB0(p, l, lds);
        GSYNC();
        phaseB1(p, l, lds);
        GSYNC();
        phaseB2(p, l);
        phaseC1(p, l, lds);
        GSYNC();
        phaseC2(p, l, lds);
        phaseD(p, l, lds);
        if (l == 0) GSYNC();
    }
}

extern "C" void kernel_launch(void* const* d_in, const int* in_sizes, int n_in, void* d_out, int out_size, void* d_ws, size_t ws_size, hipStream_t stream) {
    static int grid_blocks = 0;
    if (!grid_blocks) {
        int dev = 0, cus = 0, per_cu = 0;
        hipGetDevice(&dev);
        hipDeviceGetAttribute(&cus, hipDeviceAttributeMultiprocessorCount, dev);
        hipFuncSetAttribute((const void*)fwd_megakernel, hipFuncAttributeMaxDynamicSharedMemorySize, LDS_BYTES);
        hipOccupancyMaxActiveBlocksPerMultiprocessor(&per_cu, (const void*)fwd_megakernel, NTHREADS, LDS_BYTES);
        if (per_cu < 1) { fprintf(stderr, "occupancy query returned %d\n", per_cu); per_cu = 1; }
        if (per_cu > 1) per_cu = 1;
        grid_blocks = cus * per_cu;
        if (ws_size < WS_END) fprintf(stderr, "workspace too small: %zu < %zu\n", ws_size, (size_t)WS_END);
    }
    Params p{};
    for (int i = 0; i < 28; ++i) p.in[i] = (const float*)d_in[i];
    p.out = (float*)d_out; p.ws = (unsigned char*)d_ws;
    hipMemsetAsync((char*)d_ws + WS_CTR, 0, 256 + 3456 * 4, stream);
    void* args[] = {&p};
    hipError_t e = hipLaunchCooperativeKernel((const void*)fwd_megakernel, dim3(grid_blocks), dim3(NTHREADS), args, LDS_BYTES, stream);
    if (e != hipSuccess) fprintf(stderr, "cooperative launch failed: %s (grid %d)\n", hipGetErrorString(e), grid_blocks);
}
```

```cpp
#include <hip/hip_runtime.h>
#include <hip/hip_cooperative_groups.h>
#include <cstdio>
namespace cg = cooperative_groups;

typedef unsigned short bf16_t;
typedef short bf16x8 __attribute__((ext_vector_type(8)));
typedef short bf16x4 __attribute__((ext_vector_type(4)));
typedef float f32x4 __attribute__((ext_vector_type(4)));
typedef float f32x2 __attribute__((ext_vector_type(2)));
typedef unsigned u32x4 __attribute__((ext_vector_type(4)));
typedef unsigned u32x2 __attribute__((ext_vector_type(2)));

constexpr int NT = 8192, NTP = 4096, DM = 1024, INW = 7296, NA_COLS = 3200, PW = 2176;
constexpr int NTHREADS = 512;
constexpr int C_AU = 0, C_AV = 256, C_BR = 512, C_BK = 768, C_BV = 1024, C_WD = 1280, C_AD = 1344, C_CQ = 1408, C_CK = 1664, C_CV = 1792, C_DP = 1920;
constexpr size_t O_YP = 0, O_YS = 4194304, O_NK = 8388608, O_NV = 9437184, O_NS = 10485760;
constexpr size_t WS_WTIN = 0;
constexpr size_t WS_WTUP = WS_WTIN + (size_t)2 * INW * DM * 2;
constexpr size_t WS_WTO  = WS_WTUP + (size_t)2 * 4 * 1024 * 256 * 2;
constexpr size_t WS_MOD  = WS_WTO + (size_t)2 * 1024 * 1024 * 2;
constexpr size_t WS_ROPE = WS_MOD + (size_t)2 * 5 * 3072 * 4;
constexpr size_t WS_CTR  = WS_ROPE + 64 * 16 * 8;
constexpr size_t WS_BAR  = WS_CTR + 256;
constexpr size_t WS_H    = WS_BAR + 3456 * 4;
constexpr size_t WS_P    = WS_H + (size_t)NT * DM * 2;
constexpr size_t WS_Z    = WS_P + (size_t)NT * PW * 4;
constexpr size_t WS_RECS = WS_Z + (size_t)NT * DM * 2;
constexpr size_t WS_RECD = WS_RECS + (size_t)NT * 4 * 192 * 4;
constexpr size_t WS_O    = WS_RECD + (size_t)2 * NT * 4 * 192 * 4;
constexpr size_t WS_BC   = WS_O + (size_t)2 * NT * 256 * 4;
constexpr size_t WS_YS   = WS_BC + (size_t)NT * 4 * 4;
constexpr size_t WS_LORAT = WS_YS + (size_t)NT * DM * 2;
constexpr size_t WS_XP   = WS_LORAT + (size_t)2 * 4 * 256 * 64 * 2;
constexpr size_t WS_XCNT = WS_XP + (size_t)2 * 32 * 256 * 8 * 4;
constexpr size_t WS_END  = WS_XCNT + (size_t)4 * 32 * 256;
constexpr size_t WS_G = WS_P;
constexpr size_t WS_MERGED = WS_RECS;
constexpr size_t RECD_STRIDE = (size_t)NT * 4 * 192;

constexpr int LDS_MAIN = 131072;
constexpr int LDS_BYTES = LDS_MAIN + 16;

struct Params {
    const float* in[28];
    float* out;
    unsigned char* ws;
};
__shared__ unsigned long long s_ptab[28];
__device__ __forceinline__ const float* ld_inptr(int k) {
    const unsigned long long v = s_ptab[k];
    const unsigned lo = __builtin_amdgcn_readfirstlane((unsigned)v), hi = __builtin_amdgcn_readfirstlane((unsigned)(v >> 32));
    return (const float*)(((unsigned long long)hi << 32) | lo);
}
#define PIN(k) (ld_inptr(k))
#define POUT (p.out)
#define PWS (p.ws)

__device__ __forceinline__ int TID() { int t = threadIdx.x; asm volatile("" : "+v"(t)); return t; }
__device__ __forceinline__ unsigned cvt_pk_bf16(float lo, float hi) { unsigned r; asm volatile("v_cvt_pk_bf16_f32 %0, %1, %2" : "=v"(r) : "v"(lo), "v"(hi)); return r; }
__device__ __forceinline__ bf16_t f2bf(float f) { return (bf16_t)(cvt_pk_bf16(f, 0.f) & 0xffffu); }
__device__ __forceinline__ float bf2f(bf16_t b) { return __uint_as_float(((unsigned)b) << 16); }
__device__ __forceinline__ float sigmoidf_(float x) { return 1.0f / (1.0f + __expf(-x)); }
__device__ __forceinline__ float siluf_(float x) { return x / (1.0f + __expf(-x)); }
template <int CTRL> __device__ __forceinline__ float dpp_f(float x) { return __int_as_float(__builtin_amdgcn_update_dpp(0, __float_as_int(x), CTRL, 0xF, 0xF, false)); }
__device__ __forceinline__ float row16_sum(float x) {
    x += dpp_f<0x128>(x); x += dpp_f<0x124>(x); x += dpp_f<0x122>(x); x += dpp_f<0x121>(x); return x;
}
__device__ __forceinline__ float wave_sum(float v) { v = row16_sum(v); v += __shfl_xor(v, 16); v += __shfl_xor(v, 32); return v; }
__device__ __forceinline__ void seq_of(int tok, int& seqbase, int& L, int& pos) {
    if (tok < NTP) { seqbase = tok & ~255; L = 256; pos = tok & 255; }
    else { int t2 = tok - NTP; seqbase = NTP + (t2 & ~1023); L = 1024; pos = t2 & 1023; }
}
__device__ __forceinline__ int modrow_of(int tok) { return tok < NTP ? 0 : 1 + ((tok - NTP) >> 10); }


#define XB_TMO      128
#define XB_XCNT(j)  (256  + 64 * (j))
#define XB_XSUB(j)  (1280 + 64 * (j))
#define XB_XGEN(j)  (2304 + 64 * (j))
#define XB_TOP      3328
#define XB_TOPGEN   3392
#define XCD_BAR_WORDS 3456
#define XB_SPIN_CAP (1u << 18)
#define LAS __attribute__((address_space(3)))
__device__ __forceinline__ unsigned xb_ld(unsigned* p)              { return __hip_atomic_load(p, __ATOMIC_RELAXED, __HIP_MEMORY_SCOPE_AGENT); }
__device__ __forceinline__ unsigned xb_add(unsigned* p, unsigned v) { return __hip_atomic_fetch_add(p, v, __ATOMIC_RELAXED, __HIP_MEMORY_SCOPE_AGENT); }
__device__ __forceinline__ unsigned xb_xcc_id() { return (unsigned)__builtin_amdgcn_s_getreg((3 << 11) | 20) & 0xFu; }
#define XB_SPIN(cond, bar) do { unsigned _sp = 0; while (cond) { __builtin_amdgcn_s_sleep(1); \
    if ((++_sp & 255u) == 0u) { if (xb_ld(&(bar)[XB_TMO])) break; if (_sp > XB_SPIN_CAP) { atomicAdd(&(bar)[XB_TMO], 1u); break; } } } } while (0)
struct XcdBarrier { unsigned* bar; unsigned x; volatile LAS unsigned* st; };
__device__ __forceinline__ XcdBarrier xcd_barrier_post(unsigned* bar, volatile LAS unsigned* st) {
    XcdBarrier b; b.bar = bar; b.x = xb_xcc_id(); b.st = st;
    if (threadIdx.x == 0) (void)xb_add(&bar[XB_XCNT(b.x)], 1u);
    return b;
}
__device__ __forceinline__ void xcd_barrier_complete(unsigned* bar, unsigned x, unsigned& nloc, unsigned& nx) {
    const unsigned G = gridDim.x * gridDim.y * gridDim.z;
    unsigned sum, cnt, mine, sp = 0u;
    for (;;) {
        sum = 0u; cnt = 0u; mine = 0u;
#pragma unroll
        for (unsigned j = 0; j < 16; ++j) { const unsigned c = xb_ld(&bar[XB_XCNT(j)]); sum += c; cnt += (c > 0u) ? 1u : 0u; mine = (j == x) ? c : mine; }
        if (sum == G) break;
        __builtin_amdgcn_s_sleep(1);
        if ((++sp & 255u) == 0u) { if (xb_ld(&bar[XB_TMO])) break; if (sp > XB_SPIN_CAP) { atomicAdd(&bar[XB_TMO], 1u); break; } }
    }
    nloc = mine > 0u ? mine : 1u; nx = cnt > 0u ? cnt : 1u;
}
__device__ __forceinline__ void xcd_barrier(const XcdBarrier& b0) {
    asm volatile("s_waitcnt vmcnt(0)" ::: "memory");
    __syncthreads();
    if (threadIdx.x == 0) {
        XcdBarrier b = b0;
        { unsigned xx = xb_xcc_id(); asm volatile("" : "+s"(xx)); b.x = xx; }
        unsigned* bar = b.bar;
        __builtin_amdgcn_s_waitcnt(0);
        unsigned nloc = b.st[0], nx = b.st[1];
        if (nloc == 0u) { xcd_barrier_complete(bar, b.x, nloc, nx); b.st[0] = nloc; b.st[1] = nx; }
        const unsigned old = xb_add(&bar[XB_XSUB(b.x)], 1u);
        const unsigned gen = old / nloc;
        if (old + 1u == (gen + 1u) * nloc) {
            __builtin_amdgcn_fence(__ATOMIC_RELEASE, "agent");
            asm volatile("s_waitcnt vmcnt(0)" ::: "memory");
            const unsigned og = xb_add(&bar[XB_TOP], 1u);
            const unsigned tg = og / nx;
            if (og + 1u == (tg + 1u) * nx) xb_add(&bar[XB_TOPGEN], 1u);
            else XB_SPIN(xb_ld(&bar[XB_TOPGEN]) == tg, bar);
            __builtin_amdgcn_fence(__ATOMIC_ACQUIRE, "agent");
            xb_add(&bar[XB_XGEN(b.x)], 1u);
            asm volatile("s_waitcnt vmcnt(0)" ::: "memory");
        } else {
            XB_SPIN(xb_ld(&bar[XB_XGEN(b.x)]) == gen, bar);
            __builtin_amdgcn_fence(__ATOMIC_ACQUIRE, "agent");
            asm volatile("s_waitcnt vmcnt(0)" ::: "memory");
        }
    }
    __syncthreads();
}

__device__ void conv_tile(const float* __restrict__ src, int N, bf16_t* __restrict__ dst, int K, int kt, int nt, float* tile) {
    const int tid = TID();
    { const int r = tid >> 4, c4 = (tid & 15) * 4;
#pragma unroll
      for (int i = 0; i < 2; ++i) { const int k = r + 32 * i; const f32x4 v = __builtin_nontemporal_load((const f32x4*)(src + (size_t)(kt * 64 + k) * N + nt * 64 + c4));
          tile[k * 65 + c4 + 0] = v[0]; tile[k * 65 + c4 + 1] = v[1]; tile[k * 65 + c4 + 2] = v[2]; tile[k * 65 + c4 + 3] = v[3]; } }
    __syncthreads();
    { const int n = tid >> 3, kc = (tid & 7) * 8; u32x4 w;
      w[0] = cvt_pk_bf16(tile[(kc + 0) * 65 + n], tile[(kc + 1) * 65 + n]); w[1] = cvt_pk_bf16(tile[(kc + 2) * 65 + n], tile[(kc + 3) * 65 + n]);
      w[2] = cvt_pk_bf16(tile[(kc + 4) * 65 + n], tile[(kc + 5) * 65 + n]); w[3] = cvt_pk_bf16(tile[(kc + 6) * 65 + n], tile[(kc + 7) * 65 + n]);
      *(u32x4*)(dst + (size_t)(nt * 64 + n) * K + kt * 64 + kc) = w; }
    __syncthreads();
}

__device__ void mod_item(const Params& p, int l, int cc, float* lds) {
    const int tid = TID();
    float* sc = lds;
    float* red = lds + 5120;
    for (int i = tid; i < 5120; i += NTHREADS) { const int r = i >> 10, k = i & 1023; const float v = (r == 0) ? PIN(6)[k] : PIN(5)[(r - 1) * 1024 + k]; sc[i] = siluf_(v); }
    __syncthreads();
    const int kg = tid >> 5, c = tid & 31, col = cc * 32 + c;
    float a[5] = {0.f, 0.f, 0.f, 0.f, 0.f};
    const float* w = PIN(7) + (size_t)l * 1024 * 3072 + col;
#pragma unroll 16
    for (int k = kg * 64; k < kg * 64 + 64; ++k) { const float wv = __builtin_nontemporal_load(w + (size_t)k * 3072);
#pragma unroll
        for (int r = 0; r < 5; ++r) a[r] += sc[r * 1024 + k] * wv; }
#pragma unroll
    for (int r = 0; r < 5; ++r) red[(kg * 5 + r) * 32 + c] = a[r];
    __syncthreads();
    if (tid < 160) { const int r = tid >> 5, c2 = tid & 31; float s = PIN(8)[l * 3072 + cc * 32 + c2];
        for (int g = 0; g < 16; ++g) s += red[(g * 5 + r) * 32 + c2];
        __hip_atomic_store((float*)(PWS + WS_MOD) + (l * 5 + r) * 3072 + cc * 32 + c2, s, __ATOMIC_RELAXED, __HIP_MEMORY_SCOPE_AGENT); }
    asm volatile("s_waitcnt vmcnt(0)" ::: "memory");
    __syncthreads();
    if (tid == 0 && l == 0) __hip_atomic_fetch_add((unsigned*)(PWS + WS_CTR) + 16, 1u, __ATOMIC_RELAXED, __HIP_MEMORY_SCOPE_AGENT);
}

__device__ void phaseA0(const Params& p, int l);
__device__ void phase0(const Params& p, unsigned char* lds) {
    const int NCONV_IN = 2 * 16 * 114, NCONV_UP = 8 * 64, NCONV_O = 2 * 256, NCONV_L = 32, NMOD = 192;
    const int total = NCONV_IN + NCONV_UP + NCONV_O + NCONV_L + NMOD + 1;
    for (int it = blockIdx.x; it < total; it += gridDim.x) {
        int i = it;
        if (i < NMOD) { mod_item(p, i / 96, i % 96, (float*)lds); continue; }
        i -= NMOD;
        if (i < NCONV_IN) { const int l = i / 1824, r = i % 1824, nt = r / 16, kt = r % 16;
            conv_tile(PIN(10) + (size_t)l * 1024 * INW, INW, (bf16_t*)(PWS + WS_WTIN) + (size_t)l * INW * 1024, 1024, kt, nt, (float*)lds); continue; }
        i -= NCONV_IN;
        if (i < NCONV_UP) { const int mtx = i / 64, r = i % 64, nt = r / 4, kt = r % 4;
            conv_tile(PIN(25) + (size_t)mtx * 256 * 1024, 1024, (bf16_t*)(PWS + WS_WTUP) + (size_t)mtx * 1024 * 256, 256, kt, nt, (float*)lds); continue; }
        i -= NCONV_UP;
        if (i < NCONV_O) { const int l = i / 256, r = i % 256, nt = r / 16, kt = r % 16;
            conv_tile(PIN(26) + (size_t)l * 1024 * 1024, 1024, (bf16_t*)(PWS + WS_WTO) + (size_t)l * 1024 * 1024, 1024, kt, nt, (float*)lds); continue; }
        i -= NCONV_O;
        if (i < NCONV_L) { const int l = i >> 4, m = (i >> 2) & 3, nt = i & 3;
            conv_tile((m < 2 ? PIN(14) : PIN(16)) + (size_t)(l * 2 + (m & 1)) * 64 * 256, 256, (bf16_t*)(PWS + WS_LORAT) + (size_t)(l * 4 + m) * 256 * 64, 64, 0, nt, (float*)lds); continue; }
        for (int e = TID(); e < 1024; e += NTHREADS) { const int pos = e >> 4, f = e & 15;
            const float inv = exp2f(-(float)f * (13.287712379549449f / 16.0f)); const float ang = (float)pos * inv;
            float sn, cs; sn = sinf(ang); cs = cosf(ang);
            ((f32x2*)(PWS + WS_ROPE))[e] = (f32x2){cs, sn}; }
        for (int e = TID(); e < 4 * 32 * 64; e += NTHREADS) ((unsigned*)(PWS + WS_XCNT))[e] = 0u;
    }
    if (TID() == 0) { unsigned* mc = (unsigned*)(PWS + WS_CTR) + 16; unsigned spins = 0;
        while (__hip_atomic_load(mc, __ATOMIC_RELAXED, __HIP_MEMORY_SCOPE_AGENT) < 96u) { __builtin_amdgcn_s_sleep(2); if (++spins > (1u << 22)) break; }
        __builtin_amdgcn_fence(__ATOMIC_ACQUIRE, "agent");
        asm volatile("s_waitcnt vmcnt(0)" ::: "memory"); }
    __syncthreads();
    phaseA0(p, 0);
}

__device__ __forceinline__ const float* xrow_ptr(const Params& p, int l, int row) {
    if (l == 0) return row < NTP ? PIN(0) + (size_t)row * DM : PIN(1) + (size_t)(row - NTP) * DM;
    return POUT + (size_t)row * DM;
}
__device__ void phaseA0(const Params& p, int l) {
    const int lane = TID() & 63, gw = blockIdx.x * 8 + (TID() >> 6), W = gridDim.x * 8;
    const float* g = PIN(9) + l * DM;
    bf16_t* H = (bf16_t*)(PWS + WS_H);
    for (int row = gw; row < NT; row += W) {
        const float* x = xrow_ptr(p, l, row);
        f32x4 v[4]; float ss = 0.f;
#pragma unroll
        for (int i = 0; i < 4; ++i) { v[i] = *(const f32x4*)(x + i * 256 + lane * 4); ss += v[i][0] * v[i][0] + v[i][1] * v[i][1] + v[i][2] * v[i][2] + v[i][3] * v[i][3]; }
        ss = wave_sum(ss);
        const float rs = rsqrtf(ss * (1.0f / 1024.0f) + 1e-6f);
        const float* mod = (const float*)(PWS + WS_MOD) + (size_t)(l * 5 + modrow_of(row)) * 3072;
#pragma unroll
        for (int i = 0; i < 4; ++i) { const int c = i * 256 + lane * 4;
            const f32x4 gg = *(const f32x4*)(g + c), sh = *(const f32x4*)(mod + c), scl = *(const f32x4*)(mod + 1024 + c);
            f32x4 h = v[i] * rs * gg * (1.0f + scl) + sh;
            u32x2 w; w[0] = cvt_pk_bf16(h[0], h[1]); w[1] = cvt_pk_bf16(h[2], h[3]);
            *(u32x2*)(H + (size_t)row * DM + c) = w; }
    }
}

template <int MT>
__device__ __forceinline__ void gemm_acc(const bf16_t* __restrict__ A, int lda, const bf16_t* __restrict__ B, int ldb, int K, f32x4 (&acc)[MT][4], unsigned char* lds) {
    constexpr int BM = MT * 64, LDT = 72, A_BYTES = BM * LDT * 2, B_BYTES = 128 * LDT * 2, BUF = A_BYTES + B_BYTES;
    const int tid = TID(), lane = tid & 63, wid = tid >> 6, wr = wid >> 1, wc = wid & 1, fr = lane & 15, fq = lane >> 4;
    u32x4 ra[MT], rb[2];
    const int srow = tid >> 3, skc = tid & 7;
    const bf16_t* Ag = A + (size_t)srow * lda + skc * 8;
    const bf16_t* Bg = B + (size_t)srow * ldb + skc * 8;
    const int soff = (srow * LDT + skc * 8) * 2;
    const int nt = K >> 6;
    __syncthreads();
#pragma unroll
    for (int i = 0; i < MT; ++i) ra[i] = *(const u32x4*)(Ag + (size_t)i * 64 * lda);
#pragma unroll
    for (int i = 0; i < 2; ++i) rb[i] = *(const u32x4*)(Bg + (size_t)i * 64 * ldb);
#pragma unroll
    for (int i = 0; i < MT; ++i) *(u32x4*)(lds + soff + i * 64 * LDT * 2) = ra[i];
#pragma unroll
    for (int i = 0; i < 2; ++i) *(u32x4*)(lds + A_BYTES + soff + i * 64 * LDT * 2) = rb[i];
    __syncthreads();
    const int aoff = ((wr * MT * 16 + fr) * LDT + fq * 8) * 2, boff = A_BYTES + ((wc * 64 + fr) * LDT + fq * 8) * 2;
    for (int t = 0; t < nt; ++t) {
        if (t + 1 < nt) {
#pragma unroll
            for (int i = 0; i < MT; ++i) ra[i] = *(const u32x4*)(Ag + (size_t)i * 64 * lda + (t + 1) * 64);
#pragma unroll
            for (int i = 0; i < 2; ++i) rb[i] = *(const u32x4*)(Bg + (size_t)i * 64 * ldb + (t + 1) * 64);
        }
        const unsigned char* base = lds + (t & 1) * BUF;
#pragma unroll
        for (int kk = 0; kk < 2; ++kk) {
            bf16x8 af[MT], bfr[4];
#pragma unroll
            for (int m = 0; m < MT; ++m) af[m] = *(const bf16x8*)(base + aoff + m * 16 * LDT * 2 + kk * 64);
#pragma unroll
            for (int n = 0; n < 4; ++n) bfr[n] = *(const bf16x8*)(base + boff + n * 16 * LDT * 2 + kk * 64);
#pragma unroll
            for (int m = 0; m < MT; ++m)
#pragma unroll
                for (int n = 0; n < 4; ++n) acc[m][n] = __builtin_amdgcn_mfma_f32_16x16x32_bf16(bfr[n], af[m], acc[m][n], 0, 0, 0);
        }
        if (t + 1 < nt) {
            unsigned char* nb = lds + ((t + 1) & 1) * BUF;
#pragma unroll
            for (int i = 0; i < MT; ++i) *(u32x4*)(nb + soff + i * 64 * LDT * 2) = ra[i];
#pragma unroll
            for (int i = 0; i < 2; ++i) *(u32x4*)(nb + A_BYTES + soff + i * 64 * LDT * 2) = rb[i];
        }
        __syncthreads();
    }
}
template <int MT> __device__ __forceinline__ void zero_acc(f32x4 (&acc)[MT][4]) {
#pragma unroll
    for (int m = 0; m < MT; ++m)
#pragma unroll
        for (int n = 0; n < 4; ++n) acc[m][n] = (f32x4){0.f, 0.f, 0.f, 0.f};
}

namespace pg8 {
#define PG8_LAS __attribute__((address_space(3)))
typedef unsigned short bf16_t;
typedef short bf16x8 __attribute__((ext_vector_type(8)));
typedef float f32x4 __attribute__((ext_vector_type(4)));
typedef unsigned u32x4 __attribute__((ext_vector_type(4)));
constexpr int BM = 256, BK = 64, HALF = 128, HTB = HALF * BK * 2  , STAGE_BYTES = 8 * HTB, NXCD = 8, WGM = 8;

__host__ __device__ __forceinline__ int lds_byte(int r, int c) { const int st = (r >> 4) * 2 + (c >> 5), rr = r & 15, cc = c & 31, ob = rr * 64 + cc * 2; return st * 1024 + (ob ^ (((ob >> 9) & 1) << 5)); }
__host__ __device__ __forceinline__ void stage_rc(int b, int& R, int& C) { const int st = b / 1024, sb = b % 1024, swz = sb ^ (((sb >> 9) & 1) << 5); R = (st >> 1) * 16 + swz / 64; C = (st & 1) * 32 + (swz % 64) / 2; }
__host__ __device__ __forceinline__ int perm32(int rho) { const int n = rho >> 4, i = rho & 15; return 8 * (i >> 2) + 4 * n + (i & 3); }

struct Unit { int pm, pn; };
struct Gemm { const bf16_t* A; const bf16_t* Bt; int M, N, K; };

struct StaticOrder {
    int nM, nN, nwg, G, c;
    __host__ __device__ void init(int M, int N, int G_, int c_) { nM = M / BM; nN = N / BM; nwg = nM * nN; G = G_; c = c_; }
    __host__ __device__ bool next(int i, Unit& u) const {
        const long L = (long)i * G + c; if (L >= nwg) return false;
        int wgid = (int)L; { const int q = nwg / NXCD, r = nwg % NXCD, xcd = wgid % NXCD, off = wgid / NXCD; wgid = (xcd < r ? xcd * (q + 1) : r * (q + 1) + (xcd - r) * q) + off; }
        const int nig = WGM * nN, gid = wgid / nig, fm = gid * WGM, gsz = (nM - fm) < WGM ? (nM - fm) : WGM;
        u.pm = fm + ((wgid % nig) % gsz); u.pn = (wgid % nig) / gsz; return true;
    }
    __device__ __forceinline__ void a_ready(const Unit&) const {}
    __device__ __forceinline__ void done(const Unit&) const {}
};
template <class Epi, class Sched, bool STAMP = false>
__device__ __forceinline__ void gemm_phase(PG8_LAS unsigned char* lds, const Gemm g, const Sched& S, const Epi& E, unsigned long long* stamps) {
    const int tid = ::TID(), wid = __builtin_amdgcn_readfirstlane(tid >> 6), lane = tid & 63, wr = wid >> 2, wc = wid & 3, fr = lane & 15, fq = lane >> 4;
    const int K = g.K, nt = K / BK;
    int ts_lo = 0, ts_hi = 0, nts = 0; const unsigned long long rt_entry = STAMP ? (unsigned long long)wall_clock64() : 0ull;
#define PG8_STAMP() do { if (STAMP && wid == 0 && nts < 64) { const unsigned long long _c = (unsigned long long)clock64(); \
        ts_lo = (lane == nts) ? (int)(unsigned)_c : ts_lo; ts_hi = (lane == nts) ? (int)(unsigned)(_c >> 32) : ts_hi; ++nts; } } while (0)
    PG8_STAMP();
    unsigned voffA[2], voffB[2];
#pragma unroll
    for (int i = 0; i < 2; ++i) { int R, C; stage_rc(tid * 16 + i * 8192, R, C); const int Rb = Epi::PERM ? ((R & ~31) + perm32(R & 31)) : R;
        voffA[i] = (unsigned)(R * K + C) * 2u; voffB[i] = (unsigned)(Rb * K + C) * 2u; }
    const size_t kstep = (size_t)(BK * 2);
    const size_t hstep = (size_t)HALF * K * 2;
    const size_t tstep = 2 * hstep;
    const unsigned ldsw = (unsigned)wid * 1024u;
    const int aoff = lds_byte(wr * 64 + fr, fq * 8), boff = lds_byte(wc * 32 + fr, fq * 8);
#define PG8_SA(b, h) (((b) * 2 + (h)) * HTB)
#define PG8_SB(b, h) ((4 + (b) * 2 + (h)) * HTB)
#define PG8_STAGE(bufoff, gbase, voff) do { _Pragma("unroll") for (int _i = 0; _i < 2; ++_i) \
        __builtin_amdgcn_global_load_lds((const unsigned*)((const char*)(gbase) + (voff)[_i]), (PG8_LAS unsigned*)(lds + (bufoff) + ldsw + _i * 8192), 16, 0, 0); } while (0)
#define PG8_LDA(dst, b, h) do { _Pragma("unroll") for (int m = 0; m < 4; ++m) _Pragma("unroll") for (int k = 0; k < 2; ++k) dst[m][k] = *(const PG8_LAS bf16x8*)(lds + PG8_SA(b, h) + aoff + m * 2048 + k * 1024); } while (0)
#define PG8_LDB(dst, b, h) do { _Pragma("unroll") for (int n = 0; n < 2; ++n) _Pragma("unroll") for (int k = 0; k < 2; ++k) dst[n][k] = *(const PG8_LAS bf16x8*)(lds + PG8_SB(b, h) + boff + n * 2048 + k * 1024); } while (0)
#define PG8_MMA(ai, bj, At, Bt) do { __builtin_amdgcn_s_setprio(1); _Pragma("unroll") for (int m = 0; m < 4; ++m) _Pragma("unroll") for (int n = 0; n < 2; ++n) _Pragma("unroll") for (int k = 0; k < 2; ++k) \
        acc[ai][bj][m][n] = __builtin_amdgcn_mfma_f32_16x16x32_bf16(Bt[n][k], At[m][k], acc[ai][bj][m][n], 0, 0, 0); __builtin_amdgcn_s_setprio(0); } while (0)
#define PG8_WAIT_V(n) asm volatile("s_waitcnt vmcnt(" #n ")" ::: "memory")
#define PG8_WAIT_L(n) asm volatile("s_waitcnt lgkmcnt(" #n ")" ::: "memory")
#define PG8_BAR __builtin_amdgcn_s_barrier()
#define PG8_SCHED __builtin_amdgcn_sched_barrier(0)
    Unit cur, nxt; int ui = 0;
    if (!S.next(0, cur)) return;
    f32x4 acc[2][2][4][2];
#pragma unroll
    for (int a = 0; a < 2; ++a)
#pragma unroll
        for (int b = 0; b < 2; ++b)
#pragma unroll
            for (int m = 0; m < 4; ++m)
#pragma unroll
                for (int n = 0; n < 2; ++n) acc[a][b][m][n] = (f32x4){0.f, 0.f, 0.f, 0.f};
    bf16x8 At[4][2], B0[2][2], B1[2][2];
    const char* cA = (const char*)g.A + (size_t)cur.pm * tstep; const char* cB = (const char*)g.Bt + (size_t)cur.pn * tstep;
    S.a_ready(cur);
    PG8_STAGE(PG8_SB(0, 0), cB, voffB); PG8_STAGE(PG8_SA(0, 0), cA, voffA); PG8_STAGE(PG8_SB(0, 1), cB + hstep, voffB); PG8_STAGE(PG8_SA(0, 1), cA + hstep, voffA);
    if (wr == 1) PG8_BAR;
    PG8_WAIT_V(4); PG8_BAR;
    PG8_STAGE(PG8_SB(1, 0), cB + kstep, voffB); PG8_STAGE(PG8_SA(1, 0), cA + kstep, voffA); PG8_STAGE(PG8_SB(1, 1), cB + hstep + kstep, voffB);
    PG8_WAIT_V(6); PG8_BAR;
    PG8_STAMP();
    for (;;) {
        const bool has_next = S.next(ui + 1, nxt);
        const char* nA = has_next ? (const char*)g.A + (size_t)nxt.pm * tstep : cA; const char* nB = has_next ? (const char*)g.Bt + (size_t)nxt.pn * tstep : cB;
        for (int t = 0; t < nt; t += 2) {
            const bool last = (t == nt - 2);
            const char* a1 = cA + (size_t)(t + 1) * kstep;
            const char* a2 = last ? nA : cA + (size_t)(t + 2) * kstep; const char* b2 = last ? nB : cB + (size_t)(t + 2) * kstep;
            const char* a3 = a2 + kstep; const char* b3 = b2 + kstep;
            if (last && has_next) S.a_ready(nxt);
            PG8_LDB(B0, 0, 0); PG8_SCHED; PG8_LDA(At, 0, 0); PG8_STAGE(PG8_SA(1, 1), a1 + hstep, voffA);
            PG8_WAIT_L(8); PG8_BAR; PG8_WAIT_L(0); PG8_MMA(0, 0, At, B0); PG8_BAR; PG8_SCHED;
            PG8_LDB(B1, 0, 1); PG8_STAGE(PG8_SB(0, 0), b2, voffB);
            PG8_BAR; PG8_WAIT_L(0); PG8_MMA(0, 1, At, B1); PG8_BAR;
            PG8_LDA(At, 0, 1); PG8_STAGE(PG8_SA(0, 0), a2, voffA);
            PG8_BAR; PG8_WAIT_L(0); PG8_MMA(1, 0, At, B0); PG8_BAR; PG8_SCHED;
            PG8_STAGE(PG8_SB(0, 1), b2 + hstep, voffB);
            PG8_WAIT_V(6); PG8_BAR; PG8_MMA(1, 1, At, B1); PG8_BAR;
            PG8_LDB(B0, 1, 0); PG8_SCHED; PG8_LDA(At, 1, 0); PG8_STAGE(PG8_SA(0, 1), a2 + hstep, voffA);
            PG8_WAIT_L(8); PG8_BAR; PG8_WAIT_L(0); PG8_MMA(0, 0, At, B0); PG8_BAR; PG8_SCHED;
            PG8_LDB(B1, 1, 1); PG8_STAGE(PG8_SB(1, 0), b3, voffB);
            PG8_BAR; PG8_WAIT_L(0); PG8_MMA(0, 1, At, B1); PG8_BAR;
            PG8_LDA(At, 1, 1); PG8_STAGE(PG8_SA(1, 0), a3, voffA);
            PG8_BAR; PG8_WAIT_L(0); PG8_MMA(1, 0, At, B0); PG8_BAR; PG8_SCHED;
            PG8_STAGE(PG8_SB(1, 1), b3 + hstep, voffB);
            PG8_WAIT_V(6); PG8_BAR; PG8_MMA(1, 1, At, B1); PG8_BAR;
        }
        PG8_STAMP();
        if constexpr (!Epi::AFTER_DRAIN) { E(acc, cur, wr, wc, fr, fq); S.done(cur); }
        PG8_STAMP();
        if (!has_next) break;
#pragma unroll
        for (int a = 0; a < 2; ++a)
#pragma unroll
            for (int b = 0; b < 2; ++b)
#pragma unroll
                for (int m = 0; m < 4; ++m)
#pragma unroll
                    for (int n = 0; n < 2; ++n) acc[a][b][m][n] = (f32x4){0.f, 0.f, 0.f, 0.f};
        cur = nxt; cA = nA; cB = nB; ++ui;
    }
    PG8_WAIT_V(0);
    if (wr == 0) PG8_BAR;
    PG8_BAR;
    if constexpr (Epi::AFTER_DRAIN) { E.fused(acc, cur, wr, wc, fr, fq, lds, wid, lane); S.done(cur); }
    PG8_STAMP();
    if (STAMP && wid == 0) { stamps[lane] = lane < nts ? (((unsigned long long)(unsigned)ts_hi << 32) | (unsigned)ts_lo) : 0ull;
        if (lane == 62) stamps[62] = rt_entry; if (lane == 63) stamps[63] = (unsigned long long)wall_clock64(); }
#undef PG8_STAMP
#undef PG8_SA
#undef PG8_SB
#undef PG8_STAGE
#undef PG8_LDA
#undef PG8_LDB
#undef PG8_MMA
#undef PG8_WAIT_V
#undef PG8_WAIT_L
#undef PG8_BAR
#undef PG8_SCHED
}
}

struct EpiA {
    static constexpr bool PERM = false, AFTER_DRAIN = false;
    float* P; bf16_t* Z; float* out; int l, cbase;
    __device__ __forceinline__ void operator()(const pg8::f32x4 (&acc)[2][2][4][2], const pg8::Unit& u, int wr, int wc, int fr, int fq) const {
#pragma unroll
        for (int ai = 0; ai < 2; ++ai)
#pragma unroll
            for (int m = 0; m < 4; ++m) { const int row = u.pm * 256 + ai * 128 + wr * 64 + m * 16 + fr;
#pragma unroll
                for (int bj = 0; bj < 2; ++bj)
#pragma unroll
                    for (int n = 0; n < 2; ++n) { const int col = cbase + u.pn * 256 + bj * 128 + wc * 32 + n * 16 + fq * 4; const f32x4 v = acc[ai][bj][m][n];
                        if (col < PW) { *(f32x4*)(P + (size_t)row * PW + col) = v;
                            if (col >= C_CK && col < C_DP && row < NTP) { const int b = row >> 8, s_ = row & 255; const bool isk = col < C_CV;
                                *(f32x4*)(out + (isk ? O_NK : O_NV) + ((size_t)((b * 2 + l) * 256 + s_)) * 128 + (col - (isk ? C_CK : C_CV))) = v; } }
                        else if (col < NA_COLS) { u32x2 w; w[0] = cvt_pk_bf16(siluf_(v[0]), siluf_(v[1])); w[1] = cvt_pk_bf16(siluf_(v[2]), siluf_(v[3])); *(u32x2*)(Z + (size_t)row * DM + (col - PW)) = w; } } }
    }
};
__device__ __forceinline__ size_t g_off(int row, int cg) {
    const int n = cg >> 10, c = cg & 1023;
    const int pm = row >> 8, wr2 = (row >> 6) & 3, m = (row >> 4) & 3, fr = row & 15;
    const int pn = c >> 7, wc2 = (c >> 6) & 1, q = (c >> 4) & 3, fq2 = (c >> 2) & 3;
    size_t o = (size_t)(n * 32 + pm); o = o * 8 + pn; o = o * 4 + wr2; o = o * 2 + wc2; o = o * 4 + m; o = o * 16 + fr; o = o * 4 + fq2; o = o * 16 + q * 4;
    return o;
}
struct EpiG {
    static constexpr bool PERM = true, AFTER_DRAIN = false;
    bf16_t* G;
    __device__ __forceinline__ void operator()(const pg8::f32x4 (&acc)[2][2][4][2], const pg8::Unit& u, int wr, int wc, int fr, int fq) const {
#pragma unroll
        for (int ai = 0; ai < 2; ++ai)
#pragma unroll
            for (int m = 0; m < 4; ++m) { const int row = u.pm * 256 + ai * 128 + wr * 64 + m * 16 + fr;
#pragma unroll
                for (int bj = 0; bj < 2; ++bj) { const int col = u.pn * 256 + bj * 128 + wc * 32 + 8 * fq; const f32x4 v0 = acc[ai][bj][m][0], v1 = acc[ai][bj][m][1];
                    u32x4 w; w[0] = cvt_pk_bf16(sigmoidf_(v0[0]), sigmoidf_(v0[1])); w[1] = cvt_pk_bf16(sigmoidf_(v0[2]), sigmoidf_(v0[3]));
                    w[2] = cvt_pk_bf16(sigmoidf_(v1[0]), sigmoidf_(v1[1])); w[3] = cvt_pk_bf16(sigmoidf_(v1[2]), sigmoidf_(v1[3]));
                    u32x2 wa, wb; wa[0] = w[0]; wa[1] = w[1]; wb[0] = w[2]; wb[1] = w[3];
                    *(u32x2*)(G + g_off(row, col)) = wa; *(u32x2*)(G + g_off(row, col + 4)) = wb; } }
    }
};

__device__ void phaseA(const Params& p, int l, unsigned char* lds, int part) {
    const int G = part ? ((int)gridDim.x < 160 ? (int)gridDim.x : 160) : (int)gridDim.x;
    if ((int)blockIdx.x < G) {
        pg8::Gemm g; g.A = (const bf16_t*)(PWS + WS_H); g.Bt = (const bf16_t*)(PWS + WS_WTIN) + (size_t)l * INW * 1024 + (size_t)(part ? 2048 : 0) * 1024; g.M = NT; g.N = part ? 5 * 256 : 8 * 256; g.K = 1024;
        pg8::StaticOrder S; S.init(g.M, g.N, G, (int)blockIdx.x);
        EpiA E; E.P = (float*)(PWS + WS_P); E.Z = (bf16_t*)(PWS + WS_Z); E.out = POUT; E.l = l; E.cbase = part ? 2048 : 0;
        pg8::gemm_phase<EpiA, pg8::StaticOrder, false>((PG8_LAS unsigned char*)lds, g, S, E, nullptr);
    }
    __syncthreads();
}

__device__ void phaseB0(const Params& p, int l, unsigned char* ldsb) {
    const int tid = TID(), lane = tid & 63, wid = tid >> 6, fr = lane & 15, fq = lane >> 4;
    const int h = wid >> 1, mt = wid & 1;
    bf16_t* Awd = (bf16_t*)ldsb;
    bf16_t* Aad = Awd + 32 * 72;
    const float* P = (const float*)(PWS + WS_P);
    float* recS = (float*)(PWS + WS_RECS);
    float* recD = (float*)(PWS + WS_RECD);
    float* BC = (float*)(PWS + WS_BC);
    const bf16_t* LT = (const bf16_t*)(PWS + WS_LORAT) + (size_t)l * 4 * 256 * 64;
    const float* pkk = PIN(17) + l * 256; const float* pka = PIN(18) + l * 256; const float* prk = PIN(19) + l * 256;
    const float* pw0 = PIN(13) + l * 512; const float* pa0 = PIN(15) + l * 512;
    __shared__ int s_b0;
    unsigned* ctr0 = (unsigned*)(PWS + WS_CTR) + 4 + l;
    const int nA2 = (int)gridDim.x < 160 ? (int)gridDim.x : 160, nstat = (int)gridDim.x - nA2;
    for (int iter = 0;; ++iter) {
        int it;
        if (iter == 0 && (int)blockIdx.x >= nA2) it = (int)blockIdx.x - nA2;
        else { if (tid == 0) s_b0 = nstat + (int)atomicAdd(ctr0, 1u);
            __syncthreads();
            it = s_b0;
            __syncthreads(); }
        if (it >= NT / 32) break;
        const int tb = it * 32;
        __syncthreads();
#pragma unroll
        for (int i = 0; i < 8; ++i) { const int idx = tid + i * 512, tk = idx >> 7, j = idx & 127; const float v = P[(size_t)(tb + tk) * PW + C_WD + j];
            if (j < 64) Awd[tk * 72 + j] = f2bf(1.0f - 2.0f / (1.0f + __expf(2.0f * v))); else Aad[tk * 72 + j - 64] = f2bf(v); }
        __syncthreads();
        f32x4 acc[4][4];
#pragma unroll
        for (int m = 0; m < 4; ++m)
#pragma unroll
            for (int n = 0; n < 4; ++n) acc[m][n] = (f32x4){0.f, 0.f, 0.f, 0.f};
#pragma unroll
        for (int ks = 0; ks < 2; ++ks) {
            const bf16x8 awf = *(const bf16x8*)(Awd + (mt * 16 + fr) * 72 + ks * 32 + fq * 8), aaf = *(const bf16x8*)(Aad + (mt * 16 + fr) * 72 + ks * 32 + fq * 8);
#pragma unroll
            for (int n = 0; n < 4; ++n) { const int cb = h * 64 + n * 16 + fr;
#pragma unroll
                for (int m = 0; m < 4; ++m) { const bf16x8 bfr = *(const bf16x8*)(LT + ((size_t)m * 256 + cb) * 64 + ks * 32 + fq * 8);
                    acc[m][n] = __builtin_amdgcn_mfma_f32_16x16x32_bf16(bfr, m < 2 ? awf : aaf, acc[m][n], 0, 0, 0); } }
        }
        const int tok = tb + mt * 16 + fr; int seqbase, L, pos; seq_of(tok, seqbase, L, pos);
        const float* pr = P + (size_t)tok * PW;
        const size_t ridx = ((size_t)seqbase * 4 + (size_t)h * L + pos) * 192;
        f32x4 k4[4], kk4[4]; float ss = 0.f;
#pragma unroll
        for (int n = 0; n < 4; ++n) { const int c4 = h * 64 + n * 16 + fq * 4;
            k4[n] = *(const f32x4*)(pr + C_BK + c4); kk4[n] = k4[n] * *(const f32x4*)(pkk + c4);
            ss += (kk4[n][0] * kk4[n][0] + kk4[n][1] * kk4[n][1]) + (kk4[n][2] * kk4[n][2] + kk4[n][3] * kk4[n][3]); }
        ss += __shfl_xor(ss, 16); ss += __shfl_xor(ss, 32);
        const float rn = rsqrtf(ss + 1e-12f);
        float bsum = 0.f;
#pragma unroll
        for (int n = 0; n < 4; ++n) { const int c4 = h * 64 + n * 16 + fq * 4, j4 = n * 16 + fq * 4;
            const f32x4 r4 = *(const f32x4*)(pr + C_BR + c4), v4 = *(const f32x4*)(pr + C_BV + c4);
            const f32x4 kk = kk4[n] * rn, ka4 = *(const f32x4*)(pka + c4), rk4 = *(const f32x4*)(prk + c4);
            *(f32x4*)(recS + ridx + j4) = r4; *(f32x4*)(recS + ridx + 64 + j4) = kk; *(f32x4*)(recS + ridx + 128 + j4) = v4;
#pragma unroll
            for (int d = 0; d < 2; ++d) {
                const f32x4 w0 = *(const f32x4*)(pw0 + d * 256 + c4), a0 = *(const f32x4*)(pa0 + d * 256 + c4);
                f32x4 dec, nka, kd;
#pragma unroll
                for (int j = 0; j < 4; ++j) {
                    const float wl = w0[j] + acc[d][n][j];
                    dec[j] = __expf(-0.6065306597126334f / (1.0f + __expf(-wl)));
                    const float a = 1.0f / (1.0f + __expf(-(a0[j] + acc[2 + d][n][j])));
                    kd[j] = k4[n][j] * (1.0f + (a - 1.0f) * ka4[j]); nka[j] = -(kk[j] * a);
                    bsum += r4[j] * kd[j] * rk4[j]; }
                float* rd = recD + (size_t)d * RECD_STRIDE + ridx + j4;
                *(f32x4*)(rd) = dec; *(f32x4*)(rd + 64) = nka; *(f32x4*)(rd + 128) = kd;
            }
        }
        bsum += __shfl_xor(bsum, 16); bsum += __shfl_xor(bsum, 32);
        if (fq == 0) BC[tok * 4 + h] = bsum;
    }
}

template <int NS>
__device__ __forceinline__ void scan_run(const Params& p, int l, bool sample, int b, int h, int dir, int rg, int L, int seqbase, float* wl) {
    const int lane = TID() & 63, rl = lane >> 4, kl = lane & 15;
    int row[NS]; f32x4 S[NS]; size_t sidx[NS];
#pragma unroll
    for (int q = 0; q < NS; ++q) { row[q] = (rg * NS + q) * 4 + rl;
        sidx[q] = ((size_t)(((b * 2 + l) * 2 + dir) * 4 + h)) * 4096 + row[q] * 64 + kl * 4;
        if (sample) S[q] = *(const f32x4*)(PIN(4) + sidx[q]); else S[q] = (f32x4){0.f, 0.f, 0.f, 0.f}; }
    const float* gS = (const float*)(PWS + WS_RECS) + ((size_t)seqbase * 4 + (size_t)h * L) * 192 + lane * 4;
    const float* gD = (const float*)(PWS + WS_RECD) + (size_t)dir * RECD_STRIDE + ((size_t)seqbase * 4 + (size_t)h * L) * 192 + lane * 4;
    float* O = (float*)(PWS + WS_O) + (size_t)dir * NT * 256 + (size_t)seqbase * 256 + h * 64;
    const int nch = L >> 2;
    f32x4 rA[6], rB[6];
    auto gl = [&](f32x4 (&r)[6], int c) {
        c = c < nch ? c : nch - 1;
        const int pos0 = dir ? (L - 4 * (c + 1)) : 4 * c;
        const float* s_ = gS + (size_t)pos0 * 192; const float* d_ = gD + (size_t)pos0 * 192;
#pragma unroll
        for (int i = 0; i < 3; ++i) { r[i] = *(const f32x4*)(s_ + i * 256); r[3 + i] = *(const f32x4*)(d_ + i * 256); }
    };
    auto st = [&](const f32x4 (&r)[6], float* buf) {
#pragma unroll
        for (int i = 0; i < 3; ++i) { *(f32x4*)(buf + i * 256 + lane * 4) = r[i]; *(f32x4*)(buf + 768 + i * 256 + lane * 4) = r[3 + i]; }
    };
    struct Ops { f32x4 r, kk, w, ka, kd; float v[NS]; };
    auto ldsread = [&](const float* buf, int s) -> Ops {
        const int tc = dir ? 3 - s : s;
        const float* bs = buf + tc * 192; const float* bd = buf + 768 + tc * 192;
        Ops o; o.r = *(const f32x4*)(bs + kl * 4); o.kk = *(const f32x4*)(bs + 64 + kl * 4);
        o.w = *(const f32x4*)(bd + kl * 4); o.ka = *(const f32x4*)(bd + 64 + kl * 4); o.kd = *(const f32x4*)(bd + 128 + kl * 4);
#pragma unroll
        for (int q = 0; q < NS; ++q) o.v[q] = bs[128 + row[q]];
        return o;
    };
    float opart[NS];
#pragma unroll
    for (int q = 0; q < NS; ++q) opart[q] = 0.f;
    auto chunk = [&](const float* cur, const float* nxtbuf, Ops& ops, int c) {
        float oval[NS];
#pragma unroll
        for (int q = 0; q < NS; ++q) oval[q] = 0.f;
#pragma unroll
        for (int s = 0; s < 4; ++s) {
            const Ops nx = (s < 3) ? ldsread(cur, s + 1) : ldsread(nxtbuf, 0);
            __builtin_amdgcn_sched_barrier(0);
            float sa[NS], opr[NS]; f32x2 ta[NS], tb[NS];
            const f32x2 kka = __builtin_shufflevector(ops.kk, ops.kk, 0, 1), kkb = __builtin_shufflevector(ops.kk, ops.kk, 2, 3);
            const f32x2 wa = __builtin_shufflevector(ops.w, ops.w, 0, 1), wb = __builtin_shufflevector(ops.w, ops.w, 2, 3);
            const f32x2 na = __builtin_shufflevector(ops.ka, ops.ka, 0, 1), nb = __builtin_shufflevector(ops.ka, ops.ka, 2, 3);
            const f32x2 da = __builtin_shufflevector(ops.kd, ops.kd, 0, 1), db = __builtin_shufflevector(ops.kd, ops.kd, 2, 3);
            const f32x2 ra = __builtin_shufflevector(ops.r, ops.r, 0, 1), rb = __builtin_shufflevector(ops.r, ops.r, 2, 3);
#pragma unroll
            for (int q = 0; q < NS; ++q) { const f32x2 Sa = __builtin_shufflevector(S[q], S[q], 0, 1), Sb = __builtin_shufflevector(S[q], S[q], 2, 3);
                f32x2 pp = Sa * kka; pp = Sb * kkb + pp; sa[q] = pp[0] + pp[1];
                const f32x2 v2 = (f32x2){ops.v[q], ops.v[q]};
                ta[q] = Sa * wa + v2 * da; tb[q] = Sb * wb + v2 * db; }
#pragma unroll
            for (int q = 0; q < NS; ++q) { sa[q] = row16_sum(sa[q]); opr[q] = row16_sum(opart[q]); oval[q] = (kl == s) ? opr[q] : oval[q]; }
#pragma unroll
            for (int q = 0; q < NS; ++q) { const f32x2 s2 = (f32x2){sa[q], sa[q]};
                const f32x2 Sa = s2 * na + ta[q], Sb = s2 * nb + tb[q];
                f32x2 qq = Sa * ra; qq = Sb * rb + qq; opart[q] = qq[0] + qq[1];
                S[q] = (f32x4){Sa[0], Sa[1], Sb[0], Sb[1]}; }
            ops = nx;
        }
        const int stp = 4 * c - 1 + (kl & 3);
        const int pos = dir ? (L - 1 - stp) : stp;
#pragma unroll
        for (int q = 0; q < NS; ++q) { if (kl < 4 && stp >= 0) O[(size_t)pos * 256 + row[q]] = oval[q]; }
    };
    float* buf0 = wl; float* buf1 = wl + 1536;
    gl(rA, 0); gl(rB, 1);
    st(rA, buf0); gl(rA, 2);
    __builtin_amdgcn_wave_barrier();
    Ops ops = ldsread(buf0, 0);
    for (int c = 0; c < nch; c += 2) {
        st(rB, buf1); gl(rB, c + 3);
        __builtin_amdgcn_wave_barrier();
        chunk(buf0, buf1, ops, c);
        st(rA, buf0); gl(rA, c + 4);
        __builtin_amdgcn_wave_barrier();
        chunk(buf1, buf0, ops, c + 1);
    }
#pragma unroll
    for (int q = 0; q < NS; ++q) { const float ol = row16_sum(opart[q]); if (kl == 0) O[(size_t)(dir ? 0 : L - 1) * 256 + row[q]] = ol; }
    if (!sample) {
#pragma unroll
        for (int q = 0; q < NS; ++q) *(f32x4*)(POUT + O_NS + sidx[q]) = S[q];
    }
}

__device__ __forceinline__ void stage_qk(const float* __restrict__ src, int stride, bf16_t* dst, bool rope, int pos0, float scale, const f32x2* __restrict__ rt) {
    const int tid = TID();
#pragma unroll
    for (int i = 0; i < 2; ++i) {
        const int task = tid + i * 512, row = task >> 3, half = (task >> 2) & 1, quad = task & 3;
        const float* s = src + (size_t)row * stride + half * 32 + quad * 4;
        f32x4 x1 = *(const f32x4*)s, x2 = *(const f32x4*)(s + 16);
        if (rope) { const int pos = pos0 + row; const int pi = half ? (pos & 63) : (pos >> 6);
#pragma unroll
            for (int j = 0; j < 4; ++j) { const f32x2 cs = rt[pi * 16 + quad * 4 + j]; const float a = x1[j], b = x2[j]; x1[j] = a * cs[0] - b * cs[1]; x2[j] = b * cs[0] + a * cs[1]; } }
        x1 *= scale; x2 *= scale;
        u32x2 w1, w2; w1[0] = cvt_pk_bf16(x1[0], x1[1]); w1[1] = cvt_pk_bf16(x1[2], x1[3]); w2[0] = cvt_pk_bf16(x2[0], x2[1]); w2[1] = cvt_pk_bf16(x2[2], x2[3]);
        *(u32x2*)(dst + row * 72 + half * 32 + quad * 4) = w1; *(u32x2*)(dst + row * 72 + half * 32 + 16 + quad * 4) = w2;
    }
}
__device__ __forceinline__ void stage_vt(const float* __restrict__ src, int stride, bf16_t* vt, int nkeys = 128, int pitch = 136) {
    const int tid = TID();
    for (int task = tid; task < nkeys * 16; task += 512) { const int key = task >> 4, dq = task & 15;
        const f32x4 v = *(const f32x4*)(src + (size_t)key * stride + dq * 4);
#pragma unroll
        for (int j = 0; j < 4; ++j) vt[(dq * 4 + j) * pitch + key] = f2bf(v[j]); }
}
__device__ void attn_item(const Params& p, int l, int ai, unsigned char* lds) {
    const int tid = TID(), lane = tid & 63, wid = tid >> 6, fr = lane & 15, fq = lane >> 4;
    bf16_t* Qs = (bf16_t*)lds; bf16_t* Ks = Qs + 128 * 72; bf16_t* Vt = Ks + 128 * 72;
    const float* P = (const float*)(PWS + WS_P);
    const bf16_t* Z = (const bf16_t*)(PWS + WS_Z);
    bf16_t* YS = (bf16_t*)(PWS + WS_YS);
    const f32x2* rt = (const f32x2*)(PWS + WS_ROPE);
    bool sample; int b, head, qt, seqbase;
    if (ai < 128) { sample = true; b = ai >> 5; head = (ai >> 3) & 3; qt = ai & 7; seqbase = NTP + b * 1024; }
    else { const int j = ai - 128; sample = false; b = j >> 3; head = (j >> 1) & 3; qt = j & 1; seqbase = b * 256; }
    const int kh = head >> 1, qbase = seqbase + qt * 128;
    __syncthreads();
    stage_qk(P + (size_t)qbase * PW + C_CQ + head * 64, PW, Qs, sample, qt * 128, 0.125f, rt);
    __syncthreads();
    bf16x8 qf[2];
    qf[0] = *(const bf16x8*)(Qs + (wid * 16 + fr) * 72 + fq * 8); qf[1] = *(const bf16x8*)(Qs + (wid * 16 + fr) * 72 + 32 + fq * 8);
    float m = PIN(22)[l * 4 + head], lsum = 1.0f, lpart = 0.f;
    f32x4 oacc[4];
#pragma unroll
    for (int i = 0; i < 4; ++i) oacc[i] = (f32x4){0.f, 0.f, 0.f, 0.f};
    const int nkb = sample ? 7 : 2;
    const int qpos = qt * 128 + wid * 16 + fr;
    const float* ck = PIN(2); const float* cv = PIN(3);
    auto kinfo = [&](int kb, const float*& ks, const float*& vs, int& stride, bool& rope, bool& mask, int& kpos0) -> bool {
        if (!sample) { ks = P + (size_t)(seqbase + kb * 128) * PW + C_CK + kh * 64; vs = ks + (C_CV - C_CK); stride = PW; rope = false; mask = false; kpos0 = 0; return true; }
        if (kb < 3) { const int nbk = qt - 1 + kb; if (nbk < 0 || nbk >= 8) return false; kpos0 = nbk * 128;
            ks = P + (size_t)(seqbase + kpos0) * PW + C_CK + kh * 64; vs = ks + (C_CV - C_CK); stride = PW; rope = true; mask = (kb != 1); return true; }
        const size_t o = ((size_t)((b * 2 + l) * 512 + (kb - 3) * 128) * 2 + kh) * 64; ks = ck + o; vs = cv + o; stride = 128; rope = false; mask = false; kpos0 = 0; return true;
    };
    f32x4 kx1[2], kx2[2], vx[2][2];
    auto kload = [&](const float* ks, const float* vs, int stride) {
#pragma unroll
        for (int i = 0; i < 2; ++i) { const int task = tid + i * 512, row = task >> 3, half = (task >> 2) & 1, quad = task & 3;
            const float* s_ = ks + (size_t)row * stride + half * 32 + quad * 4; kx1[i] = *(const f32x4*)s_; kx2[i] = *(const f32x4*)(s_ + 16); }
#pragma unroll
        for (int i = 0; i < 2; ++i) { const int task = tid + i * 512, kp = task >> 4, dq = task & 15;
            vx[i][0] = *(const f32x4*)(vs + (size_t)(2 * kp) * stride + dq * 4); vx[i][1] = *(const f32x4*)(vs + (size_t)(2 * kp + 1) * stride + dq * 4); }
    };
    auto kstore = [&](bool rope, int kpos0) {
#pragma unroll
        for (int i = 0; i < 2; ++i) { const int task = tid + i * 512, row = task >> 3, half = (task >> 2) & 1, quad = task & 3;
            f32x4 x1 = kx1[i], x2 = kx2[i];
            if (rope) { const int pos = kpos0 + row; const int pi = half ? (pos & 63) : (pos >> 6);
#pragma unroll
                for (int j = 0; j < 4; ++j) { const f32x2 cs = rt[pi * 16 + quad * 4 + j]; const float a_ = x1[j], b_ = x2[j]; x1[j] = a_ * cs[0] - b_ * cs[1]; x2[j] = b_ * cs[0] + a_ * cs[1]; } }
            u32x2 w1, w2; w1[0] = cvt_pk_bf16(x1[0], x1[1]); w1[1] = cvt_pk_bf16(x1[2], x1[3]); w2[0] = cvt_pk_bf16(x2[0], x2[1]); w2[1] = cvt_pk_bf16(x2[2], x2[3]);
            *(u32x2*)(Ks + row * 72 + half * 32 + quad * 4) = w1; *(u32x2*)(Ks + row * 72 + half * 32 + 16 + quad * 4) = w2; }
#pragma unroll
        for (int i = 0; i < 2; ++i) { const int task = tid + i * 512, kp = task >> 4, dq = task & 15;
#pragma unroll
            for (int j = 0; j < 4; ++j) *(unsigned*)(Vt + (dq * 4 + j) * 136 + 2 * kp) = cvt_pk_bf16(vx[i][0][j], vx[i][1][j]); }
    };
    const float* ksrc = nullptr; const float* vsrc = nullptr; int stride = 0, kpos0n = 0; bool ropen = false, maskn = false;
    int kb = 0;
    while (kb < nkb && !kinfo(kb, ksrc, vsrc, stride, ropen, maskn, kpos0n)) ++kb;
    if (kb < nkb) kload(ksrc, vsrc, stride);
    while (kb < nkb) {
        const bool mask = maskn; const int kpos0 = kpos0n; const bool rope = ropen;
        __syncthreads();
        kstore(rope, kpos0);
        __syncthreads();
        int nk = kb + 1;
        while (nk < nkb && !kinfo(nk, ksrc, vsrc, stride, ropen, maskn, kpos0n)) ++nk;
        if (nk < nkb) kload(ksrc, vsrc, stride);
        kb = nk;
        f32x4 sc[4][2];
#pragma unroll
        for (int sb = 0; sb < 4; ++sb) {
            f32x4 s0 = (f32x4){0.f, 0.f, 0.f, 0.f}, s1 = s0;
#pragma unroll
            for (int dh = 0; dh < 2; ++dh) {
                const bf16x8 k0 = *(const bf16x8*)(Ks + (sb * 32 + fr) * 72 + dh * 32 + fq * 8), k1 = *(const bf16x8*)(Ks + (sb * 32 + 16 + fr) * 72 + dh * 32 + fq * 8);
                s0 = __builtin_amdgcn_mfma_f32_16x16x32_bf16(k0, qf[dh], s0, 0, 0, 0);
                s1 = __builtin_amdgcn_mfma_f32_16x16x32_bf16(k1, qf[dh], s1, 0, 0, 0);
            }
            if (mask) {
#pragma unroll
                for (int j = 0; j < 4; ++j) { const int k0p = kpos0 + sb * 32 + fq * 4 + j, k1p = k0p + 16; int d0 = qpos - k0p, d1 = qpos - k1p; d0 = d0 < 0 ? -d0 : d0; d1 = d1 < 0 ? -d1 : d1;
                    if (d0 > 128) s0[j] = -1e30f; if (d1 > 128) s1[j] = -1e30f; }
            }
            sc[sb][0] = s0; sc[sb][1] = s1;
        }
        float mx = -1e30f;
#pragma unroll
        for (int sb = 0; sb < 4; ++sb)
#pragma unroll
            for (int j = 0; j < 4; ++j) mx = fmaxf(mx, fmaxf(sc[sb][0][j], sc[sb][1][j]));
        mx = fmaxf(mx, __shfl_xor(mx, 16)); mx = fmaxf(mx, __shfl_xor(mx, 32));
        const float mn = fmaxf(m, mx), alpha = __expf(m - mn);
        m = mn; lsum *= alpha; lpart *= alpha;
#pragma unroll
        for (int dt = 0; dt < 4; ++dt) oacc[dt] = oacc[dt] * alpha;
#pragma unroll
        for (int sb = 0; sb < 4; ++sb) {
            f32x4 s0 = sc[sb][0], s1 = sc[sb][1];
#pragma unroll
            for (int j = 0; j < 4; ++j) { s0[j] = __expf(s0[j] - mn); s1[j] = __expf(s1[j] - mn); lpart += s0[j] + s1[j]; }
            u32x4 pw; pw[0] = cvt_pk_bf16(s0[0], s0[1]); pw[1] = cvt_pk_bf16(s0[2], s0[3]); pw[2] = cvt_pk_bf16(s1[0], s1[1]); pw[3] = cvt_pk_bf16(s1[2], s1[3]);
            bf16x8 pf; __builtin_memcpy(&pf, &pw, 16);
#pragma unroll
            for (int dt = 0; dt < 4; ++dt) {
                const bf16_t* vp = Vt + (dt * 16 + fr) * 136 + sb * 32 + fq * 4;
                u32x4 vw; const u32x2 va = *(const u32x2*)vp, vb = *(const u32x2*)(vp + 16); vw[0] = va[0]; vw[1] = va[1]; vw[2] = vb[0]; vw[3] = vb[1];
                bf16x8 vf; __builtin_memcpy(&vf, &vw, 16);
                oacc[dt] = __builtin_amdgcn_mfma_f32_16x16x32_bf16(vf, pf, oacc[dt], 0, 0, 0);
            }
        }
    }
    lpart += __shfl_xor(lpart, 16); lpart += __shfl_xor(lpart, 32);
    lsum += lpart;
    const float inv = 1.0f / lsum;
    const size_t t = (size_t)(qbase + wid * 16 + fr);
#pragma unroll
    for (int dt = 0; dt < 4; ++dt) {
        const int col = 512 + head * 64 + dt * 16 + fq * 4;
        const bf16x4 z = *(const bf16x4*)(Z + t * DM + col);
        u32x2 w; w[0] = cvt_pk_bf16(oacc[dt][0] * inv * bf2f((bf16_t)z[0]), oacc[dt][1] * inv * bf2f((bf16_t)z[1]));
        w[1] = cvt_pk_bf16(oacc[dt][2] * inv * bf2f((bf16_t)z[2]), oacc[dt][3] * inv * bf2f((bf16_t)z[3]));
        *(u32x2*)(YS + t * DM + col) = w;
    }
}

__device__ void chunk_item(const Params& p, int l, int ci, unsigned char* ldsb) {
    const int tid = TID(), lane = tid & 63, wid = tid >> 6, fr = lane & 15, fq = lane >> 4;
    const int chunk = ci >> 2, g = ci & 3, base = chunk * 128;
    bf16_t* wsb = (bf16_t*)ldsb;
    bf16_t* vt = wsb + 128 * 136;
    const float* P = (const float*)(PWS + WS_P);
    const bf16_t* Z = (const bf16_t*)(PWS + WS_Z);
    bf16_t* YS = (bf16_t*)(PWS + WS_YS);
    const float* wsrc = PIN(11) + (size_t)(l * 4 + g) * 128 * 128;
    __syncthreads();
#pragma unroll
    for (int i = 0; i < 8; ++i) { const int idx = tid + i * 512, r = idx >> 5, c4 = (idx & 31) * 4; const f32x4 v = *(const f32x4*)(wsrc + r * 128 + c4);
        u32x2 w; w[0] = cvt_pk_bf16(v[0], v[1]); w[1] = cvt_pk_bf16(v[2], v[3]); *(u32x2*)(wsb + r * 136 + c4) = w; }
    stage_vt(P + (size_t)base * PW + C_AV + g * 64, PW, vt, 128);
    __syncthreads();
    f32x4 acc[4];
#pragma unroll
    for (int n = 0; n < 4; ++n) acc[n] = (f32x4){0.f, 0.f, 0.f, 0.f};
#pragma unroll
    for (int k = 0; k < 4; ++k) {
        const bf16x8 af = *(const bf16x8*)(wsb + (wid * 16 + fr) * 136 + k * 32 + fq * 8);
#pragma unroll
        for (int n = 0; n < 4; ++n) { const bf16x8 bfv = *(const bf16x8*)(vt + (n * 16 + fr) * 136 + k * 32 + fq * 8);
            acc[n] = __builtin_amdgcn_mfma_f32_16x16x32_bf16(bfv, af, acc[n], 0, 0, 0); }
    }
    const int i = wid * 16 + fr; const size_t t = base + i;
    const float bsi = PIN(12)[(l * 4 + g) * 128 + i];
#pragma unroll
    for (int n = 0; n < 4; ++n) { const int col = g * 64 + n * 16 + fq * 4;
        const f32x4 u = *(const f32x4*)(P + t * PW + C_AU + col);
        const bf16x4 z = *(const bf16x4*)(Z + t * DM + col);
        u32x2 w; w[0] = cvt_pk_bf16(u[0] * (acc[n][0] + bsi) * bf2f((bf16_t)z[0]), u[1] * (acc[n][1] + bsi) * bf2f((bf16_t)z[1]));
        w[1] = cvt_pk_bf16(u[2] * (acc[n][2] + bsi) * bf2f((bf16_t)z[2]), u[3] * (acc[n][3] + bsi) * bf2f((bf16_t)z[3]));
        *(u32x2*)(YS + t * DM + col) = w; }
}

__device__ void pool_item(const Params& p, int l, int pi, unsigned char* ldsb) {
    const int tid = TID(), lane = tid & 63, wid = tid >> 6, fr = lane & 15, fq = lane >> 4, half = tid >> 8, ch = tid & 255, g = ch >> 6;
    const int tb = pi * 32; int seqbase, L, pos0; seq_of(tb, seqbase, L, pos0);
    float* pt = (float*)ldsb;
    bf16_t* dl = (bf16_t*)(pt + 48 * 256);
    bf16_t* wt = dl + 32 * 264;
    const float* P = (const float*)(PWS + WS_P);
    const bf16_t* Z = (const bf16_t*)(PWS + WS_Z);
    bf16_t* YS = (bf16_t*)(PWS + WS_YS);
    __syncthreads();
#pragma unroll
    for (int i = 0; i < 6; ++i) { const int idx = tid + i * 512, rr = idx >> 6, c4 = (idx & 63) * 4; const int pos = pos0 - 8 + rr;
        f32x4 v = (f32x4){0.f, 0.f, 0.f, 0.f};
        if (pos >= 0 && pos < L) v = *(const f32x4*)(P + (size_t)(seqbase + pos) * PW + C_DP + c4);
        *(f32x4*)(pt + rr * 256 + c4) = v; }
    { const float* pwsrc = PIN(23) + (size_t)l * 4 * 64 * 64;
#pragma unroll
      for (int gg = 0; gg < 4; ++gg) stage_vt(pwsrc + gg * 4096, 64, wt + gg * 64 * 72, 64, 72); }
    __syncthreads();
    const int w = 2 << g;
    for (int i = 0; i < 16; ++i) { const int tk = half * 16 + i, pos = pos0 + tk;
        int lo = pos - (w >> 1), hi = lo + w; lo = lo < 0 ? 0 : lo; hi = hi > L ? L : hi;
        float sm = 0.f;
        for (int q = lo; q < hi; ++q) sm += pt[(q - pos0 + 8) * 256 + ch];
        dl[tk * 264 + ch] = f2bf(sm / (float)(hi - lo) - pt[(tk + 8) * 256 + ch]); }
    __syncthreads();
    const int gw = wid >> 1, th = wid & 1;
    f32x4 acc[4];
#pragma unroll
    for (int n = 0; n < 4; ++n) acc[n] = (f32x4){0.f, 0.f, 0.f, 0.f};
#pragma unroll
    for (int k = 0; k < 2; ++k) {
        const bf16x8 af = *(const bf16x8*)(dl + (th * 16 + fr) * 264 + gw * 64 + k * 32 + fq * 8);
#pragma unroll
        for (int n = 0; n < 4; ++n) { const bf16x8 bfv = *(const bf16x8*)(wt + (gw * 64 + n * 16 + fr) * 72 + k * 32 + fq * 8);
            acc[n] = __builtin_amdgcn_mfma_f32_16x16x32_bf16(bfv, af, acc[n], 0, 0, 0); }
    }
    const size_t t = tb + th * 16 + fr;
#pragma unroll
    for (int n = 0; n < 4; ++n) { const int oc = gw * 64 + n * 16 + fq * 4;
        const f32x4 sc = *(const f32x4*)(PIN(24) + l * 256 + oc);
        const bf16x4 z = *(const bf16x4*)(Z + t * DM + 768 + oc);
        u32x2 wv; wv[0] = cvt_pk_bf16(acc[n][0] * sc[0] * bf2f((bf16_t)z[0]), acc[n][1] * sc[1] * bf2f((bf16_t)z[1]));
        wv[1] = cvt_pk_bf16(acc[n][2] * sc[2] * bf2f((bf16_t)z[2]), acc[n][3] * sc[3] * bf2f((bf16_t)z[3]));
        *(u32x2*)(YS + t * DM + 768 + oc) = wv; }
}

__device__ void phaseB1(const Params& p, int l, unsigned char* lds, int slot = 0, int part = 127) {
    const int tid = TID(), wid = tid >> 6;
    float* wl = (float*)lds + wid * 3072;
    if (!(part & 1)) {} else
    { const int nbh = (int)gridDim.x >> 1;
      if ((int)blockIdx.x < nbh) { if (wid < 4 && (part & 4)) for (int it = blockIdx.x * 4 + wid; it < 512; it += nbh * 4) { const int q = it >> 4, b = q >> 3;
            scan_run<1>(p, l, true, b, (q >> 1) & 3, q & 1, it & 15, 1024, NTP + b * 1024, wl); } }
      else { const int nb2 = (int)gridDim.x - nbh; if (part & 8) for (int it = ((int)blockIdx.x - nbh) * 8 + wid; it < 1024; it += nb2 * 8) { const int q = it >> 3, b = q >> 3;
            scan_run<2>(p, l, false, b, (q >> 1) & 3, q & 1, it & 7, 256, b * 256, wl); } } }
    __syncthreads();
    __shared__ int s_item;
    unsigned* ctr = (unsigned*)(PWS + WS_CTR) + l + 2 * slot;
    if (part & 2)
    for (;;) {
        if (tid == 0) s_item = (int)atomicAdd(ctr, 1u);
        __syncthreads();
        const int item = s_item;
        __syncthreads();
        if (item >= 768) break;
        if (item < 256) { if (part & 16) attn_item(p, l, item, lds); }
        else if (item < 512) { if (part & 32) chunk_item(p, l, item - 256, lds); }
        else { if (part & 64) pool_item(p, l, item - 512, lds); }
    }
}

__device__ void phaseB2(const Params& p, int l) {
    const int lane = TID() & 63, gw = blockIdx.x * 8 + (TID() >> 6), W = gridDim.x * 8;
    const float* O = (const float*)(PWS + WS_O);
    const float* recS = (const float*)(PWS + WS_RECS);
    const float* BC = (const float*)(PWS + WS_BC);
    const bf16_t* Z = (const bf16_t*)(PWS + WS_Z);
    bf16_t* YS = (bf16_t*)(PWS + WS_YS);
    const float* lng = PIN(20) + l * 256; const float* lnb = PIN(21) + l * 256;
    float g4[4], b4[4];
#pragma unroll
    for (int h = 0; h < 4; ++h) { g4[h] = lng[h * 64 + lane]; b4[h] = lnb[h * 64 + lane]; }
    for (int tok = gw; tok < NT; tok += W) {
        int seqbase, L, pos; seq_of(tok, seqbase, L, pos);
        float o[4], vv[4], z[4], mu[4], var[4];
        const f32x4 bc = *(const f32x4*)(BC + tok * 4);
#pragma unroll
        for (int h = 0; h < 4; ++h) { const int c = h * 64 + lane;
            o[h] = __builtin_nontemporal_load(O + (size_t)tok * 256 + c) + __builtin_nontemporal_load(O + (size_t)NT * 256 + (size_t)tok * 256 + c);
            vv[h] = recS[((size_t)seqbase * 4 + (size_t)h * L + pos) * 192 + 128 + lane];
            z[h] = bf2f(Z[(size_t)tok * DM + 256 + c]); }
#pragma unroll
        for (int h = 0; h < 4; ++h) mu[h] = wave_sum(o[h]) * (1.0f / 64.0f);
#pragma unroll
        for (int h = 0; h < 4; ++h) { o[h] -= mu[h]; var[h] = wave_sum(o[h] * o[h]) * (1.0f / 64.0f); }
#pragma unroll
        for (int h = 0; h < 4; ++h) { const float on = o[h] * rsqrtf(var[h] + 64e-5f);
            const float y = on * g4[h] + b4[h] + bc[h] * vv[h];
            YS[(size_t)tok * DM + 256 + h * 64 + lane] = f2bf(y * z[h]); }
    }
}

__device__ void phaseC1(const Params& p, int l, unsigned char* lds) {
    pg8::Gemm g; g.A = (const bf16_t*)(PWS + WS_H); g.Bt = (const bf16_t*)(PWS + WS_WTIN) + (size_t)l * INW * 1024 + (size_t)NA_COLS * 1024; g.M = NT; g.N = 4096; g.K = 1024;
    pg8::StaticOrder S; S.init(g.M, g.N, (int)gridDim.x, (int)blockIdx.x);
    EpiG E; E.G = (bf16_t*)(PWS + WS_G);
    pg8::gemm_phase<EpiG, pg8::StaticOrder, false>((PG8_LAS unsigned char*)lds, g, S, E, nullptr);
    __syncthreads();
}
__device__ void phaseC2(const Params& p, int l, unsigned char* lds) {
    constexpr int MT = 4, LDT = 72, A_BYTES = 256 * LDT * 2, B_BYTES = 128 * LDT * 2, BUF = A_BYTES + B_BYTES;
    const int tid = TID(), lane = tid & 63, wid = tid >> 6, wr = wid >> 1, wc = wid & 1, fr = lane & 15, fq = lane >> 4;
    const bf16_t* YS = (const bf16_t*)(PWS + WS_YS);
    const bf16_t* G = (const bf16_t*)(PWS + WS_G);
    const bf16_t* Wu = (const bf16_t*)(PWS + WS_WTUP) + (size_t)l * 4 * 1024 * 256;
    bf16_t* MG = (bf16_t*)(PWS + WS_MERGED);
    const int srow = tid >> 3, skc = tid & 7, soff = (srow * LDT + skc * 8) * 2;
    const int aoff = ((wr * MT * 16 + fr) * LDT + fq * 8) * 2, boff = A_BYTES + ((wc * 64 + fr) * LDT + fq * 8) * 2;
    const int NU = 32 * 8;
    for (int u = blockIdx.x; u < NU; u += gridDim.x) {
        const int pn = u / 32, pm = u % 32;
        const bf16_t* Ag = YS + ((size_t)pm * 256 + srow) * 1024 + skc * 8;
        const bf16_t* Bg = Wu + ((size_t)pn * 128 + srow) * 256 + skc * 8;
        f32x4 mg[4][4], acc[4][4]; zero_acc<4>(mg); zero_acc<4>(acc);
        u32x4 ra[MT], rb[2];
        auto gload = [&](int kt) {
#pragma unroll
            for (int i = 0; i < MT; ++i) ra[i] = *(const u32x4*)(Ag + (size_t)i * 64 * 1024 + kt * 64);
            const bf16_t* bb = Bg + (size_t)(kt >> 2) * 1024 * 256 + (kt & 3) * 64;
#pragma unroll
            for (int i = 0; i < 2; ++i) rb[i] = *(const u32x4*)(bb + (size_t)i * 64 * 256);
        };
        auto sstore = [&](int buf) { unsigned char* nb = lds + buf * BUF;
#pragma unroll
            for (int i = 0; i < MT; ++i) *(u32x4*)(nb + soff + i * 64 * LDT * 2) = ra[i];
#pragma unroll
            for (int i = 0; i < 2; ++i) *(u32x4*)(nb + A_BYTES + soff + i * 64 * LDT * 2) = rb[i];
        };
        __syncthreads();
        gload(0); sstore(0);
        __syncthreads();
        for (int t = 0; t < 16; ++t) {
            if (t + 1 < 16) gload(t + 1);
            const unsigned char* base = lds + (t & 1) * BUF;
#pragma unroll
            for (int kk = 0; kk < 2; ++kk) {
                bf16x8 af[MT], bfr[4];
#pragma unroll
                for (int m = 0; m < MT; ++m) af[m] = *(const bf16x8*)(base + aoff + m * 16 * LDT * 2 + kk * 64);
#pragma unroll
                for (int n = 0; n < 4; ++n) bfr[n] = *(const bf16x8*)(base + boff + n * 16 * LDT * 2 + kk * 64);
#pragma unroll
                for (int m = 0; m < MT; ++m)
#pragma unroll
                    for (int n = 0; n < 4; ++n) acc[m][n] = __builtin_amdgcn_mfma_f32_16x16x32_bf16(bfr[n], af[m], acc[m][n], 0, 0, 0);
            }
            if (t + 1 < 16) sstore((t + 1) & 1);
            if ((t & 3) == 3) {
                const int n = t >> 2;
#pragma unroll
                for (int m = 0; m < 4; ++m) { const int row = pm * 256 + wr * 64 + m * 16 + fr;
                    const bf16_t* gp = G + g_off(row, n * 1024 + pn * 128 + wc * 64 + fq * 4);
                    const bf16x8 ga = __builtin_nontemporal_load((const bf16x8*)gp), gb = __builtin_nontemporal_load((const bf16x8*)(gp + 8));
#pragma unroll
                    for (int q = 0; q < 4; ++q) {
#pragma unroll
                        for (int j = 0; j < 4; ++j) { const bf16_t gv = (bf16_t)(q < 2 ? ga[q * 4 + j] : gb[(q - 2) * 4 + j]); mg[m][q][j] += bf2f(gv) * acc[m][q][j]; }
                        acc[m][q] = (f32x4){0.f, 0.f, 0.f, 0.f}; } }
            }
            __syncthreads();
        }
#pragma unroll
        for (int m = 0; m < 4; ++m) { const size_t row = (size_t)pm * 256 + wr * 64 + m * 16 + fr;
#pragma unroll
            for (int q = 0; q < 4; ++q) { const int col = pn * 128 + wc * 64 + q * 16 + fq * 4;
                u32x2 w; w[0] = cvt_pk_bf16(mg[m][q][0], mg[m][q][1]); w[1] = cvt_pk_bf16(mg[m][q][2], mg[m][q][3]);
                __hip_atomic_store((unsigned long long*)(MG + row * DM + col), ((unsigned long long)w[1] << 32) | w[0], __ATOMIC_RELAXED, __HIP_MEMORY_SCOPE_AGENT); } }
        asm volatile("s_waitcnt vmcnt(0)" ::: "memory");
        __syncthreads();
        if (tid == 0) __hip_atomic_fetch_add((unsigned*)(PWS + WS_XCNT) + (size_t)((2 + l) * 32 + pm) * 64, 1u, __ATOMIC_RELAXED, __HIP_MEMORY_SCOPE_AGENT);
    }
}

__device__ void phaseD(const Params& p, int l, unsigned char* lds) {
    const int tid = TID(), lane = tid & 63, wid = tid >> 6, wr = wid >> 1, wc = wid & 1, fr = lane & 15, fq = lane >> 4;
    const bf16_t* MG = (const bf16_t*)(PWS + WS_MERGED);
    const bf16_t* Wo = (const bf16_t*)(PWS + WS_WTO) + (size_t)l * 1024 * 1024;
    const int NU = 32 * 8;
    for (int u = blockIdx.x; u < NU; u += gridDim.x) {
        const int pn = u / 32, pm = u % 32;
        if (tid == 0) { unsigned* c2 = (unsigned*)(PWS + WS_XCNT) + (size_t)((2 + l) * 32 + pm) * 64; unsigned spins = 0;
            while (__hip_atomic_load(c2, __ATOMIC_RELAXED, __HIP_MEMORY_SCOPE_AGENT) < 8u) { __builtin_amdgcn_s_sleep(2); if (++spins > (1u << 22)) break; }
            __builtin_amdgcn_fence(__ATOMIC_ACQUIRE, "agent");
            asm volatile("s_waitcnt vmcnt(0)" ::: "memory"); }
        __syncthreads();
        f32x4 acc[4][4]; zero_acc<4>(acc);
        gemm_acc<4>(MG + (size_t)pm * 256 * 1024, 1024, Wo + (size_t)pn * 128 * 1024, 1024, 1024, acc, lds);
        float ssq[4];
#pragma unroll
        for (int m = 0; m < 4; ++m) { const int row = pm * 256 + wr * 64 + m * 16 + fr;
            const float* xr = xrow_ptr(p, l, row);
            const float* gate = (const float*)(PWS + WS_MOD) + (size_t)(l * 5 + modrow_of(row)) * 3072 + 2048;
            float sm = 0.f;
#pragma unroll
            for (int q = 0; q < 4; ++q) { const int col = pn * 128 + wc * 64 + q * 16 + fq * 4;
                const f32x4 xo = __builtin_nontemporal_load((const f32x4*)(xr + col)), gt = *(const f32x4*)(gate + col);
                acc[m][q] = xo + gt * acc[m][q];
                sm += (acc[m][q][0] * acc[m][q][0] + acc[m][q][1] * acc[m][q][1]) + (acc[m][q][2] * acc[m][q][2] + acc[m][q][3] * acc[m][q][3]); }
            sm += __shfl_xor(sm, 16); sm += __shfl_xor(sm, 32);
            ssq[m] = sm; }
        float* Pt = (float*)lds;
        float* St = Pt + 512;
        if (fq == 0) {
#pragma unroll
            for (int m = 0; m < 4; ++m) Pt[(wr * 64 + m * 16 + fr) * 2 + wc] = ssq[m]; }
        __syncthreads();
        float* XP = (float*)(PWS + WS_XP) + ((size_t)(l * 32 + pm) * 256) * 8;
        unsigned* cnt = (unsigned*)(PWS + WS_XCNT) + (size_t)(l * 32 + pm) * 64;
        if (tid < 256) __hip_atomic_store(XP + tid * 8 + pn, Pt[tid * 2] + Pt[tid * 2 + 1], __ATOMIC_RELAXED, __HIP_MEMORY_SCOPE_AGENT);
        asm volatile("s_waitcnt vmcnt(0)" ::: "memory");
        __syncthreads();
        if (tid == 0) {
            __hip_atomic_fetch_add(cnt, 1u, __ATOMIC_RELAXED, __HIP_MEMORY_SCOPE_AGENT);
            unsigned spins = 0;
            while (__hip_atomic_load(cnt, __ATOMIC_RELAXED, __HIP_MEMORY_SCOPE_AGENT) < 8u) { __builtin_amdgcn_s_sleep(2); if (++spins > (1u << 22)) break; }
            __builtin_amdgcn_fence(__ATOMIC_ACQUIRE, "agent");
            asm volatile("s_waitcnt vmcnt(0)" ::: "memory");
        }
        __syncthreads();
        if (tid < 256) { float t = 0.f;
#pragma unroll
            for (int k = 0; k < 8; ++k) t += __hip_atomic_load(XP + tid * 8 + k, __ATOMIC_RELAXED, __HIP_MEMORY_SCOPE_AGENT);
            St[tid] = rsqrtf(t * (1.0f / 1024.0f) + 1e-6f); }
        __syncthreads();
        const float* gn = (l == 0) ? PIN(9) + DM : PIN(27);
        bf16_t* H = (bf16_t*)(PWS + WS_H);
#pragma unroll
        for (int m = 0; m < 4; ++m) { const int rl_ = wr * 64 + m * 16 + fr, row = pm * 256 + rl_;
            const float rs = St[rl_];
            const float* md = (const float*)(PWS + WS_MOD) + (size_t)(5 + modrow_of(row)) * 3072;
#pragma unroll
            for (int q = 0; q < 4; ++q) { const int col = pn * 128 + wc * 64 + q * 16 + fq * 4;
                const f32x4 gg = *(const f32x4*)(gn + col);
                if (l == 0) { *(f32x4*)(POUT + (size_t)row * DM + col) = acc[m][q];
                    const f32x4 sh = *(const f32x4*)(md + col), scl = *(const f32x4*)(md + 1024 + col);
                    const f32x4 h = acc[m][q] * rs * gg * (1.0f + scl) + sh;
                    u32x2 w; w[0] = cvt_pk_bf16(h[0], h[1]); w[1] = cvt_pk_bf16(h[2], h[3]); *(u32x2*)(H + (size_t)row * DM + col) = w; }
                else *(f32x4*)(POUT + (size_t)row * DM + col) = acc[m][q] * rs * gg; } }
    }
}

__device__ void phaseF(const Params& p) {
    const int lane = TID() & 63, gw = blockIdx.x * 8 + (TID() >> 6), W = gridDim.x * 8;
    const float* g = PIN(27);
    for (int row = gw; row < NT; row += W) {
        float* x = POUT + (size_t)row * DM;
        f32x4 v[4]; float ss = 0.f;
#pragma unroll
        for (int i = 0; i < 4; ++i) { v[i] = *(const f32x4*)(x + i * 256 + lane * 4); ss += v[i][0] * v[i][0] + v[i][1] * v[i][1] + v[i][2] * v[i][2] + v[i][3] * v[i][3]; }
        ss = wave_sum(ss);
        const float rs = rsqrtf(ss * (1.0f / 1024.0f) + 1e-6f);
#pragma unroll
        for (int i = 0; i < 4; ++i) { const int c = i * 256 + lane * 4; *(f32x4*)(x + c) = v[i] * rs * *(const f32x4*)(g + c); }
    }
}

__global__ void __launch_bounds__(NTHREADS) fwd_megakernel(Params p) {
    extern __shared__ __attribute__((aligned(16))) unsigned char lds[];
    volatile LAS unsigned* st = (volatile LAS unsigned*)(lds + LDS_MAIN);
    if (threadIdx.x < 2) st[threadIdx.x] = 0u;
    if (threadIdx.x == 0) {
#pragma unroll
        for (int i = 0; i < 28; ++i) s_ptab[i] = (unsigned long long)p.in[i];
    }
    __syncthreads();
    const XcdBarrier xb = xcd_barrier_post((unsigned*)(PWS + WS_BAR), st);
#define GSYNC() xcd_barrier(xb)
    phase0(p, lds);
    GSYNC();
#pragma unroll 1
    for (int l = 0; l < 2; ++l) {
#pragma unroll 1
        for (int ap = 0; ap < 2; ++ap) { phaseA(p, l, lds, ap); if (ap == 0) GSYNC(); }
        phaseB0(p, l, lds);
        GSYNC();
        phaseB1(p, l, lds);
        GSYNC();
        phaseB2(p, l);
        phaseC1(p, l, lds);
        GSYNC();
        phaseC2(p, l, lds);
        phaseD(p, l, lds);
        if (l == 0) GSYNC();
    }
}

extern "C" void kernel_launch(void* const* d_in, const int* in_sizes, int n_in, void* d_out, int out_size, void* d_ws, size_t ws_size, hipStream_t stream) {
    static int grid_blocks = 0;
    if (!grid_blocks) {
        int dev = 0, cus = 0, per_cu = 0;
        hipGetDevice(&dev);
        hipDeviceGetAttribute(&cus, hipDeviceAttributeMultiprocessorCount, dev);
        hipFuncSetAttribute((const void*)fwd_megakernel, hipFuncAttributeMaxDynamicSharedMemorySize, LDS_BYTES);
        hipOccupancyMaxActiveBlocksPerMultiprocessor(&per_cu, (const void*)fwd_megakernel, NTHREADS, LDS_BYTES);
        if (per_cu < 1) { fprintf(stderr, "occupancy query returned %d\n", per_cu); per_cu = 1; }
        if (per_cu > 1) per_cu = 1;
        grid_blocks = cus * per_cu;
        if (ws_size < WS_END) fprintf(stderr, "workspace too small: %zu < %zu\n", ws_size, (size_t)WS_END);
    }
    Params p{};
    for (int i = 0; i < 28; ++i) p.in[i] = (const float*)d_in[i];
    p.out = (float*)d_out; p.ws = (unsigned char*)d_ws;
    hipMemsetAsync((char*)d_ws + WS_CTR, 0, 256 + 3456 * 4, stream);
    void* args[] = {&p};
    hipError_t e = hipLaunchCooperativeKernel((const void*)fwd_megakernel, dim3(grid_blocks), dim3(NTHREADS), args, LDS_BYTES, stream);
    if (e != hipSuccess) fprintf(stderr, "cooperative launch failed: %s (grid %d)\n", hipGetErrorString(e), grid_blocks);
}
```

```cpp
#include <hip/hip_runtime.h>
#include <hip/hip_cooperative_groups.h>
#include <cstdio>
namespace cg = cooperative_groups;

typedef unsigned short bf16_t;
typedef short bf16x8 __attribute__((ext_vector_type(8)));
typedef short bf16x4 __attribute__((ext_vector_type(4)));
typedef float f32x4 __attribute__((ext_vector_type(4)));
typedef float f32x2 __attribute__((ext_vector_type(2)));
typedef unsigned u32x4 __attribute__((ext_vector_type(4)));
typedef unsigned u32x2 __attribute__((ext_vector_type(2)));

constexpr int NT = 8192, NTP = 4096, DM = 1024, INW = 7296, NA_COLS = 3200, PW = 2176;
constexpr int NTHREADS = 512;
constexpr int C_AU = 0, C_AV = 256, C_BR = 512, C_BK = 768, C_BV = 1024, C_WD = 1280, C_AD = 1344, C_CQ = 1408, C_CK = 1664, C_CV = 1792, C_DP = 1920;
constexpr size_t O_YP = 0, O_YS = 4194304, O_NK = 8388608, O_NV = 9437184, O_NS = 10485760;
constexpr size_t WS_WTIN = 0;
constexpr size_t WS_WTUP = WS_WTIN + (size_t)2 * INW * DM * 2;
constexpr size_t WS_WTO  = WS_WTUP + (size_t)2 * 4 * 1024 * 256 * 2;
constexpr size_t WS_MOD  = WS_WTO + (size_t)2 * 1024 * 1024 * 2;
constexpr size_t WS_ROPE = WS_MOD + (size_t)2 * 5 * 3072 * 4;
constexpr size_t WS_CTR  = WS_ROPE + 64 * 16 * 8;
constexpr size_t WS_BAR  = WS_CTR + 256;
constexpr size_t WS_H    = WS_BAR + 3456 * 4;
constexpr size_t WS_P    = WS_H + (size_t)NT * DM * 2;
constexpr size_t WS_Z    = WS_P + (size_t)NT * PW * 4;
constexpr size_t WS_RECS = WS_Z + (size_t)NT * DM * 2;
constexpr size_t WS_RECD = WS_RECS + (size_t)NT * 4 * 192 * 4;
constexpr size_t WS_O    = WS_RECD + (size_t)2 * NT * 4 * 192 * 4;
constexpr size_t WS_BC   = WS_O + (size_t)2 * NT * 256 * 4;
constexpr size_t WS_YS   = WS_BC + (size_t)NT * 4 * 4;
constexpr size_t WS_LORAT = WS_YS + (size_t)NT * DM * 2;
constexpr size_t WS_XP   = WS_LORAT + (size_t)2 * 4 * 256 * 64 * 2;
constexpr size_t WS_XCNT = WS_XP + (size_t)2 * 32 * 256 * 8 * 4;
constexpr size_t WS_END  = WS_XCNT + (size_t)4 * 32 * 256;
constexpr size_t WS_G = WS_P;
constexpr size_t WS_MERGED = WS_RECS;
constexpr size_t RECD_STRIDE = (size_t)NT * 4 * 192;

constexpr int LDS_MAIN = 131072;
constexpr int LDS_BYTES = LDS_MAIN + 16;

struct Params {
    const float* in[28];
    float* out;
    unsigned char* ws;
};
__shared__ unsigned long long s_ptab[28];
__device__ __forceinline__ const float* ld_inptr(int k) {
    const unsigned long long v = s_ptab[k];
    const unsigned lo = __builtin_amdgcn_readfirstlane((unsigned)v), hi = __builtin_amdgcn_readfirstlane((unsigned)(v >> 32));
    return (const float*)(((unsigned long long)hi << 32) | lo);
}
#define PIN(k) (ld_inptr(k))
#define POUT (p.out)
#define PWS (p.ws)

__device__ __forceinline__ int TID() { int t = threadIdx.x; asm volatile("" : "+v"(t)); return t; }
__device__ __forceinline__ unsigned cvt_pk_bf16(float lo, float hi) { unsigned r; asm volatile("v_cvt_pk_bf16_f32 %0, %1, %2" : "=v"(r) : "v"(lo), "v"(hi)); return r; }
__device__ __forceinline__ bf16_t f2bf(float f) { return (bf16_t)(cvt_pk_bf16(f, 0.f) & 0xffffu); }
__device__ __forceinline__ float bf2f(bf16_t b) { return __uint_as_float(((unsigned)b) << 16); }
__device__ __forceinline__ float sigmoidf_(float x) { return 1.0f / (1.0f + __expf(-x)); }
__device__ __forceinline__ float siluf_(float x) { return x / (1.0f + __expf(-x)); }
template <int CTRL> __device__ __forceinline__ float dpp_f(float x) { return __int_as_float(__builtin_amdgcn_update_dpp(0, __float_as_int(x), CTRL, 0xF, 0xF, false)); }
__device__ __forceinline__ float row16_sum(float x) {
    x += dpp_f<0x128>(x); x += dpp_f<0x124>(x); x += dpp_f<0x122>(x); x += dpp_f<0x121>(x); return x;
}
__device__ __forceinline__ float wave_sum(float v) { v = row16_sum(v); v += __shfl_xor(v, 16); v += __shfl_xor(v, 32); return v; }
__device__ __forceinline__ void seq_of(int tok, int& seqbase, int& L, int& pos) {
    if (tok < NTP) { seqbase = tok & ~255; L = 256; pos = tok & 255; }
    else { int t2 = tok - NTP; seqbase = NTP + (t2 & ~1023); L = 1024; pos = t2 & 1023; }
}
__device__ __forceinline__ int modrow_of(int tok) { return tok < NTP ? 0 : 1 + ((tok - NTP) >> 10); }


#define XB_TMO      128
#define XB_XCNT(j)  (256  + 64 * (j))
#define XB_XSUB(j)  (1280 + 64 * (j))
#define XB_XGEN(j)  (2304 + 64 * (j))
#define XB_TOP      3328
#define XB_TOPGEN   3392
#define XCD_BAR_WORDS 3456
#define XB_SPIN_CAP (1u << 18)
#define LAS __attribute__((address_space(3)))
__device__ __forceinline__ unsigned xb_ld(unsigned* p)              { return __hip_atomic_load(p, __ATOMIC_RELAXED, __HIP_MEMORY_SCOPE_AGENT); }
__device__ __forceinline__ unsigned xb_add(unsigned* p, unsigned v) { return __hip_atomic_fetch_add(p, v, __ATOMIC_RELAXED, __HIP_MEMORY_SCOPE_AGENT); }
__device__ __forceinline__ unsigned xb_xcc_id() { return (unsigned)__builtin_amdgcn_s_getreg((3 << 11) | 20) & 0xFu; }
#define XB_SPIN(cond, bar) do { unsigned _sp = 0; while (cond) { __builtin_amdgcn_s_sleep(1); \
    if ((++_sp & 255u) == 0u) { if (xb_ld(&(bar)[XB_TMO])) break; if (_sp > XB_SPIN_CAP) { atomicAdd(&(bar)[XB_TMO], 1u); break; } } } } while (0)
struct XcdBarrier { unsigned* bar; unsigned x; volatile LAS unsigned* st; };
__device__ __forceinline__ XcdBarrier xcd_barrier_post(unsigned* bar, volatile LAS unsigned* st) {
    XcdBarrier b; b.bar = bar; b.x = xb_xcc_id(); b.st = st;
    if (threadIdx.x == 0) (void)xb_add(&bar[XB_XCNT(b.x)], 1u);
    return b;
}
__device__ __forceinline__ void xcd_barrier_complete(unsigned* bar, unsigned x, unsigned& nloc, unsigned& nx) {
    const unsigned G = gridDim.x * gridDim.y * gridDim.z;
    unsigned sum, cnt, mine, sp = 0u;
    for (;;) {
        sum = 0u; cnt = 0u; mine = 0u;
#pragma unroll
        for (unsigned j = 0; j < 16; ++j) { const unsigned c = xb_ld(&bar[XB_XCNT(j)]); sum += c; cnt += (c > 0u) ? 1u : 0u; mine = (j == x) ? c : mine; }
        if (sum == G) break;
        __builtin_amdgcn_s_sleep(1);
        if ((++sp & 255u) == 0u) { if (xb_ld(&bar[XB_TMO])) break; if (sp > XB_SPIN_CAP) { atomicAdd(&bar[XB_TMO], 1u); break; } }
    }
    nloc = mine > 0u ? mine : 1u; nx = cnt > 0u ? cnt : 1u;
}
__device__ __forceinline__ void xcd_barrier(const XcdBarrier& b0) {
    asm volatile("s_waitcnt vmcnt(0)" ::: "memory");
    __syncthreads();
    if (threadIdx.x == 0) {
        XcdBarrier b = b0;
        { unsigned xx = xb_xcc_id(); asm volatile("" : "+s"(xx)); b.x = xx; }
        unsigned* bar = b.bar;
        __builtin_amdgcn_s_waitcnt(0);
        unsigned nloc = b.st[0], nx = b.st[1];
        if (nloc == 0u) { xcd_barrier_complete(bar, b.x, nloc, nx); b.st[0] = nloc; b.st[1] = nx; }
        const unsigned old = xb_add(&bar[XB_XSUB(b.x)], 1u);
        const unsigned gen = old / nloc;
        if (old + 1u == (gen + 1u) * nloc) {
            __builtin_amdgcn_fence(__ATOMIC_RELEASE, "agent");
            asm volatile("s_waitcnt vmcnt(0)" ::: "memory");
            const unsigned og = xb_add(&bar[XB_TOP], 1u);
            const unsigned tg = og / nx;
            if (og + 1u == (tg + 1u) * nx) xb_add(&bar[XB_TOPGEN], 1u);
            else XB_SPIN(xb_ld(&bar[XB_TOPGEN]) == tg, bar);
            __builtin_amdgcn_fence(__ATOMIC_ACQUIRE, "agent");
            xb_add(&bar[XB_XGEN(b.x)], 1u);
            asm volatile("s_waitcnt vmcnt(0)" ::: "memory");
        } else {
            XB_SPIN(xb_ld(&bar[XB_XGEN(b.x)]) == gen, bar);
            __builtin_amdgcn_fence(__ATOMIC_ACQUIRE, "agent");
            asm volatile("s_waitcnt vmcnt(0)" ::: "memory");
        }
    }
    __syncthreads();
}

__device__ void conv_tile(const float* __restrict__ src, int N, bf16_t* __restrict__ dst, int K, int kt, int nt, float* tile) {
    const int tid = TID();
    { const int r = tid >> 4, c4 = (tid & 15) * 4;
#pragma unroll
      for (int i = 0; i < 2; ++i) { const int k = r + 32 * i; const f32x4 v = __builtin_nontemporal_load((const f32x4*)(src + (size_t)(kt * 64 + k) * N + nt * 64 + c4));
          tile[k * 65 + c4 + 0] = v[0]; tile[k * 65 + c4 + 1] = v[1]; tile[k * 65 + c4 + 2] = v[2]; tile[k * 65 + c4 + 3] = v[3]; } }
    __syncthreads();
    { const int n = tid >> 3, kc = (tid & 7) * 8; u32x4 w;
      w[0] = cvt_pk_bf16(tile[(kc + 0) * 65 + n], tile[(kc + 1) * 65 + n]); w[1] = cvt_pk_bf16(tile[(kc + 2) * 65 + n], tile[(kc + 3) * 65 + n]);
      w[2] = cvt_pk_bf16(tile[(kc + 4) * 65 + n], tile[(kc + 5) * 65 + n]); w[3] = cvt_pk_bf16(tile[(kc + 6) * 65 + n], tile[(kc + 7) * 65 + n]);
      *(u32x4*)(dst + (size_t)(nt * 64 + n) * K + kt * 64 + kc) = w; }
    __syncthreads();
}

__device__ void mod_item(const Params& p, int l, int cc, float* lds) {
    const int tid = TID();
    float* sc = lds;
    float* red = lds + 5120;
    for (int i = tid; i < 5120; i += NTHREADS) { const int r = i >> 10, k = i & 1023; const float v = (r == 0) ? PIN(6)[k] : PIN(5)[(r - 1) * 1024 + k]; sc[i] = siluf_(v); }
    __syncthreads();
    const int kg = tid >> 5, c = tid & 31, col = cc * 32 + c;
    float a[5] = {0.f, 0.f, 0.f, 0.f, 0.f};
    const float* w = PIN(7) + (size_t)l * 1024 * 3072 + col;
#pragma unroll 16
    for (int k = kg * 64; k < kg * 64 + 64; ++k) { const float wv = __builtin_nontemporal_load(w + (size_t)k * 3072);
#pragma unroll
        for (int r = 0; r < 5; ++r) a[r] += sc[r * 1024 + k] * wv; }
#pragma unroll
    for (int r = 0; r < 5; ++r) red[(kg * 5 + r) * 32 + c] = a[r];
    __syncthreads();
    if (tid < 160) { const int r = tid >> 5, c2 = tid & 31; float s = PIN(8)[l * 3072 + cc * 32 + c2];
        for (int g = 0; g < 16; ++g) s += red[(g * 5 + r) * 32 + c2];
        __hip_atomic_store((float*)(PWS + WS_MOD) + (l * 5 + r) * 3072 + cc * 32 + c2, s, __ATOMIC_RELAXED, __HIP_MEMORY_SCOPE_AGENT); }
    asm volatile("s_waitcnt vmcnt(0)" ::: "memory");
    __syncthreads();
    if (tid == 0 && l == 0) __hip_atomic_fetch_add((unsigned*)(PWS + WS_CTR) + 16, 1u, __ATOMIC_RELAXED, __HIP_MEMORY_SCOPE_AGENT);
}

__device__ void phaseA0(const Params& p, int l);
__device__ void phase0(const Params& p, unsigned char* lds) {
    const int NCONV_IN = 2 * 16 * 114, NCONV_UP = 8 * 64, NCONV_O = 2 * 256, NCONV_L = 32, NMOD = 192;
    const int total = NCONV_IN + NCONV_UP + NCONV_O + NCONV_L + NMOD + 1;
    for (int it = blockIdx.x; it < total; it += gridDim.x) {
        int i = it;
        if (i < NMOD) { mod_item(p, i / 96, i % 96, (float*)lds); continue; }
        i -= NMOD;
        if (i < NCONV_IN) { const int l = i / 1824, r = i % 1824, nt = r / 16, kt = r % 16;
            conv_tile(PIN(10) + (size_t)l * 1024 * INW, INW, (bf16_t*)(PWS + WS_WTIN) + (size_t)l * INW * 1024, 1024, kt, nt, (float*)lds); continue; }
        i -= NCONV_IN;
        if (i < NCONV_UP) { const int mtx = i / 64, r = i % 64, nt = r / 4, kt = r % 4;
            conv_tile(PIN(25) + (size_t)mtx * 256 * 1024, 1024, (bf16_t*)(PWS + WS_WTUP) + (size_t)mtx * 1024 * 256, 256, kt, nt, (float*)lds); continue; }
        i -= NCONV_UP;
        if (i < NCONV_O) { const int l = i / 256, r = i % 256, nt = r / 16, kt = r % 16;
            conv_tile(PIN(26) + (size_t)l * 1024 * 1024, 1024, (bf16_t*)(PWS + WS_WTO) + (size_t)l * 1024 * 1024, 1024, kt, nt, (float*)lds); continue; }
        i -= NCONV_O;
        if (i < NCONV_L) { const int l = i >> 4, m = (i >> 2) & 3, nt = i & 3;
            conv_tile((m < 2 ? PIN(14) : PIN(16)) + (size_t)(l * 2 + (m & 1)) * 64 * 256, 256, (bf16_t*)(PWS + WS_LORAT) + (size_t)(l * 4 + m) * 256 * 64, 64, 0, nt, (float*)lds); continue; }
        for (int e = TID(); e < 1024; e += NTHREADS) { const int pos = e >> 4, f = e & 15;
            const float inv = exp2f(-(float)f * (13.287712379549449f / 16.0f)); const float ang = (float)pos * inv;
            float sn, cs; sn = sinf(ang); cs = cosf(ang);
            ((f32x2*)(PWS + WS_ROPE))[e] = (f32x2){cs, sn}; }
        for (int e = TID(); e < 4 * 32 * 64; e += NTHREADS) ((unsigned*)(PWS + WS_XCNT))[e] = 0u;
    }
    if (TID() == 0) { unsigned* mc = (unsigned*)(PWS + WS_CTR) + 16; unsigned spins = 0;
        while (__hip_atomic_load(mc, __ATOMIC_RELAXED, __HIP_MEMORY_SCOPE_AGENT) < 96u) { __builtin_amdgcn_s_sleep(2); if (++spins > (1u << 22)) break; }
        __builtin_amdgcn_fence(__ATOMIC_ACQUIRE, "agent");
        asm volatile("s_waitcnt vmcnt(0)" ::: "memory"); }
    __syncthreads();
    phaseA0(p, 0);
}

__device__ __forceinline__ const float* xrow_ptr(const Params& p, int l, int row) {
    if (l == 0) return row < NTP ? PIN(0) + (size_t)row * DM : PIN(1) + (size_t)(row - NTP) * DM;
    return POUT + (size_t)row * DM;
}
__device__ void phaseA0(const Params& p, int l) {
    const int lane = TID() & 63, gw = blockIdx.x * 8 + (TID() >> 6), W = gridDim.x * 8;
    const float* g = PIN(9) + l * DM;
    bf16_t* H = (bf16_t*)(PWS + WS_H);
    for (int row = gw; row < NT; row += W) {
        const float* x = xrow_ptr(p, l, row);
        f32x4 v[4]; float ss = 0.f;
#pragma unroll
        for (int i = 0; i < 4; ++i) { v[i] = *(const f32x4*)(x + i * 256 + lane * 4); ss += v[i][0] * v[i][0] + v[i][1] * v[i][1] + v[i][2] * v[i][2] + v[i][3] * v[i][3]; }
        ss = wave_sum(ss);
        const float rs = rsqrtf(ss * (1.0f / 1024.0f) + 1e-6f);
        const float* mod = (const float*)(PWS + WS_MOD) + (size_t)(l * 5 + modrow_of(row)) * 3072;
#pragma unroll
        for (int i = 0; i < 4; ++i) { const int c = i * 256 + lane * 4;
            const f32x4 gg = *(const f32x4*)(g + c), sh = *(const f32x4*)(mod + c), scl = *(const f32x4*)(mod + 1024 + c);
            f32x4 h = v[i] * rs * gg * (1.0f + scl) + sh;
            u32x2 w; w[0] = cvt_pk_bf16(h[0], h[1]); w[1] = cvt_pk_bf16(h[2], h[3]);
            *(u32x2*)(H + (size_t)row * DM + c) = w; }
    }
}

template <int MT>
__device__ __forceinline__ void gemm_acc(const bf16_t* __restrict__ A, int lda, const bf16_t* __restrict__ B, int ldb, int K, f32x4 (&acc)[MT][4], unsigned char* lds) {
    constexpr int BM = MT * 64, LDT = 72, A_BYTES = BM * LDT * 2, B_BYTES = 128 * LDT * 2, BUF = A_BYTES + B_BYTES;
    const int tid = TID(), lane = tid & 63, wid = tid >> 6, wr = wid >> 1, wc = wid & 1, fr = lane & 15, fq = lane >> 4;
    u32x4 ra[MT], rb[2];
    const int srow = tid >> 3, skc = tid & 7;
    const bf16_t* Ag = A + (size_t)srow * lda + skc * 8;
    const bf16_t* Bg = B + (size_t)srow * ldb + skc * 8;
    const int soff = (srow * LDT + skc * 8) * 2;
    const int nt = K >> 6;
    __syncthreads();
#pragma unroll
    for (int i = 0; i < MT; ++i) ra[i] = *(const u32x4*)(Ag + (size_t)i * 64 * lda);
#pragma unroll
    for (int i = 0; i < 2; ++i) rb[i] = *(const u32x4*)(Bg + (size_t)i * 64 * ldb);
#pragma unroll
    for (int i = 0; i < MT; ++i) *(u32x4*)(lds + soff + i * 64 * LDT * 2) = ra[i];
#pragma unroll
    for (int i = 0; i < 2; ++i) *(u32x4*)(lds + A_BYTES + soff + i * 64 * LDT * 2) = rb[i];
    __syncthreads();
    const int aoff = ((wr * MT * 16 + fr) * LDT + fq * 8) * 2, boff = A_BYTES + ((wc * 64 + fr) * LDT + fq * 8) * 2;
    for (int t = 0; t < nt; ++t) {
        if (t + 1 < nt) {
#pragma unroll
            for (int i = 0; i < MT; ++i) ra[i] = *(const u32x4*)(Ag + (size_t)i * 64 * lda + (t + 1) * 64);
#pragma unroll
            for (int i = 0; i < 2; ++i) rb[i] = *(const u32x4*)(Bg + (size_t)i * 64 * ldb + (t + 1) * 64);
        }
        const unsigned char* base = lds + (t & 1) * BUF;
#pragma unroll
        for (int kk = 0; kk < 2; ++kk) {
            bf16x8 af[MT], bfr[4];
#pragma unroll
            for (int m = 0; m < MT; ++m) af[m] = *(const bf16x8*)(base + aoff + m * 16 * LDT * 2 + kk * 64);
#pragma unroll
            for (int n = 0; n < 4; ++n) bfr[n] = *(const bf16x8*)(base + boff + n * 16 * LDT * 2 + kk * 64);
#pragma unroll
            for (int m = 0; m < MT; ++m)
#pragma unroll
                for (int n = 0; n < 4; ++n) acc[m][n] = __builtin_amdgcn_mfma_f32_16x16x32_bf16(bfr[n], af[m], acc[m][n], 0, 0, 0);
        }
        if (t + 1 < nt) {
            unsigned char* nb = lds + ((t + 1) & 1) * BUF;
#pragma unroll
            for (int i = 0; i < MT; ++i) *(u32x4*)(nb + soff + i * 64 * LDT * 2) = ra[i];
#pragma unroll
            for (int i = 0; i < 2; ++i) *(u32x4*)(nb + A_BYTES + soff + i * 64 * LDT * 2) = rb[i];
        }
        __syncthreads();
    }
}
template <int MT> __device__ __forceinline__ void zero_acc(f32x4 (&acc)[MT][4]) {
#pragma unroll
    for (int m = 0; m < MT; ++m)
#pragma unroll
        for (int n = 0; n < 4; ++n) acc[m][n] = (f32x4){0.f, 0.f, 0.f, 0.f};
}

namespace pg8 {
#define PG8_LAS __attribute__((address_space(3)))
typedef unsigned short bf16_t;
typedef short bf16x8 __attribute__((ext_vector_type(8)));
typedef float f32x4 __attribute__((ext_vector_type(4)));
typedef unsigned u32x4 __attribute__((ext_vector_type(4)));
constexpr int BM = 256, BK = 64, HALF = 128, HTB = HALF * BK * 2  , STAGE_BYTES = 8 * HTB, NXCD = 8, WGM = 8;

__host__ __device__ __forceinline__ int lds_byte(int r, int c) { const int st = (r >> 4) * 2 + (c >> 5), rr = r & 15, cc = c & 31, ob = rr * 64 + cc * 2; return st * 1024 + (ob ^ (((ob >> 9) & 1) << 5)); }
__host__ __device__ __forceinline__ void stage_rc(int b, int& R, int& C) { const int st = b / 1024, sb = b % 1024, swz = sb ^ (((sb >> 9) & 1) << 5); R = (st >> 1) * 16 + swz / 64; C = (st & 1) * 32 + (swz % 64) / 2; }
__host__ __device__ __forceinline__ int perm32(int rho) { const int n = rho >> 4, i = rho & 15; return 8 * (i >> 2) + 4 * n + (i & 3); }

struct Unit { int pm, pn; };
struct Gemm { const bf16_t* A; const bf16_t* Bt; int M, N, K; };

struct StaticOrder {
    int nM, nN, nwg, G, c;
    __host__ __device__ void init(int M, int N, int G_, int c_) { nM = M / BM; nN = N / BM; nwg = nM * nN; G = G_; c = c_; }
    __host__ __device__ bool next(int i, Unit& u) const {
        const long L = (long)i * G + c; if (L >= nwg) return false;
        int wgid = (int)L; { const int q = nwg / NXCD, r = nwg % NXCD, xcd = wgid % NXCD, off = wgid / NXCD; wgid = (xcd < r ? xcd * (q + 1) : r * (q + 1) + (xcd - r) * q) + off; }
        const int nig = WGM * nN, gid = wgid / nig, fm = gid * WGM, gsz = (nM - fm) < WGM ? (nM - fm) : WGM;
        u.pm = fm + ((wgid % nig) % gsz); u.pn = (wgid % nig) / gsz; return true;
    }
    __device__ __forceinline__ void a_ready(const Unit&) const {}
    __device__ __forceinline__ void done(const Unit&) const {}
};
template <class Epi, class Sched, bool STAMP = false>
__device__ __forceinline__ void gemm_phase(PG8_LAS unsigned char* lds, const Gemm g, const Sched& S, const Epi& E, unsigned long long* stamps) {
    const int tid = ::TID(), wid = __builtin_amdgcn_readfirstlane(tid >> 6), lane = tid & 63, wr = wid >> 2, wc = wid & 3, fr = lane & 15, fq = lane >> 4;
    const int K = g.K, nt = K / BK;
    int ts_lo = 0, ts_hi = 0, nts = 0; const unsigned long long rt_entry = STAMP ? (unsigned long long)wall_clock64() : 0ull;
#define PG8_STAMP() do { if (STAMP && wid == 0 && nts < 64) { const unsigned long long _c = (unsigned long long)clock64(); \
        ts_lo = (lane == nts) ? (int)(unsigned)_c : ts_lo; ts_hi = (lane == nts) ? (int)(unsigned)(_c >> 32) : ts_hi; ++nts; } } while (0)
    PG8_STAMP();
    unsigned voffA[2], voffB[2];
#pragma unroll
    for (int i = 0; i < 2; ++i) { int R, C; stage_rc(tid * 16 + i * 8192, R, C); const int Rb = Epi::PERM ? ((R & ~31) + perm32(R & 31)) : R;
        voffA[i] = (unsigned)(R * K + C) * 2u; voffB[i] = (unsigned)(Rb * K + C) * 2u; }
    const size_t kstep = (size_t)(BK * 2);
    const size_t hstep = (size_t)HALF * K * 2;
    const size_t tstep = 2 * hstep;
    const unsigned ldsw = (unsigned)wid * 1024u;
    const int aoff = lds_byte(wr * 64 + fr, fq * 8), boff = lds_byte(wc * 32 + fr, fq * 8);
#define PG8_SA(b, h) (((b) * 2 + (h)) * HTB)
#define PG8_SB(b, h) ((4 + (b) * 2 + (h)) * HTB)
#define PG8_STAGE(bufoff, gbase, voff) do { _Pragma("unroll") for (int _i = 0; _i < 2; ++_i) \
        __builtin_amdgcn_global_load_lds((const unsigned*)((const char*)(gbase) + (voff)[_i]), (PG8_LAS unsigned*)(lds + (bufoff) + ldsw + _i * 8192), 16, 0, 0); } while (0)
#define PG8_LDA(dst, b, h) do { _Pragma("unroll") for (int m = 0; m < 4; ++m) _Pragma("unroll") for (int k = 0; k < 2; ++k) dst[m][k] = *(const PG8_LAS bf16x8*)(lds + PG8_SA(b, h) + aoff + m * 2048 + k * 1024); } while (0)
#define PG8_LDB(dst, b, h) do { _Pragma("unroll") for (int n = 0; n < 2; ++n) _Pragma("unroll") for (int k = 0; k < 2; ++k) dst[n][k] = *(const PG8_LAS bf16x8*)(lds + PG8_SB(b, h) + boff + n * 2048 + k * 1024); } while (0)
#define PG8_MMA(ai, bj, At, Bt) do { __builtin_amdgcn_s_setprio(1); _Pragma("unroll") for (int m = 0; m < 4; ++m) _Pragma("unroll") for (int n = 0; n < 2; ++n) _Pragma("unroll") for (int k = 0; k < 2; ++k) \
        acc[ai][bj][m][n] = __builtin_amdgcn_mfma_f32_16x16x32_bf16(Bt[n][k], At[m][k], acc[ai][bj][m][n], 0, 0, 0); __builtin_amdgcn_s_setprio(0); } while (0)
#define PG8_WAIT_V(n) asm volatile("s_waitcnt vmcnt(" #n ")" ::: "memory")
#define PG8_WAIT_L(n) asm volatile("s_waitcnt lgkmcnt(" #n ")" ::: "memory")
#define PG8_BAR __builtin_amdgcn_s_barrier()
#define PG8_SCHED __builtin_amdgcn_sched_barrier(0)
    Unit cur, nxt; int ui = 0;
    if (!S.next(0, cur)) return;
    f32x4 acc[2][2][4][2];
#pragma unroll
    for (int a = 0; a < 2; ++a)
#pragma unroll
        for (int b = 0; b < 2; ++b)
#pragma unroll
            for (int m = 0; m < 4; ++m)
#pragma unroll
                for (int n = 0; n < 2; ++n) acc[a][b][m][n] = (f32x4){0.f, 0.f, 0.f, 0.f};
    bf16x8 At[4][2], B0[2][2], B1[2][2];
    const char* cA = (const char*)g.A + (size_t)cur.pm * tstep; const char* cB = (const char*)g.Bt + (size_t)cur.pn * tstep;
    S.a_ready(cur);
    PG8_STAGE(PG8_SB(0, 0), cB, voffB); PG8_STAGE(PG8_SA(0, 0), cA, voffA); PG8_STAGE(PG8_SB(0, 1), cB + hstep, voffB); PG8_STAGE(PG8_SA(0, 1), cA + hstep, voffA);
    if (wr == 1) PG8_BAR;
    PG8_WAIT_V(4); PG8_BAR;
    PG8_STAGE(PG8_SB(1, 0), cB + kstep, voffB); PG8_STAGE(PG8_SA(1, 0), cA + kstep, voffA); PG8_STAGE(PG8_SB(1, 1), cB + hstep + kstep, voffB);
    PG8_WAIT_V(6); PG8_BAR;
    PG8_STAMP();
    for (;;) {
        const bool has_next = S.next(ui + 1, nxt);
        const char* nA = has_next ? (const char*)g.A + (size_t)nxt.pm * tstep : cA; const char* nB = has_next ? (const char*)g.Bt + (size_t)nxt.pn * tstep : cB;
        for (int t = 0; t < nt; t += 2) {
            const bool last = (t == nt - 2);
            const char* a1 = cA + (size_t)(t + 1) * kstep;
            const char* a2 = last ? nA : cA + (size_t)(t + 2) * kstep; const char* b2 = last ? nB : cB + (size_t)(t + 2) * kstep;
            const char* a3 = a2 + kstep; const char* b3 = b2 + kstep;
            if (last && has_next) S.a_ready(nxt);
            PG8_LDB(B0, 0, 0); PG8_SCHED; PG8_LDA(At, 0, 0); PG8_STAGE(PG8_SA(1, 1), a1 + hstep, voffA);
            PG8_WAIT_L(8); PG8_BAR; PG8_WAIT_L(0); PG8_MMA(0, 0, At, B0); PG8_BAR; PG8_SCHED;
            PG8_LDB(B1, 0, 1); PG8_STAGE(PG8_SB(0, 0), b2, voffB);
            PG8_BAR; PG8_WAIT_L(0); PG8_MMA(0, 1, At, B1); PG8_BAR;
            PG8_LDA(At, 0, 1); PG8_STAGE(PG8_SA(0, 0), a2, voffA);
            PG8_BAR; PG8_WAIT_L(0); PG8_MMA(1, 0, At, B0); PG8_BAR; PG8_SCHED;
            PG8_STAGE(PG8_SB(0, 1), b2 + hstep, voffB);
            PG8_WAIT_V(6); PG8_BAR; PG8_MMA(1, 1, At, B1); PG8_BAR;
            PG8_LDB(B0, 1, 0); PG8_SCHED; PG8_LDA(At, 1, 0); PG8_STAGE(PG8_SA(0, 1), a2 + hstep, voffA);
            PG8_WAIT_L(8); PG8_BAR; PG8_WAIT_L(0); PG8_MMA(0, 0, At, B0); PG8_BAR; PG8_SCHED;
            PG8_LDB(B1, 1, 1); PG8_STAGE(PG8_SB(1, 0), b3, voffB);
            PG8_BAR; PG8_WAIT_L(0); PG8_MMA(0, 1, At, B1); PG8_BAR;
            PG8_LDA(At, 1, 1); PG8_STAGE(PG8_SA(1, 0), a3, voffA);
            PG8_BAR; PG8_WAIT_L(0); PG8_MMA(1, 0, At, B0); PG8_BAR; PG8_SCHED;
            PG8_STAGE(PG8_SB(1, 1), b3 + hstep, voffB);
            PG8_WAIT_V(6); PG8_BAR; PG8_MMA(1, 1, At, B1); PG8_BAR;
        }
        PG8_STAMP();
        if constexpr (!Epi::AFTER_DRAIN) { E(acc, cur, wr, wc, fr, fq); S.done(cur); }
        PG8_STAMP();
        if (!has_next) break;
#pragma unroll
        for (int a = 0; a < 2; ++a)
#pragma unroll
            for (int b = 0; b < 2; ++b)
#pragma unroll
                for (int m = 0; m < 4; ++m)
#pragma unroll
                    for (int n = 0; n < 2; ++n) acc[a][b][m][n] = (f32x4){0.f, 0.f, 0.f, 0.f};
        cur = nxt; cA = nA; cB = nB; ++ui;
    }
    PG8_WAIT_V(0);
    if (wr == 0) PG8_BAR;
    PG8_BAR;
    if constexpr (Epi::AFTER_DRAIN) { E.fused(acc, cur, wr, wc, fr, fq, lds, wid, lane); S.done(cur); }
    PG8_STAMP();
    if (STAMP && wid == 0) { stamps[lane] = lane < nts ? (((unsigned long long)(unsigned)ts_hi << 32) | (unsigned)ts_lo) : 0ull;
        if (lane == 62) stamps[62] = rt_entry; if (lane == 63) stamps[63] = (unsigned long long)wall_clock64(); }
#undef PG8_STAMP
#undef PG8_SA
#undef PG8_SB
#undef PG8_STAGE
#undef PG8_LDA
#undef PG8_LDB
#undef PG8_MMA
#undef PG8_WAIT_V
#undef PG8_WAIT_L
#undef PG8_BAR
#undef PG8_SCHED
}
}

struct EpiA {
    static constexpr bool PERM = false, AFTER_DRAIN = false;
    float* P; bf16_t* Z; float* out; int l, cbase;
    __device__ __forceinline__ void operator()(const pg8::f32x4 (&acc)[2][2][4][2], const pg8::Unit& u, int wr, int wc, int fr, int fq) const {
#pragma unroll
        for (int ai = 0; ai < 2; ++ai)
#pragma unroll
            for (int m = 0; m < 4; ++m) { const int row = u.pm * 256 + ai * 128 + wr * 64 + m * 16 + fr;
#pragma unroll
                for (int bj = 0; bj < 2; ++bj)
#pragma unroll
                    for (int n = 0; n < 2; ++n) { const int col = cbase + u.pn * 256 + bj * 128 + wc * 32 + n * 16 + fq * 4; const f32x4 v = acc[ai][bj][m][n];
                        if (col < PW) { *(f32x4*)(P + (size_t)row * PW + col) = v;
                            if (col >= C_CK && col < C_DP && row < NTP) { const int b = row >> 8, s_ = row & 255; const bool isk = col < C_CV;
                                *(f32x4*)(out + (isk ? O_NK : O_NV) + ((size_t)((b * 2 + l) * 256 + s_)) * 128 + (col - (isk ? C_CK : C_CV))) = v; } }
                        else if (col < NA_COLS) { u32x2 w; w[0] = cvt_pk_bf16(siluf_(v[0]), siluf_(v[1])); w[1] = cvt_pk_bf16(siluf_(v[2]), siluf_(v[3])); *(u32x2*)(Z + (size_t)row * DM + (col - PW)) = w; } } }
    }
};
__device__ __forceinline__ size_t g_off(int row, int cg) {
    const int n = cg >> 10, c = cg & 1023;
    const int pm = row >> 8, wr2 = (row >> 6) & 3, m = (row >> 4) & 3, fr = row & 15;
    const int pn = c >> 7, wc2 = (c >> 6) & 1, q = (c >> 4) & 3, fq2 = (c >> 2) & 3;
    size_t o = (size_t)(n * 32 + pm); o = o * 8 + pn; o = o * 4 + wr2; o = o * 2 + wc2; o = o * 4 + m; o = o * 16 + fr; o = o * 4 + fq2; o = o * 16 + q * 4;
    return o;
}
struct EpiG {
    static constexpr bool PERM = true, AFTER_DRAIN = false;
    bf16_t* G;
    __device__ __forceinline__ void operator()(const pg8::f32x4 (&acc)[2][2][4][2], const pg8::Unit& u, int wr, int wc, int fr, int fq) const {
#pragma unroll
        for (int ai = 0; ai < 2; ++ai)
#pragma unroll
            for (int m = 0; m < 4; ++m) { const int row = u.pm * 256 + ai * 128 + wr * 64 + m * 16 + fr;
#pragma unroll
                for (int bj = 0; bj < 2; ++bj) { const int col = u.pn * 256 + bj * 128 + wc * 32 + 8 * fq; const f32x4 v0 = acc[ai][bj][m][0], v1 = acc[ai][bj][m][1];
                    u32x4 w; w[0] = cvt_pk_bf16(sigmoidf_(v0[0]), sigmoidf_(v0[1])); w[1] = cvt_pk_bf16(sigmoidf_(v0[2]), sigmoidf_(v0[3]));
                    w[2] = cvt_pk_bf16(sigmoidf_(v1[0]), sigmoidf_(v1[1])); w[3] = cvt_pk_bf16(sigmoidf_(v1[2]), sigmoidf_(v1[3]));
                    u32x2 wa, wb; wa[0] = w[0]; wa[1] = w[1]; wb[0] = w[2]; wb[1] = w[3];
                    *(u32x2*)(G + g_off(row, col)) = wa; *(u32x2*)(G + g_off(row, col + 4)) = wb; } }
    }
};

__device__ void phaseA(const Params& p, int l, unsigned char* lds, int part) {
    const int G = part ? ((int)gridDim.x < 160 ? (int)gridDim.x : 160) : (int)gridDim.x;
    if ((int)blockIdx.x < G) {
        pg8::Gemm g; g.A = (const bf16_t*)(PWS + WS_H); g.Bt = (const bf16_t*)(PWS + WS_WTIN) + (size_t)l * INW * 1024 + (size_t)(part ? 2048 : 0) * 1024; g.M = NT; g.N = part ? 5 * 256 : 8 * 256; g.K = 1024;
        pg8::StaticOrder S; S.init(g.M, g.N, G, (int)blockIdx.x);
        EpiA E; E.P = (float*)(PWS + WS_P); E.Z = (bf16_t*)(PWS + WS_Z); E.out = POUT; E.l = l; E.cbase = part ? 2048 : 0;
        pg8::gemm_phase<EpiA, pg8::StaticOrder, false>((PG8_LAS unsigned char*)lds, g, S, E, nullptr);
    }
    __syncthreads();
}

__device__ void phaseB0(const Params& p, int l, unsigned char* ldsb) {
    const int tid = TID(), lane = tid & 63, wid = tid >> 6, fr = lane & 15, fq = lane >> 4;
    const int h = wid >> 1, mt = wid & 1;
    bf16_t* Awd = (bf16_t*)ldsb;
    bf16_t* Aad = Awd + 32 * 72;
    const float* P = (const float*)(PWS + WS_P);
    float* recS = (float*)(PWS + WS_RECS);
    float* recD = (float*)(PWS + WS_RECD);
    float* BC = (float*)(PWS + WS_BC);
    const bf16_t* LT = (const bf16_t*)(PWS + WS_LORAT) + (size_t)l * 4 * 256 * 64;
    const float* pkk = PIN(17) + l * 256; const float* pka = PIN(18) + l * 256; const float* prk = PIN(19) + l * 256;
    const float* pw0 = PIN(13) + l * 512; const float* pa0 = PIN(15) + l * 512;
    __shared__ int s_b0;
    unsigned* ctr0 = (unsigned*)(PWS + WS_CTR) + 4 + l;
    const int nA2 = (int)gridDim.x < 160 ? (int)gridDim.x : 160, nstat = (int)gridDim.x - nA2;
    for (int iter = 0;; ++iter) {
        int it;
        if (iter == 0 && (int)blockIdx.x >= nA2) it = (int)blockIdx.x - nA2;
        else { if (tid == 0) s_b0 = nstat + (int)atomicAdd(ctr0, 1u);
            __syncthreads();
            it = s_b0;
            __syncthreads(); }
        if (it >= NT / 32) break;
        const int tb = it * 32;
        __syncthreads();
#pragma unroll
        for (int i = 0; i < 8; ++i) { const int idx = tid + i * 512, tk = idx >> 7, j = idx & 127; const float v = P[(size_t)(tb + tk) * PW + C_WD + j];
            if (j < 64) Awd[tk * 72 + j] = f2bf(1.0f - 2.0f / (1.0f + __expf(2.0f * v))); else Aad[tk * 72 + j - 64] = f2bf(v); }
        __syncthreads();
        f32x4 acc[4][4];
#pragma unroll
        for (int m = 0; m < 4; ++m)
#pragma unroll
            for (int n = 0; n < 4; ++n) acc[m][n] = (f32x4){0.f, 0.f, 0.f, 0.f};
#pragma unroll
        for (int ks = 0; ks < 2; ++ks) {
            const bf16x8 awf = *(const bf16x8*)(Awd + (mt * 16 + fr) * 72 + ks * 32 + fq * 8), aaf = *(const bf16x8*)(Aad + (mt * 16 + fr) * 72 + ks * 32 + fq * 8);
#pragma unroll
            for (int n = 0; n < 4; ++n) { const int cb = h * 64 + n * 16 + fr;
#pragma unroll
                for (int m = 0; m < 4; ++m) { const bf16x8 bfr = *(const bf16x8*)(LT + ((size_t)m * 256 + cb) * 64 + ks * 32 + fq * 8);
                    acc[m][n] = __builtin_amdgcn_mfma_f32_16x16x32_bf16(bfr, m < 2 ? awf : aaf, acc[m][n], 0, 0, 0); } }
        }
        const int tok = tb + mt * 16 + fr; int seqbase, L, pos; seq_of(tok, seqbase, L, pos);
        const float* pr = P + (size_t)tok * PW;
        const size_t ridx = ((size_t)seqbase * 4 + (size_t)h * L + pos) * 192;
        f32x4 k4[4], kk4[4]; float ss = 0.f;
#pragma unroll
        for (int n = 0; n < 4; ++n) { const int c4 = h * 64 + n * 16 + fq * 4;
            k4[n] = *(const f32x4*)(pr + C_BK + c4); kk4[n] = k4[n] * *(const f32x4*)(pkk + c4);
            ss += (kk4[n][0] * kk4[n][0] + kk4[n][1] * kk4[n][1]) + (kk4[n][2] * kk4[n][2] + kk4[n][3] * kk4[n][3]); }
        ss += __shfl_xor(ss, 16); ss += __shfl_xor(ss, 32);
        const float rn = rsqrtf(ss + 1e-12f);
        float bsum = 0.f;
#pragma unroll
        for (int n = 0; n < 4; ++n) { const int c4 = h * 64 + n * 16 + fq * 4, j4 = n * 16 + fq * 4;
            const f32x4 r4 = *(const f32x4*)(pr + C_BR + c4), v4 = *(const f32x4*)(pr + C_BV + c4);
            const f32x4 kk = kk4[n] * rn, ka4 = *(const f32x4*)(pka + c4), rk4 = *(const f32x4*)(prk + c4);
            *(f32x4*)(recS + ridx + j4) = r4; *(f32x4*)(recS + ridx + 64 + j4) = kk; *(f32x4*)(recS + ridx + 128 + j4) = v4;
#pragma unroll
            for (int d = 0; d < 2; ++d) {
                const f32x4 w0 = *(const f32x4*)(pw0 + d * 256 + c4), a0 = *(const f32x4*)(pa0 + d * 256 + c4);
                f32x4 dec, nka, kd;
#pragma unroll
                for (int j = 0; j < 4; ++j) {
                    const float wl = w0[j] + acc[d][n][j];
                    dec[j] = __expf(-0.6065306597126334f / (1.0f + __expf(-wl)));
                    const float a = 1.0f / (1.0f + __expf(-(a0[j] + acc[2 + d][n][j])));
                    kd[j] = k4[n][j] * (1.0f + (a - 1.0f) * ka4[j]); nka[j] = -(kk[j] * a);
                    bsum += r4[j] * kd[j] * rk4[j]; }
                float* rd = recD + (size_t)d * RECD_STRIDE + ridx + j4;
                *(f32x4*)(rd) = dec; *(f32x4*)(rd + 64) = nka; *(f32x4*)(rd + 128) = kd;
            }
        }
        bsum += __shfl_xor(bsum, 16); bsum += __shfl_xor(bsum, 32);
        if (fq == 0) BC[tok * 4 + h] = bsum;
    }
}

template <int NS>
__device__ __forceinline__ void scan_run(const Params& p, int l, bool sample, int b, int h, int dir, int rg, int L, int seqbase, float* wl) {
    const int lane = TID() & 63, rl = lane >> 4, kl = lane & 15;
    int row[NS]; f32x4 S[NS]; size_t sidx[NS];
#pragma unroll
    for (int q = 0; q < NS; ++q) { row[q] = (rg * NS + q) * 4 + rl;
        sidx[q] = ((size_t)(((b * 2 + l) * 2 + dir) * 4 + h)) * 4096 + row[q] * 64 + kl * 4;
        if (sample) S[q] = *(const f32x4*)(PIN(4) + sidx[q]); else S[q] = (f32x4){0.f, 0.f, 0.f, 0.f}; }
    const float* gS = (const float*)(PWS + WS_RECS) + ((size_t)seqbase * 4 + (size_t)h * L) * 192 + lane * 4;
    const float* gD = (const float*)(PWS + WS_RECD) + (size_t)dir * RECD_STRIDE + ((size_t)seqbase * 4 + (size_t)h * L) * 192 + lane * 4;
    float* O = (float*)(PWS + WS_O) + (size_t)dir * NT * 256 + (size_t)seqbase * 256 + h * 64;
    const int nch = L >> 2;
    f32x4 rA[6], rB[6];
    auto gl = [&](f32x4 (&r)[6], int c) {
        c = c < nch ? c : nch - 1;
        const int pos0 = dir ? (L - 4 * (c + 1)) : 4 * c;
        const float* s_ = gS + (size_t)pos0 * 192; const float* d_ = gD + (size_t)pos0 * 192;
#pragma unroll
        for (int i = 0; i < 3; ++i) { r[i] = *(const f32x4*)(s_ + i * 256); r[3 + i] = *(const f32x4*)(d_ + i * 256); }
    };
    auto st = [&](const f32x4 (&r)[6], float* buf) {
#pragma unroll
        for (int i = 0; i < 3; ++i) { *(f32x4*)(buf + i * 256 + lane * 4) = r[i]; *(f32x4*)(buf + 768 + i * 256 + lane * 4) = r[3 + i]; }
    };
    struct Ops { f32x4 r, kk, w, ka, kd; float v[NS]; };
    auto ldsread = [&](const float* buf, int s) -> Ops {
        const int tc = dir ? 3 - s : s;
        const float* bs = buf + tc * 192; const float* bd = buf + 768 + tc * 192;
        Ops o; o.r = *(const f32x4*)(bs + kl * 4); o.kk = *(const f32x4*)(bs + 64 + kl * 4);
        o.w = *(const f32x4*)(bd + kl * 4); o.ka = *(const f32x4*)(bd + 64 + kl * 4); o.kd = *(const f32x4*)(bd + 128 + kl * 4);
#pragma unroll
        for (int q = 0; q < NS; ++q) o.v[q] = bs[128 + row[q]];
        return o;
    };
    float opart[NS];
#pragma unroll
    for (int q = 0; q < NS; ++q) opart[q] = 0.f;
    auto chunk = [&](const float* cur, const float* nxtbuf, Ops& ops, int c) {
        float oval[NS];
#pragma unroll
        for (int q = 0; q < NS; ++q) oval[q] = 0.f;
#pragma unroll
        for (int s = 0; s < 4; ++s) {
            const Ops nx = (s < 3) ? ldsread(cur, s + 1) : ldsread(nxtbuf, 0);
            __builtin_amdgcn_sched_barrier(0);
            float sa[NS], opr[NS]; f32x2 ta[NS], tb[NS];
            const f32x2 kka = __builtin_shufflevector(ops.kk, ops.kk, 0, 1), kkb = __builtin_shufflevector(ops.kk, ops.kk, 2, 3);
            const f32x2 wa = __builtin_shufflevector(ops.w, ops.w, 0, 1), wb = __builtin_shufflevector(ops.w, ops.w, 2, 3);
            const f32x2 na = __builtin_shufflevector(ops.ka, ops.ka, 0, 1), nb = __builtin_shufflevector(ops.ka, ops.ka, 2, 3);
            const f32x2 da = __builtin_shufflevector(ops.kd, ops.kd, 0, 1), db = __builtin_shufflevector(ops.kd, ops.kd, 2, 3);
            const f32x2 ra = __builtin_shufflevector(ops.r, ops.r, 0, 1), rb = __builtin_shufflevector(ops.r, ops.r, 2, 3);
#pragma unroll
            for (int q = 0; q < NS; ++q) { const f32x2 Sa = __builtin_shufflevector(S[q], S[q], 0, 1), Sb = __builtin_shufflevector(S[q], S[q], 2, 3);
                f32x2 pp = Sa * kka; pp = Sb * kkb + pp; sa[q] = pp[0] + pp[1];
                const f32x2 v2 = (f32x2){ops.v[q], ops.v[q]};
                ta[q] = Sa * wa + v2 * da; tb[q] = Sb * wb + v2 * db; }
#pragma unroll
            for (int q = 0; q < NS; ++q) { sa[q] = row16_sum(sa[q]); opr[q] = row16_sum(opart[q]); oval[q] = (kl == s) ? opr[q] : oval[q]; }
#pragma unroll
            for (int q = 0; q < NS; ++q) { const f32x2 s2 = (f32x2){sa[q], sa[q]};
                const f32x2 Sa = s2 * na + ta[q], Sb = s2 * nb + tb[q];
                f32x2 qq = Sa * ra; qq = Sb * rb + qq; opart[q] = qq[0] + qq[1];
                S[q] = (f32x4){Sa[0], Sa[1], Sb[0], Sb[1]}; }
            ops = nx;
        }
        const int stp = 4 * c - 1 + (kl & 3);
        const int pos = dir ? (L - 1 - stp) : stp;
#pragma unroll
        for (int q = 0; q < NS; ++q) { if (kl < 4 && stp >= 0) O[(size_t)pos * 256 + row[q]] = oval[q]; }
    };
    float* buf0 = wl; float* buf1 = wl + 1536;
    gl(rA, 0); gl(rB, 1);
    st(rA, buf0); gl(rA, 2);
    __builtin_amdgcn_wave_barrier();
    Ops ops = ldsread(buf0, 0);
    for (int c = 0; c < nch; c += 2) {
        st(rB, buf1); gl(rB, c + 3);
        __builtin_amdgcn_wave_barrier();
        chunk(buf0, buf1, ops, c);
        st(rA, buf0); gl(rA, c + 4);
        __builtin_amdgcn_wave_barrier();
        chunk(buf1, buf0, ops, c + 1);
    }
#pragma unroll
    for (int q = 0; q < NS; ++q) { const float ol = row16_sum(opart[q]); if (kl == 0) O[(size_t)(dir ? 0 : L - 1) * 256 + row[q]] = ol; }
    if (!sample) {
#pragma unroll
        for (int q = 0; q < NS; ++q) *(f32x4*)(POUT + O_NS + sidx[q]) = S[q];
    }
}

__device__ __forceinline__ void stage_qk(const float* __restrict__ src, int stride, bf16_t* dst, bool rope, int pos0, float scale, const f32x2* __restrict__ rt) {
    const int tid = TID();
#pragma unroll
    for (int i = 0; i < 2; ++i) {
        const int task = tid + i * 512, row = task >> 3, half = (task >> 2) & 1, quad = task & 3;
        const float* s = src + (size_t)row * stride + half * 32 + quad * 4;
        f32x4 x1 = *(const f32x4*)s, x2 = *(const f32x4*)(s + 16);
        if (rope) { const int pos = pos0 + row; const int pi = half ? (pos & 63) : (pos >> 6);
#pragma unroll
            for (int j = 0; j < 4; ++j) { const f32x2 cs = rt[pi * 16 + quad * 4 + j]; const float a = x1[j], b = x2[j]; x1[j] = a * cs[0] - b * cs[1]; x2[j] = b * cs[0] + a * cs[1]; } }
        x1 *= scale; x2 *= scale;
        u32x2 w1, w2; w1[0] = cvt_pk_bf16(x1[0], x1[1]); w1[1] = cvt_pk_bf16(x1[2], x1[3]); w2[0] = cvt_pk_bf16(x2[0], x2[1]); w2[1] = cvt_pk_bf16(x2[2], x2[3]);
        *(u32x2*)(dst + row * 72 + half * 32 + quad * 4) = w1; *(u32x2*)(dst + row * 72 + half * 32 + 16 + quad * 4) = w2;
    }
}
__device__ __forceinline__ void stage_vt(const float* __restrict__ src, int stride, bf16_t* vt, int nkeys = 128, int pitch = 136) {
    const int tid = TID();
    for (int task = tid; task < nkeys * 16; task += 512) { const int key = task >> 4, dq = task & 15;
        const f32x4 v = *(const f32x4*)(src + (size_t)key * stride + dq * 4);
#pragma unroll
        for (int j = 0; j < 4; ++j) vt[(dq * 4 + j) * pitch + key] = f2bf(v[j]); }
}
__device__ void attn_item(const Params& p, int l, int ai, unsigned char* lds) {
    const int tid = TID(), lane = tid & 63, wid = tid >> 6, fr = lane & 15, fq = lane >> 4;
    bf16_t* Qs = (bf16_t*)lds; bf16_t* Ks = Qs + 128 * 72; bf16_t* Vt = Ks + 128 * 72;
    const float* P = (const float*)(PWS + WS_P);
    const bf16_t* Z = (const bf16_t*)(PWS + WS_Z);
    bf16_t* YS = (bf16_t*)(PWS + WS_YS);
    const f32x2* rt = (const f32x2*)(PWS + WS_ROPE);
    bool sample; int b, head, qt, seqbase;
    if (ai < 128) { sample = true; b = ai >> 5; head = (ai >> 3) & 3; qt = ai & 7; seqbase = NTP + b * 1024; }
    else { const int j = ai - 128; sample = false; b = j >> 3; head = (j >> 1) & 3; qt = j & 1; seqbase = b * 256; }
    const int kh = head >> 1, qbase = seqbase + qt * 128;
    __syncthreads();
    stage_qk(P + (size_t)qbase * PW + C_CQ + head * 64, PW, Qs, sample, qt * 128, 0.125f, rt);
    __syncthreads();
    bf16x8 qf[2];
    qf[0] = *(const bf16x8*)(Qs + (wid * 16 + fr) * 72 + fq * 8); qf[1] = *(const bf16x8*)(Qs + (wid * 16 + fr) * 72 + 32 + fq * 8);
    float m = PIN(22)[l * 4 + head], lsum = 1.0f, lpart = 0.f;
    f32x4 oacc[4];
#pragma unroll
    for (int i = 0; i < 4; ++i) oacc[i] = (f32x4){0.f, 0.f, 0.f, 0.f};
    const int nkb = sample ? 7 : 2;
    const int qpos = qt * 128 + wid * 16 + fr;
    const float* ck = PIN(2); const float* cv = PIN(3);
    auto kinfo = [&](int kb, const float*& ks, const float*& vs, int& stride, bool& rope, bool& mask, int& kpos0) -> bool {
        if (!sample) { ks = P + (size_t)(seqbase + kb * 128) * PW + C_CK + kh * 64; vs = ks + (C_CV - C_CK); stride = PW; rope = false; mask = false; kpos0 = 0; return true; }
        if (kb < 3) { const int nbk = qt - 1 + kb; if (nbk < 0 || nbk >= 8) return false; kpos0 = nbk * 128;
            ks = P + (size_t)(seqbase + kpos0) * PW + C_CK + kh * 64; vs = ks + (C_CV - C_CK); stride = PW; rope = true; mask = (kb != 1); return true; }
        const size_t o = ((size_t)((b * 2 + l) * 512 + (kb - 3) * 128) * 2 + kh) * 64; ks = ck + o; vs = cv + o; stride = 128; rope = false; mask = false; kpos0 = 0; return true;
    };
    f32x4 kx1[2], kx2[2], vx[2][2];
    auto kload = [&](const float* ks, const float* vs, int stride) {
#pragma unroll
        for (int i = 0; i < 2; ++i) { const int task = tid + i * 512, row = task >> 3, half = (task >> 2) & 1, quad = task & 3;
            const float* s_ = ks + (size_t)row * stride + half * 32 + quad * 4; kx1[i] = *(const f32x4*)s_; kx2[i] = *(const f32x4*)(s_ + 16); }
#pragma unroll
        for (int i = 0; i < 2; ++i) { const int task = tid + i * 512, kp = task >> 4, dq = task & 15;
            vx[i][0] = *(const f32x4*)(vs + (size_t)(2 * kp) * stride + dq * 4); vx[i][1] = *(const f32x4*)(vs + (size_t)(2 * kp + 1) * stride + dq * 4); }
    };
    auto kstore = [&](bool rope, int kpos0) {
#pragma unroll
        for (int i = 0; i < 2; ++i) { const int task = tid + i * 512, row = task >> 3, half = (task >> 2) & 1, quad = task & 3;
            f32x4 x1 = kx1[i], x2 = kx2[i];
            if (rope) { const int pos = kpos0 + row; const int pi = half ? (pos & 63) : (pos >> 6);
#pragma unroll
                for (int j = 0; j < 4; ++j) { const f32x2 cs = rt[pi * 16 + quad * 4 + j]; const float a_ = x1[j], b_ = x2[j]; x1[j] = a_ * cs[0] - b_ * cs[1]; x2[j] = b_ * cs[0] + a_ * cs[1]; } }
            u32x2 w1, w2; w1[0] = cvt_pk_bf16(x1[0], x1[1]); w1[1] = cvt_pk_bf16(x1[2], x1[3]); w2[0] = cvt_pk_bf16(x2[0], x2[1]); w2[1] = cvt_pk_bf16(x2[2], x2[3]);
            *(u32x2*)(Ks + row * 72 + half * 32 + quad * 4) = w1; *(u32x2*)(Ks + row * 72 + half * 32 + 16 + quad * 4) = w2; }
#pragma unroll
        for (int i = 0; i < 2; ++i) { const int task = tid + i * 512, kp = task >> 4, dq = task & 15;
#pragma unroll
            for (int j = 0; j < 4; ++j) *(unsigned*)(Vt + (dq * 4 + j) * 136 + 2 * kp) = cvt_pk_bf16(vx[i][0][j], vx[i][1][j]); }
    };
    const float* ksrc = nullptr; const float* vsrc = nullptr; int stride = 0, kpos0n = 0; bool ropen = false, maskn = false;
    int kb = 0;
    while (kb < nkb && !kinfo(kb, ksrc, vsrc, stride, ropen, maskn, kpos0n)) ++kb;
    if (kb < nkb) kload(ksrc, vsrc, stride);
    while (kb < nkb) {
        const bool mask = maskn; const int kpos0 = kpos0n; const bool rope = ropen;
        __syncthreads();
        kstore(rope, kpos0);
        __syncthreads();
        int nk = kb + 1;
        while (nk < nkb && !kinfo(nk, ksrc, vsrc, stride, ropen, maskn, kpos0n)) ++nk;
        if (nk < nkb) kload(ksrc, vsrc, stride);
        kb = nk;
        f32x4 sc[4][2];
#pragma unroll
        for (int sb = 0; sb < 4; ++sb) {
            f32x4 s0 = (f32x4){0.f, 0.f, 0.f, 0.f}, s1 = s0;
#pragma unroll
            for (int dh = 0; dh < 2; ++dh) {
                const bf16x8 k0 = *(const bf16x8*)(Ks + (sb * 32 + fr) * 72 + dh * 32 + fq * 8), k1 = *(const bf16x8*)(Ks + (sb * 32 + 16 + fr) * 72 + dh * 32 + fq * 8);
                s0 = __builtin_amdgcn_mfma_f32_16x16x32_bf16(k0, qf[dh], s0, 0, 0, 0);
                s1 = __builtin_amdgcn_mfma_f32_16x16x32_bf16(k1, qf[dh], s1, 0, 0, 0);
            }
            if (mask) {
#pragma unroll
                for (int j = 0; j < 4; ++j) { const int k0p = kpos0 + sb * 32 + fq * 4 + j, k1p = k0p + 16; int d0 = qpos - k0p, d1 = qpos - k1p; d0 = d0 < 0 ? -d0 : d0; d1 = d1 < 0 ? -d1 : d1;
                    if (d0 > 128) s0[j] = -1e30f; if (d1 > 128) s1[j] = -1e30f; }
            }
            sc[sb][0] = s0; sc[sb][1] = s1;
        }
        float mx = -1e30f;
#pragma unroll
        for (int sb = 0; sb < 4; ++sb)
#pragma unroll
            for (int j = 0; j < 4; ++j) mx = fmaxf(mx, fmaxf(sc[sb][0][j], sc[sb][1][j]));
        mx = fmaxf(mx, __shfl_xor(mx, 16)); mx = fmaxf(mx, __shfl_xor(mx, 32));
        const float mn = fmaxf(m, mx), alpha = __expf(m - mn);
        m = mn; lsum *= alpha; lpart *= alpha;
#pragma unroll
        for (int dt = 0; dt < 4; ++dt) oacc[dt] = oacc[dt] * alpha;
#pragma unroll
        for (int sb = 0; sb < 4; ++sb) {
            f32x4 s0 = sc[sb][0], s1 = sc[sb][1];
#pragma unroll
            for (int j = 0; j < 4; ++j) { s0[j] = __expf(s0[j] - mn); s1[j] = __expf(s1[j] - mn); lpart += s0[j] + s1[j]; }
            u32x4 pw; pw[0] = cvt_pk_bf16(s0[0], s0[1]); pw[1] = cvt_pk_bf16(s0[2], s0[3]); pw[2] = cvt_pk_bf16(s1[0], s1[1]); pw[3] = cvt_pk_bf16(s1[2], s1[3]);
            bf16x8 pf; __builtin_memcpy(&pf, &pw, 16);
#pragma unroll
            for (int dt = 0; dt < 4; ++dt) {
                const bf16_t* vp = Vt + (dt * 16 + fr) * 136 + sb * 32 + fq * 4;
                u32x4 vw; const u32x2 va = *(const u32x2*)vp, vb = *(const u32x2*)(vp + 16); vw[0] = va[0]; vw[1] = va[1]; vw[2] = vb[0]; vw[3] = vb[1];
                bf16x8 vf; __builtin_memcpy(&vf, &vw, 16);
                oacc[dt] = __builtin_amdgcn_mfma_f32_16x16x32_bf16(vf, pf, oacc[dt], 0, 0, 0);
            }
        }
    }
    lpart += __shfl_xor(lpart, 16); lpart += __shfl_xor(lpart, 32);
    lsum += lpart;
    const float inv = 1.0f / lsum;
    const size_t t = (size_t)(qbase + wid * 16 + fr);
#pragma unroll
    for (int dt = 0; dt < 4; ++dt) {
        const int col = 512 + head * 64 + dt * 16 + fq * 4;
        const bf16x4 z = *(const bf16x4*)(Z + t * DM + col);
        u32x2 w; w[0] = cvt_pk_bf16(oacc[dt][0] * inv * bf2f((bf16_t)z[0]), oacc[dt][1] * inv * bf2f((bf16_t)z[1]));
        w[1] = cvt_pk_bf16(oacc[dt][2] * inv * bf2f((bf16_t)z[2]), oacc[dt][3] * inv * bf2f((bf16_t)z[3]));
        *(u32x2*)(YS + t * DM + col) = w;
    }
}

__device__ void chunk_item(const Params& p, int l, int ci, unsigned char* ldsb) {
    const int tid = TID(), lane = tid & 63, wid = tid >> 6, fr = lane & 15, fq = lane >> 4;
    const int chunk = ci >> 2, g = ci & 3, base = chunk * 128;
    bf16_t* wsb = (bf16_t*)ldsb;
    bf16_t* vt = wsb + 128 * 136;
    const float* P = (const float*)(PWS + WS_P);
    const bf16_t* Z = (const bf16_t*)(PWS + WS_Z);
    bf16_t* YS = (bf16_t*)(PWS + WS_YS);
    const float* wsrc = PIN(11) + (size_t)(l * 4 + g) * 128 * 128;
    __syncthreads();
#pragma unroll
    for (int i = 0; i < 8; ++i) { const int idx = tid + i * 512, r = idx >> 5, c4 = (idx & 31) * 4; const f32x4 v = *(const f32x4*)(wsrc + r * 128 + c4);
        u32x2 w; w[0] = cvt_pk_bf16(v[0], v[1]); w[1] = cvt_pk_bf16(v[2], v[3]); *(u32x2*)(wsb + r * 136 + c4) = w; }
    stage_vt(P + (size_t)base * PW + C_AV + g * 64, PW, vt, 128);
    __syncthreads();
    f32x4 acc[4];
#pragma unroll
    for (int n = 0; n < 4; ++n) acc[n] = (f32x4){0.f, 0.f, 0.f, 0.f};
#pragma unroll
    for (int k = 0; k < 4; ++k) {
        const bf16x8 af = *(const bf16x8*)(wsb + (wid * 16 + fr) * 136 + k * 32 + fq * 8);
#pragma unroll
        for (int n = 0; n < 4; ++n) { const bf16x8 bfv = *(const bf16x8*)(vt + (n * 16 + fr) * 136 + k * 32 + fq * 8);
            acc[n] = __builtin_amdgcn_mfma_f32_16x16x32_bf16(bfv, af, acc[n], 0, 0, 0); }
    }
    const int i = wid * 16 + fr; const size_t t = base + i;
    const float bsi = PIN(12)[(l * 4 + g) * 128 + i];
#pragma unroll
    for (int n = 0; n < 4; ++n) { const int col = g * 64 + n * 16 + fq * 4;
        const f32x4 u = *(const f32x4*)(P + t * PW + C_AU + col);
        const bf16x4 z = *(const bf16x4*)(Z + t * DM + col);
        u32x2 w; w[0] = cvt_pk_bf16(u[0] * (acc[n][0] + bsi) * bf2f((bf16_t)z[0]), u[1] * (acc[n][1] + bsi) * bf2f((bf16_t)z[1]));
        w[1] = cvt_pk_bf16(u[2] * (acc[n][2] + bsi) * bf2f((bf16_t)z[2]), u[3] * (acc[n][3] + bsi) * bf2f((bf16_t)z[3]));
        *(u32x2*)(YS + t * DM + col) = w; }
}

__device__ void pool_item(const Params& p, int l, int pi, unsigned char* ldsb) {
    const int tid = TID(), lane = tid & 63, wid = tid >> 6, fr = lane & 15, fq = lane >> 4, half = tid >> 8, ch = tid & 255, g = ch >> 6;
    const int tb = pi * 32; int seqbase, L, pos0; seq_of(tb, seqbase, L, pos0);
    float* pt = (float*)ldsb;
    bf16_t* dl = (bf16_t*)(pt + 48 * 256);
    bf16_t* wt = dl + 32 * 264;
    const float* P = (const float*)(PWS + WS_P);
    const bf16_t* Z = (const bf16_t*)(PWS + WS_Z);
    bf16_t* YS = (bf16_t*)(PWS + WS_YS);
    __syncthreads();
#pragma unroll
    for (int i = 0; i < 6; ++i) { const int idx = tid + i * 512, rr = idx >> 6, c4 = (idx & 63) * 4; const int pos = pos0 - 8 + rr;
        f32x4 v = (f32x4){0.f, 0.f, 0.f, 0.f};
        if (pos >= 0 && pos < L) v = *(const f32x4*)(P + (size_t)(seqbase + pos) * PW + C_DP + c4);
        *(f32x4*)(pt + rr * 256 + c4) = v; }
    { const float* pwsrc = PIN(23) + (size_t)l * 4 * 64 * 64;
#pragma unroll
      for (int gg = 0; gg < 4; ++gg) stage_vt(pwsrc + gg * 4096, 64, wt + gg * 64 * 72, 64, 72); }
    __syncthreads();
    const int w = 2 << g;
    for (int i = 0; i < 16; ++i) { const int tk = half * 16 + i, pos = pos0 + tk;
        int lo = pos - (w >> 1), hi = lo + w; lo = lo < 0 ? 0 : lo; hi = hi > L ? L : hi;
        float sm = 0.f;
        for (int q = lo; q < hi; ++q) sm += pt[(q - pos0 + 8) * 256 + ch];
        dl[tk * 264 + ch] = f2bf(sm / (float)(hi - lo) - pt[(tk + 8) * 256 + ch]); }
    __syncthreads();
    const int gw = wid >> 1, th = wid & 1;
    f32x4 acc[4];
#pragma unroll
    for (int n = 0; n < 4; ++n) acc[n] = (f32x4){0.f, 0.f, 0.f, 0.f};
#pragma unroll
    for (int k = 0; k < 2; ++k) {
        const bf16x8 af = *(const bf16x8*)(dl + (th * 16 + fr) * 264 + gw * 64 + k * 32 + fq * 8);
#pragma unroll
        for (int n = 0; n < 4; ++n) { const bf16x8 bfv = *(const bf16x8*)(wt + (gw * 64 + n * 16 + fr) * 72 + k * 32 + fq * 8);
            acc[n] = __builtin_amdgcn_mfma_f32_16x16x32_bf16(bfv, af, acc[n], 0, 0, 0); }
    }
    const size_t t = tb + th * 16 + fr;
#pragma unroll
    for (int n = 0; n < 4; ++n) { const int oc = gw * 64 + n * 16 + fq * 4;
        const f32x4 sc = *(const f32x4*)(PIN(24) + l * 256 + oc);
        const bf16x4 z = *(const bf16x4*)(Z + t * DM + 768 + oc);
        u32x2 wv; wv[0] = cvt_pk_bf16(acc[n][0] * sc[0] * bf2f((bf16_t)z[0]), acc[n][1] * sc[1] * bf2f((bf16_t)z[1]));
        wv[1] = cvt_pk_bf16(acc[n][2] * sc[2] * bf2f((bf16_t)z[2]), acc[n][3] * sc[3] * bf2f((bf16_t)z[3]));
        *(u32x2*)(YS + t * DM + 768 + oc) = wv; }
}

__device__ void phaseB1(const Params& p, int l, unsigned char* lds, int slot = 0, int part = 127) {
    const int tid = TID(), wid = tid >> 6;
    float* wl = (float*)lds + wid * 3072;
    if (!(part & 1)) {} else
    { const int nbh = (int)gridDim.x >> 1;
      if ((int)blockIdx.x < nbh) { if (wid < 4 && (part & 4)) for (int it = blockIdx.x * 4 + wid; it < 512; it += nbh * 4) { const int q = it >> 4, b = q >> 3;
            scan_run<1>(p, l, true, b, (q >> 1) & 3, q & 1, it & 15, 1024, NTP + b * 1024, wl); } }
      else { const int nb2 = (int)gridDim.x - nbh; if (part & 8) for (int it = ((int)blockIdx.x - nbh) * 8 + wid; it < 1024; it += nb2 * 8) { const int q = it >> 3, b = q >> 3;
            scan_run<2>(p, l, false, b, (q >> 1) & 3, q & 1, it & 7, 256, b * 256, wl); } } }
    __syncthreads();
    __shared__ int s_item;
    unsigned* ctr = (unsigned*)(PWS + WS_CTR) + l + 2 * slot;
    if (part & 2)
    for (;;) {
        if (tid == 0) s_item = (int)atomicAdd(ctr, 1u);
        __syncthreads();
        const int item = s_item;
        __syncthreads();
        if (item >= 768) break;
        if (item < 256) { if (part & 16) attn_item(p, l, item, lds); }
        else if (item < 512) { if (part & 64) pool_item(p, l, item - 256, lds); }
        else { if (part & 32) chunk_item(p, l, item - 512, lds); }
    }
}

__device__ void phaseB2(const Params& p, int l) {
    const int lane = TID() & 63, gw = blockIdx.x * 8 + (TID() >> 6), W = gridDim.x * 8;
    const float* O = (const float*)(PWS + WS_O);
    const float* recS = (const float*)(PWS + WS_RECS);
    const float* BC = (const float*)(PWS + WS_BC);
    const bf16_t* Z = (const bf16_t*)(PWS + WS_Z);
    bf16_t* YS = (bf16_t*)(PWS + WS_YS);
    const float* lng = PIN(20) + l * 256; const float* lnb = PIN(21) + l * 256;
    float g4[4], b4[4];
#pragma unroll
    for (int h = 0; h < 4; ++h) { g4[h] = lng[h * 64 + lane]; b4[h] = lnb[h * 64 + lane]; }
    for (int tok = gw; tok < NT; tok += W) {
        int seqbase, L, pos; seq_of(tok, seqbase, L, pos);
        float o[4], vv[4], z[4], mu[4], var[4];
        const f32x4 bc = *(const f32x4*)(BC + tok * 4);
#pragma unroll
        for (int h = 0; h < 4; ++h) { const int c = h * 64 + lane;
            o[h] = __builtin_nontemporal_load(O + (size_t)tok * 256 + c) + __builtin_nontemporal_load(O + (size_t)NT * 256 + (size_t)tok * 256 + c);
            vv[h] = recS[((size_t)seqbase * 4 + (size_t)h * L + pos) * 192 + 128 + lane];
            z[h] = bf2f(Z[(size_t)tok * DM + 256 + c]); }
#pragma unroll
        for (int h = 0; h < 4; ++h) mu[h] = wave_sum(o[h]) * (1.0f / 64.0f);
#pragma unroll
        for (int h = 0; h < 4; ++h) { o[h] -= mu[h]; var[h] = wave_sum(o[h] * o[h]) * (1.0f / 64.0f); }
#pragma unroll
        for (int h = 0; h < 4; ++h) { const float on = o[h] * rsqrtf(var[h] + 64e-5f);
            const float y = on * g4[h] + b4[h] + bc[h] * vv[h];
            YS[(size_t)tok * DM + 256 + h * 64 + lane] = f2bf(y * z[h]); }
    }
}

__device__ void phaseC1(const Params& p, int l, unsigned char* lds) {
    pg8::Gemm g; g.A = (const bf16_t*)(PWS + WS_H); g.Bt = (const bf16_t*)(PWS + WS_WTIN) + (size_t)l * INW * 1024 + (size_t)NA_COLS * 1024; g.M = NT; g.N = 4096; g.K = 1024;
    pg8::StaticOrder S; S.init(g.M, g.N, (int)gridDim.x, (int)blockIdx.x);
    EpiG E; E.G = (bf16_t*)(PWS + WS_G);
    pg8::gemm_phase<EpiG, pg8::StaticOrder, false>((PG8_LAS unsigned char*)lds, g, S, E, nullptr);
    __syncthreads();
}
__device__ void phaseC2(const Params& p, int l, unsigned char* lds) {
    constexpr int MT = 4, LDT = 72, A_BYTES = 256 * LDT * 2, B_BYTES = 128 * LDT * 2, BUF = A_BYTES + B_BYTES;
    const int tid = TID(), lane = tid & 63, wid = tid >> 6, wr = wid >> 1, wc = wid & 1, fr = lane & 15, fq = lane >> 4;
    const bf16_t* YS = (const bf16_t*)(PWS + WS_YS);
    const bf16_t* G = (const bf16_t*)(PWS + WS_G);
    const bf16_t* Wu = (const bf16_t*)(PWS + WS_WTUP) + (size_t)l * 4 * 1024 * 256;
    bf16_t* MG = (bf16_t*)(PWS + WS_MERGED);
    const int srow = tid >> 3, skc = tid & 7, soff = (srow * LDT + skc * 8) * 2;
    const int aoff = ((wr * MT * 16 + fr) * LDT + fq * 8) * 2, boff = A_BYTES + ((wc * 64 + fr) * LDT + fq * 8) * 2;
    const int NU = 32 * 8;
    for (int u = blockIdx.x; u < NU; u += gridDim.x) {
        const int pn = u / 32, pm = u % 32;
        const bf16_t* Ag = YS + ((size_t)pm * 256 + srow) * 1024 + skc * 8;
        const bf16_t* Bg = Wu + ((size_t)pn * 128 + srow) * 256 + skc * 8;
        f32x4 mg[4][4], acc[4][4]; zero_acc<4>(mg); zero_acc<4>(acc);
        u32x4 ra[MT], rb[2];
        auto gload = [&](int kt) {
#pragma unroll
            for (int i = 0; i < MT; ++i) ra[i] = *(const u32x4*)(Ag + (size_t)i * 64 * 1024 + kt * 64);
            const bf16_t* bb = Bg + (size_t)(kt >> 2) * 1024 * 256 + (kt & 3) * 64;
#pragma unroll
            for (int i = 0; i < 2; ++i) rb[i] = *(const u32x4*)(bb + (size_t)i * 64 * 256);
        };
        auto sstore = [&](int buf) { unsigned char* nb = lds + buf * BUF;
#pragma unroll
            for (int i = 0; i < MT; ++i) *(u32x4*)(nb + soff + i * 64 * LDT * 2) = ra[i];
#pragma unroll
            for (int i = 0; i < 2; ++i) *(u32x4*)(nb + A_BYTES + soff + i * 64 * LDT * 2) = rb[i];
        };
        __syncthreads();
        gload(0); sstore(0);
        __syncthreads();
        for (int t = 0; t < 16; ++t) {
            if (t + 1 < 16) gload(t + 1);
            const unsigned char* base = lds + (t & 1) * BUF;
#pragma unroll
            for (int kk = 0; kk < 2; ++kk) {
                bf16x8 af[MT], bfr[4];
#pragma unroll
                for (int m = 0; m < MT; ++m) af[m] = *(const bf16x8*)(base + aoff + m * 16 * LDT * 2 + kk * 64);
#pragma unroll
                for (int n = 0; n < 4; ++n) bfr[n] = *(const bf16x8*)(base + boff + n * 16 * LDT * 2 + kk * 64);
#pragma unroll
                for (int m = 0; m < MT; ++m)
#pragma unroll
                    for (int n = 0; n < 4; ++n) acc[m][n] = __builtin_amdgcn_mfma_f32_16x16x32_bf16(bfr[n], af[m], acc[m][n], 0, 0, 0);
            }
            if (t + 1 < 16) sstore((t + 1) & 1);
            if ((t & 3) == 3) {
                const int n = t >> 2;
#pragma unroll
                for (int m = 0; m < 4; ++m) { const int row = pm * 256 + wr * 64 + m * 16 + fr;
                    const bf16_t* gp = G + g_off(row, n * 1024 + pn * 128 + wc * 64 + fq * 4);
                    const bf16x8 ga = __builtin_nontemporal_load((const bf16x8*)gp), gb = __builtin_nontemporal_load((const bf16x8*)(gp + 8));
#pragma unroll
                    for (int q = 0; q < 4; ++q) {
#pragma unroll
                        for (int j = 0; j < 4; ++j) { const bf16_t gv = (bf16_t)(q < 2 ? ga[q * 4 + j] : gb[(q - 2) * 4 + j]); mg[m][q][j] += bf2f(gv) * acc[m][q][j]; }
                        acc[m][q] = (f32x4){0.f, 0.f, 0.f, 0.f}; } }
            }
            __syncthreads();
        }
#pragma unroll
        for (int m = 0; m < 4; ++m) { const size_t row = (size_t)pm * 256 + wr * 64 + m * 16 + fr;
#pragma unroll
            for (int q = 0; q < 4; ++q) { const int col = pn * 128 + wc * 64 + q * 16 + fq * 4;
                u32x2 w; w[0] = cvt_pk_bf16(mg[m][q][0], mg[m][q][1]); w[1] = cvt_pk_bf16(mg[m][q][2], mg[m][q][3]);
                __hip_atomic_store((unsigned long long*)(MG + row * DM + col), ((unsigned long long)w[1] << 32) | w[0], __ATOMIC_RELAXED, __HIP_MEMORY_SCOPE_AGENT); } }
        asm volatile("s_waitcnt vmcnt(0)" ::: "memory");
        __syncthreads();
        if (tid == 0) __hip_atomic_fetch_add((unsigned*)(PWS + WS_XCNT) + (size_t)((2 + l) * 32 + pm) * 64, 1u, __ATOMIC_RELAXED, __HIP_MEMORY_SCOPE_AGENT);
    }
}

__device__ void phaseD(const Params& p, int l, unsigned char* lds) {
    const int tid = TID(), lane = tid & 63, wid = tid >> 6, wr = wid >> 1, wc = wid & 1, fr = lane & 15, fq = lane >> 4;
    const bf16_t* MG = (const bf16_t*)(PWS + WS_MERGED);
    const bf16_t* Wo = (const bf16_t*)(PWS + WS_WTO) + (size_t)l * 1024 * 1024;
    const int NU = 32 * 8;
    for (int u = blockIdx.x; u < NU; u += gridDim.x) {
        const int pn = u / 32, pm = u % 32;
        if (tid == 0) { unsigned* c2 = (unsigned*)(PWS + WS_XCNT) + (size_t)((2 + l) * 32 + pm) * 64; unsigned spins = 0;
            while (__hip_atomic_load(c2, __ATOMIC_RELAXED, __HIP_MEMORY_SCOPE_AGENT) < 8u) { __builtin_amdgcn_s_sleep(2); if (++spins > (1u << 22)) break; }
            __builtin_amdgcn_fence(__ATOMIC_ACQUIRE, "agent");
            asm volatile("s_waitcnt vmcnt(0)" ::: "memory"); }
        __syncthreads();
        f32x4 acc[4][4]; zero_acc<4>(acc);
        gemm_acc<4>(MG + (size_t)pm * 256 * 1024, 1024, Wo + (size_t)pn * 128 * 1024, 1024, 1024, acc, lds);
        float ssq[4];
#pragma unroll
        for (int m = 0; m < 4; ++m) { const int row = pm * 256 + wr * 64 + m * 16 + fr;
            const float* xr = xrow_ptr(p, l, row);
            const float* gate = (const float*)(PWS + WS_MOD) + (size_t)(l * 5 + modrow_of(row)) * 3072 + 2048;
            float sm = 0.f;
#pragma unroll
            for (int q = 0; q < 4; ++q) { const int col = pn * 128 + wc * 64 + q * 16 + fq * 4;
                const f32x4 xo = __builtin_nontemporal_load((const f32x4*)(xr + col)), gt = *(const f32x4*)(gate + col);
                acc[m][q] = xo + gt * acc[m][q];
                sm += (acc[m][q][0] * acc[m][q][0] + acc[m][q][1] * acc[m][q][1]) + (acc[m][q][2] * acc[m][q][2] + acc[m][q][3] * acc[m][q][3]); }
            sm += __shfl_xor(sm, 16); sm += __shfl_xor(sm, 32);
            ssq[m] = sm; }
        float* Pt = (float*)lds;
        float* St = Pt + 512;
        if (fq == 0) {
#pragma unroll
            for (int m = 0; m < 4; ++m) Pt[(wr * 64 + m * 16 + fr) * 2 + wc] = ssq[m]; }
        __syncthreads();
        float* XP = (float*)(PWS + WS_XP) + ((size_t)(l * 32 + pm) * 256) * 8;
        unsigned* cnt = (unsigned*)(PWS + WS_XCNT) + (size_t)(l * 32 + pm) * 64;
        if (tid < 256) __hip_atomic_store(XP + tid * 8 + pn, Pt[tid * 2] + Pt[tid * 2 + 1], __ATOMIC_RELAXED, __HIP_MEMORY_SCOPE_AGENT);
        asm volatile("s_waitcnt vmcnt(0)" ::: "memory");
        __syncthreads();
        if (tid == 0) {
            __hip_atomic_fetch_add(cnt, 1u, __ATOMIC_RELAXED, __HIP_MEMORY_SCOPE_AGENT);
            unsigned spins = 0;
            while (__hip_atomic_load(cnt, __ATOMIC_RELAXED, __HIP_MEMORY_SCOPE_AGENT) < 8u) { __builtin_amdgcn_s_sleep(2); if (++spins > (1u << 22)) break; }
            __builtin_amdgcn_fence(__ATOMIC_ACQUIRE, "agent");
            asm volatile("s_waitcnt vmcnt(0)" ::: "memory");
        }
        __syncthreads();
        if (tid < 256) { float t = 0.f;
#pragma unroll
            for (int k = 0; k < 8; ++k) t += __hip_atomic_load(XP + tid * 8 + k, __ATOMIC_RELAXED, __HIP_MEMORY_SCOPE_AGENT);
            St[tid] = rsqrtf(t * (1.0f / 1024.0f) + 1e-6f); }
        __syncthreads();
        const float* gn = (l == 0) ? PIN(9) + DM : PIN(27);
        bf16_t* H = (bf16_t*)(PWS + WS_H);
#pragma unroll
        for (int m = 0; m < 4; ++m) { const int rl_ = wr * 64 + m * 16 + fr, row = pm * 256 + rl_;
            const float rs = St[rl_];
            const float* md = (const float*)(PWS + WS_MOD) + (size_t)(5 + modrow_of(row)) * 3072;
#pragma unroll
            for (int q = 0; q < 4; ++q) { const int col = pn * 128 + wc * 64 + q * 16 + fq * 4;
                const f32x4 gg = *(const f32x4*)(gn + col);
                if (l == 0) { *(f32x4*)(POUT + (size_t)row * DM + col) = acc[m][q];
                    const f32x4 sh = *(const f32x4*)(md + col), scl = *(const f32x4*)(md + 1024 + col);
                    const f32x4 h = acc[m][q] * rs * gg * (1.0f + scl) + sh;
                    u32x2 w; w[0] = cvt_pk_bf16(h[0], h[1]); w[1] = cvt_pk_bf16(h[2], h[3]); *(u32x2*)(H + (size_t)row * DM + col) = w; }
                else *(f32x4*)(POUT + (size_t)row * DM + col) = acc[m][q] * rs * gg; } }
    }
}

__device__ void phaseF(const Params& p) {
    const int lane = TID() & 63, gw = blockIdx.x * 8 + (TID() >> 6), W = gridDim.x * 8;
    const float* g = PIN(27);
    for (int row = gw; row < NT; row += W) {
        float* x = POUT + (size_t)row * DM;
        f32x4 v[4]; float ss = 0.f;
#pragma unroll
        for (int i = 0; i < 4; ++i) { v[i] = *(const f32x4*)(x + i * 256 + lane * 4); ss += v[i][0] * v[i][0] + v[i][1] * v[i][1] + v[i][2] * v[i][2] + v[i][3] * v[i][3]; }
        ss = wave_sum(ss);
        const float rs = rsqrtf(ss * (1.0f / 1024.0f) + 1e-6f);
#pragma unroll
        for (int i = 0; i < 4; ++i) { const int c = i * 256 + lane * 4; *(f32x4*)(x + c) = v[i] * rs * *(const f32x4*)(g + c); }
    }
}

__global__ void __launch_bounds__(NTHREADS) fwd_megakernel(Params p) {
    extern __shared__ __attribute__((aligned(16))) unsigned char lds[];
    volatile LAS unsigned* st = (volatile LAS unsigned*)(lds + LDS_MAIN);
    if (threadIdx.x < 2) st[threadIdx.x] = 0u;
    if (threadIdx.x == 0) {
#pragma unroll
        for (int i = 0; i < 28; ++i) s_ptab[i] = (unsigned long long)p.in[i];
    }
    __syncthreads();
    const XcdBarrier xb = xcd_barrier_post((unsigned*)(PWS + WS_BAR), st);
#define GSYNC() xcd_barrier(xb)
    phase0(p, lds);
    GSYNC();
#pragma unroll 1
    for (int l = 0; l < 2; ++l) {
#pragma unroll 1
        for (int ap = 0; ap < 2; ++ap) { phaseA(p, l, lds, ap); if (ap == 0) GSYNC(); }
        phaseB0(p, l, lds);
        GSYNC();
        phaseB1(p, l, lds);
        GSYNC();
        phaseB2(p, l);
        phaseC1(p, l, lds);
        GSYNC();
        phaseC2(p, l, lds);
        phaseD(p, l, lds);
        if (l == 0) GSYNC();
    }
}

extern "C" void kernel_launch(void* const* d_in, const int* in_sizes, int n_in, void* d_out, int out_size, void* d_ws, size_t ws_size, hipStream_t stream) {
    static int grid_blocks = 0;
    if (!grid_blocks) {
        int dev = 0, cus = 0, per_cu = 0;
        hipGetDevice(&dev);
        hipDeviceGetAttribute(&cus, hipDeviceAttributeMultiprocessorCount, dev);
        hipFuncSetAttribute((const void*)fwd_megakernel, hipFuncAttributeMaxDynamicSharedMemorySize, LDS_BYTES);
        hipOccupancyMaxActiveBlocksPerMultiprocessor(&per_cu, (const void*)fwd_megakernel, NTHREADS, LDS_BYTES);
        if (per_cu < 1) { fprintf(stderr, "occupancy query returned %d\n", per_cu); per_cu = 1; }
        if (per_cu > 1) per_cu = 1;
        grid_blocks = cus * per_cu;
        if (ws_size < WS_END) fprintf(stderr, "workspace too small: %zu < %zu\n", ws_size, (size_t)WS_END);
    }
    Params p{};
    for (int i = 0; i < 28; ++i) p.in[i] = (const float*)d_in[i];
    p.out = (float*)d_out; p.ws = (unsigned char*)d_ws;
    hipMemsetAsync((char*)d_ws + WS_CTR, 0, 256 + 3456 * 4, stream);
    void* args[] = {&p};
    hipError_t e = hipLaunchCooperativeKernel((const void*)fwd_megakernel, dim3(grid_blocks), dim3(NTHREADS), args, LDS_BYTES, stream);
    if (e != hipSuccess) fprintf(stderr, "cooperative launch failed: %s (grid %d)\n", hipGetErrorString(e), grid_blocks);
}
```
